# Optimizing an MI355X kernel written in HIP

```python
import jax, jax.numpy as jnp
from jax import lax
import numpy as np

D_MODEL = 1024
BATCH = 16
SEQ = 2048
DEPTH = 1

CHUNK = 64
Q_BLOCK = 128
D_MIX = D_MODEL
SB_WIDTH = D_MIX // 2
SB_HEAD_DIM = 64
SB_HEADS = SB_WIDTH // SB_HEAD_DIM
GLA_WIDTH = D_MIX - SB_WIDTH
GLA_HEADS = 4
GLA_VAL_DIM = GLA_WIDTH // GLA_HEADS
GLA_KEY_DIM = GLA_VAL_DIM // 2
GLA_QK_WIDTH = GLA_HEADS * GLA_KEY_DIM
GLA_GATE_RANK = 16
GLA_GATE_TAU = 16.0
IN_SIZES = (SB_WIDTH, SB_WIDTH, SB_WIDTH, GLA_QK_WIDTH, GLA_QK_WIDTH, GLA_WIDTH, GLA_WIDTH, GLA_GATE_RANK)
IN_DIM = sum(IN_SIZES)
N_GROUPS = 4
EXPERTS_PER_GROUP = 8
N_EXPERTS = N_GROUPS * EXPERTS_PER_GROUP
TOP_K = 2
D_EXPERT = D_MODEL // 2
EXPERT_BLOCK = 128
EPS = 1e-6

kernel_name = 'hymba_sb_gla_hiermoe_block'


def rms_norm(x, g):
    xf = x.astype(jnp.float32)
    y = xf * lax.rsqrt(jnp.mean(xf * xf, axis=-1, keepdims=True) + EPS)
    return (y * g.astype(jnp.float32)).astype(x.dtype)


def split_cols(a, sizes):
    out, off = [], 0
    for s in sizes:
        out.append(a[..., off:off + s])
        off += s
    return out


def stick_breaking_attention(q, k, v):
    B, T, H, Dh = q.shape
    scale = Dh ** -0.5
    outs = []
    for i in range(T // Q_BLOCK):
        q0 = i * Q_BLOCK
        kend = q0 + Q_BLOCK
        qb = q[:, q0:kend]
        kb = k[:, :kend]
        vb = v[:, :kend]
        z = jnp.einsum('bqhd,bshd->bhqs', qb, kb).astype(jnp.float32) * scale
        t_idx = q0 + jnp.arange(Q_BLOCK)[:, None]
        s_idx = jnp.arange(kend)[None, :]
        strict = s_idx < t_idx
        log_beta = jax.nn.log_sigmoid(z)
        log_1mb = jnp.where(strict, jax.nn.log_sigmoid(-z), 0.0)
        tail = lax.cumsum(log_1mb, axis=3, reverse=True) - log_1mb
        a = jnp.where(strict, jnp.exp(log_beta + tail), 0.0)
        outs.append(jnp.einsum('bhqs,bshd->bqhd', a.astype(vb.dtype), vb))
    return jnp.concatenate(outs, axis=1)


def gla_chunked(q, k, v, log_g):
    B, T, H, Dk = q.shape
    Dv = v.shape[-1]
    nc = T // CHUNK

    def to_chunks(a):
        return jnp.moveaxis(a.reshape(B, nc, CHUNK, H, a.shape[-1]), 1, 0)

    def step(S, inp):
        qi, ki, vi, gi = inp
        lcum = jnp.cumsum(gi.astype(jnp.float32), axis=1)
        total = lcum[:, -1]
        k_dec = ki.astype(jnp.float32) * jnp.exp(total[:, None] - lcum)
        S = jnp.exp(total)[..., None] * S + jnp.einsum('bchk,bchv->bhkv', k_dec, vi.astype(jnp.float32))
        o = jnp.einsum('bchk,bhkv->bchv', qi.astype(jnp.float32), S)
        return S, o

    S0 = jnp.zeros((B, H, Dk, Dv), jnp.float32)
    _, o = lax.scan(step, S0, (to_chunks(q), to_chunks(k), to_chunks(v), to_chunks(log_g)))
    return jnp.moveaxis(o, 0, 1).reshape(B, T, H, Dv).astype(v.dtype)


def hierarchical_moe(h, w_grp, b_grp, w_exp, b_exp, w_gate, w_up, w_down):
    B, T, D = h.shape
    N = B * T
    hf = h.reshape(N, D)
    grp_logits = (hf @ w_grp + b_grp).astype(jnp.float32)
    grp_prob = jax.nn.softmax(grp_logits, axis=-1)
    g_sel = jnp.argmax(grp_logits, axis=-1).astype(jnp.int32)
    p_grp = jnp.take_along_axis(grp_prob, g_sel[:, None], axis=-1)
    exp_logits = (hf @ w_exp + b_exp).astype(jnp.float32).reshape(N, N_GROUPS, EXPERTS_PER_GROUP)
    exp_logits = jnp.take_along_axis(exp_logits, g_sel[:, None, None], axis=1)[:, 0]
    p_exp = jax.nn.softmax(exp_logits, axis=-1)
    top_p, top_local = lax.top_k(p_exp, TOP_K)
    top_p = top_p / jnp.sum(top_p, axis=-1, keepdims=True)
    gates = p_grp * top_p
    expert_id = g_sel[:, None] * EXPERTS_PER_GROUP + top_local.astype(jnp.int32)

    nk = N * TOP_K
    e_flat = expert_id.reshape(nk)
    tok_flat = jnp.repeat(jnp.arange(N, dtype=jnp.int32), TOP_K)
    gate_flat = gates.reshape(nk)
    order = jnp.argsort(e_flat)
    e_sorted = e_flat[order]
    counts = jnp.zeros((N_EXPERTS,), jnp.int32).at[e_flat].add(1)
    padded = (counts + EXPERT_BLOCK - 1) // EXPERT_BLOCK * EXPERT_BLOCK
    start = jnp.cumsum(counts) - counts
    pend = jnp.cumsum(padded)
    pstart = pend - padded
    rank = jnp.arange(nk, dtype=jnp.int32) - start[e_sorted]
    dest = pstart[e_sorted] + rank
    n_blocks = -(-nk // EXPERT_BLOCK) + N_EXPERTS
    R = n_blocks * EXPERT_BLOCK
    row_tok = jnp.full((R,), N, jnp.int32).at[dest].set(tok_flat[order])
    row_gate = jnp.zeros((R,), hf.dtype).at[dest].set(gate_flat[order].astype(hf.dtype))
    hf_pad = jnp.concatenate([hf, jnp.zeros((1, D), hf.dtype)], axis=0)
    rows = hf_pad[row_tok].reshape(n_blocks, EXPERT_BLOCK, D)
    block_start = jnp.arange(n_blocks, dtype=jnp.int32) * EXPERT_BLOCK
    block_expert = jnp.minimum(jnp.sum(block_start[:, None] >= pend[None, :], axis=1), N_EXPERTS - 1).astype(jnp.int32)

    def expert_block(args):
        xb, e = args
        return (jax.nn.silu(xb @ w_gate[e]) * (xb @ w_up[e])) @ w_down[e]

    y_rows = lax.map(expert_block, (rows, block_expert)).reshape(R, D)
    y = jnp.zeros((N + 1, D), hf.dtype).at[row_tok].add(y_rows * row_gate[:, None])
    return y[:N].reshape(B, T, D)


def setup_inputs(seed: int = 0) -> dict:
    key = jax.random.key(seed)
    ks = jax.random.split(key, 18)
    f = jnp.float32

    def nrm(k, shape, scale):
        return jax.random.normal(k, shape, f) * scale

    def gain(k, shape):
        return 1.0 + 0.02 * jax.random.normal(k, shape, f)

    L = DEPTH
    return {
        'x': jax.random.normal(ks[0], (BATCH, SEQ, D_MODEL), f),
        'attn_norm_g': gain(ks[1], (L, D_MODEL)),
        'w_in': nrm(ks[2], (L, D_MODEL, IN_DIM), D_MODEL ** -0.5),
        'sb_q_norm_g': gain(ks[3], (L, SB_HEAD_DIM)),
        'sb_k_norm_g': gain(ks[4], (L, SB_HEAD_DIM)),
        'sb_out_norm_g': gain(ks[5], (L, SB_HEADS, SB_HEAD_DIM)),
        'gla_gate_w2': nrm(ks[6], (L, GLA_GATE_RANK, GLA_QK_WIDTH), GLA_GATE_RANK ** -0.5),
        'gla_gate_b': nrm(ks[7], (L, GLA_QK_WIDTH), 0.1),
        'gla_out_norm_g': gain(ks[8], (L, GLA_VAL_DIM)),
        'w_out': nrm(ks[9], (L, D_MIX, D_MODEL), D_MIX ** -0.5),
        'ffn_norm_g': gain(ks[10], (L, D_MODEL)),
        'router_group_w': nrm(ks[11], (L, D_MODEL, N_GROUPS), D_MODEL ** -0.5),
        'router_group_b': nrm(ks[12], (L, N_GROUPS), 0.01),
        'router_expert_w': nrm(ks[13], (L, D_MODEL, N_EXPERTS), D_MODEL ** -0.5),
        'router_expert_b': nrm(ks[14], (L, N_EXPERTS), 0.01),
        'expert_w_gate': nrm(ks[15], (L, N_EXPERTS, D_MODEL, D_EXPERT), D_MODEL ** -0.5),
        'expert_w_up': nrm(ks[16], (L, N_EXPERTS, D_MODEL, D_EXPERT), D_MODEL ** -0.5),
        'expert_w_down': nrm(ks[17], (L, N_EXPERTS, D_EXPERT, D_MODEL), D_EXPERT ** -0.5),
    }


def reference(x, attn_norm_g, w_in, sb_q_norm_g, sb_k_norm_g, sb_out_norm_g, gla_gate_w2, gla_gate_b,
              gla_out_norm_g, w_out, ffn_norm_g, router_group_w, router_group_b, router_expert_w,
              router_expert_b, expert_w_gate, expert_w_up, expert_w_down):
    B, T, _ = x.shape
    h = x
    for l in range(DEPTH):
        u = rms_norm(h, attn_norm_g[l])
        proj = u @ w_in[l]
        sq, sk, sv, gq, gk, gv, gr, glr = split_cols(proj, IN_SIZES)

        sq = rms_norm(sq.reshape(B, T, SB_HEADS, SB_HEAD_DIM), sb_q_norm_g[l])
        sk = rms_norm(sk.reshape(B, T, SB_HEADS, SB_HEAD_DIM), sb_k_norm_g[l])
        sv = sv.reshape(B, T, SB_HEADS, SB_HEAD_DIM)
        sb = stick_breaking_attention(sq, sk, sv)
        sb = rms_norm(sb, sb_out_norm_g[l]).reshape(B, T, SB_WIDTH)

        gq = gq.reshape(B, T, GLA_HEADS, GLA_KEY_DIM) * (GLA_KEY_DIM ** -0.5)
        gk = gk.reshape(B, T, GLA_HEADS, GLA_KEY_DIM)
        gv = gv.reshape(B, T, GLA_HEADS, GLA_VAL_DIM)
        log_g = jax.nn.log_sigmoid((glr @ gla_gate_w2[l] + gla_gate_b[l]).astype(jnp.float32)) / GLA_GATE_TAU
        log_g = log_g.reshape(B, T, GLA_HEADS, GLA_KEY_DIM)
        go = gla_chunked(gq, gk, gv, log_g)
        go = rms_norm(go, gla_out_norm_g[l]) * jax.nn.silu(gr.reshape(B, T, GLA_HEADS, GLA_VAL_DIM))
        go = go.reshape(B, T, GLA_WIDTH)

        h = h + jnp.concatenate([sb, go], axis=-1) @ w_out[l]

        v = rms_norm(h, ffn_norm_g[l])
        h = h + hierarchical_moe(v, router_group_w[l], router_group_b[l], router_expert_w[l],
                                 router_expert_b[l], expert_w_gate[l], expert_w_up[l], expert_w_down[l])
    return h
```

```cpp
#include <hip/hip_runtime.h>
#include <cstdio>
#include <cstdint>

#ifndef MK_N_LAUNCHES
#define MK_N_LAUNCHES 1
#endif

#define LAS __attribute__((address_space(3)))
#define GAS __attribute__((address_space(1)))
typedef unsigned short bf16;
typedef short bf16x8 __attribute__((ext_vector_type(8)));
typedef float f32x4 __attribute__((ext_vector_type(4)));
typedef float f32x16 __attribute__((ext_vector_type(16)));
typedef unsigned u32x4 __attribute__((ext_vector_type(4)));
typedef unsigned u32x2 __attribute__((ext_vector_type(2)));
typedef float f32x2_t __attribute__((ext_vector_type(2)));
typedef __bf16 bf16x2_t __attribute__((ext_vector_type(2)));
typedef GAS unsigned gu32;
typedef int v8i __attribute__((ext_vector_type(8)));
typedef int v4i __attribute__((ext_vector_type(4)));
typedef _Float16 f16x8 __attribute__((ext_vector_type(8)));
typedef _Float16 f16x2 __attribute__((ext_vector_type(2)));

constexpr int BATCH = 16, SEQ = 2048, DM = 1024, NTOK = BATCH * SEQ;
constexpr int IN_DIM = 3088;
constexpr int NEXP = 32, DEXP = 512;
constexpr float EPS = 1e-6f;
constexpr float LOG2E = 1.4426950408889634f;
constexpr float WGU_SC = 64.f, WD_SC = 32.f, ACT_SC = 8.f, Y_SC = 8.f;
constexpr int NA = 1792, NB = 1280;
constexpr int NGRP = NTOK / 128;

constexpr size_t MiB = 1u << 20;
constexpr size_t WS_CTL = 0, CTL_ZERO_BYTES = 64 * 1024;
constexpr size_t WS_WA = 2 * MiB;
constexpr size_t WS_WB = 6 * MiB;
constexpr size_t WS_WO = 9 * MiB;
constexpr size_t WS_WR = 11 * MiB;
constexpr size_t WS_W2T = WS_WR + 2 * 48 * 1024 * 2;
constexpr size_t WS_WGU = 12 * MiB;
constexpr size_t WS_WD = 76 * MiB;
constexpr size_t WS_H = 108 * MiB;
constexpr size_t WS_KV = WS_H;
constexpr size_t WS_U = 172 * MiB;
constexpr size_t WS_MIX = WS_U;
constexpr size_t WS_SQ = 236 * MiB;
constexpr size_t WS_SK = 268 * MiB;
constexpr size_t WS_GQ = 300 * MiB;
constexpr size_t WS_GRS = 316 * MiB;
constexpr size_t WS_TT = 348 * MiB;
constexpr size_t WS_GLR = 428 * MiB;
constexpr size_t WS_ST = 429 * MiB;
constexpr size_t WS_DTOT = 461 * MiB;
constexpr size_t WS_ACT = 236 * MiB;
constexpr size_t WS_H8 = 272 * MiB;
constexpr size_t WS_Y = 308 * MiB;
constexpr size_t WS_LOCL = 462 * MiB;
constexpr size_t WS_CNTS = 467 * MiB;
constexpr size_t WS_GATE = 470 * MiB;
constexpr size_t WS_RSTD = WS_GATE + 512 * 1024;
constexpr size_t WS_END = 472 * MiB;
constexpr int CW_TMO = 0, CW_CODE = 1;
constexpr int CW_BAR = 4096;
constexpr int CW_CNT = 16384;

constexpr int RING_OFF = 0, RING_BYTES = 131072;
constexpr int LDSCTL_OFF = RING_BYTES, MISC_OFF = LDSCTL_OFF + 320;
constexpr int TAB_OFF = LDSCTL_OFF + 1024;
constexpr int LDS_BYTES = 147456;
constexpr int T_CNT = 0, T_TBASE = 128, T_NT = 264, T_TILE_E = 272, T_ROWTAB = 272 + 320 * 4, NU_MAX = 8;
static_assert(TAB_OFF + T_ROWTAB + NU_MAX * 256 * 4 <= LDS_BYTES, "LDS tables");

#define RLX_AGENT __ATOMIC_RELAXED, __HIP_MEMORY_SCOPE_AGENT
#define LDS_WAIT() asm volatile("s_waitcnt lgkmcnt(0)" ::: "memory")
#define VM_WAIT() asm volatile("s_waitcnt vmcnt(0)" ::: "memory")

__device__ __forceinline__ unsigned cvtpk(float lo, float hi) { f32x2_t v = {lo, hi}; bf16x2_t b = __builtin_convertvector(v, bf16x2_t); return __builtin_bit_cast(unsigned, b); }
__device__ __forceinline__ u32x2 pack8_fp8(const float* a) { int lo = __builtin_amdgcn_cvt_pk_fp8_f32(a[0], a[1], 0, false); lo = __builtin_amdgcn_cvt_pk_fp8_f32(a[2], a[3], lo, true);
    int hi = __builtin_amdgcn_cvt_pk_fp8_f32(a[4], a[5], 0, false); hi = __builtin_amdgcn_cvt_pk_fp8_f32(a[6], a[7], hi, true); u32x2 r; r.x = (unsigned)lo; r.y = (unsigned)hi; return r; }
__device__ __forceinline__ float bf2f(short s) { return __uint_as_float(((unsigned)(unsigned short)s) << 16); }
__device__ __forceinline__ bf16x8 pack8(const float* a) { u32x4 p; p.x = cvtpk(a[0], a[1]); p.y = cvtpk(a[2], a[3]); p.z = cvtpk(a[4], a[5]); p.w = cvtpk(a[6], a[7]); return __builtin_bit_cast(bf16x8, p); }
__device__ __forceinline__ int PI32(int i) { return 16 * ((i >> 2) & 1) + (i & 3) + 4 * (i >> 3); }
#define MFMA32(a, b, c) __builtin_amdgcn_mfma_f32_32x32x16_bf16((a), (b), (c), 0, 0, 0)
#define MFMA16(a, b, c) __builtin_amdgcn_mfma_f32_16x16x32_bf16((a), (b), (c), 0, 0, 0)
__device__ __forceinline__ void swap32(float x, float& lo, float& hi) { auto rr = __builtin_amdgcn_permlane32_swap(__float_as_uint(x), __float_as_uint(x), false, false); lo = __uint_as_float(rr[0]); hi = __uint_as_float(rr[1]); }

namespace pg8 {
#define PG8_LAS __attribute__((address_space(3)))
constexpr int BM = 256, BK = 64, HALF = 128, HTB = HALF * BK * 2, STAGE_BYTES = 8 * HTB, NXCD = 8, WGM = 8;
__host__ __device__ __forceinline__ int lds_byte(int r, int c) { const int st = (r >> 4) * 2 + (c >> 5), rr = r & 15, cc = c & 31, ob = rr * 64 + cc * 2; return st * 1024 + (ob ^ (((ob >> 9) & 1) << 5)); }
__host__ __device__ __forceinline__ void stage_rc(int b, int& R, int& C) { const int st = b / 1024, sb = b % 1024, swz = sb ^ (((sb >> 9) & 1) << 5); R = (st >> 1) * 16 + swz / 64; C = (st & 1) * 32 + (swz % 64) / 2; }
__host__ __device__ __forceinline__ int perm32(int rho) { const int n = rho >> 4, i = rho & 15; return 8 * (i >> 2) + 4 * n + (i & 3); }

struct Unit { int pm, pn, e, rt, nv; };

struct SchedDense {
    const char* A; const char* Bt; int K; int nM, nN, nwg, G, c;
    __device__ void init(const void* A_, const void* Bt_, int M, int N, int K_, int G_, int c_) { A = (const char*)A_; Bt = (const char*)Bt_; K = K_; nM = M / BM; nN = N / BM; nwg = nM * nN; G = G_; c = c_; }
    __device__ __forceinline__ bool next(int i, Unit& u) const {
        const long L = (long)i * G + c; if (L >= nwg) return false;
        int wgid = (int)L; { const int q = nwg / NXCD, r = nwg % NXCD, xcd = wgid % NXCD, off = wgid / NXCD; wgid = (xcd < r ? xcd * (q + 1) : r * (q + 1) + (xcd - r) * q) + off; }
        const int nig = WGM * nN, gid = wgid / nig, fm = gid * WGM, gsz = (nM - fm) < WGM ? (nM - fm) : WGM;
        u.pm = fm + ((wgid % nig) % gsz); u.pn = (wgid % nig) / gsz; u.e = 0; u.rt = 0; u.nv = 256; return true;
    }
    __device__ __forceinline__ const char* a_ptr(const Unit& u) const { return A + (size_t)u.pm * BM * K * 2; }
    __device__ __forceinline__ const char* b_ptr(const Unit& u) const { return Bt + (size_t)u.pn * BM * K * 2; }
    __device__ __forceinline__ void a_voff(int, const Unit&, int tid, unsigned (&v)[2][2]) const {
#pragma unroll
        for (int i = 0; i < 2; ++i) { int R, C; stage_rc(tid * 16 + i * 8192, R, C);
#pragma unroll
            for (int h = 0; h < 2; ++h) v[h][i] = (unsigned)((h * HALF + R) * K + C) * 2u; }
    }
};
template <bool GATHER> struct SchedMoE {
    const char* A; const char* Bt; int K; size_t bstride; int G, c;
    const PG8_LAS int* tab;
    __device__ __forceinline__ bool next(int i, Unit& u) const {
        const int L = i * G + c; const int NT = tab[T_NT / 4];
        if (L >= NT * 4) return false;
        const int tile = L >> 2; u.pm = tile; u.pn = L & 3; const int e = tab[T_TILE_E / 4 + tile]; u.e = e;
        u.rt = tile - tab[T_TBASE / 4 + e]; const int rem = tab[T_CNT / 4 + e] - u.rt * 256; u.nv = rem < 256 ? rem : 256; return true;
    }
    __device__ __forceinline__ const char* a_ptr(const Unit& u) const { return GATHER ? A : A + (size_t)u.pm * BM * K * 2; }
    __device__ __forceinline__ const char* b_ptr(const Unit& u) const { return Bt + (size_t)u.e * bstride + (size_t)u.pn * BM * K * 2; }
    __device__ __forceinline__ void a_voff(int ui, const Unit&, int tid, unsigned (&v)[2][2]) const {
        asm volatile("" : "+v"(tid));
#pragma unroll
        for (int i = 0; i < 2; ++i) { int R, C; stage_rc(tid * 16 + i * 8192, R, C);
#pragma unroll
            for (int h = 0; h < 2; ++h) {
                if (GATHER) { const int tok = tab[T_ROWTAB / 4 + ui * 256 + h * HALF + R] >> 1; v[h][i] = (unsigned)(tok * K + C) * 2u; }
                else v[h][i] = (unsigned)((h * HALF + R) * K + C) * 2u; } }
    }
};

template <class Epi, class Sched, bool TAIL = false, bool FP8 = false>
__device__ __forceinline__ void gemm_phase(PG8_LAS unsigned char* lds, const int K, const Sched& S, const Epi& E) {
    const int tid = threadIdx.x, wid = __builtin_amdgcn_readfirstlane(tid >> 6), lane = tid & 63, wr = wid >> 2, wc = wid & 3, fr = lane & 15, fq = lane >> 4;
    const int nt = K / BK;
    unsigned voffB[1][2];
#pragma unroll
    for (int i = 0; i < 2; ++i) { int R, C; stage_rc(tid * 16 + i * 8192, R, C); const int Rb = (R & ~31) + perm32(R & 31);
        voffB[0][i] = (unsigned)(Rb * K + C) * 2u; }
    const size_t hstepB = (size_t)HALF * K * 2;
    const size_t kstep = (size_t)(BK * 2);
    const unsigned ldsw = (unsigned)wid * 1024u;
    const int aoff = lds_byte(wr * 64 + fr, fq * 8), boff = lds_byte(wc * 32 + fr, fq * 8);
#define PG8_SA(b, h) (((b) * 2 + (h)) * HTB)
#define PG8_SB(b, h) ((4 + (b) * 2 + (h)) * HTB)
#define PG8_STAGE(bufoff, gbase, voff) do { _Pragma("unroll") for (int _i = 0; _i < 2; ++_i) \
        __builtin_amdgcn_global_load_lds((const unsigned*)((const char*)(gbase) + (voff)[_i]), (PG8_LAS unsigned*)(lds + (bufoff) + ldsw + _i * 8192), 16, 0, 0); } while (0)
#define PG8_RD16(off) (*(const PG8_LAS v4i*)(lds + (off)))
#define PG8_LDA(dst, b, h) do { _Pragma("unroll") for (int m = 0; m < 4; ++m) { \
        if constexpr (FP8) At8[m] = __builtin_shufflevector(PG8_RD16(PG8_SA(b, h) + aoff + m * 2048), PG8_RD16(PG8_SA(b, h) + aoff + m * 2048 + 1024), 0, 1, 2, 3, 4, 5, 6, 7); \
        else { _Pragma("unroll") for (int k = 0; k < 2; ++k) dst[m][k] = *(const PG8_LAS bf16x8*)(lds + PG8_SA(b, h) + aoff + m * 2048 + k * 1024); } } } while (0)
#define PG8_LDB(dst, b, h) do { _Pragma("unroll") for (int n = 0; n < 2; ++n) { \
        if constexpr (FP8) dst##8[n] = __builtin_shufflevector(PG8_RD16(PG8_SB(b, h) + boff + n * 2048), PG8_RD16(PG8_SB(b, h) + boff + n * 2048 + 1024), 0, 1, 2, 3, 4, 5, 6, 7); \
        else { _Pragma("unroll") for (int k = 0; k < 2; ++k) dst[n][k] = *(const PG8_LAS bf16x8*)(lds + PG8_SB(b, h) + boff + n * 2048 + k * 1024); } } } while (0)
#define PG8_MMA(ai, bj, At, Bt) do { __builtin_amdgcn_s_setprio(1); _Pragma("unroll") for (int m = 0; m < 4; ++m) _Pragma("unroll") for (int n = 0; n < 2; ++n) { \
        if constexpr (FP8) asm volatile("v_mfma_scale_f32_16x16x128_f8f6f4 %0, %1, %2, %0, %3, %3 op_sel_hi:[0,0,0]" : "+v"(acc[ai][bj][m][n]) : "v"(Bt##8[n]), "v"(At8[m]), "v"(sc1)); \
        else { _Pragma("unroll") for (int k = 0; k < 2; ++k) acc[ai][bj][m][n] = __builtin_amdgcn_mfma_f32_16x16x32_bf16(Bt[n][k], At[m][k], acc[ai][bj][m][n], 0, 0, 0); } } \
        __builtin_amdgcn_s_setprio(0); } while (0)
#define PG8_WAIT_V(n) asm volatile("s_waitcnt vmcnt(" #n ")" ::: "memory")
#define PG8_WAIT_L(n) asm volatile("s_waitcnt lgkmcnt(" #n ")" ::: "memory")
#define PG8_BAR __builtin_amdgcn_s_barrier()
#define PG8_SCHED __builtin_amdgcn_sched_barrier(0)
    Unit cur, nxt; int ui = 0;
    if (!S.next(0, cur)) return;
    f32x4 acc[2][2][4][2];
#pragma unroll
    for (int a = 0; a < 2; ++a)
#pragma unroll
        for (int b = 0; b < 2; ++b)
#pragma unroll
            for (int m = 0; m < 4; ++m)
#pragma unroll
                for (int n = 0; n < 2; ++n) acc[a][b][m][n] = (f32x4){0.f, 0.f, 0.f, 0.f};
    bf16x8 At[4][2], B0[2][2], B1[2][2];
    v8i At8[4], B08[2], B18[2];
    int sc1 = 0x7f7f7f7f; asm volatile("" : "+v"(sc1));
    unsigned vc[2][2], vn[2][2];
    S.a_voff(0, cur, tid, vc);
    const char* cA = S.a_ptr(cur); const char* cB = S.b_ptr(cur);
    PG8_STAGE(PG8_SB(0, 0), cB, voffB[0]); PG8_STAGE(PG8_SB(0, 1), (cB) + hstepB, voffB[0]); PG8_STAGE(PG8_SA(0, 0), cA, vc[0]); PG8_STAGE(PG8_SA(0, 1), cA, vc[1]);
    if (wr == 1) PG8_BAR;
    PG8_WAIT_V(2); PG8_BAR;
    PG8_STAGE(PG8_SB(1, 0), cB + kstep, voffB[0]); PG8_STAGE(PG8_SA(1, 0), cA + kstep, vc[0]); PG8_STAGE(PG8_SB(1, 1), (cB + kstep) + hstepB, voffB[0]);
    PG8_WAIT_V(6); PG8_BAR;
    for (;;) {
        const bool has_next = S.next(ui + 1, nxt);
        const char* nA = has_next ? S.a_ptr(nxt) : cA; const char* nB = has_next ? S.b_ptr(nxt) : cB;
        if (has_next) S.a_voff(ui + 1, nxt, tid, vn);
        else {
#pragma unroll
            for (int h = 0; h < 2; ++h)
#pragma unroll
                for (int i = 0; i < 2; ++i) vn[h][i] = vc[h][i]; }
        const bool full_hi = !TAIL || cur.nv > HALF;
        for (int t = 0; t < nt; t += 2) {
            const bool last = (t == nt - 2);
            const char* a1 = cA + (size_t)(t + 1) * kstep;
            const char* a2 = last ? nA : cA + (size_t)(t + 2) * kstep; const char* b2 = last ? nB : cB + (size_t)(t + 2) * kstep;
            const char* a3 = a2 + kstep; const char* b3 = b2 + kstep;
            unsigned w0[2], w1[2];
            w0[0] = last ? vn[0][0] : vc[0][0]; w0[1] = last ? vn[0][1] : vc[0][1]; w1[0] = last ? vn[1][0] : vc[1][0]; w1[1] = last ? vn[1][1] : vc[1][1];
            PG8_LDB(B0, 0, 0); PG8_LDB(B1, 0, 1); PG8_SCHED; PG8_LDA(At, 0, 0); PG8_STAGE(PG8_SA(1, 1), a1, vc[1]);
            PG8_WAIT_V(8); PG8_WAIT_L(0); PG8_BAR; PG8_MMA(0, 0, At, B0); PG8_MMA(0, 1, At, B1); PG8_BAR; PG8_SCHED;
            PG8_LDA(At, 0, 1); PG8_STAGE(PG8_SB(0, 0), b2, voffB[0]); PG8_STAGE(PG8_SB(0, 1), (b2) + hstepB, voffB[0]); PG8_STAGE(PG8_SA(0, 0), a2, w0);
            PG8_WAIT_V(8); PG8_WAIT_L(0); PG8_BAR; if (full_hi) { PG8_MMA(1, 0, At, B0); PG8_MMA(1, 1, At, B1); } PG8_BAR; PG8_SCHED;
            PG8_LDB(B0, 1, 0); PG8_LDB(B1, 1, 1); PG8_SCHED; PG8_LDA(At, 1, 0); PG8_STAGE(PG8_SA(0, 1), a2, w1);
            PG8_WAIT_V(8); PG8_WAIT_L(0); PG8_BAR; PG8_MMA(0, 0, At, B0); PG8_MMA(0, 1, At, B1); PG8_BAR; PG8_SCHED;
            PG8_LDA(At, 1, 1); PG8_STAGE(PG8_SB(1, 0), b3, voffB[0]); PG8_STAGE(PG8_SB(1, 1), (b3) + hstepB, voffB[0]); PG8_STAGE(PG8_SA(1, 0), a3, w0);
            PG8_WAIT_V(8); PG8_WAIT_L(0); PG8_BAR; if (full_hi) { PG8_MMA(1, 0, At, B0); PG8_MMA(1, 1, At, B1); } PG8_BAR; PG8_SCHED;
        }
        if (wr == 0) PG8_BAR;
        if constexpr (FP8) asm volatile("s_nop 15\n\ts_nop 15" ::: "memory");
        { int t2_ = threadIdx.x; asm volatile("" : "+v"(t2_)); E(acc, cur, ui, wr, wc, t2_ & 15, (t2_ >> 4) & 3); }
        if (!has_next) break;
#pragma unroll
        for (int a = 0; a < 2; ++a)
#pragma unroll
            for (int b = 0; b < 2; ++b)
#pragma unroll
                for (int m = 0; m < 4; ++m)
#pragma unroll
                    for (int n = 0; n < 2; ++n) acc[a][b][m][n] = (f32x4){0.f, 0.f, 0.f, 0.f};
        cur = nxt; cA = nA; cB = nB; ++ui;
#pragma unroll
        for (int h = 0; h < 2; ++h)
#pragma unroll
            for (int i = 0; i < 2; ++i) vc[h][i] = vn[h][i];
        if (wr == 1) PG8_BAR;
    }
    PG8_WAIT_V(0);
    PG8_BAR;
#undef PG8_SA
#undef PG8_SB
#undef PG8_STAGE
#undef PG8_LDA
#undef PG8_LDB
#undef PG8_MMA
#undef PG8_RD16
#undef PG8_WAIT_V
#undef PG8_WAIT_L
#undef PG8_BAR
#undef PG8_SCHED
}

struct EpiBf16 {
    bf16* O; int ldc;
    __device__ __forceinline__ void operator()(const f32x4 (&acc)[2][2][4][2], const Unit& u, int, int wr, int wc, int fr, int fq) const {
        const int row0 = u.pm * BM + wr * 64 + fr, col0 = u.pn * BM + wc * 32 + 8 * fq;
#pragma unroll
        for (int ai = 0; ai < 2; ++ai)
#pragma unroll
            for (int m = 0; m < 4; ++m) { bf16* rowp = O + (size_t)(row0 + ai * HALF + m * 16) * ldc + col0;
#pragma unroll
                for (int bj = 0; bj < 2; ++bj) { const f32x4 v0 = acc[ai][bj][m][0], v1 = acc[ai][bj][m][1];
                    u32x4 w; w.x = cvtpk(v0[0], v0[1]); w.y = cvtpk(v0[2], v0[3]); w.z = cvtpk(v1[0], v1[1]); w.w = cvtpk(v1[2], v1[3]);
                    *(u32x4*)(rowp + bj * HALF) = w; } }
    }
};
struct EpiTT {
    bf16* O;
    __device__ __forceinline__ void operator()(const f32x4 (&acc)[2][2][4][2], const Unit& u, int, int wr, int wc, int fr, int fq) const {
        const int row0 = u.pm * BM + wr * 64 + fr, tokb0 = u.pn * 8 + wc;
#pragma unroll
        for (int ai = 0; ai < 2; ++ai)
#pragma unroll
            for (int m = 0; m < 4; ++m) { const int col = row0 + ai * HALF + m * 16;
#pragma unroll
                for (int bj = 0; bj < 2; ++bj) { const f32x4 v0 = acc[ai][bj][m][0], v1 = acc[ai][bj][m][1];
                    u32x4 w; w.x = cvtpk(v0[0], v0[1]); w.y = cvtpk(v0[2], v0[3]); w.z = cvtpk(v1[0], v1[1]); w.w = cvtpk(v1[2], v1[3]);
                    *(u32x4*)(O + ((size_t)(tokb0 + 4 * bj) * 1280 + col) * 32 + 8 * fq) = w; } }
    }
};
struct EpiA {
    bf16 *SQ, *SK, *GQ, *GRS; const float *gq_norm, *gk_norm;
    __device__ __forceinline__ void operator()(const f32x4 (&acc)[2][2][4][2], const Unit& u, int, int wr, int wc, int fr, int fq) const {
        const int pn = u.pn; const int row0 = u.pm * BM + wr * 64 + fr;
        bf16* base; int ldc, colt; int mode;
        float scale = 1.f; const float* gain = nullptr;
        if (pn < 2)      { base = SQ; ldc = 512; colt = pn * 256; mode = 0; gain = gq_norm; scale = 0.125f * LOG2E; }
        else if (pn < 4) { base = SK; ldc = 512; colt = (pn - 2) * 256; mode = 0; gain = gk_norm; scale = 1.f; }
        else if (pn < 5) { base = GQ; ldc = 256; colt = 0; mode = 1; scale = 0.125f; }
        else             { base = GRS; ldc = 512; colt = (pn - 5) * 256; mode = 2; }
        const int col0 = colt + wc * 64 + 8 * fq;
        f32x4 gv[2][2];
#pragma unroll
        for (int bj = 0; bj < 2; ++bj)
#pragma unroll
            for (int n = 0; n < 2; ++n) { if (mode == 0) { gv[bj][n] = *(const f32x4*)(gain + 32 * bj + 8 * fq + 4 * n); gv[bj][n] = gv[bj][n] * scale; } else gv[bj][n] = (f32x4){scale, scale, scale, scale}; }
#pragma unroll
        for (int ai = 0; ai < 2; ++ai)
#pragma unroll
            for (int m = 0; m < 4; ++m) {
                float rs = 1.f;
                if (mode == 0) { float s = 0.f;
#pragma unroll
                    for (int bj = 0; bj < 2; ++bj)
#pragma unroll
                        for (int n = 0; n < 2; ++n) { const f32x4 x = acc[ai][bj][m][n]; s += (x[0] * x[0] + x[1] * x[1]) + (x[2] * x[2] + x[3] * x[3]); }
                    s += __shfl_xor(s, 16); s += __shfl_xor(s, 32);
                    rs = __builtin_amdgcn_rsqf(s * (1.f / 64.f) + EPS); }
                bf16* rowp = base + (size_t)(row0 + ai * HALF + m * 16) * ldc + col0;
#pragma unroll
                for (int bj = 0; bj < 2; ++bj) { f32x4 v0 = acc[ai][bj][m][0], v1 = acc[ai][bj][m][1];
                    if (mode == 2) {
#pragma unroll
                        for (int e = 0; e < 4; ++e) { v0[e] = v0[e] * __builtin_amdgcn_rcpf(1.f + __builtin_amdgcn_exp2f(-v0[e] * LOG2E)); v1[e] = v1[e] * __builtin_amdgcn_rcpf(1.f + __builtin_amdgcn_exp2f(-v1[e] * LOG2E)); }
                    } else { v0 = v0 * rs * gv[bj][0]; v1 = v1 * rs * gv[bj][1]; }
                    u32x4 w; w.x = cvtpk(v0[0], v0[1]); w.y = cvtpk(v0[2], v0[3]); w.z = cvtpk(v1[0], v1[1]); w.w = cvtpk(v1[2], v1[3]);
                    *(u32x4*)(rowp + bj * 32) = w; } }
    }
};
struct EpiH {
    const float* X; bf16* H; unsigned char* H8;
    __device__ __forceinline__ void operator()(const f32x4 (&acc)[2][2][4][2], const Unit& u, int, int wr, int wc, int fr, int fq) const {
        const int row0 = u.pm * BM + wr * 64 + fr, col0 = u.pn * BM + wc * 32 + 8 * fq;
#pragma unroll
        for (int ai = 0; ai < 2; ++ai) {
            f32x4 xv[4][2][2];
#pragma unroll
            for (int m = 0; m < 4; ++m) { const size_t off = (size_t)(row0 + ai * HALF + m * 16) * DM + col0;
#pragma unroll
                for (int bj = 0; bj < 2; ++bj) { xv[m][bj][0] = *(const f32x4*)(X + off + bj * HALF); xv[m][bj][1] = *(const f32x4*)(X + off + bj * HALF + 4); } }
#pragma unroll
            for (int m = 0; m < 4; ++m) { const size_t off = (size_t)(row0 + ai * HALF + m * 16) * DM + col0;
#pragma unroll
                for (int bj = 0; bj < 2; ++bj) { const f32x4 v0 = acc[ai][bj][m][0] + xv[m][bj][0], v1 = acc[ai][bj][m][1] + xv[m][bj][1];
                    u32x4 w; w.x = cvtpk(v0[0], v0[1]); w.y = cvtpk(v0[2], v0[3]); w.z = cvtpk(v1[0], v1[1]); w.w = cvtpk(v1[2], v1[3]);
                    *(u32x4*)(H + off + bj * HALF) = w;
                    const float f8[8] = {v0[0], v0[1], v0[2], v0[3], v1[0], v1[1], v1[2], v1[3]};
                    *(u32x2*)(H8 + off + bj * HALF) = pack8_fp8(f8); } }
        }
    }
};
struct EpiGU {
    unsigned char* ACT; const float* RSTD; const PG8_LAS int* tab;
    __device__ __forceinline__ void operator()(const f32x4 (&acc)[2][2][4][2], const Unit& u, int ui, int wr, int wc, int fr, int fq) const {
        const int col0 = u.pn * 128 + wc * 32 + 8 * fq;
        float rsv[2][4];
#pragma unroll
        for (int ai = 0; ai < 2; ++ai)
#pragma unroll
            for (int m = 0; m < 4; ++m) { const int rl = ai * HALF + wr * 64 + m * 16 + fr; rsv[ai][m] = RSTD[tab[T_ROWTAB / 4 + ui * 256 + rl] >> 1]; }
#pragma unroll
        for (int ai = 0; ai < 2; ++ai)
#pragma unroll
            for (int m = 0; m < 4; ++m) { const int rl = ai * HALF + wr * 64 + m * 16 + fr;
                if (rl < u.nv) {
                    const float rs = rsv[ai][m] * (1.f / WGU_SC);
                    f32x4 g0 = acc[ai][0][m][0] * rs, g1 = acc[ai][0][m][1] * rs, u0 = acc[ai][1][m][0] * rs, u1 = acc[ai][1][m][1] * rs;
#pragma unroll
                    for (int e = 0; e < 4; ++e) { g0[e] = g0[e] * __builtin_amdgcn_rcpf(1.f + __builtin_amdgcn_exp2f(-g0[e] * LOG2E)) * u0[e]; g1[e] = g1[e] * __builtin_amdgcn_rcpf(1.f + __builtin_amdgcn_exp2f(-g1[e] * LOG2E)) * u1[e]; }
                    float f8[8] = {g0[0] * ACT_SC, g0[1] * ACT_SC, g0[2] * ACT_SC, g0[3] * ACT_SC, g1[0] * ACT_SC, g1[1] * ACT_SC, g1[2] * ACT_SC, g1[3] * ACT_SC};
#pragma unroll
                    for (int e = 0; e < 8; ++e) f8[e] = __builtin_fminf(__builtin_fmaxf(f8[e], -448.f), 448.f);
                    *(u32x2*)(ACT + (size_t)(u.pm * 256 + rl) * DEXP + col0) = pack8_fp8(f8); } }
    }
};
struct EpiDown {
    unsigned char* Y; const PG8_LAS int* tab;
    __device__ __forceinline__ void operator()(const f32x4 (&acc)[2][2][4][2], const Unit& u, int ui, int wr, int wc, int fr, int fq) const {
        const int col0 = u.pn * BM + wc * 32 + 8 * fq; const float sc = Y_SC / (WD_SC * ACT_SC);
#pragma unroll
        for (int ai = 0; ai < 2; ++ai)
#pragma unroll
            for (int m = 0; m < 4; ++m) { const int rl = ai * HALF + wr * 64 + m * 16 + fr;
                if (rl < u.nv) { const unsigned ts = (unsigned)tab[T_ROWTAB / 4 + ui * 256 + rl]; unsigned char* rowp = Y + (size_t)ts * DM + col0;
#pragma unroll
                    for (int bj = 0; bj < 2; ++bj) { const f32x4 v0 = acc[ai][bj][m][0] * sc, v1 = acc[ai][bj][m][1] * sc;
                        const float f8[8] = {v0[0], v0[1], v0[2], v0[3], v1[0], v1[1], v1[2], v1[3]};
                        *(u32x2*)(rowp + bj * HALF) = pack8_fp8(f8); } } }
    }
};
}

#define XB_TMO      128
#define XB_XCNT(j)  (256  + 64 * (j))
#define XB_XSUB(j)  (1280 + 64 * (j))
#define XB_XGEN(j)  (2304 + 64 * (j))
#define XB_TOP      3328
#define XB_TOPGEN   3392
#define XCD_BAR_WORDS 3456
#define XB_SPIN_CAP (1u << 18)
__device__ __forceinline__ unsigned xb_ld(unsigned* p)              { return __hip_atomic_load(p, __ATOMIC_RELAXED, __HIP_MEMORY_SCOPE_AGENT); }
__device__ __forceinline__ unsigned xb_add(unsigned* p, unsigned v) { return __hip_atomic_fetch_add(p, v, __ATOMIC_RELAXED, __HIP_MEMORY_SCOPE_AGENT); }
__device__ __forceinline__ unsigned xb_xcc_id() { return (unsigned)__builtin_amdgcn_s_getreg((3 << 11) | 20) & 0xFu; }
#define XB_SPIN(cond, bar) do { unsigned _sp = 0; while (cond) { __builtin_amdgcn_s_sleep(1); \
    if ((++_sp & 255u) == 0u) { if (xb_ld(&(bar)[XB_TMO])) break; if (_sp > XB_SPIN_CAP) { atomicAdd(&(bar)[XB_TMO], 1u); break; } } } } while (0)
struct XcdBarrier { unsigned* bar; unsigned x; volatile LAS unsigned* st; };
__device__ __forceinline__ XcdBarrier xcd_barrier_post(unsigned* bar, volatile LAS unsigned* st) {
    XcdBarrier b; b.bar = bar; b.x = xb_xcc_id(); b.st = st;
    if (threadIdx.x == 0) (void)xb_add(&bar[XB_XCNT(b.x)], 1u);
    return b;
}
__device__ __forceinline__ void xcd_barrier_complete(unsigned* bar, unsigned x, unsigned& nloc, unsigned& nx) {
    const unsigned G = gridDim.x * gridDim.y * gridDim.z;
    unsigned sum, cnt, mine, sp = 0u;
    for (;;) {
        sum = 0u; cnt = 0u; mine = 0u;
#pragma unroll
        for (unsigned j = 0; j < 16; ++j) { const unsigned c = xb_ld(&bar[XB_XCNT(j)]); sum += c; cnt += (c > 0u) ? 1u : 0u; mine = (j == x) ? c : mine; }
        if (sum == G) break;
        __builtin_amdgcn_s_sleep(1);
        if ((++sp & 255u) == 0u) { if (xb_ld(&bar[XB_TMO])) break; if (sp > XB_SPIN_CAP) { atomicAdd(&bar[XB_TMO], 1u); break; } }
    }
    nloc = mine > 0u ? mine : 1u; nx = cnt > 0u ? cnt : 1u;
}
__device__ __forceinline__ void xcd_barrier(const XcdBarrier& b) {
    asm volatile("s_waitcnt vmcnt(0)" ::: "memory");
    __syncthreads();
    if (threadIdx.x == 0) {
        unsigned* bar = b.bar;
        __builtin_amdgcn_s_waitcnt(0);
        unsigned nloc = b.st[0], nx = b.st[1];
        if (nloc == 0u) { xcd_barrier_complete(bar, b.x, nloc, nx); b.st[0] = nloc; b.st[1] = nx; }
        const unsigned old = xb_add(&bar[XB_XSUB(b.x)], 1u);
        const unsigned gen = old / nloc;
        if (old + 1u == (gen + 1u) * nloc) {
            __builtin_amdgcn_fence(__ATOMIC_RELEASE, "agent");
            asm volatile("s_waitcnt vmcnt(0)" ::: "memory");
            const unsigned og = xb_add(&bar[XB_TOP], 1u);
            const unsigned tg = og / nx;
            if (og + 1u == (tg + 1u) * nx) xb_add(&bar[XB_TOPGEN], 1u);
            else XB_SPIN(xb_ld(&bar[XB_TOPGEN]) == tg, bar);
            __builtin_amdgcn_fence(__ATOMIC_ACQUIRE, "agent");
            xb_add(&bar[XB_XGEN(b.x)], 1u);
            asm volatile("s_waitcnt vmcnt(0)" ::: "memory");
        } else {
            XB_SPIN(xb_ld(&bar[XB_XGEN(b.x)]) == gen, bar);
            __builtin_amdgcn_fence(__ATOMIC_ACQUIRE, "agent");
            asm volatile("s_waitcnt vmcnt(0)" ::: "memory");
        }
    }
    __syncthreads();
}

__device__ __forceinline__ float wave_sum(float v) {
#pragma unroll
    for (int o = 1; o < 64; o <<= 1) v += __shfl_xor(v, o);
    return v;
}
__device__ __forceinline__ void tr_item(const float* src, int srcN, int k0, int n0, bf16* dst, int drow0, int dK, const float* kscale, LAS float* scr, int lane) {
    float w[32];
    const float* sp = src + (size_t)(k0 + (lane >> 5)) * srcN + n0 + (lane & 31);
#pragma unroll
    for (int i = 0; i < 32; ++i) w[i] = sp[(size_t)(2 * i) * srcN];
    if (kscale) { const float ksv = kscale[k0 + lane];
#pragma unroll
        for (int i = 0; i < 32; ++i) { const float a = __int_as_float(__builtin_amdgcn_readlane(__float_as_int(ksv), 2 * i)), b = __int_as_float(__builtin_amdgcn_readlane(__float_as_int(ksv), 2 * i + 1)); w[i] *= (lane >> 5) ? b : a; } }
#pragma unroll
    for (int i = 0; i < 32; ++i) scr[(2 * i + (lane >> 5)) * 33 + (lane & 31)] = w[i];
    LDS_WAIT(); asm volatile("" ::: "memory");
    const int c = lane & 7;
#pragma unroll
    for (int j = 0; j < 4; ++j) { const int n = (lane >> 3) + 8 * j; const LAS float* s = scr + (8 * c) * 33 + n;
        u32x4 o; o.x = cvtpk(s[0 * 33], s[1 * 33]); o.y = cvtpk(s[2 * 33], s[3 * 33]); o.z = cvtpk(s[4 * 33], s[5 * 33]); o.w = cvtpk(s[6 * 33], s[7 * 33]);
        *(GAS u32x4*)(dst + (size_t)(drow0 + n) * dK + k0 + 8 * c) = o; }
    LDS_WAIT(); asm volatile("" ::: "memory");
}

__device__ __forceinline__ void tr_item8(const float* src, int srcN, int k0, int n0, unsigned char* dst, int drow0, int dK, const float* kscale, float scale, LAS float* scr, int lane) {
    float w[32];
    const float* sp = src + (size_t)(k0 + (lane >> 5)) * srcN + n0 + (lane & 31);
#pragma unroll
    for (int i = 0; i < 32; ++i) w[i] = sp[(size_t)(2 * i) * srcN];
    float ksv = scale; if (kscale) ksv *= kscale[k0 + lane];
#pragma unroll
    for (int i = 0; i < 32; ++i) { const float a = __int_as_float(__builtin_amdgcn_readlane(__float_as_int(ksv), 2 * i)), b = __int_as_float(__builtin_amdgcn_readlane(__float_as_int(ksv), 2 * i + 1)); w[i] *= (lane >> 5) ? b : a; }
#pragma unroll
    for (int i = 0; i < 32; ++i) scr[(2 * i + (lane >> 5)) * 33 + (lane & 31)] = w[i];
    LDS_WAIT(); asm volatile("" ::: "memory");
#pragma unroll
    for (int j = 0; j < 2; ++j) { const int idx = lane + 64 * j, n = idx >> 2, c = idx & 3; const LAS float* sc_ = scr + (16 * c) * 33 + n;
        float f[16];
#pragma unroll
        for (int i = 0; i < 16; ++i) f[i] = sc_[i * 33];
        const u32x2 lo = pack8_fp8(f), hi = pack8_fp8(f + 8);
        u32x4 o; o.x = lo.x; o.y = lo.y; o.z = hi.x; o.w = hi.y;
        *(GAS u32x4*)(dst + (size_t)(drow0 + n) * dK + k0 + 16 * c) = o; }
    LDS_WAIT(); asm volatile("" ::: "memory");
}

struct Ptrs {
    const float *x, *attn_g, *w_in, *sbq_g, *sbk_g, *sbo_g, *w2, *gate_b, *glan_g, *w_out, *ffn_g, *rg_w, *rg_b, *re_w, *re_b, *wg, *wu, *wd;
    float* out; unsigned char* ws;
};

constexpr int SB_SPAN = 14, SB_VOFF = SB_SPAN * 4096;
__device__ __forceinline__ int sb_keyK(int r) { return ((r >> 1) & 3) | (((r >> 4) & 1) << 2); }
__device__ __forceinline__ int sb_keyV(int r) { return ((r >> 2) & 1) | (((r >> 4) & 1) << 1); }
__device__ __forceinline__ void sb_round(LAS unsigned char* lds, const bf16* SQ, const bf16* SK, const bf16* TT, const float* gout, bf16* MIX, int b, int h, int qg, int tid, int wave, int lane) {
    const int il = lane & 31, hi = lane >> 5, pil = PI32(il);
    const int qt = 8 * qg + wave;
    const size_t row0 = (size_t)b * SEQ + (size_t)qt * 32;
    bf16x8 qf[4];
    { const bf16* qp = SQ + (row0 + il) * 512 + h * 64 + 32 * hi;
#pragma unroll
      for (int s = 0; s < 4; ++s) qf[s] = *(const bf16x8*)(qp + 8 * s); }
    const int lo = (8 * qg - 6) > 0 ? (8 * qg - 6) : 0, nblk = 8 * qg + 8 - lo;
    {
        u32x4 st[SB_SPAN];
        const bool isK = tid < 256; const int q = tid - 256;
        const bf16* src = isK ? SK + ((size_t)b * SEQ + (size_t)lo * 32 + (tid >> 3)) * 512 + h * 64 + 8 * (tid & 7)
                              : TT + ((size_t)(b * (SEQ / 32) + lo) * NB + h * 64 + (q >> 2)) * 32 + 8 * (q & 3);
        const size_t bstep = isK ? (size_t)32 * 512 : (size_t)NB * 32;
#pragma unroll
        for (int i = 0; i < SB_SPAN; ++i) if (i < nblk) st[i] = *(const u32x4*)(src + (size_t)i * bstep);
        const int r = isK ? (tid >> 3) : (q >> 2);
        const unsigned dst = isK ? (unsigned)(r * 128 + (((tid & 7) ^ sb_keyK(r)) << 4)) : (unsigned)(SB_VOFF + r * 64 + (((q & 3) ^ sb_keyV(r & 31)) << 4));
#pragma unroll
        for (int i = 0; i < SB_SPAN; ++i) if (i < nblk) *(LAS u32x4*)(lds + dst + i * 4096) = st[i];
    }
    __syncthreads();
    f32x16 o0, o1;
#pragma unroll
    for (int r = 0; r < 16; ++r) { o0[r] = 0.f; o1[r] = 0.f; }
    float R = 1.f;
#define SB_MATH(KC, VC, kb_) do { \
        f32x16 z; \
        _Pragma("unroll") for (int r = 0; r < 16; ++r) z[r] = 0.f; \
        _Pragma("unroll") for (int s = 0; s < 4; ++s) z = MFMA32(KC[s], qf[s], z); \
        float beta[16], omb[16]; \
        const bool diag = ((kb_) == qt); \
        _Pragma("unroll") for (int r = 0; r < 16; ++r) { \
            const float zz = z[r]; const float t = __builtin_amdgcn_exp2f(-__builtin_fabsf(zz)); const float rr = __builtin_amdgcn_rcpf(1.f + t); const float sm = t * rr; \
            const bool pos = zz >= 0.f; float be = pos ? rr : sm; float om = pos ? sm : rr; \
            if (diag) { const bool valid = (16 * hi + r) < il; be = valid ? be : 0.f; om = valid ? om : 1.f; } \
            beta[r] = be; omb[r] = om; } \
        float e[16]; e[15] = 1.f; \
        _Pragma("unroll") for (int r = 14; r >= 0; --r) e[r] = e[r + 1] * omb[r + 1]; \
        const float P16 = e[0] * omb[0]; \
        float Plo, Phi; swap32(P16, Plo, Phi); \
        const float base = R * (hi ? 1.f : Phi); \
        float a[16]; \
        _Pragma("unroll") for (int r = 0; r < 16; ++r) a[r] = beta[r] * e[r] * base; \
        R = R * (Plo * Phi); \
        const bf16x8 p0 = pack8(a), p1 = pack8(a + 8); \
        o0 = MFMA32(VC[0][0], p0, o0); o0 = MFMA32(VC[0][1], p1, o0); \
        o1 = MFMA32(VC[1][0], p0, o1); o1 = MFMA32(VC[1][1], p1, o1); } while (0)
    bool fin = false;
    {
        const unsigned kbase = (unsigned)(pil * 128), vbase = (unsigned)(SB_VOFF + pil * 64);
        unsigned kx[4], vx[2];
#pragma unroll
        for (int s = 0; s < 4; ++s) kx[s] = (unsigned)(((4 * hi + s) ^ sb_keyK(pil)) << 4);
#pragma unroll
        for (int s = 0; s < 2; ++s) vx[s] = (unsigned)(((2 * hi + s) ^ sb_keyV(pil)) << 4);
        for (int kb = qt; ; --kb) {
            const unsigned so = (unsigned)(kb - lo) * 4096u;
            bf16x8 kf[4], vf[2][2];
#pragma unroll
            for (int s = 0; s < 4; ++s) kf[s] = *(const LAS bf16x8*)(lds + so + kbase + kx[s]);
#pragma unroll
            for (int dt = 0; dt < 2; ++dt)
#pragma unroll
                for (int s = 0; s < 2; ++s) vf[dt][s] = *(const LAS bf16x8*)(lds + so + vbase + dt * 2048 + vx[s]);
            SB_MATH(kf, vf, kb);
            if (kb == 0 || __all(R == 0.f)) { fin = true; break; }
            if (kb == lo) break;
        }
    }
    if (!fin) {
        for (int kb = lo - 1; ; --kb) {
            bf16x8 kf[4], vf[2][2];
            const bf16* kp = SK + ((size_t)b * SEQ + (size_t)kb * 32 + pil) * 512 + h * 64 + 32 * hi;
#pragma unroll
            for (int s = 0; s < 4; ++s) kf[s] = *(const bf16x8*)(kp + 8 * s);
            const bf16* vp = TT + ((size_t)(b * (SEQ / 32) + kb) * NB + h * 64 + pil) * 32 + 16 * hi;
#pragma unroll
            for (int dt = 0; dt < 2; ++dt)
#pragma unroll
                for (int s = 0; s < 2; ++s) vf[dt][s] = *(const bf16x8*)(vp + dt * 32 * 32 + 8 * s);
            SB_MATH(kf, vf, kb);
            if (kb == 0 || __all(R == 0.f)) break;
        }
    }
#undef SB_MATH
    float ss = 0.f;
#pragma unroll
    for (int r = 0; r < 16; ++r) ss += o0[r] * o0[r] + o1[r] * o1[r];
    float slo, shi; swap32(ss, slo, shi);
    const float rstd = __builtin_amdgcn_rsqf((slo + shi) * (1.f / 64.f) + EPS);
    bf16* op = MIX + (row0 + il) * DM + h * 64 + 16 * hi;
#pragma unroll
    for (int dt = 0; dt < 2; ++dt) {
        float v[16];
#pragma unroll
        for (int r4 = 0; r4 < 4; ++r4) { const f32x4 g = *(const f32x4*)(gout + 32 * dt + 16 * hi + 4 * r4);
#pragma unroll
            for (int e2 = 0; e2 < 4; ++e2) v[4 * r4 + e2] = (dt ? o1[4 * r4 + e2] : o0[4 * r4 + e2]) * rstd * g[e2]; }
        *(bf16x8*)(op + 32 * dt) = pack8(v); *(bf16x8*)(op + 32 * dt + 8) = pack8(v + 8);
    }
    __syncthreads();
}

__device__ __forceinline__ void gla_a(const bf16* GLR, const bf16* W2T, const float* gate_b, const bf16* TT, bf16* KV, float* DTOT, int bh, int j, int lane) {
    const int il = lane & 31, hi = lane >> 5, pil = PI32(il);
    const int b = bh >> 2, h = bh & 3;
    const size_t t0 = (size_t)b * SEQ + (size_t)j * 64;
    bf16x8 gf[2], wf[2], gkf[2][2][2], bvf[4][4]; float bias[2];
#pragma unroll
    for (int ch = 0; ch < 2; ++ch) gf[ch] = *(const bf16x8*)(GLR + (t0 + 32 * ch + pil) * 16 + 8 * hi);
#pragma unroll
    for (int kh = 0; kh < 2; ++kh) { const int kcol = 64 * h + 32 * kh + pil; wf[kh] = *(const bf16x8*)(W2T + kcol * 16 + 8 * hi); bias[kh] = gate_b[kcol];
        const bf16* gkp = TT + ((t0 >> 5) * NB + 512 + kcol) * 32 + 16 * hi;
#pragma unroll
        for (int ch = 0; ch < 2; ++ch) { gkf[kh][ch][0] = *(const bf16x8*)(gkp + ch * NB * 32); gkf[kh][ch][1] = *(const bf16x8*)(gkp + ch * NB * 32 + 8); } }
#pragma unroll
    for (int vq = 0; vq < 4; ++vq) { const bf16* vp = TT + ((t0 >> 5) * NB + 768 + 128 * h + 32 * vq + il) * 32 + 16 * hi;
#pragma unroll
        for (int s = 0; s < 4; ++s) bvf[vq][s] = *(const bf16x8*)(vp + (s >> 1) * NB * 32 + 8 * (s & 1)); }
    bf16x8 akf[2][4];
#pragma unroll
    for (int kh = 0; kh < 2; ++kh) {
        const int kcol = 64 * h + 32 * kh + pil;
        float cs[2][16];
#pragma unroll
        for (int ch = 0; ch < 2; ++ch) {
            f32x16 g;
#pragma unroll
            for (int r = 0; r < 16; ++r) g[r] = 0.f;
            g = MFMA32(gf[ch], wf[kh], g);
            if (kh == 0 && ch == 0) asm volatile("" : "+v"(g) :: "memory");
            float run = 0.f;
#pragma unroll
            for (int r = 0; r < 16; ++r) { const float x = g[r] + bias[kh];
                const float ls2 = __builtin_fminf(x, 0.f) * LOG2E - __builtin_amdgcn_logf(1.f + __builtin_amdgcn_exp2f(-__builtin_fabsf(x) * LOG2E));
                run += ls2 * (1.f / 16.f); cs[ch][r] = run; }
        }
        float t0lo, t0hi, t1lo, t1hi; swap32(cs[0][15], t0lo, t0hi); swap32(cs[1][15], t1lo, t1hi);
        const float off0 = hi ? t0lo : 0.f, off1 = (t0lo + t0hi) + (hi ? t1lo : 0.f), total = (t0lo + t0hi) + (t1lo + t1hi);
        if (hi == 0) DTOT[((size_t)bh * 32 + j) * 64 + 32 * kh + pil] = __builtin_amdgcn_exp2f(total);
#pragma unroll
        for (int ch = 0; ch < 2; ++ch) {
            const bf16x8 k0 = gkf[kh][ch][0], k1 = gkf[kh][ch][1];
            float kd[16]; const float off = ch ? off1 : off0;
#pragma unroll
            for (int r = 0; r < 16; ++r) { const float dec = __builtin_amdgcn_exp2f(total - (cs[ch][r] + off)); kd[r] = bf2f(r < 8 ? k0[r] : k1[r - 8]) * dec; }
            akf[kh][2 * ch] = pack8(kd); akf[kh][2 * ch + 1] = pack8(kd + 8);
        }
    }
#pragma unroll
    for (int vq = 0; vq < 4; ++vq) {
#pragma unroll
        for (int kh = 0; kh < 2; ++kh) {
            f32x16 kv;
#pragma unroll
            for (int r = 0; r < 16; ++r) kv[r] = 0.f;
#pragma unroll
            for (int s = 0; s < 4; ++s) kv = MFMA32(akf[kh][s], bvf[vq][s], kv);
            bf16* dst = KV + (((size_t)bh * 32 + j) * 128 + 32 * vq + il) * 64 + 32 * kh + 16 * hi;
            float kvf[16];
#pragma unroll
            for (int r = 0; r < 16; ++r) kvf[r] = kv[r];
            *(bf16x8*)dst = pack8(kvf); *(bf16x8*)(dst + 8) = pack8(kvf + 8);
        }
    }
}
__device__ __forceinline__ void gla_b(const bf16* KV, const float* DTOT, bf16* ST, int task, int lane) {
    const int bh = task >> 5, part = task & 31; const int e0 = part * 256 + lane * 4; const int k = e0 & 63;
    f32x4 S = (f32x4){0.f, 0.f, 0.f, 0.f};
#pragma unroll
    for (int half = 0; half < 2; ++half) {
        u32x2 kvp[16]; f32x4 d[16];
#pragma unroll
        for (int q = 0; q < 16; ++q) { const int j = 16 * half + q;
            kvp[q] = *(const u32x2*)(KV + ((size_t)bh * 32 + j) * 8192 + e0); d[q] = *(const f32x4*)(DTOT + ((size_t)bh * 32 + j) * 64 + k); }
#pragma unroll
        for (int q = 0; q < 16; ++q) { const int j = 16 * half + q;
            const f32x4 kv = (f32x4){__uint_as_float(kvp[q].x << 16), __uint_as_float(kvp[q].x & 0xffff0000u), __uint_as_float(kvp[q].y << 16), __uint_as_float(kvp[q].y & 0xffff0000u)};
            S = d[q] * S + kv;
            u32x2 w; w.x = cvtpk(S[0], S[1]); w.y = cvtpk(S[2], S[3]);
            *(u32x2*)(ST + ((size_t)bh * 32 + j) * 8192 + e0) = w; }
        asm volatile("" ::: "memory");
    }
}
__device__ __forceinline__ void gla_c(const bf16* ST, const bf16* GQ, const bf16* GRS, const float* gn, bf16* MIX, int bh, int j, int lane) {
    const int il = lane & 31, hi = lane >> 5, pil = PI32(il);
    const int b = bh >> 2, h = bh & 3;
    const size_t t0 = (size_t)b * SEQ + (size_t)j * 64;
    const bf16* sp = ST + (((size_t)bh * 32 + j) * 128 + pil) * 64 + 8 * hi;
#pragma unroll
    for (int ch = 0; ch < 2; ++ch) {
        const size_t row = t0 + 32 * ch + il;
        bf16x8 bq[4];
#pragma unroll
        for (int s = 0; s < 4; ++s) bq[s] = *(const bf16x8*)(GQ + row * 256 + 64 * h + 16 * s + 8 * hi);
        f32x16 O[4]; float ss = 0.f;
#pragma unroll
        for (int vt = 0; vt < 4; ++vt) {
#pragma unroll
            for (int r = 0; r < 16; ++r) O[vt][r] = 0.f;
#pragma unroll
            for (int s = 0; s < 4; ++s) { const bf16x8 af = *(const bf16x8*)(sp + (size_t)vt * 32 * 64 + 16 * s); O[vt] = MFMA32(af, bq[s], O[vt]); }
#pragma unroll
            for (int r = 0; r < 16; ++r) ss += O[vt][r] * O[vt][r];
        }
        float slo, shi; swap32(ss, slo, shi);
        const float rstd = __builtin_amdgcn_rsqf((slo + shi) * (1.f / 128.f) + EPS);
#pragma unroll
        for (int vt = 0; vt < 4; ++vt) {
            const int vc0 = 32 * vt + 16 * hi;
            const bf16x8 g0 = *(const bf16x8*)(GRS + row * 512 + 128 * h + vc0), g1 = *(const bf16x8*)(GRS + row * 512 + 128 * h + vc0 + 8);
            float v[16];
#pragma unroll
            for (int r4 = 0; r4 < 4; ++r4) { const f32x4 g = *(const f32x4*)(gn + vc0 + 4 * r4);
#pragma unroll
                for (int e2 = 0; e2 < 4; ++e2) { const int r = 4 * r4 + e2; v[r] = O[vt][r] * rstd * g[e2] * bf2f(r < 8 ? g0[r] : g1[r - 8]); } }
            bf16* op = MIX + row * DM + 512 + 128 * h + vc0;
            *(bf16x8*)(op) = pack8(v); *(bf16x8*)(op + 8) = pack8(v + 8);
        }
    }
}

constexpr int NWAVES = 8;
constexpr int N_PHASES = 10;
struct Args { Ptrs p; int ph_lo, ph_hi; };

__global__ void __launch_bounds__(NWAVES * 64, 2) fwd_kernel(Args args) {
    extern __shared__ __attribute__((aligned(16))) unsigned char lds_raw[];
    LAS unsigned char* lds = (LAS unsigned char*)lds_raw;
    const Ptrs& P = args.p;
    const int tid = threadIdx.x, lane = tid & 63, wave = __builtin_amdgcn_readfirstlane(tid >> 6);
    const int G = gridDim.x; const int bx = blockIdx.x; const int vcu = (G % 8 == 0) ? (bx % 8) * (G / 8) + bx / 8 : bx;
    const int gw = vcu * NWAVES + wave, NGW = G * NWAVES;
    unsigned char* ws = P.ws;
    gu32* ctl = (gu32*)(ws + WS_CTL);
    volatile LAS unsigned* MISC = (volatile LAS unsigned*)(lds + MISC_OFF);
    LAS int* tab = (LAS int*)(lds + TAB_OFF);
    for (int u = tid; u < (LDS_BYTES - LDSCTL_OFF) / 4; u += NWAVES * 64) ((LAS unsigned*)(lds + LDSCTL_OFF))[u] = 0u;
    __syncthreads();
    XcdBarrier bar; bar.bar = (unsigned*)(ctl + CW_BAR); bar.x = 0; bar.st = nullptr;
    if (MK_N_LAUNCHES == 1) bar = xcd_barrier_post((unsigned*)(ctl + CW_BAR), MISC + 8);
#define GRID_BAR() do { if (MK_N_LAUNCHES == 1) xcd_barrier(bar); } while (0)
    const int lo = args.ph_lo, hi_ph = args.ph_hi;
#ifndef PHASE_MASK
#define PHASE_MASK 0x3ff
#endif
#define IN(k) (((PHASE_MASK >> (k)) & 1) && lo <= (k) && (k) < hi_ph)
#define BOTH(k) (IN(k) && IN((k) + 1))
#ifndef PROBE_TWICE
#define PROBE_TWICE -1
#endif
#define REP(k) for (int rep_ = 0; rep_ < ((PROBE_TWICE == (k)) ? 2 : 1); ++rep_)
#define REPBAR(k) do { if (PROBE_TWICE == (k) && rep_ == 0) GRID_BAR(); } while (0)

    bf16* WA = (bf16*)(ws + WS_WA); bf16* WB = (bf16*)(ws + WS_WB); bf16* WO = (bf16*)(ws + WS_WO);
    bf16* WRH = (bf16*)(ws + WS_WR); bf16* WRL = WRH + 48 * 1024; bf16* W2T = (bf16*)(ws + WS_W2T);
    bf16* WGU = (bf16*)(ws + WS_WGU); bf16* WD = (bf16*)(ws + WS_WD);
    bf16* H = (bf16*)(ws + WS_H); bf16* KV = (bf16*)(ws + WS_KV);
    bf16* U = (bf16*)(ws + WS_U); bf16* MIX = (bf16*)(ws + WS_MIX);
    bf16* SQ = (bf16*)(ws + WS_SQ); bf16* SK = (bf16*)(ws + WS_SK); bf16* GQ = (bf16*)(ws + WS_GQ); bf16* GRS = (bf16*)(ws + WS_GRS);
    bf16* TT = (bf16*)(ws + WS_TT); bf16* GLR = (bf16*)(ws + WS_GLR); bf16* ST = (bf16*)(ws + WS_ST); float* DTOT = (float*)(ws + WS_DTOT);
    unsigned char* ACT = ws + WS_ACT; unsigned char* Y = ws + WS_Y;
    unsigned char* WGU8 = ws + WS_WGU; unsigned char* WD8 = ws + WS_WD; unsigned char* H8 = ws + WS_H8;
    unsigned* LOCL = (unsigned*)(ws + WS_LOCL); unsigned* CNTS = (unsigned*)(ws + WS_CNTS); float* GATE = (float*)(ws + WS_GATE); float* RSTD = (float*)(ws + WS_RSTD);

    if (IN(0)) { REP(0) {
        LAS float* scr = (LAS float*)(lds + RING_OFF + wave * 16384);
        constexpr int I_A = (NA / 32) * 16, I_B = (NB / 32) * 16, I_O = 32 * 16, I_GU = 32 * 32 * 16, I_D = 32 * 32 * 8;
        constexpr int NITEMS = I_A + I_B + I_O + I_GU;
        for (int it = gw; it < NITEMS; it += NGW) {
            int r = it;
            if (r < I_A) { const int ib = r >> 4, kb = r & 15, P0 = 32 * ib; const int pn = P0 >> 8, bj = (P0 >> 7) & 1, wcc = (P0 >> 5) & 3; const int LA = 256 * pn + 64 * wcc + 32 * bj;
                const int sc = LA < 1024 ? LA : (LA < 1280 ? 1536 + (LA - 1024) : 2560 + (LA - 1280));
                tr_item(P.w_in, IN_DIM, 64 * kb, sc, WA, P0, DM, nullptr, scr, lane); continue; } r -= I_A;
            if (r < I_B) { const int ib = r >> 4, kb = r & 15, P0 = 32 * ib; const int sc = P0 < 512 ? 1024 + P0 : (P0 < 768 ? 1792 + (P0 - 512) : 2048 + (P0 - 768));
                tr_item(P.w_in, IN_DIM, 64 * kb, sc, WB, P0, DM, nullptr, scr, lane); continue; } r -= I_B;
            if (r < I_O) { const int ib = r >> 4, kb = r & 15; tr_item(P.w_out, DM, 64 * kb, 32 * ib, WO, 32 * ib, DM, nullptr, scr, lane); continue; } r -= I_O;
            if (r < I_GU) { const int e = r >> 9, q = r & 511, ib = 4 * (q >> 6) + (q & 3), kb = 2 * ((q >> 3) & 7) + ((q >> 2) & 1), P0 = 32 * ib; const int pn = P0 >> 8, bj = (P0 >> 7) & 1, r0 = P0 & 127;
                const float* src = (bj ? P.wu : P.wg) + (size_t)e * DM * DEXP;
                tr_item8(src, DEXP, 64 * kb, 128 * pn + r0, WGU8 + (size_t)e * DM * DM, P0, DM, P.ffn_g, WGU_SC, scr, lane); continue; }
        }
        (void)I_D;
        for (int idx = gw * 64 + lane; idx < 48 * 1024; idx += NGW * 64) {
            const int rho = idx >> 10, k = idx & 1023, m = rho >> 4, i = rho & 15;
            float v = (m < 2) ? P.re_w[k * 32 + 8 * (i >> 2) + 4 * m + (i & 3)] : P.rg_w[k * 4 + (i & 3)];
            v *= P.ffn_g[k];
            WRH[idx] = __builtin_bit_cast(unsigned short, (_Float16)v);
        }
        for (int idx = gw * 64 + lane; idx < 256 * 16; idx += NGW * 64) { const int kc = idx >> 4, r = idx & 15; W2T[idx] = (bf16)(cvtpk(P.w2[r * 256 + kc], 0.f) & 0xffffu); }
        __syncthreads();
        constexpr int WLP = 1032;
        LAS bf16* wl = (LAS bf16*)(lds + RING_OFF);
        for (int idx = tid; idx < 16 * 1024; idx += NWAVES * 64) { const int c = idx & 15, k = idx >> 4; wl[c * WLP + k] = (bf16)(cvtpk(P.w_in[(size_t)k * IN_DIM + 3072 + c], 0.f) & 0xffffu); }
        __syncthreads();
        {
            f32x4 g4[4];
#pragma unroll
            for (int j = 0; j < 4; ++j) g4[j] = *((const GAS f32x4*)P.attn_g + lane + 64 * j);
            for (int task = gw; task < NTOK / 16; task += NGW) {
                const size_t row0 = (size_t)task * 16;
                f32x4 cur[4], nxt[4];
#pragma unroll
                for (int j = 0; j < 4; ++j) { cur[j] = *((const GAS f32x4*)(P.x + row0 * DM) + lane + 64 * j); nxt[j] = cur[j]; }
#pragma unroll 2
                for (int r = 0; r < 16; ++r) {
                    if (r < 15) {
#pragma unroll
                        for (int j = 0; j < 4; ++j) nxt[j] = *((const GAS f32x4*)(P.x + (row0 + r + 1) * DM) + lane + 64 * j); }
                    float s2 = 0.f;
#pragma unroll
                    for (int j = 0; j < 4; ++j) s2 += (cur[j].x * cur[j].x + cur[j].y * cur[j].y) + (cur[j].z * cur[j].z + cur[j].w * cur[j].w);
                    const float rstd = __builtin_amdgcn_rsqf(wave_sum(s2) * (1.f / DM) + EPS);
                    GAS unsigned long long* o8 = (GAS unsigned long long*)(U + (row0 + r) * DM) + lane;
#pragma unroll
                    for (int j = 0; j < 4; ++j) { const f32x4 v = cur[j] * rstd * g4[j];
                        o8[64 * j] = (unsigned long long)cvtpk(v.x, v.y) | ((unsigned long long)cvtpk(v.z, v.w) << 32); }
#pragma unroll
                    for (int j = 0; j < 4; ++j) cur[j] = nxt[j];
                }
                VM_WAIT();
                const int fr = lane & 15, fq = lane >> 4;
                f32x4 acc = (f32x4){0.f, 0.f, 0.f, 0.f};
                const bf16* up = U + (row0 + fr) * DM + 8 * fq;
#pragma unroll 8
                for (int ks = 0; ks < 32; ++ks) { const bf16x8 ub = *(const bf16x8*)(up + 32 * ks); const bf16x8 wb = *(const LAS bf16x8*)(wl + fr * WLP + 32 * ks + 8 * fq); acc = MFMA16(wb, ub, acc); }
                u32x2 o; o.x = cvtpk(acc[0], acc[1]); o.y = cvtpk(acc[2], acc[3]);
                *(u32x2*)(GLR + (row0 + fr) * 16 + 4 * fq) = o;
            }
        }
        __syncthreads();
        REPBAR(0); }
        if (BOTH(0)) GRID_BAR();
    }

#define PH1_BODY() do { \
        { pg8::SchedDense S; S.init(U, WA, NTOK, NA, DM, G, bx); \
          pg8::EpiA E{SQ, SK, GQ, GRS, P.sbq_g, P.sbk_g}; \
          pg8::gemm_phase<pg8::EpiA, pg8::SchedDense>(lds + RING_OFF, DM, S, E); } \
        { pg8::SchedDense S; S.init(WB, U, NB, NTOK, DM, G, (bx + G / 2) % G); \
          pg8::EpiTT E{TT}; \
          pg8::gemm_phase<pg8::EpiTT, pg8::SchedDense>(lds + RING_OFF, DM, S, E); } } while (0)
    if (IN(1)) {
        if (PROBE_TWICE == 1) { PH1_BODY(); GRID_BAR(); }
        PH1_BODY();
        if (BOTH(1)) GRID_BAR();
    }

#define SB_ROUND(rho_) do { for (int u__ = (rho_) * G + vcu; u__ < 1024; u__ += 4 * G) { const int bh_ = u__ & 127; \
        sb_round(lds + RING_OFF, SQ, SK, TT, P.sbo_g + (bh_ & 7) * 64, MIX, bh_ >> 3, bh_ & 7, u__ >> 7, tid, wave, lane); } } while (0)
#define REPX(code) for (int rx_ = 0; rx_ < ((PROBE_TWICE == (code)) ? 5 : 1); ++rx_)
    if (IN(2)) { REP(2) {
        REPX(20) for (int t = gw; t < 2048; t += NGW) gla_a(GLR, W2T, P.gate_b, TT, KV, DTOT, t >> 5, t & 31, lane);
        REPX(21) SB_ROUND(0);
        REPBAR(2); }
        if (BOTH(2)) GRID_BAR();
    }
    if (IN(3)) { REP(3) {
        REPX(22) for (int t = gw; t < 2048; t += NGW) gla_b(KV, DTOT, ST, t, lane);
        SB_ROUND(1);
        REPBAR(3); }
        if (BOTH(3)) GRID_BAR();
    }
    if (IN(4)) { REP(4) {
        REPX(23) for (int t = gw; t < 2048; t += NGW) gla_c(ST, GQ, GRS, P.glan_g, MIX, t >> 5, t & 31, lane);
        SB_ROUND(2); SB_ROUND(3);
        REPBAR(4); }
        if (BOTH(4)) GRID_BAR();
    }

#define PH5_BODY() do { \
        pg8::SchedDense S; S.init(MIX, WO, NTOK, DM, DM, G, bx); \
        pg8::EpiH E{P.x, H, H8}; \
        pg8::gemm_phase<pg8::EpiH, pg8::SchedDense>(lds + RING_OFF, DM, S, E); } while (0)
    if (IN(5)) {
        if (PROBE_TWICE == 5) { PH5_BODY(); GRID_BAR(); }
        PH5_BODY();
        if (BOTH(5)) GRID_BAR();
    }

    if (IN(6)) { REP(6) {
        constexpr int WP = 1032;
        LAS unsigned short* wl16 = (LAS unsigned short*)(lds + RING_OFF);
        LAS unsigned* lcount = (LAS unsigned*)(lds + RING_OFF + 48 * WP * 2);
        for (int idx = tid; idx < 48 * 128; idx += NWAVES * 64) { const int row = idx >> 7, c = idx & 127; *(LAS u32x4*)(wl16 + row * WP + 8 * c) = *(const u32x4*)(WRH + row * 1024 + 8 * c); }
        const int fr = lane & 15, fq = lane >> 4;
        for (int it = 0; it * G < NGRP; ++it) {
            const int grp = it * G + vcu;
            const int tile = grp * 8 + wave; const int ntile = NGRP * 8;
            if (tid < 32) lcount[tid] = 0u;
            __syncthreads();
            bool owner = false; int e1 = 0, e2 = 0; unsigned lr1 = 0, lr2 = 0; int tok = 0;
            if (tile < ntile) {
                tok = tile * 16 + fr;
                const bf16* hp = H + (size_t)tok * DM + 8 * fq;
                f32x4 acc[3]; acc[0] = acc[1] = acc[2] = (f32x4){0.f, 0.f, 0.f, 0.f};
                float ssq = 0.f;
#pragma unroll 1
                for (int half = 0; half < 2; ++half) {
                    bf16x8 hb[16];
#pragma unroll
                    for (int q = 0; q < 16; ++q) hb[q] = *(const bf16x8*)(hp + 32 * (16 * half + q));
#pragma unroll
                    for (int q = 0; q < 16; ++q) { const int ks = 16 * half + q;
                        float f[8];
#pragma unroll
                        for (int e = 0; e < 8; ++e) { f[e] = bf2f(hb[q][e]); ssq += f[e] * f[e]; }
                        f16x8 hh;
#pragma unroll
                        for (int e = 0; e < 8; ++e) hh[e] = (_Float16)f[e];
#pragma unroll
                        for (int m = 0; m < 3; ++m) { const f16x8 wv = *(const LAS f16x8*)(wl16 + (16 * m + fr) * WP + 32 * ks + 8 * fq);
                            acc[m] = __builtin_amdgcn_mfma_f32_16x16x32_f16(wv, hh, acc[m], 0, 0, 0); }
                    }
                }
                ssq += __shfl_xor(ssq, 16); ssq += __shfl_xor(ssq, 32);
                const float rstd = __builtin_amdgcn_rsqf(ssq * (1.f / DM) + EPS);
                float gl[4];
#pragma unroll
                for (int r = 0; r < 4; ++r) gl[r] = acc[2][r] * rstd + P.rg_b[r];
                int gsel = 0; float gmax = gl[0];
#pragma unroll
                for (int r = 1; r < 4; ++r) if (gl[r] > gmax) { gmax = gl[r]; gsel = r; }
                float gden = 0.f;
#pragma unroll
                for (int r = 0; r < 4; ++r) gden += __builtin_amdgcn_exp2f((gl[r] - gmax) * LOG2E);
                const float pgrp = 1.f / gden;
                float el[8];
#pragma unroll
                for (int r = 0; r < 4; ++r) { el[r] = acc[0][r] * rstd + P.re_b[8 * fq + r]; el[4 + r] = acc[1][r] * rstd + P.re_b[8 * fq + 4 + r]; }
                int i1 = 0; float l1 = el[0];
#pragma unroll
                for (int r = 1; r < 8; ++r) if (el[r] > l1) { l1 = el[r]; i1 = r; }
                int i2 = -1; float l2 = -3.0e38f;
#pragma unroll
                for (int r = 0; r < 8; ++r) if (r != i1 && el[r] > l2) { l2 = el[r]; i2 = r; }
                const float ex = __builtin_amdgcn_exp2f((l2 - l1) * LOG2E);
                const float p1 = 1.f / (1.f + ex), p2 = ex * p1;
                owner = (fq == gsel);
                if (owner) {
                    e1 = 8 * gsel + i1; e2 = 8 * gsel + i2;
                    lr1 = __hip_atomic_fetch_add(lcount + e1, 1u, __ATOMIC_RELAXED, __HIP_MEMORY_SCOPE_WORKGROUP);
                    lr2 = __hip_atomic_fetch_add(lcount + e2, 1u, __ATOMIC_RELAXED, __HIP_MEMORY_SCOPE_WORKGROUP);
                    RSTD[tok] = rstd; GATE[2 * tok] = pgrp * p1; GATE[2 * tok + 1] = pgrp * p2;
                }
            }
            __syncthreads();
            if (grp < NGRP) {
                if (tid < 32) CNTS[grp * 32 + tid] = lcount[tid];
                if (owner) { LOCL[((size_t)grp * 32 + e1) * 128 + lr1] = 2u * tok; LOCL[((size_t)grp * 32 + e2) * 128 + lr2] = 2u * tok + 1u; }
            }
            __syncthreads();
        }
        REPBAR(6); }
        if (BOTH(6)) GRID_BAR();
    }

    if (IN(7) || IN(8)) {
        LAS int* pre = (LAS int*)(lds + RING_OFF);
        LAS int* segsum = pre + NGRP * 32;
        for (int i = tid; i < NGRP * 32; i += NWAVES * 64) pre[i] = (int)CNTS[i];
        __syncthreads();
        { const int e = tid & 31, seg = tid >> 5; int run = 0;
          for (int g = seg * 16; g < seg * 16 + 16; ++g) { const int c = pre[g * 32 + e]; pre[g * 32 + e] = run; run += c; }
          segsum[seg * 32 + e] = run; }
        __syncthreads();
        { const int e = tid & 31, seg = tid >> 5; int off = 0, tot = 0;
          for (int q = 0; q < 16; ++q) { const int v = segsum[q * 32 + e]; if (q < seg) off += v; tot += v; }
          for (int g = seg * 16; g < seg * 16 + 16; ++g) pre[g * 32 + e] += off;
          if (seg == 0) tab[T_CNT / 4 + e] = tot; }
        __syncthreads();
        if (tid == 0) { int tb = 0; for (int e = 0; e < 32; ++e) { tab[T_TBASE / 4 + e] = tb; tb += (tab[T_CNT / 4 + e] + 255) >> 8; } tab[T_TBASE / 4 + 32] = tb; tab[T_NT / 4] = tb; }
        __syncthreads();
        { const int NT = tab[T_NT / 4];
          for (int t = tid; t < NT; t += NWAVES * 64) { int e = 0; for (int q = 0; q < 32; ++q) if (tab[T_TBASE / 4 + q] <= t && t < tab[T_TBASE / 4 + q + 1]) e = q; tab[T_TILE_E / 4 + t] = e; } }
        __syncthreads();
        { pg8::SchedMoE<false> S0; S0.A = nullptr; S0.Bt = nullptr; S0.K = 0; S0.bstride = 0; S0.G = G; S0.c = bx; S0.tab = tab;
          const int half = tid >> 8, r = tid & 255; unsigned vals[NU_MAX / 2]; bool ok[NU_MAX / 2];
#pragma unroll
          for (int k = 0; k < NU_MAX / 2; ++k) { const int ui = 2 * k + half; pg8::Unit u; ok[k] = S0.next(ui, u); vals[k] = 0u;
              if (ok[k]) { const int cnt = tab[T_CNT / 4 + u.e], e = u.e; int p = u.rt * 256 + r; if (p > cnt - 1) p = cnt - 1;
                  int lo_ = 0, hi_ = NGRP - 1;
                  while (lo_ < hi_) { const int mid = (lo_ + hi_ + 1) >> 1; if (pre[mid * 32 + e] <= p) lo_ = mid; else hi_ = mid - 1; }
                  vals[k] = LOCL[((size_t)lo_ * 32 + e) * 128 + (p - pre[lo_ * 32 + e])]; } }
#pragma unroll
          for (int k = 0; k < NU_MAX / 2; ++k) if (ok[k]) tab[T_ROWTAB / 4 + (2 * k + half) * 256 + r] = (int)vals[k];
        }
        __syncthreads();
    }
#define PH7_BODY() do { \
        pg8::SchedMoE<true> S; S.A = (const char*)H8; S.Bt = (const char*)WGU8; S.K = DM / 2; S.bstride = (size_t)DM * DM; S.G = G; S.c = bx; S.tab = tab; \
        pg8::EpiGU E{ACT, RSTD, tab}; \
        pg8::gemm_phase<pg8::EpiGU, pg8::SchedMoE<true>, false, true>(lds + RING_OFF, DM / 2, S, E); } while (0)
    if (IN(7)) {
        if (PROBE_TWICE == 7) { PH7_BODY(); GRID_BAR(); }
        PH7_BODY();
        {
            const int NT4 = tab[T_NT / 4] * 4, remu = NT4 % G;
            const bool early = (remu == 0) || (bx >= remu); const int nE = (remu == 0) ? G : (G - remu), rank = (remu == 0) ? bx : (bx - remu);
            if (early) { LAS float* scr = (LAS float*)(lds + RING_OFF + wave * 16384);
                for (int r = rank * NWAVES + wave; r < 32 * 32 * 8; r += nE * NWAVES) {
                    const int e = r >> 8, q = r & 255, nb = 4 * (q >> 5) + (q & 3), kb = 2 * ((q >> 3) & 3) + ((q >> 2) & 1);
                    tr_item8(P.wd + (size_t)e * DEXP * DM, DM, 64 * kb, 32 * nb, WD8 + (size_t)e * DM * DEXP, 32 * nb, DEXP, nullptr, WD_SC, scr, lane); } }
        }
        if (BOTH(7)) GRID_BAR();
    }
    if (IN(8)) { REP(8) {
        pg8::SchedMoE<false> S; S.A = (const char*)ACT; S.Bt = (const char*)WD8; S.K = DEXP / 2; S.bstride = (size_t)DM * DEXP; S.G = G; S.c = bx; S.tab = tab;
        pg8::EpiDown E{Y, tab};
        pg8::gemm_phase<pg8::EpiDown, pg8::SchedMoE<false>, false, true>(lds + RING_OFF, DEXP / 2, S, E);
        REPBAR(8); }
        if (BOTH(8)) GRID_BAR();
    }
    if (IN(9)) { REP(9) {
        for (int m0 = gw; m0 < NTOK; m0 += 2 * NGW) {
            bf16x8 hv[2][2]; u32x4 ya[2], yb[2]; float g0[2], g1[2];
#pragma unroll
            for (int t = 0; t < 2; ++t) { int m = m0 + t * NGW; if (m >= NTOK) m = m0;
                g0[t] = GATE[2 * m] * (1.f / Y_SC); g1[t] = GATE[2 * m + 1] * (1.f / Y_SC);
                const bf16* hp = H + (size_t)m * DM + 16 * lane; const unsigned char* y0 = Y + (size_t)(2 * m) * DM + 16 * lane;
                hv[t][0] = *(const bf16x8*)(hp); hv[t][1] = *(const bf16x8*)(hp + 8); ya[t] = *(const u32x4*)(y0); yb[t] = *(const u32x4*)(y0 + DM); }
#pragma unroll
            for (int t = 0; t < 2; ++t) { const int m = m0 + t * NGW; if (m < NTOK) {
                float* op = P.out + (size_t)m * DM + 16 * lane;
#pragma unroll
                for (int q = 0; q < 4; ++q) { const unsigned wa = ya[t][q], wb = yb[t][q];
                    const f32x2_t a0 = __builtin_amdgcn_cvt_pk_f32_fp8((int)wa, false), a1 = __builtin_amdgcn_cvt_pk_f32_fp8((int)wa, true);
                    const f32x2_t b0 = __builtin_amdgcn_cvt_pk_f32_fp8((int)wb, false), b1 = __builtin_amdgcn_cvt_pk_f32_fp8((int)wb, true);
                    const bf16x8 hh = hv[t][q >> 1]; const int e0 = 4 * (q & 1);
                    f32x4 o; o[0] = bf2f(hh[e0]) + g0[t] * a0.x + g1[t] * b0.x; o[1] = bf2f(hh[e0 + 1]) + g0[t] * a0.y + g1[t] * b0.y;
                    o[2] = bf2f(hh[e0 + 2]) + g0[t] * a1.x + g1[t] * b1.x; o[3] = bf2f(hh[e0 + 3]) + g0[t] * a1.y + g1[t] * b1.y;
                    *(f32x4*)(op + 4 * q) = o; } } }
        }
    REPBAR(9); } }
#undef IN
#undef BOTH
}

extern "C" void kernel_launch(void* const* d_in, const int* in_sizes, int n_in, void* d_out, int out_size, void* d_ws, size_t ws_size, hipStream_t stream) {
    static int grid = 0;
    if (grid == 0) {
        if (n_in != 18 || in_sizes[0] != NTOK * DM || out_size != NTOK * DM || ws_size < WS_END) { fprintf(stderr, "kernel_launch: unexpected shapes / workspace (n_in %d, in0 %d, out %d, ws %zu, need %zu)\n", n_in, n_in > 0 ? in_sizes[0] : -1, out_size, ws_size, (size_t)WS_END); grid = -1; return; }
        int dev = 0, cus = 0, per_cu = 0;
        if (hipGetDevice(&dev) != hipSuccess || hipDeviceGetAttribute(&cus, hipDeviceAttributeMultiprocessorCount, dev) != hipSuccess) { grid = -1; return; }
        if (hipFuncSetAttribute((const void*)fwd_kernel, hipFuncAttributeMaxDynamicSharedMemorySize, LDS_BYTES) != hipSuccess) { fprintf(stderr, "kernel_launch: hipFuncSetAttribute failed\n"); grid = -1; return; }
        if (hipOccupancyMaxActiveBlocksPerMultiprocessor(&per_cu, (const void*)fwd_kernel, NWAVES * 64, LDS_BYTES) != hipSuccess || per_cu < 1) fprintf(stderr, "kernel_launch: occupancy query reports %d\n", per_cu);
        (void)hipGetLastError();
        grid = cus;
    }
    if (grid < 0) return;
    if (hipMemsetAsync((char*)d_ws + WS_CTL, 0, CTL_ZERO_BYTES, stream) != hipSuccess) return;
    Args a{};
    const float** pp = (const float**)&a.p;
    for (int i = 0; i < 18; ++i) pp[i] = (const float*)d_in[i];
    a.p.out = (float*)d_out; a.p.ws = (unsigned char*)d_ws;
    if (MK_N_LAUNCHES == 1) { a.ph_lo = 0; a.ph_hi = N_PHASES; hipLaunchKernelGGL(fwd_kernel, dim3(grid), dim3(NWAVES * 64), LDS_BYTES, stream, a); }
    else for (int li = 0; li < N_PHASES; ++li) { a.ph_lo = li; a.ph_hi = li + 1; hipLaunchKernelGGL(fwd_kernel, dim3(grid), dim3(NWAVES * 64), LDS_BYTES, stream, a); }
}
```

```cpp
#include <hip/hip_runtime.h>
#include <cstdio>
#include <cstdint>

#ifndef MK_N_LAUNCHES
#define MK_N_LAUNCHES 1
#endif

#define LAS __attribute__((address_space(3)))
#define GAS __attribute__((address_space(1)))
typedef unsigned short bf16;
typedef short bf16x8 __attribute__((ext_vector_type(8)));
typedef float f32x4 __attribute__((ext_vector_type(4)));
typedef float f32x16 __attribute__((ext_vector_type(16)));
typedef unsigned u32x4 __attribute__((ext_vector_type(4)));
typedef unsigned u32x2 __attribute__((ext_vector_type(2)));
typedef float f32x2_t __attribute__((ext_vector_type(2)));
typedef __bf16 bf16x2_t __attribute__((ext_vector_type(2)));
typedef GAS unsigned gu32;
typedef int v8i __attribute__((ext_vector_type(8)));
typedef int v4i __attribute__((ext_vector_type(4)));
typedef _Float16 f16x8 __attribute__((ext_vector_type(8)));
typedef _Float16 f16x2 __attribute__((ext_vector_type(2)));

constexpr int BATCH = 16, SEQ = 2048, DM = 1024, NTOK = BATCH * SEQ;
constexpr int IN_DIM = 3088;
constexpr int NEXP = 32, DEXP = 512;
constexpr float EPS = 1e-6f;
constexpr float LOG2E = 1.4426950408889634f;
constexpr float WGU_SC = 64.f, WD_SC = 32.f, ACT_SC = 8.f, Y_SC = 8.f;
constexpr int NA = 1792, NB = 1280;
constexpr int NGRP = NTOK / 128;

constexpr size_t MiB = 1u << 20;
constexpr size_t WS_CTL = 0, CTL_ZERO_BYTES = 64 * 1024;
constexpr size_t WS_WA = 2 * MiB;
constexpr size_t WS_WB = 6 * MiB;
constexpr size_t WS_WO = 9 * MiB;
constexpr size_t WS_WR = 11 * MiB;
constexpr size_t WS_W2T = WS_WR + 2 * 48 * 1024 * 2;
constexpr size_t WS_WGU = 12 * MiB;
constexpr size_t WS_WD = 76 * MiB;
constexpr size_t WS_H = 108 * MiB;
constexpr size_t WS_KV = WS_H;
constexpr size_t WS_U = 172 * MiB;
constexpr size_t WS_MIX = WS_U;
constexpr size_t WS_SQ = 236 * MiB;
constexpr size_t WS_SK = 268 * MiB;
constexpr size_t WS_GQ = 300 * MiB;
constexpr size_t WS_GRS = 316 * MiB;
constexpr size_t WS_TT = 348 * MiB;
constexpr size_t WS_GLR = 428 * MiB;
constexpr size_t WS_ST = 429 * MiB;
constexpr size_t WS_DTOT = 461 * MiB;
constexpr size_t WS_ACT = 236 * MiB;
constexpr size_t WS_H8 = 272 * MiB;
constexpr size_t WS_Y = 308 * MiB;
constexpr size_t WS_LOCL = 462 * MiB;
constexpr size_t WS_CNTS = 467 * MiB;
constexpr size_t WS_GATE = 470 * MiB;
constexpr size_t WS_RSTD = WS_GATE + 512 * 1024;
constexpr size_t WS_END = 472 * MiB;
constexpr int CW_TMO = 0, CW_CODE = 1;
constexpr int CW_BAR = 4096;
constexpr int CW_CNT = 16384;

constexpr int RING_OFF = 0, RING_BYTES = 131072;
constexpr int LDSCTL_OFF = RING_BYTES, MISC_OFF = LDSCTL_OFF + 320;
constexpr int TAB_OFF = LDSCTL_OFF + 1024;
constexpr int LDS_BYTES = 147456;
constexpr int T_CNT = 0, T_TBASE = 128, T_NT = 264, T_TILE_E = 272, T_ROWTAB = 272 + 320 * 4, NU_MAX = 8;
static_assert(TAB_OFF + T_ROWTAB + NU_MAX * 256 * 4 <= LDS_BYTES, "LDS tables");

#define RLX_AGENT __ATOMIC_RELAXED, __HIP_MEMORY_SCOPE_AGENT
#define LDS_WAIT() asm volatile("s_waitcnt lgkmcnt(0)" ::: "memory")
#define VM_WAIT() asm volatile("s_waitcnt vmcnt(0)" ::: "memory")

__device__ __forceinline__ unsigned cvtpk(float lo, float hi) { f32x2_t v = {lo, hi}; bf16x2_t b = __builtin_convertvector(v, bf16x2_t); return __builtin_bit_cast(unsigned, b); }
__device__ __forceinline__ u32x2 pack8_fp8(const float* a) { int lo = __builtin_amdgcn_cvt_pk_fp8_f32(a[0], a[1], 0, false); lo = __builtin_amdgcn_cvt_pk_fp8_f32(a[2], a[3], lo, true);
    int hi = __builtin_amdgcn_cvt_pk_fp8_f32(a[4], a[5], 0, false); hi = __builtin_amdgcn_cvt_pk_fp8_f32(a[6], a[7], hi, true); u32x2 r; r.x = (unsigned)lo; r.y = (unsigned)hi; return r; }
__device__ __forceinline__ float bf2f(short s) { return __uint_as_float(((unsigned)(unsigned short)s) << 16); }
__device__ __forceinline__ bf16x8 pack8(const float* a) { u32x4 p; p.x = cvtpk(a[0], a[1]); p.y = cvtpk(a[2], a[3]); p.z = cvtpk(a[4], a[5]); p.w = cvtpk(a[6], a[7]); return __builtin_bit_cast(bf16x8, p); }
__device__ __forceinline__ int PI32(int i) { return 16 * ((i >> 2) & 1) + (i & 3) + 4 * (i >> 3); }
#define MFMA32(a, b, c) __builtin_amdgcn_mfma_f32_32x32x16_bf16((a), (b), (c), 0, 0, 0)
#define MFMA16(a, b, c) __builtin_amdgcn_mfma_f32_16x16x32_bf16((a), (b), (c), 0, 0, 0)
__device__ __forceinline__ void swap32(float x, float& lo, float& hi) { auto rr = __builtin_amdgcn_permlane32_swap(__float_as_uint(x), __float_as_uint(x), false, false); lo = __uint_as_float(rr[0]); hi = __uint_as_float(rr[1]); }

namespace pg8 {
#define PG8_LAS __attribute__((address_space(3)))
constexpr int BM = 256, BK = 64, HALF = 128, HTB = HALF * BK * 2, STAGE_BYTES = 8 * HTB, NXCD = 8, WGM = 8;
__host__ __device__ __forceinline__ int lds_byte(int r, int c) { const int st = (r >> 4) * 2 + (c >> 5), rr = r & 15, cc = c & 31, ob = rr * 64 + cc * 2; return st * 1024 + (ob ^ (((ob >> 9) & 1) << 5)); }
__host__ __device__ __forceinline__ void stage_rc(int b, int& R, int& C) { const int st = b / 1024, sb = b % 1024, swz = sb ^ (((sb >> 9) & 1) << 5); R = (st >> 1) * 16 + swz / 64; C = (st & 1) * 32 + (swz % 64) / 2; }
__host__ __device__ __forceinline__ int perm32(int rho) { const int n = rho >> 4, i = rho & 15; return 8 * (i >> 2) + 4 * n + (i & 3); }

struct Unit { int pm, pn, e, rt, nv; };

struct SchedDense {
    const char* A; const char* Bt; int K; int nM, nN, nwg, G, c;
    __device__ void init(const void* A_, const void* Bt_, int M, int N, int K_, int G_, int c_) { A = (const char*)A_; Bt = (const char*)Bt_; K = K_; nM = M / BM; nN = N / BM; nwg = nM * nN; G = G_; c = c_; }
    __device__ __forceinline__ bool next(int i, Unit& u) const {
        const long L = (long)i * G + c; if (L >= nwg) return false;
        int wgid = (int)L; { const int q = nwg / NXCD, r = nwg % NXCD, xcd = wgid % NXCD, off = wgid / NXCD; wgid = (xcd < r ? xcd * (q + 1) : r * (q + 1) + (xcd - r) * q) + off; }
        const int nig = WGM * nN, gid = wgid / nig, fm = gid * WGM, gsz = (nM - fm) < WGM ? (nM - fm) : WGM;
        u.pm = fm + ((wgid % nig) % gsz); u.pn = (wgid % nig) / gsz; u.e = 0; u.rt = 0; u.nv = 256; return true;
    }
    __device__ __forceinline__ const char* a_ptr(const Unit& u) const { return A + (size_t)u.pm * BM * K * 2; }
    __device__ __forceinline__ const char* b_ptr(const Unit& u) const { return Bt + (size_t)u.pn * BM * K * 2; }
    __device__ __forceinline__ void a_voff(int, const Unit&, int tid, unsigned (&v)[2][2]) const {
#pragma unroll
        for (int i = 0; i < 2; ++i) { int R, C; stage_rc(tid * 16 + i * 8192, R, C);
#pragma unroll
            for (int h = 0; h < 2; ++h) v[h][i] = (unsigned)((h * HALF + R) * K + C) * 2u; }
    }
};
template <bool GATHER> struct SchedMoE {
    const char* A; const char* Bt; int K; size_t bstride; int G, c;
    const PG8_LAS int* tab;
    __device__ __forceinline__ bool next(int i, Unit& u) const {
        const int L = i * G + c; const int NT = tab[T_NT / 4];
        if (L >= NT * 4) return false;
        const int tile = L >> 2; u.pm = tile; u.pn = L & 3; const int e = tab[T_TILE_E / 4 + tile]; u.e = e;
        u.rt = tile - tab[T_TBASE / 4 + e]; const int rem = tab[T_CNT / 4 + e] - u.rt * 256; u.nv = rem < 256 ? rem : 256; return true;
    }
    __device__ __forceinline__ const char* a_ptr(const Unit& u) const { return GATHER ? A : A + (size_t)u.pm * BM * K * 2; }
    __device__ __forceinline__ const char* b_ptr(const Unit& u) const { return Bt + (size_t)u.e * bstride + (size_t)u.pn * BM * K * 2; }
    __device__ __forceinline__ void a_voff(int ui, const Unit&, int tid, unsigned (&v)[2][2]) const {
        asm volatile("" : "+v"(tid));
#pragma unroll
        for (int i = 0; i < 2; ++i) { int R, C; stage_rc(tid * 16 + i * 8192, R, C);
#pragma unroll
            for (int h = 0; h < 2; ++h) {
                if (GATHER) { const int tok = tab[T_ROWTAB / 4 + ui * 256 + h * HALF + R] >> 1; v[h][i] = (unsigned)(tok * K + C) * 2u; }
                else v[h][i] = (unsigned)((h * HALF + R) * K + C) * 2u; } }
    }
};

template <class Epi, class Sched, bool TAIL = false, bool FP8 = false>
__device__ __forceinline__ void gemm_phase(PG8_LAS unsigned char* lds, const int K, const Sched& S, const Epi& E) {
    const int tid = threadIdx.x, wid = __builtin_amdgcn_readfirstlane(tid >> 6), lane = tid & 63, wr = wid >> 2, wc = wid & 3, fr = lane & 15, fq = lane >> 4;
    const int nt = K / BK;
    unsigned voffB[1][2];
#pragma unroll
    for (int i = 0; i < 2; ++i) { int R, C; stage_rc(tid * 16 + i * 8192, R, C); const int Rb = (R & ~31) + perm32(R & 31);
        voffB[0][i] = (unsigned)(Rb * K + C) * 2u; }
    const size_t hstepB = (size_t)HALF * K * 2;
    const size_t kstep = (size_t)(BK * 2);
    const unsigned ldsw = (unsigned)wid * 1024u;
    const int aoff = lds_byte(wr * 64 + fr, fq * 8), boff = lds_byte(wc * 32 + fr, fq * 8);
#define PG8_SA(b, h) (((b) * 2 + (h)) * HTB)
#define PG8_SB(b, h) ((4 + (b) * 2 + (h)) * HTB)
#define PG8_STAGE(bufoff, gbase, voff) do { _Pragma("unroll") for (int _i = 0; _i < 2; ++_i) \
        __builtin_amdgcn_global_load_lds((const unsigned*)((const char*)(gbase) + (voff)[_i]), (PG8_LAS unsigned*)(lds + (bufoff) + ldsw + _i * 8192), 16, 0, 0); } while (0)
#define PG8_RD16(off) (*(const PG8_LAS v4i*)(lds + (off)))
#define PG8_LDA(dst, b, h) do { _Pragma("unroll") for (int m = 0; m < 4; ++m) { \
        if constexpr (FP8) At8[m] = __builtin_shufflevector(PG8_RD16(PG8_SA(b, h) + aoff + m * 2048), PG8_RD16(PG8_SA(b, h) + aoff + m * 2048 + 1024), 0, 1, 2, 3, 4, 5, 6, 7); \
        else { _Pragma("unroll") for (int k = 0; k < 2; ++k) dst[m][k] = *(const PG8_LAS bf16x8*)(lds + PG8_SA(b, h) + aoff + m * 2048 + k * 1024); } } } while (0)
#define PG8_LDB(dst, b, h) do { _Pragma("unroll") for (int n = 0; n < 2; ++n) { \
        if constexpr (FP8) dst##8[n] = __builtin_shufflevector(PG8_RD16(PG8_SB(b, h) + boff + n * 2048), PG8_RD16(PG8_SB(b, h) + boff + n * 2048 + 1024), 0, 1, 2, 3, 4, 5, 6, 7); \
        else { _Pragma("unroll") for (int k = 0; k < 2; ++k) dst[n][k] = *(const PG8_LAS bf16x8*)(lds + PG8_SB(b, h) + boff + n * 2048 + k * 1024); } } } while (0)
#define PG8_MMA(ai, bj, At, Bt) do { __builtin_amdgcn_s_setprio(1); _Pragma("unroll") for (int m = 0; m < 4; ++m) _Pragma("unroll") for (int n = 0; n < 2; ++n) { \
        if constexpr (FP8) asm volatile("v_mfma_scale_f32_16x16x128_f8f6f4 %0, %1, %2, %0, %3, %3 op_sel_hi:[0,0,0]" : "+v"(acc[ai][bj][m][n]) : "v"(Bt##8[n]), "v"(At8[m]), "v"(sc1)); \
        else { _Pragma("unroll") for (int k = 0; k < 2; ++k) acc[ai][bj][m][n] = __builtin_amdgcn_mfma_f32_16x16x32_bf16(Bt[n][k], At[m][k], acc[ai][bj][m][n], 0, 0, 0); } } \
        __builtin_amdgcn_s_setprio(0); } while (0)
#define PG8_WAIT_V(n) asm volatile("s_waitcnt vmcnt(" #n ")" ::: "memory")
#define PG8_WAIT_L(n) asm volatile("s_waitcnt lgkmcnt(" #n ")" ::: "memory")
#define PG8_BAR __builtin_amdgcn_s_barrier()
#define PG8_SCHED __builtin_amdgcn_sched_barrier(0)
    Unit cur, nxt; int ui = 0;
    if (!S.next(0, cur)) return;
    f32x4 acc[2][2][4][2];
#pragma unroll
    for (int a = 0; a < 2; ++a)
#pragma unroll
        for (int b = 0; b < 2; ++b)
#pragma unroll
            for (int m = 0; m < 4; ++m)
#pragma unroll
                for (int n = 0; n < 2; ++n) acc[a][b][m][n] = (f32x4){0.f, 0.f, 0.f, 0.f};
    bf16x8 At[4][2], B0[2][2], B1[2][2];
    v8i At8[4], B08[2], B18[2];
    int sc1 = 0x7f7f7f7f; asm volatile("" : "+v"(sc1));
    unsigned vc[2][2], vn[2][2];
    S.a_voff(0, cur, tid, vc);
    const char* cA = S.a_ptr(cur); const char* cB = S.b_ptr(cur);
    PG8_STAGE(PG8_SB(0, 0), cB, voffB[0]); PG8_STAGE(PG8_SB(0, 1), (cB) + hstepB, voffB[0]); PG8_STAGE(PG8_SA(0, 0), cA, vc[0]); PG8_STAGE(PG8_SA(0, 1), cA, vc[1]);
    if (wr == 1) PG8_BAR;
    PG8_WAIT_V(2); PG8_BAR;
    PG8_STAGE(PG8_SB(1, 0), cB + kstep, voffB[0]); PG8_STAGE(PG8_SA(1, 0), cA + kstep, vc[0]); PG8_STAGE(PG8_SB(1, 1), (cB + kstep) + hstepB, voffB[0]);
    PG8_WAIT_V(6); PG8_BAR;
    for (;;) {
        const bool has_next = S.next(ui + 1, nxt);
        const char* nA = has_next ? S.a_ptr(nxt) : cA; const char* nB = has_next ? S.b_ptr(nxt) : cB;
        if (has_next) S.a_voff(ui + 1, nxt, tid, vn);
        else {
#pragma unroll
            for (int h = 0; h < 2; ++h)
#pragma unroll
                for (int i = 0; i < 2; ++i) vn[h][i] = vc[h][i]; }
        const bool full_hi = !TAIL || cur.nv > HALF;
        for (int t = 0; t < nt; t += 2) {
            const bool last = (t == nt - 2);
            const char* a1 = cA + (size_t)(t + 1) * kstep;
            const char* a2 = last ? nA : cA + (size_t)(t + 2) * kstep; const char* b2 = last ? nB : cB + (size_t)(t + 2) * kstep;
            const char* a3 = a2 + kstep; const char* b3 = b2 + kstep;
            unsigned w0[2], w1[2];
            w0[0] = last ? vn[0][0] : vc[0][0]; w0[1] = last ? vn[0][1] : vc[0][1]; w1[0] = last ? vn[1][0] : vc[1][0]; w1[1] = last ? vn[1][1] : vc[1][1];
            PG8_LDB(B0, 0, 0); PG8_LDB(B1, 0, 1); PG8_SCHED; PG8_LDA(At, 0, 0); PG8_STAGE(PG8_SA(1, 1), a1, vc[1]);
            PG8_WAIT_V(8); PG8_WAIT_L(0); PG8_BAR; PG8_MMA(0, 0, At, B0); PG8_MMA(0, 1, At, B1); PG8_BAR; PG8_SCHED;
            PG8_LDA(At, 0, 1); PG8_STAGE(PG8_SB(0, 0), b2, voffB[0]); PG8_STAGE(PG8_SB(0, 1), (b2) + hstepB, voffB[0]); PG8_STAGE(PG8_SA(0, 0), a2, w0);
            PG8_WAIT_V(8); PG8_WAIT_L(0); PG8_BAR; if (full_hi) { PG8_MMA(1, 0, At, B0); PG8_MMA(1, 1, At, B1); } PG8_BAR; PG8_SCHED;
            PG8_LDB(B0, 1, 0); PG8_LDB(B1, 1, 1); PG8_SCHED; PG8_LDA(At, 1, 0); PG8_STAGE(PG8_SA(0, 1), a2, w1);
            PG8_WAIT_V(8); PG8_WAIT_L(0); PG8_BAR; PG8_MMA(0, 0, At, B0); PG8_MMA(0, 1, At, B1); PG8_BAR; PG8_SCHED;
            PG8_LDA(At, 1, 1); PG8_STAGE(PG8_SB(1, 0), b3, voffB[0]); PG8_STAGE(PG8_SB(1, 1), (b3) + hstepB, voffB[0]); PG8_STAGE(PG8_SA(1, 0), a3, w0);
            PG8_WAIT_V(8); PG8_WAIT_L(0); PG8_BAR; if (full_hi) { PG8_MMA(1, 0, At, B0); PG8_MMA(1, 1, At, B1); } PG8_BAR; PG8_SCHED;
        }
        if (wr == 0) PG8_BAR;
        if constexpr (FP8) asm volatile("s_nop 15\n\ts_nop 15" ::: "memory");
        { int t2_ = threadIdx.x; asm volatile("" : "+v"(t2_)); E(acc, cur, ui, wr, wc, t2_ & 15, (t2_ >> 4) & 3); }
        if (!has_next) break;
#pragma unroll
        for (int a = 0; a < 2; ++a)
#pragma unroll
            for (int b = 0; b < 2; ++b)
#pragma unroll
                for (int m = 0; m < 4; ++m)
#pragma unroll
                    for (int n = 0; n < 2; ++n) acc[a][b][m][n] = (f32x4){0.f, 0.f, 0.f, 0.f};
        cur = nxt; cA = nA; cB = nB; ++ui;
#pragma unroll
        for (int h = 0; h < 2; ++h)
#pragma unroll
            for (int i = 0; i < 2; ++i) vc[h][i] = vn[h][i];
        if (wr == 1) PG8_BAR;
    }
    PG8_WAIT_V(0);
    PG8_BAR;
#undef PG8_SA
#undef PG8_SB
#undef PG8_STAGE
#undef PG8_LDA
#undef PG8_LDB
#undef PG8_MMA
#undef PG8_RD16
#undef PG8_WAIT_V
#undef PG8_WAIT_L
#undef PG8_BAR
#undef PG8_SCHED
}

struct EpiBf16 {
    bf16* O; int ldc;
    __device__ __forceinline__ void operator()(const f32x4 (&acc)[2][2][4][2], const Unit& u, int, int wr, int wc, int fr, int fq) const {
        const int row0 = u.pm * BM + wr * 64 + fr, col0 = u.pn * BM + wc * 32 + 8 * fq;
#pragma unroll
        for (int ai = 0; ai < 2; ++ai)
#pragma unroll
            for (int m = 0; m < 4; ++m) { bf16* rowp = O + (size_t)(row0 + ai * HALF + m * 16) * ldc + col0;
#pragma unroll
                for (int bj = 0; bj < 2; ++bj) { const f32x4 v0 = acc[ai][bj][m][0], v1 = acc[ai][bj][m][1];
                    u32x4 w; w.x = cvtpk(v0[0], v0[1]); w.y = cvtpk(v0[2], v0[3]); w.z = cvtpk(v1[0], v1[1]); w.w = cvtpk(v1[2], v1[3]);
                    *(u32x4*)(rowp + bj * HALF) = w; } }
    }
};
struct EpiTT {
    bf16* O;
    __device__ __forceinline__ void operator()(const f32x4 (&acc)[2][2][4][2], const Unit& u, int, int wr, int wc, int fr, int fq) const {
        const int row0 = u.pm * BM + wr * 64 + fr, tokb0 = u.pn * 8 + wc;
#pragma unroll
        for (int ai = 0; ai < 2; ++ai)
#pragma unroll
            for (int m = 0; m < 4; ++m) { const int col = row0 + ai * HALF + m * 16;
#pragma unroll
                for (int bj = 0; bj < 2; ++bj) { const f32x4 v0 = acc[ai][bj][m][0], v1 = acc[ai][bj][m][1];
                    u32x4 w; w.x = cvtpk(v0[0], v0[1]); w.y = cvtpk(v0[2], v0[3]); w.z = cvtpk(v1[0], v1[1]); w.w = cvtpk(v1[2], v1[3]);
                    *(u32x4*)(O + ((size_t)(tokb0 + 4 * bj) * 1280 + col) * 32 + 8 * fq) = w; } }
    }
};
struct EpiA {
    bf16 *SQ, *SK, *GQ, *GRS; const float *gq_norm, *gk_norm;
    __device__ __forceinline__ void operator()(const f32x4 (&acc)[2][2][4][2], const Unit& u, int, int wr, int wc, int fr, int fq) const {
        const int pn = u.pn; const int row0 = u.pm * BM + wr * 64 + fr;
        bf16* base; int ldc, colt; int mode;
        float scale = 1.f; const float* gain = nullptr;
        if (pn < 2)      { base = SQ; ldc = 512; colt = pn * 256; mode = 0; gain = gq_norm; scale = 0.125f * LOG2E; }
        else if (pn < 4) { base = SK; ldc = 512; colt = (pn - 2) * 256; mode = 0; gain = gk_norm; scale = 1.f; }
        else if (pn < 5) { base = GQ; ldc = 256; colt = 0; mode = 1; scale = 0.125f; }
        else             { base = GRS; ldc = 512; colt = (pn - 5) * 256; mode = 2; }
        const int col0 = colt + wc * 64 + 8 * fq;
        f32x4 gv[2][2];
#pragma unroll
        for (int bj = 0; bj < 2; ++bj)
#pragma unroll
            for (int n = 0; n < 2; ++n) { if (mode == 0) { gv[bj][n] = *(const f32x4*)(gain + 32 * bj + 8 * fq + 4 * n); gv[bj][n] = gv[bj][n] * scale; } else gv[bj][n] = (f32x4){scale, scale, scale, scale}; }
#pragma unroll
        for (int ai = 0; ai < 2; ++ai)
#pragma unroll
            for (int m = 0; m < 4; ++m) {
                float rs = 1.f;
                if (mode == 0) { float s = 0.f;
#pragma unroll
                    for (int bj = 0; bj < 2; ++bj)
#pragma unroll
                        for (int n = 0; n < 2; ++n) { const f32x4 x = acc[ai][bj][m][n]; s += (x[0] * x[0] + x[1] * x[1]) + (x[2] * x[2] + x[3] * x[3]); }
                    s += __shfl_xor(s, 16); s += __shfl_xor(s, 32);
                    rs = __builtin_amdgcn_rsqf(s * (1.f / 64.f) + EPS); }
                bf16* rowp = base + (size_t)(row0 + ai * HALF + m * 16) * ldc + col0;
#pragma unroll
                for (int bj = 0; bj < 2; ++bj) { f32x4 v0 = acc[ai][bj][m][0], v1 = acc[ai][bj][m][1];
                    if (mode == 2) {
#pragma unroll
                        for (int e = 0; e < 4; ++e) { v0[e] = v0[e] * __builtin_amdgcn_rcpf(1.f + __builtin_amdgcn_exp2f(-v0[e] * LOG2E)); v1[e] = v1[e] * __builtin_amdgcn_rcpf(1.f + __builtin_amdgcn_exp2f(-v1[e] * LOG2E)); }
                    } else { v0 = v0 * rs * gv[bj][0]; v1 = v1 * rs * gv[bj][1]; }
                    u32x4 w; w.x = cvtpk(v0[0], v0[1]); w.y = cvtpk(v0[2], v0[3]); w.z = cvtpk(v1[0], v1[1]); w.w = cvtpk(v1[2], v1[3]);
                    *(u32x4*)(rowp + bj * 32) = w; } }
    }
};
struct EpiH {
    const float* X; bf16* H; unsigned char* H8;
    __device__ __forceinline__ void operator()(const f32x4 (&acc)[2][2][4][2], const Unit& u, int, int wr, int wc, int fr, int fq) const {
        const int row0 = u.pm * BM + wr * 64 + fr, col0 = u.pn * BM + wc * 32 + 8 * fq;
#pragma unroll
        for (int ai = 0; ai < 2; ++ai) {
            f32x4 xv[4][2][2];
#pragma unroll
            for (int m = 0; m < 4; ++m) { const size_t off = (size_t)(row0 + ai * HALF + m * 16) * DM + col0;
#pragma unroll
                for (int bj = 0; bj < 2; ++bj) { xv[m][bj][0] = *(const f32x4*)(X + off + bj * HALF); xv[m][bj][1] = *(const f32x4*)(X + off + bj * HALF + 4); } }
#pragma unroll
            for (int m = 0; m < 4; ++m) { const size_t off = (size_t)(row0 + ai * HALF + m * 16) * DM + col0;
#pragma unroll
                for (int bj = 0; bj < 2; ++bj) { const f32x4 v0 = acc[ai][bj][m][0] + xv[m][bj][0], v1 = acc[ai][bj][m][1] + xv[m][bj][1];
                    u32x4 w; w.x = cvtpk(v0[0], v0[1]); w.y = cvtpk(v0[2], v0[3]); w.z = cvtpk(v1[0], v1[1]); w.w = cvtpk(v1[2], v1[3]);
                    *(u32x4*)(H + off + bj * HALF) = w;
                    const float f8[8] = {v0[0], v0[1], v0[2], v0[3], v1[0], v1[1], v1[2], v1[3]};
                    *(u32x2*)(H8 + off + bj * HALF) = pack8_fp8(f8); } }
        }
    }
};
struct EpiGU {
    unsigned char* ACT; const float* RSTD; const PG8_LAS int* tab;
    __device__ __forceinline__ void operator()(const f32x4 (&acc)[2][2][4][2], const Unit& u, int ui, int wr, int wc, int fr, int fq) const {
        const int col0 = u.pn * 128 + wc * 32 + 8 * fq;
        float rsv[2][4];
#pragma unroll
        for (int ai = 0; ai < 2; ++ai)
#pragma unroll
            for (int m = 0; m < 4; ++m) { const int rl = ai * HALF + wr * 64 + m * 16 + fr; rsv[ai][m] = RSTD[tab[T_ROWTAB / 4 + ui * 256 + rl] >> 1]; }
#pragma unroll
        for (int ai = 0; ai < 2; ++ai)
#pragma unroll
            for (int m = 0; m < 4; ++m) { const int rl = ai * HALF + wr * 64 + m * 16 + fr;
                if (rl < u.nv) {
                    const float rs = rsv[ai][m] * (1.f / WGU_SC);
                    f32x4 g0 = acc[ai][0][m][0] * rs, g1 = acc[ai][0][m][1] * rs, u0 = acc[ai][1][m][0] * rs, u1 = acc[ai][1][m][1] * rs;
#pragma unroll
                    for (int e = 0; e < 4; ++e) { g0[e] = g0[e] * __builtin_amdgcn_rcpf(1.f + __builtin_amdgcn_exp2f(-g0[e] * LOG2E)) * u0[e]; g1[e] = g1[e] * __builtin_amdgcn_rcpf(1.f + __builtin_amdgcn_exp2f(-g1[e] * LOG2E)) * u1[e]; }
                    float f8[8] = {g0[0] * ACT_SC, g0[1] * ACT_SC, g0[2] * ACT_SC, g0[3] * ACT_SC, g1[0] * ACT_SC, g1[1] * ACT_SC, g1[2] * ACT_SC, g1[3] * ACT_SC};
#pragma unroll
                    for (int e = 0; e < 8; ++e) f8[e] = __builtin_fminf(__builtin_fmaxf(f8[e], -448.f), 448.f);
                    *(u32x2*)(ACT + (size_t)(u.pm * 256 + rl) * DEXP + col0) = pack8_fp8(f8); } }
    }
};
struct EpiDown {
    unsigned char* Y; const PG8_LAS int* tab;
    __device__ __forceinline__ void operator()(const f32x4 (&acc)[2][2][4][2], const Unit& u, int ui, int wr, int wc, int fr, int fq) const {
        const int col0 = u.pn * BM + wc * 32 + 8 * fq; const float sc = Y_SC / (WD_SC * ACT_SC);
#pragma unroll
        for (int ai = 0; ai < 2; ++ai)
#pragma unroll
            for (int m = 0; m < 4; ++m) { const int rl = ai * HALF + wr * 64 + m * 16 + fr;
                if (rl < u.nv) { const unsigned ts = (unsigned)tab[T_ROWTAB / 4 + ui * 256 + rl]; unsigned char* rowp = Y + (size_t)ts * DM + col0;
#pragma unroll
                    for (int bj = 0; bj < 2; ++bj) { const f32x4 v0 = acc[ai][bj][m][0] * sc, v1 = acc[ai][bj][m][1] * sc;
                        const float f8[8] = {v0[0], v0[1], v0[2], v0[3], v1[0], v1[1], v1[2], v1[3]};
                        *(u32x2*)(rowp + bj * HALF) = pack8_fp8(f8); } } }
    }
};
}

#define XB_TMO      128
#define XB_XCNT(j)  (256  + 64 * (j))
#define XB_XSUB(j)  (1280 + 64 * (j))
#define XB_XGEN(j)  (2304 + 64 * (j))
#define XB_TOP      3328
#define XB_TOPGEN   3392
#define XCD_BAR_WORDS 3456
#define XB_SPIN_CAP (1u << 18)
__device__ __forceinline__ unsigned xb_ld(unsigned* p)              { return __hip_atomic_load(p, __ATOMIC_RELAXED, __HIP_MEMORY_SCOPE_AGENT); }
__device__ __forceinline__ unsigned xb_add(unsigned* p, unsigned v) { return __hip_atomic_fetch_add(p, v, __ATOMIC_RELAXED, __HIP_MEMORY_SCOPE_AGENT); }
__device__ __forceinline__ unsigned xb_xcc_id() { return (unsigned)__builtin_amdgcn_s_getreg((3 << 11) | 20) & 0xFu; }
#define XB_SPIN(cond, bar) do { unsigned _sp = 0; while (cond) { __builtin_amdgcn_s_sleep(1); \
    if ((++_sp & 255u) == 0u) { if (xb_ld(&(bar)[XB_TMO])) break; if (_sp > XB_SPIN_CAP) { atomicAdd(&(bar)[XB_TMO], 1u); break; } } } } while (0)
struct XcdBarrier { unsigned* bar; unsigned x; volatile LAS unsigned* st; };
__device__ __forceinline__ XcdBarrier xcd_barrier_post(unsigned* bar, volatile LAS unsigned* st) {
    XcdBarrier b; b.bar = bar; b.x = xb_xcc_id(); b.st = st;
    if (threadIdx.x == 0) (void)xb_add(&bar[XB_XCNT(b.x)], 1u);
    return b;
}
__device__ __forceinline__ void xcd_barrier_complete(unsigned* bar, unsigned x, unsigned& nloc, unsigned& nx) {
    const unsigned G = gridDim.x * gridDim.y * gridDim.z;
    unsigned sum, cnt, mine, sp = 0u;
    for (;;) {
        sum = 0u; cnt = 0u; mine = 0u;
#pragma unroll
        for (unsigned j = 0; j < 16; ++j) { const unsigned c = xb_ld(&bar[XB_XCNT(j)]); sum += c; cnt += (c > 0u) ? 1u : 0u; mine = (j == x) ? c : mine; }
        if (sum == G) break;
        __builtin_amdgcn_s_sleep(1);
        if ((++sp & 255u) == 0u) { if (xb_ld(&bar[XB_TMO])) break; if (sp > XB_SPIN_CAP) { atomicAdd(&bar[XB_TMO], 1u); break; } }
    }
    nloc = mine > 0u ? mine : 1u; nx = cnt > 0u ? cnt : 1u;
}
__device__ __forceinline__ void xcd_barrier(const XcdBarrier& b) {
    asm volatile("s_waitcnt vmcnt(0)" ::: "memory");
    __syncthreads();
    if (threadIdx.x == 0) {
        unsigned* bar = b.bar;
        __builtin_amdgcn_s_waitcnt(0);
        unsigned nloc = b.st[0], nx = b.st[1];
        if (nloc == 0u) { xcd_barrier_complete(bar, b.x, nloc, nx); b.st[0] = nloc; b.st[1] = nx; }
        const unsigned old = xb_add(&bar[XB_XSUB(b.x)], 1u);
        const unsigned gen = old / nloc;
        if (old + 1u == (gen + 1u) * nloc) {
            __builtin_amdgcn_fence(__ATOMIC_RELEASE, "agent");
            asm volatile("s_waitcnt vmcnt(0)" ::: "memory");
            const unsigned og = xb_add(&bar[XB_TOP], 1u);
            const unsigned tg = og / nx;
            if (og + 1u == (tg + 1u) * nx) xb_add(&bar[XB_TOPGEN], 1u);
            else XB_SPIN(xb_ld(&bar[XB_TOPGEN]) == tg, bar);
            __builtin_amdgcn_fence(__ATOMIC_ACQUIRE, "agent");
            xb_add(&bar[XB_XGEN(b.x)], 1u);
            asm volatile("s_waitcnt vmcnt(0)" ::: "memory");
        } else {
            XB_SPIN(xb_ld(&bar[XB_XGEN(b.x)]) == gen, bar);
            __builtin_amdgcn_fence(__ATOMIC_ACQUIRE, "agent");
            asm volatile("s_waitcnt vmcnt(0)" ::: "memory");
        }
    }
    __syncthreads();
}

__device__ __forceinline__ float wave_sum(float v) {
#pragma unroll
    for (int o = 1; o < 64; o <<= 1) v += __shfl_xor(v, o);
    return v;
}
__device__ __forceinline__ void tr_item(const float* src, int srcN, int k0, int n0, bf16* dst, int drow0, int dK, const float* kscale, LAS float* scr, int lane) {
    float w[32];
    const float* sp = src + (size_t)(k0 + (lane >> 5)) * srcN + n0 + (lane & 31);
#pragma unroll
    for (int i = 0; i < 32; ++i) w[i] = sp[(size_t)(2 * i) * srcN];
    if (kscale) { const float ksv = kscale[k0 + lane];
#pragma unroll
        for (int i = 0; i < 32; ++i) { const float a = __int_as_float(__builtin_amdgcn_readlane(__float_as_int(ksv), 2 * i)), b = __int_as_float(__builtin_amdgcn_readlane(__float_as_int(ksv), 2 * i + 1)); w[i] *= (lane >> 5) ? b : a; } }
#pragma unroll
    for (int i = 0; i < 32; ++i) scr[(2 * i + (lane >> 5)) * 33 + (lane & 31)] = w[i];
    LDS_WAIT(); asm volatile("" ::: "memory");
    const int c = lane & 7;
#pragma unroll
    for (int j = 0; j < 4; ++j) { const int n = (lane >> 3) + 8 * j; const LAS float* s = scr + (8 * c) * 33 + n;
        u32x4 o; o.x = cvtpk(s[0 * 33], s[1 * 33]); o.y = cvtpk(s[2 * 33], s[3 * 33]); o.z = cvtpk(s[4 * 33], s[5 * 33]); o.w = cvtpk(s[6 * 33], s[7 * 33]);
        *(GAS u32x4*)(dst + (size_t)(drow0 + n) * dK + k0 + 8 * c) = o; }
    LDS_WAIT(); asm volatile("" ::: "memory");
}

__device__ __forceinline__ void tr_item8(const float* src, int srcN, int k0, int n0, unsigned char* dst, int drow0, int dK, const float* kscale, float scale, LAS float* scr, int lane) {
    float w[32];
    const float* sp = src + (size_t)(k0 + (lane >> 5)) * srcN + n0 + (lane & 31);
#pragma unroll
    for (int i = 0; i < 32; ++i) w[i] = sp[(size_t)(2 * i) * srcN];
    float ksv = scale; if (kscale) ksv *= kscale[k0 + lane];
#pragma unroll
    for (int i = 0; i < 32; ++i) { const float a = __int_as_float(__builtin_amdgcn_readlane(__float_as_int(ksv), 2 * i)), b = __int_as_float(__builtin_amdgcn_readlane(__float_as_int(ksv), 2 * i + 1)); w[i] *= (lane >> 5) ? b : a; }
#pragma unroll
    for (int i = 0; i < 32; ++i) scr[(2 * i + (lane >> 5)) * 33 + (lane & 31)] = w[i];
    LDS_WAIT(); asm volatile("" ::: "memory");
#pragma unroll
    for (int j = 0; j < 2; ++j) { const int idx = lane + 64 * j, n = idx >> 2, c = idx & 3; const LAS float* sc_ = scr + (16 * c) * 33 + n;
        float f[16];
#pragma unroll
        for (int i = 0; i < 16; ++i) f[i] = sc_[i * 33];
        const u32x2 lo = pack8_fp8(f), hi = pack8_fp8(f + 8);
        u32x4 o; o.x = lo.x; o.y = lo.y; o.z = hi.x; o.w = hi.y;
        *(GAS u32x4*)(dst + (size_t)(drow0 + n) * dK + k0 + 16 * c) = o; }
    LDS_WAIT(); asm volatile("" ::: "memory");
}

struct Ptrs {
    const float *x, *attn_g, *w_in, *sbq_g, *sbk_g, *sbo_g, *w2, *gate_b, *glan_g, *w_out, *ffn_g, *rg_w, *rg_b, *re_w, *re_b, *wg, *wu, *wd;
    float* out; unsigned char* ws;
};

constexpr int SB_SPAN = 14, SB_VOFF = SB_SPAN * 4096;
__device__ __forceinline__ int sb_keyK(int r) { return ((r >> 1) & 3) | (((r >> 4) & 1) << 2); }
__device__ __forceinline__ int sb_keyV(int r) { return ((r >> 2) & 1) | (((r >> 4) & 1) << 1); }
__device__ __forceinline__ void sb_round(LAS unsigned char* lds, const bf16* SQ, const bf16* SK, const bf16* TT, const float* gout, bf16* MIX, int b, int h, int qg, int tid, int wave, int lane) {
    const int il = lane & 31, hi = lane >> 5, pil = PI32(il);
    const int qt = 8 * qg + wave;
    const size_t row0 = (size_t)b * SEQ + (size_t)qt * 32;
    bf16x8 qf[4];
    { const bf16* qp = SQ + (row0 + il) * 512 + h * 64 + 32 * hi;
#pragma unroll
      for (int s = 0; s < 4; ++s) qf[s] = *(const bf16x8*)(qp + 8 * s); }
    const int lo = (8 * qg - 6) > 0 ? (8 * qg - 6) : 0, nblk = 8 * qg + 8 - lo;
    {
        u32x4 st[SB_SPAN];
        const bool isK = tid < 256; const int q = tid - 256;
        const bf16* src = isK ? SK + ((size_t)b * SEQ + (size_t)lo * 32 + (tid >> 3)) * 512 + h * 64 + 8 * (tid & 7)
                              : TT + ((size_t)(b * (SEQ / 32) + lo) * NB + h * 64 + (q >> 2)) * 32 + 8 * (q & 3);
        const size_t bstep = isK ? (size_t)32 * 512 : (size_t)NB * 32;
#pragma unroll
        for (int i = 0; i < SB_SPAN; ++i) if (i < nblk) st[i] = *(const u32x4*)(src + (size_t)i * bstep);
        const int r = isK ? (tid >> 3) : (q >> 2);
        const unsigned dst = isK ? (unsigned)(r * 128 + (((tid & 7) ^ sb_keyK(r)) << 4)) : (unsigned)(SB_VOFF + r * 64 + (((q & 3) ^ sb_keyV(r & 31)) << 4));
#pragma unroll
        for (int i = 0; i < SB_SPAN; ++i) if (i < nblk) *(LAS u32x4*)(lds + dst + i * 4096) = st[i];
    }
    __syncthreads();
    f32x16 o0, o1;
#pragma unroll
    for (int r = 0; r < 16; ++r) { o0[r] = 0.f; o1[r] = 0.f; }
    float R = 1.f;
#define SB_MATH(KC, VC, kb_) do { \
        f32x16 z; \
        _Pragma("unroll") for (int r = 0; r < 16; ++r) z[r] = 0.f; \
        _Pragma("unroll") for (int s = 0; s < 4; ++s) z = MFMA32(KC[s], qf[s], z); \
        float beta[16], omb[16]; \
        const bool diag = ((kb_) == qt); \
        _Pragma("unroll") for (int r = 0; r < 16; ++r) { \
            const float zz = z[r]; const float t = __builtin_amdgcn_exp2f(-__builtin_fabsf(zz)); const float rr = __builtin_amdgcn_rcpf(1.f + t); const float sm = t * rr; \
            const bool pos = zz >= 0.f; float be = pos ? rr : sm; float om = pos ? sm : rr; \
            if (diag) { const bool valid = (16 * hi + r) < il; be = valid ? be : 0.f; om = valid ? om : 1.f; } \
            beta[r] = be; omb[r] = om; } \
        float e[16]; e[15] = 1.f; \
        _Pragma("unroll") for (int r = 14; r >= 0; --r) e[r] = e[r + 1] * omb[r + 1]; \
        const float P16 = e[0] * omb[0]; \
        float Plo, Phi; swap32(P16, Plo, Phi); \
        const float base = R * (hi ? 1.f : Phi); \
        float a[16]; \
        _Pragma("unroll") for (int r = 0; r < 16; ++r) a[r] = beta[r] * e[r] * base; \
        R = R * (Plo * Phi); \
        const bf16x8 p0 = pack8(a), p1 = pack8(a + 8); \
        o0 = MFMA32(VC[0][0], p0, o0); o0 = MFMA32(VC[0][1], p1, o0); \
        o1 = MFMA32(VC[1][0], p0, o1); o1 = MFMA32(VC[1][1], p1, o1); } while (0)
    bool fin = false;
    {
        const unsigned kbase = (unsigned)(pil * 128), vbase = (unsigned)(SB_VOFF + pil * 64);
        unsigned kx[4], vx[2];
#pragma unroll
        for (int s = 0; s < 4; ++s) kx[s] = (unsigned)(((4 * hi + s) ^ sb_keyK(pil)) << 4);
#pragma unroll
        for (int s = 0; s < 2; ++s) vx[s] = (unsigned)(((2 * hi + s) ^ sb_keyV(pil)) << 4);
        for (int kb = qt; ; --kb) {
            const unsigned so = (unsigned)(kb - lo) * 4096u;
            bf16x8 kf[4], vf[2][2];
#pragma unroll
            for (int s = 0; s < 4; ++s) kf[s] = *(const LAS bf16x8*)(lds + so + kbase + kx[s]);
#pragma unroll
            for (int dt = 0; dt < 2; ++dt)
#pragma unroll
                for (int s = 0; s < 2; ++s) vf[dt][s] = *(const LAS bf16x8*)(lds + so + vbase + dt * 2048 + vx[s]);
            SB_MATH(kf, vf, kb);
            if (kb == 0 || __all(R == 0.f)) { fin = true; break; }
            if (kb == lo) break;
        }
    }
    if (!fin) {
        for (int kb = lo - 1; ; --kb) {
            bf16x8 kf[4], vf[2][2];
            const bf16* kp = SK + ((size_t)b * SEQ + (size_t)kb * 32 + pil) * 512 + h * 64 + 32 * hi;
#pragma unroll
            for (int s = 0; s < 4; ++s) kf[s] = *(const bf16x8*)(kp + 8 * s);
            const bf16* vp = TT + ((size_t)(b * (SEQ / 32) + kb) * NB + h * 64 + pil) * 32 + 16 * hi;
#pragma unroll
            for (int dt = 0; dt < 2; ++dt)
#pragma unroll
                for (int s = 0; s < 2; ++s) vf[dt][s] = *(const bf16x8*)(vp + dt * 32 * 32 + 8 * s);
            SB_MATH(kf, vf, kb);
            if (kb == 0 || __all(R == 0.f)) break;
        }
    }
#undef SB_MATH
    float ss = 0.f;
#pragma unroll
    for (int r = 0; r < 16; ++r) ss += o0[r] * o0[r] + o1[r] * o1[r];
    float slo, shi; swap32(ss, slo, shi);
    const float rstd = __builtin_amdgcn_rsqf((slo + shi) * (1.f / 64.f) + EPS);
    bf16* op = MIX + (row0 + il) * DM + h * 64 + 16 * hi;
#pragma unroll
    for (int dt = 0; dt < 2; ++dt) {
        float v[16];
#pragma unroll
        for (int r4 = 0; r4 < 4; ++r4) { const f32x4 g = *(const f32x4*)(gout + 32 * dt + 16 * hi + 4 * r4);
#pragma unroll
            for (int e2 = 0; e2 < 4; ++e2) v[4 * r4 + e2] = (dt ? o1[4 * r4 + e2] : o0[4 * r4 + e2]) * rstd * g[e2]; }
        *(bf16x8*)(op + 32 * dt) = pack8(v); *(bf16x8*)(op + 32 * dt + 8) = pack8(v + 8);
    }
    __syncthreads();
}

__device__ __forceinline__ void gla_a(const bf16* GLR, const bf16* W2T, const float* gate_b, const bf16* TT, bf16* KV, float* DTOT, int bh, int j, int lane) {
    const int il = lane & 31, hi = lane >> 5, pil = PI32(il);
    const int b = bh >> 2, h = bh & 3;
    const size_t t0 = (size_t)b * SEQ + (size_t)j * 64;
    bf16x8 gf[2], wf[2], gkf[2][2][2], bvf[4][4]; float bias[2];
#pragma unroll
    for (int ch = 0; ch < 2; ++ch) gf[ch] = *(const bf16x8*)(GLR + (t0 + 32 * ch + pil) * 16 + 8 * hi);
#pragma unroll
    for (int kh = 0; kh < 2; ++kh) { const int kcol = 64 * h + 32 * kh + pil; wf[kh] = *(const bf16x8*)(W2T + kcol * 16 + 8 * hi); bias[kh] = gate_b[kcol];
        const bf16* gkp = TT + ((t0 >> 5) * NB + 512 + kcol) * 32 + 16 * hi;
#pragma unroll
        for (int ch = 0; ch < 2; ++ch) { gkf[kh][ch][0] = *(const bf16x8*)(gkp + ch * NB * 32); gkf[kh][ch][1] = *(const bf16x8*)(gkp + ch * NB * 32 + 8); } }
#pragma unroll
    for (int vq = 0; vq < 4; ++vq) { const bf16* vp = TT + ((t0 >> 5) * NB + 768 + 128 * h + 32 * vq + il) * 32 + 16 * hi;
#pragma unroll
        for (int s = 0; s < 4; ++s) bvf[vq][s] = *(const bf16x8*)(vp + (s >> 1) * NB * 32 + 8 * (s & 1)); }
    bf16x8 akf[2][4];
#pragma unroll
    for (int kh = 0; kh < 2; ++kh) {
        const int kcol = 64 * h + 32 * kh + pil;
        float cs[2][16];
#pragma unroll
        for (int ch = 0; ch < 2; ++ch) {
            f32x16 g;
#pragma unroll
            for (int r = 0; r < 16; ++r) g[r] = 0.f;
            g = MFMA32(gf[ch], wf[kh], g);
            if (kh == 0 && ch == 0) asm volatile("" : "+v"(g) :: "memory");
            float run = 0.f;
#pragma unroll
            for (int r = 0; r < 16; ++r) { const float x = g[r] + bias[kh];
                const float ls2 = __builtin_fminf(x, 0.f) * LOG2E - __builtin_amdgcn_logf(1.f + __builtin_amdgcn_exp2f(-__builtin_fabsf(x) * LOG2E));
                run += ls2 * (1.f / 16.f); cs[ch][r] = run; }
        }
        float t0lo, t0hi, t1lo, t1hi; swap32(cs[0][15], t0lo, t0hi); swap32(cs[1][15], t1lo, t1hi);
        const float off0 = hi ? t0lo : 0.f, off1 = (t0lo + t0hi) + (hi ? t1lo : 0.f), total = (t0lo + t0hi) + (t1lo + t1hi);
        if (hi == 0) DTOT[((size_t)bh * 32 + j) * 64 + 32 * kh + pil] = __builtin_amdgcn_exp2f(total);
#pragma unroll
        for (int ch = 0; ch < 2; ++ch) {
            const bf16x8 k0 = gkf[kh][ch][0], k1 = gkf[kh][ch][1];
            float kd[16]; const float off = ch ? off1 : off0;
#pragma unroll
            for (int r = 0; r < 16; ++r) { const float dec = __builtin_amdgcn_exp2f(total - (cs[ch][r] + off)); kd[r] = bf2f(r < 8 ? k0[r] : k1[r - 8]) * dec; }
            akf[kh][2 * ch] = pack8(kd); akf[kh][2 * ch + 1] = pack8(kd + 8);
        }
    }
#pragma unroll
    for (int vq = 0; vq < 4; ++vq) {
#pragma unroll
        for (int kh = 0; kh < 2; ++kh) {
            f32x16 kv;
#pragma unroll
            for (int r = 0; r < 16; ++r) kv[r] = 0.f;
#pragma unroll
            for (int s = 0; s < 4; ++s) kv = MFMA32(akf[kh][s], bvf[vq][s], kv);
            bf16* dst = KV + (((size_t)bh * 32 + j) * 128 + 32 * vq + il) * 64 + 32 * kh + 16 * hi;
            float kvf[16];
#pragma unroll
            for (int r = 0; r < 16; ++r) kvf[r] = kv[r];
            *(bf16x8*)dst = pack8(kvf); *(bf16x8*)(dst + 8) = pack8(kvf + 8);
        }
    }
}
__device__ __forceinline__ void gla_b(const bf16* KV, const float* DTOT, bf16* ST, int task, int lane) {
    const int bh = task >> 5, part = task & 31; const int e0 = part * 256 + lane * 4; const int k = e0 & 63;
    f32x4 S = (f32x4){0.f, 0.f, 0.f, 0.f};
#pragma unroll
    for (int half = 0; half < 2; ++half) {
        u32x2 kvp[16]; f32x4 d[16];
#pragma unroll
        for (int q = 0; q < 16; ++q) { const int j = 16 * half + q;
            kvp[q] = *(const u32x2*)(KV + ((size_t)bh * 32 + j) * 8192 + e0); d[q] = *(const f32x4*)(DTOT + ((size_t)bh * 32 + j) * 64 + k); }
#pragma unroll
        for (int q = 0; q < 16; ++q) { const int j = 16 * half + q;
            const f32x4 kv = (f32x4){__uint_as_float(kvp[q].x << 16), __uint_as_float(kvp[q].x & 0xffff0000u), __uint_as_float(kvp[q].y << 16), __uint_as_float(kvp[q].y & 0xffff0000u)};
            S = d[q] * S + kv;
            u32x2 w; w.x = cvtpk(S[0], S[1]); w.y = cvtpk(S[2], S[3]);
            *(u32x2*)(ST + ((size_t)bh * 32 + j) * 8192 + e0) = w; }
        asm volatile("" ::: "memory");
    }
}
__device__ __forceinline__ void gla_c(LAS unsigned char* wl, const bf16* ST, const bf16* GQ, const bf16* GRS, const float* gn, bf16* MIX, int bh, int j, int lane) {
    const int il = lane & 31, hi = lane >> 5, pil = PI32(il);
    const int b = bh >> 2, h = bh & 3;
    const size_t t0 = (size_t)b * SEQ + (size_t)j * 64;
    const bf16* sp = ST + ((size_t)bh * 32 + j) * 8192 + lane * 8;
    u32x4 st[16];
#pragma unroll
    for (int i = 0; i < 16; ++i) st[i] = *(const u32x4*)(sp + i * 512);
    bf16x8 bq[2][4], gr[2][4][2];
#pragma unroll
    for (int ch = 0; ch < 2; ++ch) { const size_t row = t0 + 32 * ch + il;
#pragma unroll
        for (int s = 0; s < 4; ++s) bq[ch][s] = *(const bf16x8*)(GQ + row * 256 + 64 * h + 16 * s + 8 * hi); }
    { const size_t row = t0 + il;
#pragma unroll
      for (int vt = 0; vt < 4; ++vt) { gr[0][vt][0] = *(const bf16x8*)(GRS + row * 512 + 128 * h + 32 * vt + 16 * hi); gr[0][vt][1] = *(const bf16x8*)(GRS + row * 512 + 128 * h + 32 * vt + 16 * hi + 8); } }
    { const int vr = lane >> 3, c = lane & 7;
#pragma unroll
      for (int i = 0; i < 16; ++i) { const int v = 8 * i + vr; *(LAS u32x4*)(wl + v * 128 + ((c ^ sb_keyK(v & 31)) << 4)) = st[i]; } }
    LDS_WAIT(); asm volatile("" ::: "memory");
    unsigned ax[4];
#pragma unroll
    for (int s = 0; s < 4; ++s) ax[s] = (unsigned)(pil * 128 + (((2 * s + hi) ^ sb_keyK(pil)) << 4));
#pragma unroll
    for (int ch = 0; ch < 2; ++ch) {
        const size_t row = t0 + 32 * ch + il;
        f32x16 O[4]; float ss = 0.f;
#pragma unroll
        for (int vt = 0; vt < 4; ++vt) {
#pragma unroll
            for (int r = 0; r < 16; ++r) O[vt][r] = 0.f;
#pragma unroll
            for (int s = 0; s < 4; ++s) { const bf16x8 af = *(const LAS bf16x8*)(wl + vt * 4096 + ax[s]); O[vt] = MFMA32(af, bq[ch][s], O[vt]); }
            if (ch == 0 && vt == 0) {
                const size_t row1 = t0 + 32 + il;
#pragma unroll
                for (int v2 = 0; v2 < 4; ++v2) { gr[1][v2][0] = *(const bf16x8*)(GRS + row1 * 512 + 128 * h + 32 * v2 + 16 * hi); gr[1][v2][1] = *(const bf16x8*)(GRS + row1 * 512 + 128 * h + 32 * v2 + 16 * hi + 8); }
                asm volatile("" : "+v"(O[0]) :: "memory"); }
#pragma unroll
            for (int r = 0; r < 16; ++r) ss += O[vt][r] * O[vt][r];
        }
        float slo, shi; swap32(ss, slo, shi);
        const float rstd = __builtin_amdgcn_rsqf((slo + shi) * (1.f / 128.f) + EPS);
#pragma unroll
        for (int vt = 0; vt < 4; ++vt) {
            const int vc0 = 32 * vt + 16 * hi;
            float v[16];
#pragma unroll
            for (int r4 = 0; r4 < 4; ++r4) { const f32x4 g = *(const f32x4*)(gn + vc0 + 4 * r4);
#pragma unroll
                for (int e2 = 0; e2 < 4; ++e2) { const int r = 4 * r4 + e2; v[r] = O[vt][r] * rstd * g[e2] * bf2f(r < 8 ? gr[ch][vt][0][r] : gr[ch][vt][1][r - 8]); } }
            bf16* op = MIX + row * DM + 512 + 128 * h + vc0;
            *(bf16x8*)(op) = pack8(v); *(bf16x8*)(op + 8) = pack8(v + 8);
        }
    }
    LDS_WAIT(); asm volatile("" ::: "memory");
}

constexpr int NWAVES = 8;
constexpr int N_PHASES = 10;
struct Args { Ptrs p; int ph_lo, ph_hi; };

__global__ void __launch_bounds__(NWAVES * 64, 2) fwd_kernel(Args args) {
    extern __shared__ __attribute__((aligned(16))) unsigned char lds_raw[];
    LAS unsigned char* lds = (LAS unsigned char*)lds_raw;
    const Ptrs& P = args.p;
    const int tid = threadIdx.x, lane = tid & 63, wave = __builtin_amdgcn_readfirstlane(tid >> 6);
    const int G = gridDim.x; const int bx = blockIdx.x; const int vcu = (G % 8 == 0) ? (bx % 8) * (G / 8) + bx / 8 : bx;
    const int gw = vcu * NWAVES + wave, NGW = G * NWAVES;
    unsigned char* ws = P.ws;
    gu32* ctl = (gu32*)(ws + WS_CTL);
    volatile LAS unsigned* MISC = (volatile LAS unsigned*)(lds + MISC_OFF);
    LAS int* tab = (LAS int*)(lds + TAB_OFF);
    for (int u = tid; u < (LDS_BYTES - LDSCTL_OFF) / 4; u += NWAVES * 64) ((LAS unsigned*)(lds + LDSCTL_OFF))[u] = 0u;
    __syncthreads();
    XcdBarrier bar; bar.bar = (unsigned*)(ctl + CW_BAR); bar.x = 0; bar.st = nullptr;
    if (MK_N_LAUNCHES == 1) bar = xcd_barrier_post((unsigned*)(ctl + CW_BAR), MISC + 8);
#define GRID_BAR() do { if (MK_N_LAUNCHES == 1) xcd_barrier(bar); } while (0)
    const int lo = args.ph_lo, hi_ph = args.ph_hi;
#ifndef PHASE_MASK
#define PHASE_MASK 0x3ff
#endif
#define IN(k) (((PHASE_MASK >> (k)) & 1) && lo <= (k) && (k) < hi_ph)
#define BOTH(k) (IN(k) && IN((k) + 1))
#ifndef PROBE_TWICE
#define PROBE_TWICE -1
#endif
#define REP(k) for (int rep_ = 0; rep_ < ((PROBE_TWICE == (k)) ? 2 : 1); ++rep_)
#define REPBAR(k) do { if (PROBE_TWICE == (k) && rep_ == 0) GRID_BAR(); } while (0)

    bf16* WA = (bf16*)(ws + WS_WA); bf16* WB = (bf16*)(ws + WS_WB); bf16* WO = (bf16*)(ws + WS_WO);
    bf16* WRH = (bf16*)(ws + WS_WR); bf16* WRL = WRH + 48 * 1024; bf16* W2T = (bf16*)(ws + WS_W2T);
    bf16* WGU = (bf16*)(ws + WS_WGU); bf16* WD = (bf16*)(ws + WS_WD);
    bf16* H = (bf16*)(ws + WS_H); bf16* KV = (bf16*)(ws + WS_KV);
    bf16* U = (bf16*)(ws + WS_U); bf16* MIX = (bf16*)(ws + WS_MIX);
    bf16* SQ = (bf16*)(ws + WS_SQ); bf16* SK = (bf16*)(ws + WS_SK); bf16* GQ = (bf16*)(ws + WS_GQ); bf16* GRS = (bf16*)(ws + WS_GRS);
    bf16* TT = (bf16*)(ws + WS_TT); bf16* GLR = (bf16*)(ws + WS_GLR); bf16* ST = (bf16*)(ws + WS_ST); float* DTOT = (float*)(ws + WS_DTOT);
    unsigned char* ACT = ws + WS_ACT; unsigned char* Y = ws + WS_Y;
    unsigned char* WGU8 = ws + WS_WGU; unsigned char* WD8 = ws + WS_WD; unsigned char* H8 = ws + WS_H8;
    unsigned* LOCL = (unsigned*)(ws + WS_LOCL); unsigned* CNTS = (unsigned*)(ws + WS_CNTS); float* GATE = (float*)(ws + WS_GATE); float* RSTD = (float*)(ws + WS_RSTD);

    if (IN(0)) { REP(0) {
        LAS float* scr = (LAS float*)(lds + RING_OFF + wave * 16384);
        constexpr int I_A = (NA / 32) * 16, I_B = (NB / 32) * 16, I_O = 32 * 16, I_GU = 32 * 32 * 16, I_D = 32 * 32 * 8;
        constexpr int NITEMS = I_A + I_B + I_O + I_GU;
        for (int it = gw; it < NITEMS; it += NGW) {
            int r = it;
            if (r < I_A) { const int ib = r >> 4, kb = r & 15, P0 = 32 * ib; const int pn = P0 >> 8, bj = (P0 >> 7) & 1, wcc = (P0 >> 5) & 3; const int LA = 256 * pn + 64 * wcc + 32 * bj;
                const int sc = LA < 1024 ? LA : (LA < 1280 ? 1536 + (LA - 1024) : 2560 + (LA - 1280));
                tr_item(P.w_in, IN_DIM, 64 * kb, sc, WA, P0, DM, nullptr, scr, lane); continue; } r -= I_A;
            if (r < I_B) { const int ib = r >> 4, kb = r & 15, P0 = 32 * ib; const int sc = P0 < 512 ? 1024 + P0 : (P0 < 768 ? 1792 + (P0 - 512) : 2048 + (P0 - 768));
                tr_item(P.w_in, IN_DIM, 64 * kb, sc, WB, P0, DM, nullptr, scr, lane); continue; } r -= I_B;
            if (r < I_O) { const int ib = r >> 4, kb = r & 15; tr_item(P.w_out, DM, 64 * kb, 32 * ib, WO, 32 * ib, DM, nullptr, scr, lane); continue; } r -= I_O;
            if (r < I_GU) { const int e = r >> 9, q = r & 511, ib = 4 * (q >> 6) + (q & 3), kb = 2 * ((q >> 3) & 7) + ((q >> 2) & 1), P0 = 32 * ib; const int pn = P0 >> 8, bj = (P0 >> 7) & 1, r0 = P0 & 127;
                const float* src = (bj ? P.wu : P.wg) + (size_t)e * DM * DEXP;
                tr_item8(src, DEXP, 64 * kb, 128 * pn + r0, WGU8 + (size_t)e * DM * DM, P0, DM, P.ffn_g, WGU_SC, scr, lane); continue; }
        }
        (void)I_D;
        for (int idx = gw * 64 + lane; idx < 48 * 1024; idx += NGW * 64) {
            const int rho = idx >> 10, k = idx & 1023, m = rho >> 4, i = rho & 15;
            float v = (m < 2) ? P.re_w[k * 32 + 8 * (i >> 2) + 4 * m + (i & 3)] : P.rg_w[k * 4 + (i & 3)];
            v *= P.ffn_g[k];
            WRH[idx] = __builtin_bit_cast(unsigned short, (_Float16)v);
        }
        for (int idx = gw * 64 + lane; idx < 256 * 16; idx += NGW * 64) { const int kc = idx >> 4, r = idx & 15; W2T[idx] = (bf16)(cvtpk(P.w2[r * 256 + kc], 0.f) & 0xffffu); }
        __syncthreads();
        constexpr int WLP = 1032;
        LAS bf16* wl = (LAS bf16*)(lds + RING_OFF);
        for (int idx = tid; idx < 16 * 1024; idx += NWAVES * 64) { const int c = idx & 15, k = idx >> 4; wl[c * WLP + k] = (bf16)(cvtpk(P.w_in[(size_t)k * IN_DIM + 3072 + c], 0.f) & 0xffffu); }
        __syncthreads();
        {
            f32x4 g4[4];
#pragma unroll
            for (int j = 0; j < 4; ++j) g4[j] = *((const GAS f32x4*)P.attn_g + lane + 64 * j);
            for (int task = gw; task < NTOK / 16; task += NGW) {
                const size_t row0 = (size_t)task * 16;
                f32x4 cur[4], nxt[4];
#pragma unroll
                for (int j = 0; j < 4; ++j) { cur[j] = *((const GAS f32x4*)(P.x + row0 * DM) + lane + 64 * j); nxt[j] = cur[j]; }
#pragma unroll 2
                for (int r = 0; r < 16; ++r) {
                    if (r < 15) {
#pragma unroll
                        for (int j = 0; j < 4; ++j) nxt[j] = *((const GAS f32x4*)(P.x + (row0 + r + 1) * DM) + lane + 64 * j); }
                    float s2 = 0.f;
#pragma unroll
                    for (int j = 0; j < 4; ++j) s2 += (cur[j].x * cur[j].x + cur[j].y * cur[j].y) + (cur[j].z * cur[j].z + cur[j].w * cur[j].w);
                    const float rstd = __builtin_amdgcn_rsqf(wave_sum(s2) * (1.f / DM) + EPS);
                    GAS unsigned long long* o8 = (GAS unsigned long long*)(U + (row0 + r) * DM) + lane;
#pragma unroll
                    for (int j = 0; j < 4; ++j) { const f32x4 v = cur[j] * rstd * g4[j];
                        o8[64 * j] = (unsigned long long)cvtpk(v.x, v.y) | ((unsigned long long)cvtpk(v.z, v.w) << 32); }
#pragma unroll
                    for (int j = 0; j < 4; ++j) cur[j] = nxt[j];
                }
                VM_WAIT();
                const int fr = lane & 15, fq = lane >> 4;
                f32x4 acc = (f32x4){0.f, 0.f, 0.f, 0.f};
                const bf16* up = U + (row0 + fr) * DM + 8 * fq;
#pragma unroll 8
                for (int ks = 0; ks < 32; ++ks) { const bf16x8 ub = *(const bf16x8*)(up + 32 * ks); const bf16x8 wb = *(const LAS bf16x8*)(wl + fr * WLP + 32 * ks + 8 * fq); acc = MFMA16(wb, ub, acc); }
                u32x2 o; o.x = cvtpk(acc[0], acc[1]); o.y = cvtpk(acc[2], acc[3]);
                *(u32x2*)(GLR + (row0 + fr) * 16 + 4 * fq) = o;
            }
        }
        __syncthreads();
        REPBAR(0); }
        if (BOTH(0)) GRID_BAR();
    }

#define PH1_BODY() do { \
        { pg8::SchedDense S; S.init(U, WA, NTOK, NA, DM, G, bx); \
          pg8::EpiA E{SQ, SK, GQ, GRS, P.sbq_g, P.sbk_g}; \
          pg8::gemm_phase<pg8::EpiA, pg8::SchedDense>(lds + RING_OFF, DM, S, E); } \
        { pg8::SchedDense S; S.init(WB, U, NB, NTOK, DM, G, (bx + G / 2) % G); \
          pg8::EpiTT E{TT}; \
          pg8::gemm_phase<pg8::EpiTT, pg8::SchedDense>(lds + RING_OFF, DM, S, E); } } while (0)
    if (IN(1)) {
        if (PROBE_TWICE == 1) { PH1_BODY(); GRID_BAR(); }
        PH1_BODY();
        if (BOTH(1)) GRID_BAR();
    }

#define SB_ROUND(rho_) do { for (int u__ = (rho_) * G + vcu; u__ < 1024; u__ += 4 * G) { const int bh_ = u__ & 127; \
        sb_round(lds + RING_OFF, SQ, SK, TT, P.sbo_g + (bh_ & 7) * 64, MIX, bh_ >> 3, bh_ & 7, u__ >> 7, tid, wave, lane); } } while (0)
#define REPX(code) for (int rx_ = 0; rx_ < ((PROBE_TWICE == (code)) ? 5 : 1); ++rx_)
    if (IN(2)) { REP(2) {
        REPX(20) for (int t = gw; t < 2048; t += NGW) gla_a(GLR, W2T, P.gate_b, TT, KV, DTOT, t >> 5, t & 31, lane);
        REPX(21) SB_ROUND(0);
        REPBAR(2); }
        if (BOTH(2)) GRID_BAR();
    }
    if (IN(3)) { REP(3) {
        REPX(22) for (int t = gw; t < 2048; t += NGW) gla_b(KV, DTOT, ST, t, lane);
        SB_ROUND(1);
        REPBAR(3); }
        if (BOTH(3)) GRID_BAR();
    }
    if (IN(4)) { REP(4) {
        REPX(23) for (int t = gw; t < 2048; t += NGW) gla_c(lds + RING_OFF + wave * 16384, ST, GQ, GRS, P.glan_g, MIX, t >> 5, t & 31, lane);
        __syncthreads();
        SB_ROUND(2); SB_ROUND(3);
        REPBAR(4); }
        if (BOTH(4)) GRID_BAR();
    }

#define PH5_BODY() do { \
        pg8::SchedDense S; S.init(MIX, WO, NTOK, DM, DM, G, bx); \
        pg8::EpiH E{P.x, H, H8}; \
        pg8::gemm_phase<pg8::EpiH, pg8::SchedDense>(lds + RING_OFF, DM, S, E); } while (0)
    if (IN(5)) {
        if (PROBE_TWICE == 5) { PH5_BODY(); GRID_BAR(); }
        PH5_BODY();
        if (BOTH(5)) GRID_BAR();
    }

    if (IN(6)) { REP(6) {
        constexpr int WP = 1032;
        LAS unsigned short* wl16 = (LAS unsigned short*)(lds + RING_OFF);
        LAS unsigned* lcount = (LAS unsigned*)(lds + RING_OFF + 48 * WP * 2);
        for (int idx = tid; idx < 48 * 128; idx += NWAVES * 64) { const int row = idx >> 7, c = idx & 127; *(LAS u32x4*)(wl16 + row * WP + 8 * c) = *(const u32x4*)(WRH + row * 1024 + 8 * c); }
        const int fr = lane & 15, fq = lane >> 4;
        for (int it = 0; it * G < NGRP; ++it) {
            const int grp = it * G + vcu;
            const int tile = grp * 8 + wave; const int ntile = NGRP * 8;
            if (tid < 32) lcount[tid] = 0u;
            __syncthreads();
            bool owner = false; int e1 = 0, e2 = 0; unsigned lr1 = 0, lr2 = 0; int tok = 0;
            if (tile < ntile) {
                tok = tile * 16 + fr;
                const bf16* hp = H + (size_t)tok * DM + 8 * fq;
                f32x4 acc[3]; acc[0] = acc[1] = acc[2] = (f32x4){0.f, 0.f, 0.f, 0.f};
                float ssq = 0.f;
#pragma unroll 1
                for (int half = 0; half < 2; ++half) {
                    bf16x8 hb[16];
#pragma unroll
                    for (int q = 0; q < 16; ++q) hb[q] = *(const bf16x8*)(hp + 32 * (16 * half + q));
#pragma unroll
                    for (int q = 0; q < 16; ++q) { const int ks = 16 * half + q;
                        float f[8];
#pragma unroll
                        for (int e = 0; e < 8; ++e) { f[e] = bf2f(hb[q][e]); ssq += f[e] * f[e]; }
                        f16x8 hh;
#pragma unroll
                        for (int e = 0; e < 8; ++e) hh[e] = (_Float16)f[e];
#pragma unroll
                        for (int m = 0; m < 3; ++m) { const f16x8 wv = *(const LAS f16x8*)(wl16 + (16 * m + fr) * WP + 32 * ks + 8 * fq);
                            acc[m] = __builtin_amdgcn_mfma_f32_16x16x32_f16(wv, hh, acc[m], 0, 0, 0); }
                    }
                }
                ssq += __shfl_xor(ssq, 16); ssq += __shfl_xor(ssq, 32);
                const float rstd = __builtin_amdgcn_rsqf(ssq * (1.f / DM) + EPS);
                float gl[4];
#pragma unroll
                for (int r = 0; r < 4; ++r) gl[r] = acc[2][r] * rstd + P.rg_b[r];
                int gsel = 0; float gmax = gl[0];
#pragma unroll
                for (int r = 1; r < 4; ++r) if (gl[r] > gmax) { gmax = gl[r]; gsel = r; }
                float gden = 0.f;
#pragma unroll
                for (int r = 0; r < 4; ++r) gden += __builtin_amdgcn_exp2f((gl[r] - gmax) * LOG2E);
                const float pgrp = 1.f / gden;
                float el[8];
#pragma unroll
                for (int r = 0; r < 4; ++r) { el[r] = acc[0][r] * rstd + P.re_b[8 * fq + r]; el[4 + r] = acc[1][r] * rstd + P.re_b[8 * fq + 4 + r]; }
                int i1 = 0; float l1 = el[0];
#pragma unroll
                for (int r = 1; r < 8; ++r) if (el[r] > l1) { l1 = el[r]; i1 = r; }
                int i2 = -1; float l2 = -3.0e38f;
#pragma unroll
                for (int r = 0; r < 8; ++r) if (r != i1 && el[r] > l2) { l2 = el[r]; i2 = r; }
                const float ex = __builtin_amdgcn_exp2f((l2 - l1) * LOG2E);
                const float p1 = 1.f / (1.f + ex), p2 = ex * p1;
                owner = (fq == gsel);
                if (owner) {
                    e1 = 8 * gsel + i1; e2 = 8 * gsel + i2;
                    lr1 = __hip_atomic_fetch_add(lcount + e1, 1u, __ATOMIC_RELAXED, __HIP_MEMORY_SCOPE_WORKGROUP);
                    lr2 = __hip_atomic_fetch_add(lcount + e2, 1u, __ATOMIC_RELAXED, __HIP_MEMORY_SCOPE_WORKGROUP);
                    RSTD[tok] = rstd; GATE[2 * tok] = pgrp * p1; GATE[2 * tok + 1] = pgrp * p2;
                }
            }
            __syncthreads();
            if (grp < NGRP) {
                if (tid < 32) CNTS[grp * 32 + tid] = lcount[tid];
                if (owner) { LOCL[((size_t)grp * 32 + e1) * 128 + lr1] = 2u * tok; LOCL[((size_t)grp * 32 + e2) * 128 + lr2] = 2u * tok + 1u; }
            }
            __syncthreads();
        }
        REPBAR(6); }
        if (BOTH(6)) GRID_BAR();
    }

    if (IN(7) || IN(8)) {
        LAS int* pre = (LAS int*)(lds + RING_OFF);
        LAS int* segsum = pre + NGRP * 32;
        for (int i = tid; i < NGRP * 32; i += NWAVES * 64) pre[i] = (int)CNTS[i];
        __syncthreads();
        { const int e = tid & 31, seg = tid >> 5; int run = 0;
          for (int g = seg * 16; g < seg * 16 + 16; ++g) { const int c = pre[g * 32 + e]; pre[g * 32 + e] = run; run += c; }
          segsum[seg * 32 + e] = run; }
        __syncthreads();
        { const int e = tid & 31, seg = tid >> 5; int off = 0, tot = 0;
          for (int q = 0; q < 16; ++q) { const int v = segsum[q * 32 + e]; if (q < seg) off += v; tot += v; }
          for (int g = seg * 16; g < seg * 16 + 16; ++g) pre[g * 32 + e] += off;
          if (seg == 0) tab[T_CNT / 4 + e] = tot; }
        __syncthreads();
        if (tid == 0) { int tb = 0; for (int e = 0; e < 32; ++e) { tab[T_TBASE / 4 + e] = tb; tb += (tab[T_CNT / 4 + e] + 255) >> 8; } tab[T_TBASE / 4 + 32] = tb; tab[T_NT / 4] = tb; }
        __syncthreads();
        { const int NT = tab[T_NT / 4];
          for (int t = tid; t < NT; t += NWAVES * 64) { int e = 0; for (int q = 0; q < 32; ++q) if (tab[T_TBASE / 4 + q] <= t && t < tab[T_TBASE / 4 + q + 1]) e = q; tab[T_TILE_E / 4 + t] = e; } }
        __syncthreads();
        { pg8::SchedMoE<false> S0; S0.A = nullptr; S0.Bt = nullptr; S0.K = 0; S0.bstride = 0; S0.G = G; S0.c = bx; S0.tab = tab;
          const int half = tid >> 8, r = tid & 255; unsigned vals[NU_MAX / 2]; bool ok[NU_MAX / 2];
#pragma unroll
          for (int k = 0; k < NU_MAX / 2; ++k) { const int ui = 2 * k + half; pg8::Unit u; ok[k] = S0.next(ui, u); vals[k] = 0u;
              if (ok[k]) { const int cnt = tab[T_CNT / 4 + u.e], e = u.e; int p = u.rt * 256 + r; if (p > cnt - 1) p = cnt - 1;
                  int lo_ = 0, hi_ = NGRP - 1;
                  while (lo_ < hi_) { const int mid = (lo_ + hi_ + 1) >> 1; if (pre[mid * 32 + e] <= p) lo_ = mid; else hi_ = mid - 1; }
                  vals[k] = LOCL[((size_t)lo_ * 32 + e) * 128 + (p - pre[lo_ * 32 + e])]; } }
#pragma unroll
          for (int k = 0; k < NU_MAX / 2; ++k) if (ok[k]) tab[T_ROWTAB / 4 + (2 * k + half) * 256 + r] = (int)vals[k];
        }
        __syncthreads();
    }
#define PH7_BODY() do { \
        pg8::SchedMoE<true> S; S.A = (const char*)H8; S.Bt = (const char*)WGU8; S.K = DM / 2; S.bstride = (size_t)DM * DM; S.G = G; S.c = bx; S.tab = tab; \
        pg8::EpiGU E{ACT, RSTD, tab}; \
        pg8::gemm_phase<pg8::EpiGU, pg8::SchedMoE<true>, false, true>(lds + RING_OFF, DM / 2, S, E); } while (0)
    if (IN(7)) {
        if (PROBE_TWICE == 7) { PH7_BODY(); GRID_BAR(); }
        PH7_BODY();
        {
            const int NT4 = tab[T_NT / 4] * 4, remu = NT4 % G;
            const bool early = (remu == 0) || (bx >= remu); const int nE = (remu == 0) ? G : (G - remu), rank = (remu == 0) ? bx : (bx - remu);
            if (early) { LAS float* scr = (LAS float*)(lds + RING_OFF + wave * 16384);
                for (int r = rank * NWAVES + wave; r < 32 * 32 * 8; r += nE * NWAVES) {
                    const int e = r >> 8, q = r & 255, nb = 4 * (q >> 5) + (q & 3), kb = 2 * ((q >> 3) & 3) + ((q >> 2) & 1);
                    tr_item8(P.wd + (size_t)e * DEXP * DM, DM, 64 * kb, 32 * nb, WD8 + (size_t)e * DM * DEXP, 32 * nb, DEXP, nullptr, WD_SC, scr, lane); } }
        }
        if (BOTH(7)) GRID_BAR();
    }
    if (IN(8)) { REP(8) {
        pg8::SchedMoE<false> S; S.A = (const char*)ACT; S.Bt = (const char*)WD8; S.K = DEXP / 2; S.bstride = (size_t)DM * DEXP; S.G = G; S.c = bx; S.tab = tab;
        pg8::EpiDown E{Y, tab};
        pg8::gemm_phase<pg8::EpiDown, pg8::SchedMoE<false>, false, true>(lds + RING_OFF, DEXP / 2, S, E);
        REPBAR(8); }
        if (BOTH(8)) GRID_BAR();
    }
    if (IN(9)) { REP(9) {
        for (int m0 = gw; m0 < NTOK; m0 += 2 * NGW) {
            bf16x8 hv[2][2]; u32x4 ya[2], yb[2]; float g0[2], g1[2];
#pragma unroll
            for (int t = 0; t < 2; ++t) { int m = m0 + t * NGW; if (m >= NTOK) m = m0;
                g0[t] = GATE[2 * m] * (1.f / Y_SC); g1[t] = GATE[2 * m + 1] * (1.f / Y_SC);
                const bf16* hp = H + (size_t)m * DM + 16 * lane; const unsigned char* y0 = Y + (size_t)(2 * m) * DM + 16 * lane;
                hv[t][0] = *(const bf16x8*)(hp); hv[t][1] = *(const bf16x8*)(hp + 8); ya[t] = *(const u32x4*)(y0); yb[t] = *(const u32x4*)(y0 + DM); }
#pragma unroll
            for (int t = 0; t < 2; ++t) { const int m = m0 + t * NGW; if (m < NTOK) {
                float* op = P.out + (size_t)m * DM + 16 * lane;
#pragma unroll
                for (int q = 0; q < 4; ++q) { const unsigned wa = ya[t][q], wb = yb[t][q];
                    const f32x2_t a0 = __builtin_amdgcn_cvt_pk_f32_fp8((int)wa, false), a1 = __builtin_amdgcn_cvt_pk_f32_fp8((int)wa, true);
                    const f32x2_t b0 = __builtin_amdgcn_cvt_pk_f32_fp8((int)wb, false), b1 = __builtin_amdgcn_cvt_pk_f32_fp8((int)wb, true);
                    const bf16x8 hh = hv[t][q >> 1]; const int e0 = 4 * (q & 1);
                    f32x4 o; o[0] = bf2f(hh[e0]) + g0[t] * a0.x + g1[t] * b0.x; o[1] = bf2f(hh[e0 + 1]) + g0[t] * a0.y + g1[t] * b0.y;
                    o[2] = bf2f(hh[e0 + 2]) + g0[t] * a1.x + g1[t] * b1.x; o[3] = bf2f(hh[e0 + 3]) + g0[t] * a1.y + g1[t] * b1.y;
                    *(f32x4*)(op + 4 * q) = o; } } }
        }
    REPBAR(9); } }
#undef IN
#undef BOTH
}

extern "C" void kernel_launch(void* const* d_in, const int* in_sizes, int n_in, void* d_out, int out_size, void* d_ws, size_t ws_size, hipStream_t stream) {
    static int grid = 0;
    if (grid == 0) {
        if (n_in != 18 || in_sizes[0] != NTOK * DM || out_size != NTOK * DM || ws_size < WS_END) { fprintf(stderr, "kernel_launch: unexpected shapes / workspace (n_in %d, in0 %d, out %d, ws %zu, need %zu)\n", n_in, n_in > 0 ? in_sizes[0] : -1, out_size, ws_size, (size_t)WS_END); grid = -1; return; }
        int dev = 0, cus = 0, per_cu = 0;
        if (hipGetDevice(&dev) != hipSuccess || hipDeviceGetAttribute(&cus, hipDeviceAttributeMultiprocessorCount, dev) != hipSuccess) { grid = -1; return; }
        if (hipFuncSetAttribute((const void*)fwd_kernel, hipFuncAttributeMaxDynamicSharedMemorySize, LDS_BYTES) != hipSuccess) { fprintf(stderr, "kernel_launch: hipFuncSetAttribute failed\n"); grid = -1; return; }
        if (hipOccupancyMaxActiveBlocksPerMultiprocessor(&per_cu, (const void*)fwd_kernel, NWAVES * 64, LDS_BYTES) != hipSuccess || per_cu < 1) fprintf(stderr, "kernel_launch: occupancy query reports %d\n", per_cu);
        (void)hipGetLastError();
        grid = cus;
    }
    if (grid < 0) return;
    if (hipMemsetAsync((char*)d_ws + WS_CTL, 0, CTL_ZERO_BYTES, stream) != hipSuccess) return;
    Args a{};
    const float** pp = (const float**)&a.p;
    for (int i = 0; i < 18; ++i) pp[i] = (const float*)d_in[i];
    a.p.out = (float*)d_out; a.p.ws = (unsigned char*)d_ws;
    if (MK_N_LAUNCHES == 1) { a.ph_lo = 0; a.ph_hi = N_PHASES; hipLaunchKernelGGL(fwd_kernel, dim3(grid), dim3(NWAVES * 64), LDS_BYTES, stream, a); }
    else for (int li = 0; li < N_PHASES; ++li) { a.ph_lo = li; a.ph_hi = li + 1; hipLaunchKernelGGL(fwd_kernel, dim3(grid), dim3(NWAVES * 64), LDS_BYTES, stream, a); }
}
```

```cpp
#include <hip/hip_runtime.h>
#include <cstdio>
#include <cstdint>

#ifndef MK_N_LAUNCHES
#define MK_N_LAUNCHES 1
#endif

#define LAS __attribute__((address_space(3)))
#define GAS __attribute__((address_space(1)))
typedef unsigned short bf16;
typedef short bf16x8 __attribute__((ext_vector_type(8)));
typedef float f32x4 __attribute__((ext_vector_type(4)));
typedef float f32x16 __attribute__((ext_vector_type(16)));
typedef unsigned u32x4 __attribute__((ext_vector_type(4)));
typedef unsigned u32x2 __attribute__((ext_vector_type(2)));
typedef float f32x2_t __attribute__((ext_vector_type(2)));
typedef __bf16 bf16x2_t __attribute__((ext_vector_type(2)));
typedef GAS unsigned gu32;
typedef int v8i __attribute__((ext_vector_type(8)));
typedef int v4i __attribute__((ext_vector_type(4)));
typedef _Float16 f16x8 __attribute__((ext_vector_type(8)));
typedef _Float16 f16x2 __attribute__((ext_vector_type(2)));

constexpr int BATCH = 16, SEQ = 2048, DM = 1024, NTOK = BATCH * SEQ;
constexpr int IN_DIM = 3088;
constexpr int NEXP = 32, DEXP = 512;
constexpr float EPS = 1e-6f;
constexpr float LOG2E = 1.4426950408889634f;
constexpr float WGU_SC = 64.f, WD_SC = 32.f, ACT_SC = 8.f, Y_SC = 8.f;
constexpr int NA = 1792, NB = 1280;
constexpr int NGRP = NTOK / 128;

constexpr size_t MiB = 1u << 20;
constexpr size_t WS_CTL = 0, CTL_ZERO_BYTES = 64 * 1024;
constexpr size_t WS_WA = 2 * MiB;
constexpr size_t WS_WB = 6 * MiB;
constexpr size_t WS_WO = 9 * MiB;
constexpr size_t WS_WR = 11 * MiB;
constexpr size_t WS_W2T = WS_WR + 2 * 48 * 1024 * 2;
constexpr size_t WS_WGU = 12 * MiB;
constexpr size_t WS_WD = 76 * MiB;
constexpr size_t WS_H = 108 * MiB;
constexpr size_t WS_KV = WS_H;
constexpr size_t WS_XB = 44 * MiB;
constexpr size_t WS_MIX = 172 * MiB;
constexpr size_t WS_SQ = 236 * MiB;
constexpr size_t WS_SK = 268 * MiB;
constexpr size_t WS_GQ = 300 * MiB;
constexpr size_t WS_GRS = 316 * MiB;
constexpr size_t WS_TT = 348 * MiB;
constexpr size_t WS_GLR = 428 * MiB;
constexpr size_t WS_ST = 429 * MiB;
constexpr size_t WS_DTOT = 461 * MiB;
constexpr size_t WS_ACT = 236 * MiB;
constexpr size_t WS_H8 = 272 * MiB;
constexpr size_t WS_Y = 308 * MiB;
constexpr size_t WS_LOCL = 462 * MiB;
constexpr size_t WS_CNTS = 467 * MiB;
constexpr size_t WS_GATE = 470 * MiB;
constexpr size_t WS_RSTD = WS_GATE + 512 * 1024;
constexpr size_t WS_RSTD1 = WS_GATE + 768 * 1024;
constexpr size_t WS_END = 472 * MiB;
constexpr int CW_TMO = 0, CW_CODE = 1;
constexpr int CW_BAR = 4096;
constexpr int CW_CNT = 16384;

constexpr int RING_OFF = 0, RING_BYTES = 131072;
constexpr int LDSCTL_OFF = RING_BYTES, MISC_OFF = LDSCTL_OFF + 320;
constexpr int TAB_OFF = LDSCTL_OFF + 1024;
constexpr int LDS_BYTES = 147456;
constexpr int T_CNT = 0, T_TBASE = 128, T_NT = 264, T_TILE_E = 272, T_ROWTAB = 272 + 320 * 4, NU_MAX = 8;
static_assert(TAB_OFF + T_ROWTAB + NU_MAX * 256 * 4 <= LDS_BYTES, "LDS tables");

#define RLX_AGENT __ATOMIC_RELAXED, __HIP_MEMORY_SCOPE_AGENT
#define LDS_WAIT() asm volatile("s_waitcnt lgkmcnt(0)" ::: "memory")
#define VM_WAIT() asm volatile("s_waitcnt vmcnt(0)" ::: "memory")

__device__ __forceinline__ unsigned cvtpk(float lo, float hi) { f32x2_t v = {lo, hi}; bf16x2_t b = __builtin_convertvector(v, bf16x2_t); return __builtin_bit_cast(unsigned, b); }
__device__ __forceinline__ u32x2 pack8_fp8(const float* a) { int lo = __builtin_amdgcn_cvt_pk_fp8_f32(a[0], a[1], 0, false); lo = __builtin_amdgcn_cvt_pk_fp8_f32(a[2], a[3], lo, true);
    int hi = __builtin_amdgcn_cvt_pk_fp8_f32(a[4], a[5], 0, false); hi = __builtin_amdgcn_cvt_pk_fp8_f32(a[6], a[7], hi, true); u32x2 r; r.x = (unsigned)lo; r.y = (unsigned)hi; return r; }
__device__ __forceinline__ float bf2f(short s) { return __uint_as_float(((unsigned)(unsigned short)s) << 16); }
__device__ __forceinline__ bf16x8 pack8(const float* a) { u32x4 p; p.x = cvtpk(a[0], a[1]); p.y = cvtpk(a[2], a[3]); p.z = cvtpk(a[4], a[5]); p.w = cvtpk(a[6], a[7]); return __builtin_bit_cast(bf16x8, p); }
__device__ __forceinline__ int PI32(int i) { return 16 * ((i >> 2) & 1) + (i & 3) + 4 * (i >> 3); }
#define MFMA32(a, b, c) __builtin_amdgcn_mfma_f32_32x32x16_bf16((a), (b), (c), 0, 0, 0)
#define MFMA16(a, b, c) __builtin_amdgcn_mfma_f32_16x16x32_bf16((a), (b), (c), 0, 0, 0)
__device__ __forceinline__ void swap32(float x, float& lo, float& hi) { auto rr = __builtin_amdgcn_permlane32_swap(__float_as_uint(x), __float_as_uint(x), false, false); lo = __uint_as_float(rr[0]); hi = __uint_as_float(rr[1]); }

namespace pg8 {
#define PG8_LAS __attribute__((address_space(3)))
constexpr int BM = 256, BK = 64, HALF = 128, HTB = HALF * BK * 2, STAGE_BYTES = 8 * HTB, NXCD = 8, WGM = 8;
__host__ __device__ __forceinline__ int lds_byte(int r, int c) { const int st = (r >> 4) * 2 + (c >> 5), rr = r & 15, cc = c & 31, ob = rr * 64 + cc * 2; return st * 1024 + (ob ^ (((ob >> 9) & 1) << 5)); }
__host__ __device__ __forceinline__ void stage_rc(int b, int& R, int& C) { const int st = b / 1024, sb = b % 1024, swz = sb ^ (((sb >> 9) & 1) << 5); R = (st >> 1) * 16 + swz / 64; C = (st & 1) * 32 + (swz % 64) / 2; }
__host__ __device__ __forceinline__ int perm32(int rho) { const int n = rho >> 4, i = rho & 15; return 8 * (i >> 2) + 4 * n + (i & 3); }

struct Unit { int pm, pn, e, rt, nv; };

struct SchedDense {
    const char* A; const char* Bt; int K; int nM, nN, nwg, G, c;
    __device__ void init(const void* A_, const void* Bt_, int M, int N, int K_, int G_, int c_) { A = (const char*)A_; Bt = (const char*)Bt_; K = K_; nM = M / BM; nN = N / BM; nwg = nM * nN; G = G_; c = c_; }
    __device__ __forceinline__ bool next(int i, Unit& u) const {
        const long L = (long)i * G + c; if (L >= nwg) return false;
        int wgid = (int)L; { const int q = nwg / NXCD, r = nwg % NXCD, xcd = wgid % NXCD, off = wgid / NXCD; wgid = (xcd < r ? xcd * (q + 1) : r * (q + 1) + (xcd - r) * q) + off; }
        const int nig = WGM * nN, gid = wgid / nig, fm = gid * WGM, gsz = (nM - fm) < WGM ? (nM - fm) : WGM;
        u.pm = fm + ((wgid % nig) % gsz); u.pn = (wgid % nig) / gsz; u.e = 0; u.rt = 0; u.nv = 256; return true;
    }
    __device__ __forceinline__ const char* a_ptr(const Unit& u) const { return A + (size_t)u.pm * BM * K * 2; }
    __device__ __forceinline__ const char* b_ptr(const Unit& u) const { return Bt + (size_t)u.pn * BM * K * 2; }
    __device__ __forceinline__ void a_voff(int, const Unit&, int tid, unsigned (&v)[2][2]) const {
#pragma unroll
        for (int i = 0; i < 2; ++i) { int R, C; stage_rc(tid * 16 + i * 8192, R, C);
#pragma unroll
            for (int h = 0; h < 2; ++h) v[h][i] = (unsigned)((h * HALF + R) * K + C) * 2u; }
    }
};
template <bool GATHER> struct SchedMoE {
    const char* A; const char* Bt; int K; size_t bstride; int G, c;
    const PG8_LAS int* tab;
    __device__ __forceinline__ bool next(int i, Unit& u) const {
        const int L = i * G + c; const int NT = tab[T_NT / 4];
        if (L >= NT * 4) return false;
        const int tile = L >> 2; u.pm = tile; u.pn = L & 3; const int e = tab[T_TILE_E / 4 + tile]; u.e = e;
        u.rt = tile - tab[T_TBASE / 4 + e]; const int rem = tab[T_CNT / 4 + e] - u.rt * 256; u.nv = rem < 256 ? rem : 256; return true;
    }
    __device__ __forceinline__ const char* a_ptr(const Unit& u) const { return GATHER ? A : A + (size_t)u.pm * BM * K * 2; }
    __device__ __forceinline__ const char* b_ptr(const Unit& u) const { return Bt + (size_t)u.e * bstride + (size_t)u.pn * BM * K * 2; }
    __device__ __forceinline__ void a_voff(int ui, const Unit&, int tid, unsigned (&v)[2][2]) const {
        asm volatile("" : "+v"(tid));
#pragma unroll
        for (int i = 0; i < 2; ++i) { int R, C; stage_rc(tid * 16 + i * 8192, R, C);
#pragma unroll
            for (int h = 0; h < 2; ++h) {
                if (GATHER) { const int tok = tab[T_ROWTAB / 4 + ui * 256 + h * HALF + R] >> 1; v[h][i] = (unsigned)(tok * K + C) * 2u; }
                else v[h][i] = (unsigned)((h * HALF + R) * K + C) * 2u; } }
    }
};

template <class Epi, class Sched, bool TAIL = false, bool FP8 = false>
__device__ __forceinline__ void gemm_phase(PG8_LAS unsigned char* lds, const int K, const Sched& S, const Epi& E) {
    const int tid = threadIdx.x, wid = __builtin_amdgcn_readfirstlane(tid >> 6), lane = tid & 63, wr = wid >> 2, wc = wid & 3, fr = lane & 15, fq = lane >> 4;
    const int nt = K / BK;
    unsigned voffB[1][2];
#pragma unroll
    for (int i = 0; i < 2; ++i) { int R, C; stage_rc(tid * 16 + i * 8192, R, C); const int Rb = (R & ~31) + perm32(R & 31);
        voffB[0][i] = (unsigned)(Rb * K + C) * 2u; }
    const size_t hstepB = (size_t)HALF * K * 2;
    const size_t kstep = (size_t)(BK * 2);
    const unsigned ldsw = (unsigned)wid * 1024u;
    const int aoff = lds_byte(wr * 64 + fr, fq * 8), boff = lds_byte(wc * 32 + fr, fq * 8);
#define PG8_SA(b, h) (((b) * 2 + (h)) * HTB)
#define PG8_SB(b, h) ((4 + (b) * 2 + (h)) * HTB)
#define PG8_STAGE(bufoff, gbase, voff) do { _Pragma("unroll") for (int _i = 0; _i < 2; ++_i) \
        __builtin_amdgcn_global_load_lds((const unsigned*)((const char*)(gbase) + (voff)[_i]), (PG8_LAS unsigned*)(lds + (bufoff) + ldsw + _i * 8192), 16, 0, 0); } while (0)
#define PG8_RD16(off) (*(const PG8_LAS v4i*)(lds + (off)))
#define PG8_LDA(dst, b, h) do { _Pragma("unroll") for (int m = 0; m < 4; ++m) { \
        if constexpr (FP8) At8[m] = __builtin_shufflevector(PG8_RD16(PG8_SA(b, h) + aoff + m * 2048), PG8_RD16(PG8_SA(b, h) + aoff + m * 2048 + 1024), 0, 1, 2, 3, 4, 5, 6, 7); \
        else { _Pragma("unroll") for (int k = 0; k < 2; ++k) dst[m][k] = *(const PG8_LAS bf16x8*)(lds + PG8_SA(b, h) + aoff + m * 2048 + k * 1024); } } } while (0)
#define PG8_LDB(dst, b, h) do { _Pragma("unroll") for (int n = 0; n < 2; ++n) { \
        if constexpr (FP8) dst##8[n] = __builtin_shufflevector(PG8_RD16(PG8_SB(b, h) + boff + n * 2048), PG8_RD16(PG8_SB(b, h) + boff + n * 2048 + 1024), 0, 1, 2, 3, 4, 5, 6, 7); \
        else { _Pragma("unroll") for (int k = 0; k < 2; ++k) dst[n][k] = *(const PG8_LAS bf16x8*)(lds + PG8_SB(b, h) + boff + n * 2048 + k * 1024); } } } while (0)
#define PG8_MMA(ai, bj, At, Bt) do { __builtin_amdgcn_s_setprio(1); _Pragma("unroll") for (int m = 0; m < 4; ++m) _Pragma("unroll") for (int n = 0; n < 2; ++n) { \
        if constexpr (FP8) asm volatile("v_mfma_scale_f32_16x16x128_f8f6f4 %0, %1, %2, %0, %3, %3 op_sel_hi:[0,0,0]" : "+v"(acc[ai][bj][m][n]) : "v"(Bt##8[n]), "v"(At8[m]), "v"(sc1)); \
        else { _Pragma("unroll") for (int k = 0; k < 2; ++k) acc[ai][bj][m][n] = __builtin_amdgcn_mfma_f32_16x16x32_bf16(Bt[n][k], At[m][k], acc[ai][bj][m][n], 0, 0, 0); } } \
        __builtin_amdgcn_s_setprio(0); } while (0)
#define PG8_WAIT_V(n) asm volatile("s_waitcnt vmcnt(" #n ")" ::: "memory")
#define PG8_WAIT_L(n) asm volatile("s_waitcnt lgkmcnt(" #n ")" ::: "memory")
#define PG8_BAR __builtin_amdgcn_s_barrier()
#define PG8_SCHED __builtin_amdgcn_sched_barrier(0)
    Unit cur, nxt; int ui = 0;
    if (!S.next(0, cur)) return;
    f32x4 acc[2][2][4][2];
#pragma unroll
    for (int a = 0; a < 2; ++a)
#pragma unroll
        for (int b = 0; b < 2; ++b)
#pragma unroll
            for (int m = 0; m < 4; ++m)
#pragma unroll
                for (int n = 0; n < 2; ++n) acc[a][b][m][n] = (f32x4){0.f, 0.f, 0.f, 0.f};
    bf16x8 At[4][2], B0[2][2], B1[2][2];
    v8i At8[4], B08[2], B18[2];
    int sc1 = 0x7f7f7f7f; asm volatile("" : "+v"(sc1));
    unsigned vc[2][2], vn[2][2];
    S.a_voff(0, cur, tid, vc);
    const char* cA = S.a_ptr(cur); const char* cB = S.b_ptr(cur);
    PG8_STAGE(PG8_SB(0, 0), cB, voffB[0]); PG8_STAGE(PG8_SB(0, 1), (cB) + hstepB, voffB[0]); PG8_STAGE(PG8_SA(0, 0), cA, vc[0]); PG8_STAGE(PG8_SA(0, 1), cA, vc[1]);
    if (wr == 1) PG8_BAR;
    PG8_WAIT_V(2); PG8_BAR;
    PG8_STAGE(PG8_SB(1, 0), cB + kstep, voffB[0]); PG8_STAGE(PG8_SA(1, 0), cA + kstep, vc[0]); PG8_STAGE(PG8_SB(1, 1), (cB + kstep) + hstepB, voffB[0]);
    PG8_WAIT_V(6); PG8_BAR;
    for (;;) {
        const bool has_next = S.next(ui + 1, nxt);
        const char* nA = has_next ? S.a_ptr(nxt) : cA; const char* nB = has_next ? S.b_ptr(nxt) : cB;
        if (has_next) S.a_voff(ui + 1, nxt, tid, vn);
        else {
#pragma unroll
            for (int h = 0; h < 2; ++h)
#pragma unroll
                for (int i = 0; i < 2; ++i) vn[h][i] = vc[h][i]; }
        const bool full_hi = !TAIL || cur.nv > HALF;
        for (int t = 0; t < nt; t += 2) {
            const bool last = (t == nt - 2);
            const char* a1 = cA + (size_t)(t + 1) * kstep;
            const char* a2 = last ? nA : cA + (size_t)(t + 2) * kstep; const char* b2 = last ? nB : cB + (size_t)(t + 2) * kstep;
            const char* a3 = a2 + kstep; const char* b3 = b2 + kstep;
            unsigned w0[2], w1[2];
            w0[0] = last ? vn[0][0] : vc[0][0]; w0[1] = last ? vn[0][1] : vc[0][1]; w1[0] = last ? vn[1][0] : vc[1][0]; w1[1] = last ? vn[1][1] : vc[1][1];
            PG8_LDB(B0, 0, 0); PG8_LDB(B1, 0, 1); PG8_SCHED; PG8_LDA(At, 0, 0); PG8_STAGE(PG8_SA(1, 1), a1, vc[1]);
            PG8_WAIT_V(8); PG8_WAIT_L(0); PG8_BAR; PG8_MMA(0, 0, At, B0); PG8_MMA(0, 1, At, B1); PG8_BAR; PG8_SCHED;
            PG8_LDA(At, 0, 1); PG8_STAGE(PG8_SB(0, 0), b2, voffB[0]); PG8_STAGE(PG8_SB(0, 1), (b2) + hstepB, voffB[0]); PG8_STAGE(PG8_SA(0, 0), a2, w0);
            PG8_WAIT_V(8); PG8_WAIT_L(0); PG8_BAR; if (full_hi) { PG8_MMA(1, 0, At, B0); PG8_MMA(1, 1, At, B1); } PG8_BAR; PG8_SCHED;
            PG8_LDB(B0, 1, 0); PG8_LDB(B1, 1, 1); PG8_SCHED; PG8_LDA(At, 1, 0); PG8_STAGE(PG8_SA(0, 1), a2, w1);
            PG8_WAIT_V(8); PG8_WAIT_L(0); PG8_BAR; PG8_MMA(0, 0, At, B0); PG8_MMA(0, 1, At, B1); PG8_BAR; PG8_SCHED;
            PG8_LDA(At, 1, 1); PG8_STAGE(PG8_SB(1, 0), b3, voffB[0]); PG8_STAGE(PG8_SB(1, 1), (b3) + hstepB, voffB[0]); PG8_STAGE(PG8_SA(1, 0), a3, w0);
            PG8_WAIT_V(8); PG8_WAIT_L(0); PG8_BAR; if (full_hi) { PG8_MMA(1, 0, At, B0); PG8_MMA(1, 1, At, B1); } PG8_BAR; PG8_SCHED;
        }
        if (wr == 0) PG8_BAR;
        if constexpr (FP8) asm volatile("s_nop 15\n\ts_nop 15" ::: "memory");
        { int t2_ = threadIdx.x; asm volatile("" : "+v"(t2_)); E(acc, cur, ui, wr, wc, t2_ & 15, (t2_ >> 4) & 3); }
        if (!has_next) break;
#pragma unroll
        for (int a = 0; a < 2; ++a)
#pragma unroll
            for (int b = 0; b < 2; ++b)
#pragma unroll
                for (int m = 0; m < 4; ++m)
#pragma unroll
                    for (int n = 0; n < 2; ++n) acc[a][b][m][n] = (f32x4){0.f, 0.f, 0.f, 0.f};
        cur = nxt; cA = nA; cB = nB; ++ui;
#pragma unroll
        for (int h = 0; h < 2; ++h)
#pragma unroll
            for (int i = 0; i < 2; ++i) vc[h][i] = vn[h][i];
        if (wr == 1) PG8_BAR;
    }
    PG8_WAIT_V(0);
    PG8_BAR;
#undef PG8_SA
#undef PG8_SB
#undef PG8_STAGE
#undef PG8_LDA
#undef PG8_LDB
#undef PG8_MMA
#undef PG8_RD16
#undef PG8_WAIT_V
#undef PG8_WAIT_L
#undef PG8_BAR
#undef PG8_SCHED
}

struct EpiBf16 {
    bf16* O; int ldc;
    __device__ __forceinline__ void operator()(const f32x4 (&acc)[2][2][4][2], const Unit& u, int, int wr, int wc, int fr, int fq) const {
        const int row0 = u.pm * BM + wr * 64 + fr, col0 = u.pn * BM + wc * 32 + 8 * fq;
#pragma unroll
        for (int ai = 0; ai < 2; ++ai)
#pragma unroll
            for (int m = 0; m < 4; ++m) { bf16* rowp = O + (size_t)(row0 + ai * HALF + m * 16) * ldc + col0;
#pragma unroll
                for (int bj = 0; bj < 2; ++bj) { const f32x4 v0 = acc[ai][bj][m][0], v1 = acc[ai][bj][m][1];
                    u32x4 w; w.x = cvtpk(v0[0], v0[1]); w.y = cvtpk(v0[2], v0[3]); w.z = cvtpk(v1[0], v1[1]); w.w = cvtpk(v1[2], v1[3]);
                    *(u32x4*)(rowp + bj * HALF) = w; } }
    }
};
struct EpiTT {
    bf16* O; const float* RS;
    __device__ __forceinline__ void operator()(const f32x4 (&acc)[2][2][4][2], const Unit& u, int, int wr, int wc, int fr, int fq) const {
        const int row0 = u.pm * BM + wr * 64 + fr, tokb0 = u.pn * 8 + wc;
        f32x4 rs[2][2];
#pragma unroll
        for (int bj = 0; bj < 2; ++bj) { const float* rp = RS + (size_t)(tokb0 + 4 * bj) * 32 + 8 * fq; rs[bj][0] = *(const f32x4*)rp; rs[bj][1] = *(const f32x4*)(rp + 4); }
#pragma unroll
        for (int ai = 0; ai < 2; ++ai)
#pragma unroll
            for (int m = 0; m < 4; ++m) { const int col = row0 + ai * HALF + m * 16;
#pragma unroll
                for (int bj = 0; bj < 2; ++bj) { const f32x4 v0 = acc[ai][bj][m][0] * rs[bj][0], v1 = acc[ai][bj][m][1] * rs[bj][1];
                    u32x4 w; w.x = cvtpk(v0[0], v0[1]); w.y = cvtpk(v0[2], v0[3]); w.z = cvtpk(v1[0], v1[1]); w.w = cvtpk(v1[2], v1[3]);
                    *(u32x4*)(O + ((size_t)(tokb0 + 4 * bj) * 1280 + col) * 32 + 8 * fq) = w; } }
    }
};
struct EpiA {
    bf16 *SQ, *SK, *GQ, *GRS; const float *gq_norm, *gk_norm; const float* RS;
    __device__ __forceinline__ void operator()(const f32x4 (&acc)[2][2][4][2], const Unit& u, int, int wr, int wc, int fr, int fq) const {
        const int pn = u.pn; const int row0 = u.pm * BM + wr * 64 + fr;
        bf16* base; int ldc, colt; int mode;
        float scale = 1.f; const float* gain = nullptr;
        if (pn < 2)      { base = SQ; ldc = 512; colt = pn * 256; mode = 0; gain = gq_norm; scale = 0.125f * LOG2E; }
        else if (pn < 4) { base = SK; ldc = 512; colt = (pn - 2) * 256; mode = 0; gain = gk_norm; scale = 1.f; }
        else if (pn < 5) { base = GQ; ldc = 256; colt = 0; mode = 1; scale = 0.125f; }
        else             { base = GRS; ldc = 512; colt = (pn - 5) * 256; mode = 2; }
        const int col0 = colt + wc * 64 + 8 * fq;
        f32x4 gv[2][2];
#pragma unroll
        for (int bj = 0; bj < 2; ++bj)
#pragma unroll
            for (int n = 0; n < 2; ++n) { if (mode == 0) { gv[bj][n] = *(const f32x4*)(gain + 32 * bj + 8 * fq + 4 * n); gv[bj][n] = gv[bj][n] * scale; } else gv[bj][n] = (f32x4){scale, scale, scale, scale}; }
        float rs1v[2][4];
#pragma unroll
        for (int ai = 0; ai < 2; ++ai)
#pragma unroll
            for (int m = 0; m < 4; ++m) rs1v[ai][m] = RS[row0 + ai * HALF + m * 16];
#pragma unroll
        for (int ai = 0; ai < 2; ++ai)
#pragma unroll
            for (int m = 0; m < 4; ++m) {
                const float rs1 = rs1v[ai][m]; float rs = rs1;
                if (mode == 0) { float s = 0.f;
#pragma unroll
                    for (int bj = 0; bj < 2; ++bj)
#pragma unroll
                        for (int n = 0; n < 2; ++n) { const f32x4 x = acc[ai][bj][m][n]; s += (x[0] * x[0] + x[1] * x[1]) + (x[2] * x[2] + x[3] * x[3]); }
                    s += __shfl_xor(s, 16); s += __shfl_xor(s, 32);
                    rs = rs1 * __builtin_amdgcn_rsqf(rs1 * rs1 * s * (1.f / 64.f) + EPS); }
                bf16* rowp = base + (size_t)(row0 + ai * HALF + m * 16) * ldc + col0;
#pragma unroll
                for (int bj = 0; bj < 2; ++bj) { f32x4 v0 = acc[ai][bj][m][0], v1 = acc[ai][bj][m][1];
                    if (mode == 2) {
#pragma unroll
                        for (int e = 0; e < 4; ++e) { v0[e] *= rs1; v1[e] *= rs1; v0[e] = v0[e] * __builtin_amdgcn_rcpf(1.f + __builtin_amdgcn_exp2f(-v0[e] * LOG2E)); v1[e] = v1[e] * __builtin_amdgcn_rcpf(1.f + __builtin_amdgcn_exp2f(-v1[e] * LOG2E)); }
                    } else { v0 = v0 * rs * gv[bj][0]; v1 = v1 * rs * gv[bj][1]; }
                    u32x4 w; w.x = cvtpk(v0[0], v0[1]); w.y = cvtpk(v0[2], v0[3]); w.z = cvtpk(v1[0], v1[1]); w.w = cvtpk(v1[2], v1[3]);
                    *(u32x4*)(rowp + bj * 32) = w; } }
    }
};
struct EpiH {
    const bf16* XB; bf16* H; unsigned char* H8;
    __device__ __forceinline__ void operator()(const f32x4 (&acc)[2][2][4][2], const Unit& u, int, int wr, int wc, int fr, int fq) const {
        const int row0 = u.pm * BM + wr * 64 + fr, col0 = u.pn * BM + wc * 32 + 8 * fq;
#pragma unroll
        for (int ai = 0; ai < 2; ++ai) {
            bf16x8 xv[4][2];
#pragma unroll
            for (int m = 0; m < 4; ++m) { const size_t off = (size_t)(row0 + ai * HALF + m * 16) * DM + col0;
#pragma unroll
                for (int bj = 0; bj < 2; ++bj) xv[m][bj] = *(const bf16x8*)(XB + off + bj * HALF); }
#pragma unroll
            for (int m = 0; m < 4; ++m) { const size_t off = (size_t)(row0 + ai * HALF + m * 16) * DM + col0;
#pragma unroll
                for (int bj = 0; bj < 2; ++bj) { const bf16x8 xx = xv[m][bj];
                    const f32x4 v0 = acc[ai][bj][m][0] + (f32x4){bf2f(xx[0]), bf2f(xx[1]), bf2f(xx[2]), bf2f(xx[3])}, v1 = acc[ai][bj][m][1] + (f32x4){bf2f(xx[4]), bf2f(xx[5]), bf2f(xx[6]), bf2f(xx[7])};
                    u32x4 w; w.x = cvtpk(v0[0], v0[1]); w.y = cvtpk(v0[2], v0[3]); w.z = cvtpk(v1[0], v1[1]); w.w = cvtpk(v1[2], v1[3]);
                    *(u32x4*)(H + off + bj * HALF) = w;
                    const float f8[8] = {v0[0], v0[1], v0[2], v0[3], v1[0], v1[1], v1[2], v1[3]};
                    *(u32x2*)(H8 + off + bj * HALF) = pack8_fp8(f8); } }
        }
    }
};
struct EpiGU {
    unsigned char* ACT; const float* RSTD; const PG8_LAS int* tab;
    __device__ __forceinline__ void operator()(const f32x4 (&acc)[2][2][4][2], const Unit& u, int ui, int wr, int wc, int fr, int fq) const {
        const int col0 = u.pn * 128 + wc * 32 + 8 * fq;
        float rsv[2][4];
#pragma unroll
        for (int ai = 0; ai < 2; ++ai)
#pragma unroll
            for (int m = 0; m < 4; ++m) { const int rl = ai * HALF + wr * 64 + m * 16 + fr; rsv[ai][m] = RSTD[tab[T_ROWTAB / 4 + ui * 256 + rl] >> 1]; }
#pragma unroll
        for (int ai = 0; ai < 2; ++ai)
#pragma unroll
            for (int m = 0; m < 4; ++m) { const int rl = ai * HALF + wr * 64 + m * 16 + fr;
                if (rl < u.nv) {
                    const float rs = rsv[ai][m] * (1.f / WGU_SC);
                    f32x4 g0 = acc[ai][0][m][0] * rs, g1 = acc[ai][0][m][1] * rs, u0 = acc[ai][1][m][0] * rs, u1 = acc[ai][1][m][1] * rs;
#pragma unroll
                    for (int e = 0; e < 4; ++e) { g0[e] = g0[e] * __builtin_amdgcn_rcpf(1.f + __builtin_amdgcn_exp2f(-g0[e] * LOG2E)) * u0[e]; g1[e] = g1[e] * __builtin_amdgcn_rcpf(1.f + __builtin_amdgcn_exp2f(-g1[e] * LOG2E)) * u1[e]; }
                    float f8[8] = {g0[0] * ACT_SC, g0[1] * ACT_SC, g0[2] * ACT_SC, g0[3] * ACT_SC, g1[0] * ACT_SC, g1[1] * ACT_SC, g1[2] * ACT_SC, g1[3] * ACT_SC};
#pragma unroll
                    for (int e = 0; e < 8; ++e) f8[e] = __builtin_fminf(__builtin_fmaxf(f8[e], -448.f), 448.f);
                    *(u32x2*)(ACT + (size_t)(u.pm * 256 + rl) * DEXP + col0) = pack8_fp8(f8); } }
    }
};
struct EpiDown {
    unsigned char* Y; const PG8_LAS int* tab;
    __device__ __forceinline__ void operator()(const f32x4 (&acc)[2][2][4][2], const Unit& u, int ui, int wr, int wc, int fr, int fq) const {
        const int col0 = u.pn * BM + wc * 32 + 8 * fq; const float sc = Y_SC / (WD_SC * ACT_SC);
#pragma unroll
        for (int ai = 0; ai < 2; ++ai)
#pragma unroll
            for (int m = 0; m < 4; ++m) { const int rl = ai * HALF + wr * 64 + m * 16 + fr;
                if (rl < u.nv) { const unsigned ts = (unsigned)tab[T_ROWTAB / 4 + ui * 256 + rl]; unsigned char* rowp = Y + (size_t)ts * DM + col0;
#pragma unroll
                    for (int bj = 0; bj < 2; ++bj) { const f32x4 v0 = acc[ai][bj][m][0] * sc, v1 = acc[ai][bj][m][1] * sc;
                        const float f8[8] = {v0[0], v0[1], v0[2], v0[3], v1[0], v1[1], v1[2], v1[3]};
                        *(u32x2*)(rowp + bj * HALF) = pack8_fp8(f8); } } }
    }
};
}

#define XB_TMO      128
#define XB_XCNT(j)  (256  + 64 * (j))
#define XB_XSUB(j)  (1280 + 64 * (j))
#define XB_XGEN(j)  (2304 + 64 * (j))
#define XB_TOP      3328
#define XB_TOPGEN   3392
#define XCD_BAR_WORDS 3456
#define XB_SPIN_CAP (1u << 18)
__device__ __forceinline__ unsigned xb_ld(unsigned* p)              { return __hip_atomic_load(p, __ATOMIC_RELAXED, __HIP_MEMORY_SCOPE_AGENT); }
__device__ __forceinline__ unsigned xb_add(unsigned* p, unsigned v) { return __hip_atomic_fetch_add(p, v, __ATOMIC_RELAXED, __HIP_MEMORY_SCOPE_AGENT); }
__device__ __forceinline__ unsigned xb_xcc_id() { return (unsigned)__builtin_amdgcn_s_getreg((3 << 11) | 20) & 0xFu; }
#define XB_SPIN(cond, bar) do { unsigned _sp = 0; while (cond) { __builtin_amdgcn_s_sleep(1); \
    if ((++_sp & 255u) == 0u) { if (xb_ld(&(bar)[XB_TMO])) break; if (_sp > XB_SPIN_CAP) { atomicAdd(&(bar)[XB_TMO], 1u); break; } } } } while (0)
struct XcdBarrier { unsigned* bar; unsigned x; volatile LAS unsigned* st; };
__device__ __forceinline__ XcdBarrier xcd_barrier_post(unsigned* bar, volatile LAS unsigned* st) {
    XcdBarrier b; b.bar = bar; b.x = xb_xcc_id(); b.st = st;
    if (threadIdx.x == 0) (void)xb_add(&bar[XB_XCNT(b.x)], 1u);
    return b;
}
__device__ __forceinline__ void xcd_barrier_complete(unsigned* bar, unsigned x, unsigned& nloc, unsigned& nx) {
    const unsigned G = gridDim.x * gridDim.y * gridDim.z;
    unsigned sum, cnt, mine, sp = 0u;
    for (;;) {
        sum = 0u; cnt = 0u; mine = 0u;
#pragma unroll
        for (unsigned j = 0; j < 16; ++j) { const unsigned c = xb_ld(&bar[XB_XCNT(j)]); sum += c; cnt += (c > 0u) ? 1u : 0u; mine = (j == x) ? c : mine; }
        if (sum == G) break;
        __builtin_amdgcn_s_sleep(1);
        if ((++sp & 255u) == 0u) { if (xb_ld(&bar[XB_TMO])) break; if (sp > XB_SPIN_CAP) { atomicAdd(&bar[XB_TMO], 1u); break; } }
    }
    nloc = mine > 0u ? mine : 1u; nx = cnt > 0u ? cnt : 1u;
}
__device__ __forceinline__ void xcd_barrier(const XcdBarrier& b) {
    asm volatile("s_waitcnt vmcnt(0)" ::: "memory");
    __syncthreads();
    if (threadIdx.x == 0) {
        unsigned* bar = b.bar;
        __builtin_amdgcn_s_waitcnt(0);
        unsigned nloc = b.st[0], nx = b.st[1];
        if (nloc == 0u) { xcd_barrier_complete(bar, b.x, nloc, nx); b.st[0] = nloc; b.st[1] = nx; }
        const unsigned old = xb_add(&bar[XB_XSUB(b.x)], 1u);
        const unsigned gen = old / nloc;
        if (old + 1u == (gen + 1u) * nloc) {
            __builtin_amdgcn_fence(__ATOMIC_RELEASE, "agent");
            asm volatile("s_waitcnt vmcnt(0)" ::: "memory");
            const unsigned og = xb_add(&bar[XB_TOP], 1u);
            const unsigned tg = og / nx;
            if (og + 1u == (tg + 1u) * nx) xb_add(&bar[XB_TOPGEN], 1u);
            else XB_SPIN(xb_ld(&bar[XB_TOPGEN]) == tg, bar);
            __builtin_amdgcn_fence(__ATOMIC_ACQUIRE, "agent");
            xb_add(&bar[XB_XGEN(b.x)], 1u);
            asm volatile("s_waitcnt vmcnt(0)" ::: "memory");
        } else {
            XB_SPIN(xb_ld(&bar[XB_XGEN(b.x)]) == gen, bar);
            __builtin_amdgcn_fence(__ATOMIC_ACQUIRE, "agent");
            asm volatile("s_waitcnt vmcnt(0)" ::: "memory");
        }
    }
    __syncthreads();
}

__device__ __forceinline__ float wave_sum(float v) {
#pragma unroll
    for (int o = 1; o < 64; o <<= 1) v += __shfl_xor(v, o);
    return v;
}
__device__ __forceinline__ void tr_item(const float* src, int srcN, int k0, int n0, bf16* dst, int drow0, int dK, const float* kscale, LAS float* scr, int lane) {
    float w[32];
    const float* sp = src + (size_t)(k0 + (lane >> 5)) * srcN + n0 + (lane & 31);
#pragma unroll
    for (int i = 0; i < 32; ++i) w[i] = sp[(size_t)(2 * i) * srcN];
    if (kscale) { const float ksv = kscale[k0 + lane];
#pragma unroll
        for (int i = 0; i < 32; ++i) { const float a = __int_as_float(__builtin_amdgcn_readlane(__float_as_int(ksv), 2 * i)), b = __int_as_float(__builtin_amdgcn_readlane(__float_as_int(ksv), 2 * i + 1)); w[i] *= (lane >> 5) ? b : a; } }
#pragma unroll
    for (int i = 0; i < 32; ++i) scr[(2 * i + (lane >> 5)) * 33 + (lane & 31)] = w[i];
    LDS_WAIT(); asm volatile("" ::: "memory");
    const int c = lane & 7;
#pragma unroll
    for (int j = 0; j < 4; ++j) { const int n = (lane >> 3) + 8 * j; const LAS float* s = scr + (8 * c) * 33 + n;
        u32x4 o; o.x = cvtpk(s[0 * 33], s[1 * 33]); o.y = cvtpk(s[2 * 33], s[3 * 33]); o.z = cvtpk(s[4 * 33], s[5 * 33]); o.w = cvtpk(s[6 * 33], s[7 * 33]);
        *(GAS u32x4*)(dst + (size_t)(drow0 + n) * dK + k0 + 8 * c) = o; }
    LDS_WAIT(); asm volatile("" ::: "memory");
}

__device__ __forceinline__ void tr_item8(const float* src, int srcN, int k0, int n0, unsigned char* dst, int drow0, int dK, const float* kscale, float scale, LAS float* scr, int lane) {
    float w[32];
    const float* sp = src + (size_t)(k0 + (lane >> 5)) * srcN + n0 + (lane & 31);
#pragma unroll
    for (int i = 0; i < 32; ++i) w[i] = sp[(size_t)(2 * i) * srcN];
    float ksv = scale; if (kscale) ksv *= kscale[k0 + lane];
#pragma unroll
    for (int i = 0; i < 32; ++i) { const float a = __int_as_float(__builtin_amdgcn_readlane(__float_as_int(ksv), 2 * i)), b = __int_as_float(__builtin_amdgcn_readlane(__float_as_int(ksv), 2 * i + 1)); w[i] *= (lane >> 5) ? b : a; }
#pragma unroll
    for (int i = 0; i < 32; ++i) scr[(2 * i + (lane >> 5)) * 33 + (lane & 31)] = w[i];
    LDS_WAIT(); asm volatile("" ::: "memory");
#pragma unroll
    for (int j = 0; j < 2; ++j) { const int idx = lane + 64 * j, n = idx >> 2, c = idx & 3; const LAS float* sc_ = scr + (16 * c) * 33 + n;
        float f[16];
#pragma unroll
        for (int i = 0; i < 16; ++i) f[i] = sc_[i * 33];
        const u32x2 lo = pack8_fp8(f), hi = pack8_fp8(f + 8);
        u32x4 o; o.x = lo.x; o.y = lo.y; o.z = hi.x; o.w = hi.y;
        *(GAS u32x4*)(dst + (size_t)(drow0 + n) * dK + k0 + 16 * c) = o; }
    LDS_WAIT(); asm volatile("" ::: "memory");
}

struct Ptrs {
    const float *x, *attn_g, *w_in, *sbq_g, *sbk_g, *sbo_g, *w2, *gate_b, *glan_g, *w_out, *ffn_g, *rg_w, *rg_b, *re_w, *re_b, *wg, *wu, *wd;
    float* out; unsigned char* ws;
};

constexpr int SB_SPAN = 14, SB_VOFF = SB_SPAN * 4096;
__device__ __forceinline__ int sb_keyK(int r) { return ((r >> 1) & 3) | (((r >> 4) & 1) << 2); }
__device__ __forceinline__ int sb_keyV(int r) { return ((r >> 2) & 1) | (((r >> 4) & 1) << 1); }
__device__ __forceinline__ void sb_round(LAS unsigned char* lds, const bf16* SQ, const bf16* SK, const bf16* TT, const float* gout, bf16* MIX, int b, int h, int qg, int tid, int wave, int lane) {
    const int il = lane & 31, hi = lane >> 5, pil = PI32(il);
    const int qt = 8 * qg + wave;
    const size_t row0 = (size_t)b * SEQ + (size_t)qt * 32;
    bf16x8 qf[4];
    { const bf16* qp = SQ + (row0 + il) * 512 + h * 64 + 32 * hi;
#pragma unroll
      for (int s = 0; s < 4; ++s) qf[s] = *(const bf16x8*)(qp + 8 * s); }
    const int lo = (8 * qg - 6) > 0 ? (8 * qg - 6) : 0, nblk = 8 * qg + 8 - lo;
    {
        u32x4 st[SB_SPAN];
        const bool isK = tid < 256; const int q = tid - 256;
        const bf16* src = isK ? SK + ((size_t)b * SEQ + (size_t)lo * 32 + (tid >> 3)) * 512 + h * 64 + 8 * (tid & 7)
                              : TT + ((size_t)(b * (SEQ / 32) + lo) * NB + h * 64 + (q >> 2)) * 32 + 8 * (q & 3);
        const size_t bstep = isK ? (size_t)32 * 512 : (size_t)NB * 32;
#pragma unroll
        for (int i = 0; i < SB_SPAN; ++i) if (i < nblk) st[i] = *(const u32x4*)(src + (size_t)i * bstep);
        const int r = isK ? (tid >> 3) : (q >> 2);
        const unsigned dst = isK ? (unsigned)(r * 128 + (((tid & 7) ^ sb_keyK(r)) << 4)) : (unsigned)(SB_VOFF + r * 64 + (((q & 3) ^ sb_keyV(r & 31)) << 4));
#pragma unroll
        for (int i = 0; i < SB_SPAN; ++i) if (i < nblk) *(LAS u32x4*)(lds + dst + i * 4096) = st[i];
    }
    __syncthreads();
    f32x16 o0, o1;
#pragma unroll
    for (int r = 0; r < 16; ++r) { o0[r] = 0.f; o1[r] = 0.f; }
    float R = 1.f;
#define SB_MATH(KC, VC, kb_) do { \
        f32x16 z; \
        _Pragma("unroll") for (int r = 0; r < 16; ++r) z[r] = 0.f; \
        _Pragma("unroll") for (int s = 0; s < 4; ++s) z = MFMA32(KC[s], qf[s], z); \
        float beta[16], omb[16]; \
        const bool diag = ((kb_) == qt); \
        _Pragma("unroll") for (int r = 0; r < 16; ++r) { \
            const float zz = z[r]; const float t = __builtin_amdgcn_exp2f(-__builtin_fabsf(zz)); const float rr = __builtin_amdgcn_rcpf(1.f + t); const float sm = t * rr; \
            const bool pos = zz >= 0.f; float be = pos ? rr : sm; float om = pos ? sm : rr; \
            if (diag) { const bool valid = (16 * hi + r) < il; be = valid ? be : 0.f; om = valid ? om : 1.f; } \
            beta[r] = be; omb[r] = om; } \
        float e[16]; e[15] = 1.f; \
        _Pragma("unroll") for (int r = 14; r >= 0; --r) e[r] = e[r + 1] * omb[r + 1]; \
        const float P16 = e[0] * omb[0]; \
        float Plo, Phi; swap32(P16, Plo, Phi); \
        const float base = R * (hi ? 1.f : Phi); \
        float a[16]; \
        _Pragma("unroll") for (int r = 0; r < 16; ++r) a[r] = beta[r] * e[r] * base; \
        R = R * (Plo * Phi); \
        const bf16x8 p0 = pack8(a), p1 = pack8(a + 8); \
        o0 = MFMA32(VC[0][0], p0, o0); o0 = MFMA32(VC[0][1], p1, o0); \
        o1 = MFMA32(VC[1][0], p0, o1); o1 = MFMA32(VC[1][1], p1, o1); } while (0)
    bool fin = false;
    {
        const unsigned kbase = (unsigned)(pil * 128), vbase = (unsigned)(SB_VOFF + pil * 64);
        unsigned kx[4], vx[2];
#pragma unroll
        for (int s = 0; s < 4; ++s) kx[s] = (unsigned)(((4 * hi + s) ^ sb_keyK(pil)) << 4);
#pragma unroll
        for (int s = 0; s < 2; ++s) vx[s] = (unsigned)(((2 * hi + s) ^ sb_keyV(pil)) << 4);
        for (int kb = qt; ; --kb) {
            const unsigned so = (unsigned)(kb - lo) * 4096u;
            bf16x8 kf[4], vf[2][2];
#pragma unroll
            for (int s = 0; s < 4; ++s) kf[s] = *(const LAS bf16x8*)(lds + so + kbase + kx[s]);
#pragma unroll
            for (int dt = 0; dt < 2; ++dt)
#pragma unroll
                for (int s = 0; s < 2; ++s) vf[dt][s] = *(const LAS bf16x8*)(lds + so + vbase + dt * 2048 + vx[s]);
            SB_MATH(kf, vf, kb);
            if (kb == 0 || __all(R == 0.f)) { fin = true; break; }
            if (kb == lo) break;
        }
    }
    if (!fin) {
        for (int kb = lo - 1; ; --kb) {
            bf16x8 kf[4], vf[2][2];
            const bf16* kp = SK + ((size_t)b * SEQ + (size_t)kb * 32 + pil) * 512 + h * 64 + 32 * hi;
#pragma unroll
            for (int s = 0; s < 4; ++s) kf[s] = *(const bf16x8*)(kp + 8 * s);
            const bf16* vp = TT + ((size_t)(b * (SEQ / 32) + kb) * NB + h * 64 + pil) * 32 + 16 * hi;
#pragma unroll
            for (int dt = 0; dt < 2; ++dt)
#pragma unroll
                for (int s = 0; s < 2; ++s) vf[dt][s] = *(const bf16x8*)(vp + dt * 32 * 32 + 8 * s);
            SB_MATH(kf, vf, kb);
            if (kb == 0 || __all(R == 0.f)) break;
        }
    }
#undef SB_MATH
    float ss = 0.f;
#pragma unroll
    for (int r = 0; r < 16; ++r) ss += o0[r] * o0[r] + o1[r] * o1[r];
    float slo, shi; swap32(ss, slo, shi);
    const float rstd = __builtin_amdgcn_rsqf((slo + shi) * (1.f / 64.f) + EPS);
    bf16* op = MIX + (row0 + il) * DM + h * 64 + 16 * hi;
#pragma unroll
    for (int dt = 0; dt < 2; ++dt) {
        float v[16];
#pragma unroll
        for (int r4 = 0; r4 < 4; ++r4) { const f32x4 g = *(const f32x4*)(gout + 32 * dt + 16 * hi + 4 * r4);
#pragma unroll
            for (int e2 = 0; e2 < 4; ++e2) v[4 * r4 + e2] = (dt ? o1[4 * r4 + e2] : o0[4 * r4 + e2]) * rstd * g[e2]; }
        *(bf16x8*)(op + 32 * dt) = pack8(v); *(bf16x8*)(op + 32 * dt + 8) = pack8(v + 8);
    }
    __syncthreads();
}

__device__ __forceinline__ void gla_a(const bf16* GLR, const bf16* W2T, const float* gate_b, const bf16* TT, bf16* KV, float* DTOT, int bh, int j, int lane) {
    const int il = lane & 31, hi = lane >> 5, pil = PI32(il);
    const int b = bh >> 2, h = bh & 3;
    const size_t t0 = (size_t)b * SEQ + (size_t)j * 64;
    bf16x8 gf[2], wf[2], gkf[2][2][2], bvf[4][4]; float bias[2];
#pragma unroll
    for (int ch = 0; ch < 2; ++ch) gf[ch] = *(const bf16x8*)(GLR + (t0 + 32 * ch + pil) * 16 + 8 * hi);
#pragma unroll
    for (int kh = 0; kh < 2; ++kh) { const int kcol = 64 * h + 32 * kh + pil; wf[kh] = *(const bf16x8*)(W2T + kcol * 16 + 8 * hi); bias[kh] = gate_b[kcol];
        const bf16* gkp = TT + ((t0 >> 5) * NB + 512 + kcol) * 32 + 16 * hi;
#pragma unroll
        for (int ch = 0; ch < 2; ++ch) { gkf[kh][ch][0] = *(const bf16x8*)(gkp + ch * NB * 32); gkf[kh][ch][1] = *(const bf16x8*)(gkp + ch * NB * 32 + 8); } }
#pragma unroll
    for (int vq = 0; vq < 4; ++vq) { const bf16* vp = TT + ((t0 >> 5) * NB + 768 + 128 * h + 32 * vq + il) * 32 + 16 * hi;
#pragma unroll
        for (int s = 0; s < 4; ++s) bvf[vq][s] = *(const bf16x8*)(vp + (s >> 1) * NB * 32 + 8 * (s & 1)); }
    bf16x8 akf[2][4];
#pragma unroll
    for (int kh = 0; kh < 2; ++kh) {
        const int kcol = 64 * h + 32 * kh + pil;
        float cs[2][16];
#pragma unroll
        for (int ch = 0; ch < 2; ++ch) {
            f32x16 g;
#pragma unroll
            for (int r = 0; r < 16; ++r) g[r] = 0.f;
            g = MFMA32(gf[ch], wf[kh], g);
            if (kh == 0 && ch == 0) asm volatile("" : "+v"(g) :: "memory");
            float run = 0.f;
#pragma unroll
            for (int r = 0; r < 16; ++r) { const float x = g[r] + bias[kh];
                const float ls2 = __builtin_fminf(x, 0.f) * LOG2E - __builtin_amdgcn_logf(1.f + __builtin_amdgcn_exp2f(-__builtin_fabsf(x) * LOG2E));
                run += ls2 * (1.f / 16.f); cs[ch][r] = run; }
        }
        float t0lo, t0hi, t1lo, t1hi; swap32(cs[0][15], t0lo, t0hi); swap32(cs[1][15], t1lo, t1hi);
        const float off0 = hi ? t0lo : 0.f, off1 = (t0lo + t0hi) + (hi ? t1lo : 0.f), total = (t0lo + t0hi) + (t1lo + t1hi);
        if (hi == 0) DTOT[((size_t)bh * 32 + j) * 64 + 32 * kh + pil] = __builtin_amdgcn_exp2f(total);
#pragma unroll
        for (int ch = 0; ch < 2; ++ch) {
            const bf16x8 k0 = gkf[kh][ch][0], k1 = gkf[kh][ch][1];
            float kd[16]; const float off = ch ? off1 : off0;
#pragma unroll
            for (int r = 0; r < 16; ++r) { const float dec = __builtin_amdgcn_exp2f(total - (cs[ch][r] + off)); kd[r] = bf2f(r < 8 ? k0[r] : k1[r - 8]) * dec; }
            akf[kh][2 * ch] = pack8(kd); akf[kh][2 * ch + 1] = pack8(kd + 8);
        }
    }
#pragma unroll
    for (int vq = 0; vq < 4; ++vq) {
#pragma unroll
        for (int kh = 0; kh < 2; ++kh) {
            f32x16 kv;
#pragma unroll
            for (int r = 0; r < 16; ++r) kv[r] = 0.f;
#pragma unroll
            for (int s = 0; s < 4; ++s) kv = MFMA32(akf[kh][s], bvf[vq][s], kv);
            bf16* dst = KV + (((size_t)bh * 32 + j) * 128 + 32 * vq + il) * 64 + 32 * kh + 16 * hi;
            float kvf[16];
#pragma unroll
            for (int r = 0; r < 16; ++r) kvf[r] = kv[r];
            *(bf16x8*)dst = pack8(kvf); *(bf16x8*)(dst + 8) = pack8(kvf + 8);
        }
    }
}
__device__ __forceinline__ void gla_b(const bf16* KV, const float* DTOT, bf16* ST, int task, int lane) {
    const int bh = task >> 5, part = task & 31; const int e0 = part * 256 + lane * 4; const int k = e0 & 63;
    f32x4 S = (f32x4){0.f, 0.f, 0.f, 0.f};
#pragma unroll
    for (int half = 0; half < 2; ++half) {
        u32x2 kvp[16]; f32x4 d[16];
#pragma unroll
        for (int q = 0; q < 16; ++q) { const int j = 16 * half + q;
            kvp[q] = *(const u32x2*)(KV + ((size_t)bh * 32 + j) * 8192 + e0); d[q] = *(const f32x4*)(DTOT + ((size_t)bh * 32 + j) * 64 + k); }
#pragma unroll
        for (int q = 0; q < 16; ++q) { const int j = 16 * half + q;
            const f32x4 kv = (f32x4){__uint_as_float(kvp[q].x << 16), __uint_as_float(kvp[q].x & 0xffff0000u), __uint_as_float(kvp[q].y << 16), __uint_as_float(kvp[q].y & 0xffff0000u)};
            S = d[q] * S + kv;
            u32x2 w; w.x = cvtpk(S[0], S[1]); w.y = cvtpk(S[2], S[3]);
            *(u32x2*)(ST + ((size_t)bh * 32 + j) * 8192 + e0) = w; }
        asm volatile("" ::: "memory");
    }
}
__device__ __forceinline__ void gla_c(LAS unsigned char* wl, const bf16* ST, const bf16* GQ, const bf16* GRS, const float* gn, bf16* MIX, int bh, int j, int lane) {
    const int il = lane & 31, hi = lane >> 5, pil = PI32(il);
    const int b = bh >> 2, h = bh & 3;
    const size_t t0 = (size_t)b * SEQ + (size_t)j * 64;
    const bf16* sp = ST + ((size_t)bh * 32 + j) * 8192 + lane * 8;
    u32x4 st[16];
#pragma unroll
    for (int i = 0; i < 16; ++i) st[i] = *(const u32x4*)(sp + i * 512);
    bf16x8 bq[2][4], gr[2][4][2];
#pragma unroll
    for (int ch = 0; ch < 2; ++ch) { const size_t row = t0 + 32 * ch + il;
#pragma unroll
        for (int s = 0; s < 4; ++s) bq[ch][s] = *(const bf16x8*)(GQ + row * 256 + 64 * h + 16 * s + 8 * hi); }
    { const size_t row = t0 + il;
#pragma unroll
      for (int vt = 0; vt < 4; ++vt) { gr[0][vt][0] = *(const bf16x8*)(GRS + row * 512 + 128 * h + 32 * vt + 16 * hi); gr[0][vt][1] = *(const bf16x8*)(GRS + row * 512 + 128 * h + 32 * vt + 16 * hi + 8); } }
    { const int vr = lane >> 3, c = lane & 7;
#pragma unroll
      for (int i = 0; i < 16; ++i) { const int v = 8 * i + vr; *(LAS u32x4*)(wl + v * 128 + ((c ^ sb_keyK(v & 31)) << 4)) = st[i]; } }
    LDS_WAIT(); asm volatile("" ::: "memory");
    unsigned ax[4];
#pragma unroll
    for (int s = 0; s < 4; ++s) ax[s] = (unsigned)(pil * 128 + (((2 * s + hi) ^ sb_keyK(pil)) << 4));
#pragma unroll
    for (int ch = 0; ch < 2; ++ch) {
        const size_t row = t0 + 32 * ch + il;
        f32x16 O[4]; float ss = 0.f;
#pragma unroll
        for (int vt = 0; vt < 4; ++vt) {
#pragma unroll
            for (int r = 0; r < 16; ++r) O[vt][r] = 0.f;
#pragma unroll
            for (int s = 0; s < 4; ++s) { const bf16x8 af = *(const LAS bf16x8*)(wl + vt * 4096 + ax[s]); O[vt] = MFMA32(af, bq[ch][s], O[vt]); }
            if (ch == 0 && vt == 0) {
                const size_t row1 = t0 + 32 + il;
#pragma unroll
                for (int v2 = 0; v2 < 4; ++v2) { gr[1][v2][0] = *(const bf16x8*)(GRS + row1 * 512 + 128 * h + 32 * v2 + 16 * hi); gr[1][v2][1] = *(const bf16x8*)(GRS + row1 * 512 + 128 * h + 32 * v2 + 16 * hi + 8); }
                asm volatile("" : "+v"(O[0]) :: "memory"); }
#pragma unroll
            for (int r = 0; r < 16; ++r) ss += O[vt][r] * O[vt][r];
        }
        float slo, shi; swap32(ss, slo, shi);
        const float rstd = __builtin_amdgcn_rsqf((slo + shi) * (1.f / 128.f) + EPS);
#pragma unroll
        for (int vt = 0; vt < 4; ++vt) {
            const int vc0 = 32 * vt + 16 * hi;
            float v[16];
#pragma unroll
            for (int r4 = 0; r4 < 4; ++r4) { const f32x4 g = *(const f32x4*)(gn + vc0 + 4 * r4);
#pragma unroll
                for (int e2 = 0; e2 < 4; ++e2) { const int r = 4 * r4 + e2; v[r] = O[vt][r] * rstd * g[e2] * bf2f(r < 8 ? gr[ch][vt][0][r] : gr[ch][vt][1][r - 8]); } }
            bf16* op = MIX + row * DM + 512 + 128 * h + vc0;
            *(bf16x8*)(op) = pack8(v); *(bf16x8*)(op + 8) = pack8(v + 8);
        }
    }
    LDS_WAIT(); asm volatile("" ::: "memory");
}

constexpr int NWAVES = 8;
constexpr int N_PHASES = 10;
struct Args { Ptrs p; int ph_lo, ph_hi; };

__global__ void __launch_bounds__(NWAVES * 64, 2) fwd_kernel(Args args) {
    extern __shared__ __attribute__((aligned(16))) unsigned char lds_raw[];
    LAS unsigned char* lds = (LAS unsigned char*)lds_raw;
    const Ptrs& P = args.p;
    const int tid = threadIdx.x, lane = tid & 63, wave = __builtin_amdgcn_readfirstlane(tid >> 6);
    const int G = gridDim.x; const int bx = blockIdx.x; const int vcu = (G % 8 == 0) ? (bx % 8) * (G / 8) + bx / 8 : bx;
    const int gw = vcu * NWAVES + wave, NGW = G * NWAVES;
    unsigned char* ws = P.ws;
    gu32* ctl = (gu32*)(ws + WS_CTL);
    volatile LAS unsigned* MISC = (volatile LAS unsigned*)(lds + MISC_OFF);
    LAS int* tab = (LAS int*)(lds + TAB_OFF);
    for (int u = tid; u < (LDS_BYTES - LDSCTL_OFF) / 4; u += NWAVES * 64) ((LAS unsigned*)(lds + LDSCTL_OFF))[u] = 0u;
    __syncthreads();
    XcdBarrier bar; bar.bar = (unsigned*)(ctl + CW_BAR); bar.x = 0; bar.st = nullptr;
    if (MK_N_LAUNCHES == 1) bar = xcd_barrier_post((unsigned*)(ctl + CW_BAR), MISC + 8);
#define GRID_BAR() do { if (MK_N_LAUNCHES == 1) xcd_barrier(bar); } while (0)
    const int lo = args.ph_lo, hi_ph = args.ph_hi;
#ifndef PHASE_MASK
#define PHASE_MASK 0x3ff
#endif
#define IN(k) (((PHASE_MASK >> (k)) & 1) && lo <= (k) && (k) < hi_ph)
#define BOTH(k) (IN(k) && IN((k) + 1))
#ifndef PROBE_TWICE
#define PROBE_TWICE -1
#endif
#define REP(k) for (int rep_ = 0; rep_ < ((PROBE_TWICE == (k)) ? 2 : 1); ++rep_)
#define REPBAR(k) do { if (PROBE_TWICE == (k) && rep_ == 0) GRID_BAR(); } while (0)

    bf16* WA = (bf16*)(ws + WS_WA); bf16* WB = (bf16*)(ws + WS_WB); bf16* WO = (bf16*)(ws + WS_WO);
    bf16* WRH = (bf16*)(ws + WS_WR); bf16* WRL = WRH + 48 * 1024; bf16* W2T = (bf16*)(ws + WS_W2T);
    bf16* WGU = (bf16*)(ws + WS_WGU); bf16* WD = (bf16*)(ws + WS_WD);
    bf16* H = (bf16*)(ws + WS_H); bf16* KV = (bf16*)(ws + WS_KV);
    bf16* XB = (bf16*)(ws + WS_XB); bf16* MIX = (bf16*)(ws + WS_MIX); float* RSTD1 = (float*)(ws + WS_RSTD1);
    bf16* SQ = (bf16*)(ws + WS_SQ); bf16* SK = (bf16*)(ws + WS_SK); bf16* GQ = (bf16*)(ws + WS_GQ); bf16* GRS = (bf16*)(ws + WS_GRS);
    bf16* TT = (bf16*)(ws + WS_TT); bf16* GLR = (bf16*)(ws + WS_GLR); bf16* ST = (bf16*)(ws + WS_ST); float* DTOT = (float*)(ws + WS_DTOT);
    unsigned char* ACT = ws + WS_ACT; unsigned char* Y = ws + WS_Y;
    unsigned char* WGU8 = ws + WS_WGU; unsigned char* WD8 = ws + WS_WD; unsigned char* H8 = ws + WS_H8;
    unsigned* LOCL = (unsigned*)(ws + WS_LOCL); unsigned* CNTS = (unsigned*)(ws + WS_CNTS); float* GATE = (float*)(ws + WS_GATE); float* RSTD = (float*)(ws + WS_RSTD);

    if (IN(0)) { REP(0) {
        LAS float* scr = (LAS float*)(lds + RING_OFF + wave * 16384);
        constexpr int I_A = (NA / 32) * 16, I_B = (NB / 32) * 16, I_O = 32 * 16, I_GU = 32 * 32 * 16, I_D = 32 * 32 * 8;
        constexpr int NITEMS = I_A + I_B + I_O + I_GU;
        for (int it = gw; it < NITEMS; it += NGW) {
            int r = it;
            if (r < I_A) { const int ib = r >> 4, kb = r & 15, P0 = 32 * ib; const int pn = P0 >> 8, bj = (P0 >> 7) & 1, wcc = (P0 >> 5) & 3; const int LA = 256 * pn + 64 * wcc + 32 * bj;
                const int sc = LA < 1024 ? LA : (LA < 1280 ? 1536 + (LA - 1024) : 2560 + (LA - 1280));
                tr_item(P.w_in, IN_DIM, 64 * kb, sc, WA, P0, DM, P.attn_g, scr, lane); continue; } r -= I_A;
            if (r < I_B) { const int ib = r >> 4, kb = r & 15, P0 = 32 * ib; const int sc = P0 < 512 ? 1024 + P0 : (P0 < 768 ? 1792 + (P0 - 512) : 2048 + (P0 - 768));
                tr_item(P.w_in, IN_DIM, 64 * kb, sc, WB, P0, DM, P.attn_g, scr, lane); continue; } r -= I_B;
            if (r < I_O) { const int ib = r >> 4, kb = r & 15; tr_item(P.w_out, DM, 64 * kb, 32 * ib, WO, 32 * ib, DM, nullptr, scr, lane); continue; } r -= I_O;
            if (r < I_GU) { const int e = r >> 9, q = r & 511, ib = 4 * (q >> 6) + (q & 3), kb = 2 * ((q >> 3) & 7) + ((q >> 2) & 1), P0 = 32 * ib; const int pn = P0 >> 8, bj = (P0 >> 7) & 1, r0 = P0 & 127;
                const float* src = (bj ? P.wu : P.wg) + (size_t)e * DM * DEXP;
                tr_item8(src, DEXP, 64 * kb, 128 * pn + r0, WGU8 + (size_t)e * DM * DM, P0, DM, P.ffn_g, WGU_SC, scr, lane); continue; }
        }
        (void)I_D;
        for (int idx = gw * 64 + lane; idx < 48 * 1024; idx += NGW * 64) {
            const int rho = idx >> 10, k = idx & 1023, m = rho >> 4, i = rho & 15;
            float v = (m < 2) ? P.re_w[k * 32 + 8 * (i >> 2) + 4 * m + (i & 3)] : P.rg_w[k * 4 + (i & 3)];
            v *= P.ffn_g[k];
            WRH[idx] = __builtin_bit_cast(unsigned short, (_Float16)v);
        }
        for (int idx = gw * 64 + lane; idx < 256 * 16; idx += NGW * 64) { const int kc = idx >> 4, r = idx & 15; W2T[idx] = (bf16)(cvtpk(P.w2[r * 256 + kc], 0.f) & 0xffffu); }
        __syncthreads();
        constexpr int WLP = 1032;
        LAS bf16* wl = (LAS bf16*)(lds + RING_OFF);
        for (int idx = tid; idx < 16 * 1024; idx += NWAVES * 64) { const int c = idx & 15, k = idx >> 4; wl[c * WLP + k] = (bf16)(cvtpk(P.attn_g[k] * P.w_in[(size_t)k * IN_DIM + 3072 + c], 0.f) & 0xffffu); }
        __syncthreads();
        {
            for (int task = gw; task < NTOK / 16; task += NGW) {
                const size_t row0 = (size_t)task * 16;
                f32x4 cur[4], nxt[4]; float rsv = 0.f;
#pragma unroll
                for (int j = 0; j < 4; ++j) { cur[j] = *((const GAS f32x4*)(P.x + row0 * DM) + lane + 64 * j); nxt[j] = cur[j]; }
#pragma unroll 2
                for (int r = 0; r < 16; ++r) {
                    if (r < 15) {
#pragma unroll
                        for (int j = 0; j < 4; ++j) nxt[j] = *((const GAS f32x4*)(P.x + (row0 + r + 1) * DM) + lane + 64 * j); }
                    float s2 = 0.f;
#pragma unroll
                    for (int j = 0; j < 4; ++j) s2 += (cur[j].x * cur[j].x + cur[j].y * cur[j].y) + (cur[j].z * cur[j].z + cur[j].w * cur[j].w);
                    const float rstd = __builtin_amdgcn_rsqf(wave_sum(s2) * (1.f / DM) + EPS);
                    if ((lane & 15) == r) rsv = rstd;
                    GAS unsigned long long* o8 = (GAS unsigned long long*)(XB + (row0 + r) * DM) + lane;
#pragma unroll
                    for (int j = 0; j < 4; ++j) { const f32x4 v = cur[j];
                        o8[64 * j] = (unsigned long long)cvtpk(v.x, v.y) | ((unsigned long long)cvtpk(v.z, v.w) << 32); }
#pragma unroll
                    for (int j = 0; j < 4; ++j) cur[j] = nxt[j];
                }
                if (lane < 16) RSTD1[row0 + lane] = rsv;
                VM_WAIT();
                const int fr = lane & 15, fq = lane >> 4;
                f32x4 acc = (f32x4){0.f, 0.f, 0.f, 0.f};
                const bf16* up = XB + (row0 + fr) * DM + 8 * fq;
#pragma unroll 8
                for (int ks = 0; ks < 32; ++ks) { const bf16x8 ub = *(const bf16x8*)(up + 32 * ks); const bf16x8 wb = *(const LAS bf16x8*)(wl + fr * WLP + 32 * ks + 8 * fq); acc = MFMA16(wb, ub, acc); }
                u32x2 o; o.x = cvtpk(acc[0] * rsv, acc[1] * rsv); o.y = cvtpk(acc[2] * rsv, acc[3] * rsv);
                *(u32x2*)(GLR + (row0 + fr) * 16 + 4 * fq) = o;
            }
        }
        __syncthreads();
        REPBAR(0); }
        if (BOTH(0)) GRID_BAR();
    }

#define PH1_BODY() do { \
        { pg8::SchedDense S; S.init(XB, WA, NTOK, NA, DM, G, bx); \
          pg8::EpiA E{SQ, SK, GQ, GRS, P.sbq_g, P.sbk_g, RSTD1}; \
          pg8::gemm_phase<pg8::EpiA, pg8::SchedDense>(lds + RING_OFF, DM, S, E); } \
        { pg8::SchedDense S; S.init(WB, XB, NB, NTOK, DM, G, (bx + G / 2) % G); \
          pg8::EpiTT E{TT, RSTD1}; \
          pg8::gemm_phase<pg8::EpiTT, pg8::SchedDense>(lds + RING_OFF, DM, S, E); } } while (0)
    if (IN(1)) {
        if (PROBE_TWICE == 1) { PH1_BODY(); GRID_BAR(); }
        PH1_BODY();
        if (BOTH(1)) GRID_BAR();
    }

#define SB_ROUND(rho_) do { for (int u__ = (rho_) * G + vcu; u__ < 1024; u__ += 4 * G) { const int bh_ = u__ & 127; \
        sb_round(lds + RING_OFF, SQ, SK, TT, P.sbo_g + (bh_ & 7) * 64, MIX, bh_ >> 3, bh_ & 7, u__ >> 7, tid, wave, lane); } } while (0)
#define REPX(code) for (int rx_ = 0; rx_ < ((PROBE_TWICE == (code)) ? 5 : 1); ++rx_)
    if (IN(2)) { REP(2) {
        REPX(20) for (int t = gw; t < 2048; t += NGW) gla_a(GLR, W2T, P.gate_b, TT, KV, DTOT, t >> 5, t & 31, lane);
        REPX(21) SB_ROUND(0);
        REPBAR(2); }
        if (BOTH(2)) GRID_BAR();
    }
    if (IN(3)) { REP(3) {
        REPX(22) for (int t = gw; t < 2048; t += NGW) gla_b(KV, DTOT, ST, t, lane);
        SB_ROUND(1);
        REPBAR(3); }
        if (BOTH(3)) GRID_BAR();
    }
    if (IN(4)) { REP(4) {
        REPX(23) for (int t = gw; t < 2048; t += NGW) gla_c(lds + RING_OFF + wave * 16384, ST, GQ, GRS, P.glan_g, MIX, t >> 5, t & 31, lane);
        __syncthreads();
        SB_ROUND(2); SB_ROUND(3);
        REPBAR(4); }
        if (BOTH(4)) GRID_BAR();
    }

#define PH5_BODY() do { \
        pg8::SchedDense S; S.init(MIX, WO, NTOK, DM, DM, G, bx); \
        pg8::EpiH E{XB, H, H8}; \
        pg8::gemm_phase<pg8::EpiH, pg8::SchedDense>(lds + RING_OFF, DM, S, E); } while (0)
    if (IN(5)) {
        if (PROBE_TWICE == 5) { PH5_BODY(); GRID_BAR(); }
        PH5_BODY();
        if (BOTH(5)) GRID_BAR();
    }

    if (IN(6)) { REP(6) {
        constexpr int WP = 1032;
        LAS unsigned short* wl16 = (LAS unsigned short*)(lds + RING_OFF);
        LAS unsigned* lcount = (LAS unsigned*)(lds + RING_OFF + 48 * WP * 2);
        for (int idx = tid; idx < 48 * 128; idx += NWAVES * 64) { const int row = idx >> 7, c = idx & 127; *(LAS u32x4*)(wl16 + row * WP + 8 * c) = *(const u32x4*)(WRH + row * 1024 + 8 * c); }
        const int fr = lane & 15, fq = lane >> 4;
        for (int it = 0; it * G < NGRP; ++it) {
            const int grp = it * G + vcu;
            const int tile = grp * 8 + wave; const int ntile = NGRP * 8;
            if (tid < 32) lcount[tid] = 0u;
            __syncthreads();
            bool owner = false; int e1 = 0, e2 = 0; unsigned lr1 = 0, lr2 = 0; int tok = 0;
            if (tile < ntile) {
                tok = tile * 16 + fr;
                const bf16* hp = H + (size_t)tok * DM + 8 * fq;
                f32x4 acc[3]; acc[0] = acc[1] = acc[2] = (f32x4){0.f, 0.f, 0.f, 0.f};
                float ssq = 0.f;
#pragma unroll 1
                for (int half = 0; half < 2; ++half) {
                    bf16x8 hb[16];
#pragma unroll
                    for (int q = 0; q < 16; ++q) hb[q] = *(const bf16x8*)(hp + 32 * (16 * half + q));
#pragma unroll
                    for (int q = 0; q < 16; ++q) { const int ks = 16 * half + q;
                        float f[8];
#pragma unroll
                        for (int e = 0; e < 8; ++e) { f[e] = bf2f(hb[q][e]); ssq += f[e] * f[e]; }
                        f16x8 hh;
#pragma unroll
                        for (int e = 0; e < 8; ++e) hh[e] = (_Float16)f[e];
#pragma unroll
                        for (int m = 0; m < 3; ++m) { const f16x8 wv = *(const LAS f16x8*)(wl16 + (16 * m + fr) * WP + 32 * ks + 8 * fq);
                            acc[m] = __builtin_amdgcn_mfma_f32_16x16x32_f16(wv, hh, acc[m], 0, 0, 0); }
                    }
                }
                ssq += __shfl_xor(ssq, 16); ssq += __shfl_xor(ssq, 32);
                const float rstd = __builtin_amdgcn_rsqf(ssq * (1.f / DM) + EPS);
                float gl[4];
#pragma unroll
                for (int r = 0; r < 4; ++r) gl[r] = acc[2][r] * rstd + P.rg_b[r];
                int gsel = 0; float gmax = gl[0];
#pragma unroll
                for (int r = 1; r < 4; ++r) if (gl[r] > gmax) { gmax = gl[r]; gsel = r; }
                float gden = 0.f;
#pragma unroll
                for (int r = 0; r < 4; ++r) gden += __builtin_amdgcn_exp2f((gl[r] - gmax) * LOG2E);
                const float pgrp = 1.f / gden;
                float el[8];
#pragma unroll
                for (int r = 0; r < 4; ++r) { el[r] = acc[0][r] * rstd + P.re_b[8 * fq + r]; el[4 + r] = acc[1][r] * rstd + P.re_b[8 * fq + 4 + r]; }
                int i1 = 0; float l1 = el[0];
#pragma unroll
                for (int r = 1; r < 8; ++r) if (el[r] > l1) { l1 = el[r]; i1 = r; }
                int i2 = -1; float l2 = -3.0e38f;
#pragma unroll
                for (int r = 0; r < 8; ++r) if (r != i1 && el[r] > l2) { l2 = el[r]; i2 = r; }
                const float ex = __builtin_amdgcn_exp2f((l2 - l1) * LOG2E);
                const float p1 = 1.f / (1.f + ex), p2 = ex * p1;
                owner = (fq == gsel);
                if (owner) {
                    e1 = 8 * gsel + i1; e2 = 8 * gsel + i2;
                    lr1 = __hip_atomic_fetch_add(lcount + e1, 1u, __ATOMIC_RELAXED, __HIP_MEMORY_SCOPE_WORKGROUP);
                    lr2 = __hip_atomic_fetch_add(lcount + e2, 1u, __ATOMIC_RELAXED, __HIP_MEMORY_SCOPE_WORKGROUP);
                    RSTD[tok] = rstd; GATE[2 * tok] = pgrp * p1; GATE[2 * tok + 1] = pgrp * p2;
                }
            }
            __syncthreads();
            if (grp < NGRP) {
                if (tid < 32) CNTS[grp * 32 + tid] = lcount[tid];
                if (owner) { LOCL[((size_t)grp * 32 + e1) * 128 + lr1] = 2u * tok; LOCL[((size_t)grp * 32 + e2) * 128 + lr2] = 2u * tok + 1u; }
            }
            __syncthreads();
        }
        REPBAR(6); }
        if (BOTH(6)) GRID_BAR();
    }

    if (IN(7) || IN(8)) {
        LAS int* pre = (LAS int*)(lds + RING_OFF);
        LAS int* segsum = pre + NGRP * 32;
        for (int i = tid; i < NGRP * 32; i += NWAVES * 64) pre[i] = (int)CNTS[i];
        __syncthreads();
        { const int e = tid & 31, seg = tid >> 5; int run = 0;
          for (int g = seg * 16; g < seg * 16 + 16; ++g) { const int c = pre[g * 32 + e]; pre[g * 32 + e] = run; run += c; }
          segsum[seg * 32 + e] = run; }
        __syncthreads();
        { const int e = tid & 31, seg = tid >> 5; int off = 0, tot = 0;
          for (int q = 0; q < 16; ++q) { const int v = segsum[q * 32 + e]; if (q < seg) off += v; tot += v; }
          for (int g = seg * 16; g < seg * 16 + 16; ++g) pre[g * 32 + e] += off;
          if (seg == 0) tab[T_CNT / 4 + e] = tot; }
        __syncthreads();
        if (tid == 0) { int tb = 0; for (int e = 0; e < 32; ++e) { tab[T_TBASE / 4 + e] = tb; tb += (tab[T_CNT / 4 + e] + 255) >> 8; } tab[T_TBASE / 4 + 32] = tb; tab[T_NT / 4] = tb; }
        __syncthreads();
        { const int NT = tab[T_NT / 4];
          for (int t = tid; t < NT; t += NWAVES * 64) { int e = 0; for (int q = 0; q < 32; ++q) if (tab[T_TBASE / 4 + q] <= t && t < tab[T_TBASE / 4 + q + 1]) e = q; tab[T_TILE_E / 4 + t] = e; } }
        __syncthreads();
        { pg8::SchedMoE<false> S0; S0.A = nullptr; S0.Bt = nullptr; S0.K = 0; S0.bstride = 0; S0.G = G; S0.c = bx; S0.tab = tab;
          const int half = tid >> 8, r = tid & 255; unsigned vals[NU_MAX / 2]; bool ok[NU_MAX / 2];
#pragma unroll
          for (int k = 0; k < NU_MAX / 2; ++k) { const int ui = 2 * k + half; pg8::Unit u; ok[k] = S0.next(ui, u); vals[k] = 0u;
              if (ok[k]) { const int cnt = tab[T_CNT / 4 + u.e], e = u.e; int p = u.rt * 256 + r; if (p > cnt - 1) p = cnt - 1;
                  int lo_ = 0, hi_ = NGRP - 1;
                  while (lo_ < hi_) { const int mid = (lo_ + hi_ + 1) >> 1; if (pre[mid * 32 + e] <= p) lo_ = mid; else hi_ = mid - 1; }
                  vals[k] = LOCL[((size_t)lo_ * 32 + e) * 128 + (p - pre[lo_ * 32 + e])]; } }
#pragma unroll
          for (int k = 0; k < NU_MAX / 2; ++k) if (ok[k]) tab[T_ROWTAB / 4 + (2 * k + half) * 256 + r] = (int)vals[k];
        }
        __syncthreads();
    }
#define PH7_BODY() do { \
        pg8::SchedMoE<true> S; S.A = (const char*)H8; S.Bt = (const char*)WGU8; S.K = DM / 2; S.bstride = (size_t)DM * DM; S.G = G; S.c = bx; S.tab = tab; \
        pg8::EpiGU E{ACT, RSTD, tab}; \
        pg8::gemm_phase<pg8::EpiGU, pg8::SchedMoE<true>, false, true>(lds + RING_OFF, DM / 2, S, E); } while (0)
    if (IN(7)) {
        if (PROBE_TWICE == 7) { PH7_BODY(); GRID_BAR(); }
        PH7_BODY();
        {
            const int NT4 = tab[T_NT / 4] * 4, remu = NT4 % G;
            const bool early = (remu == 0) || (bx >= remu); const int nE = (remu == 0) ? G : (G - remu), rank = (remu == 0) ? bx : (bx - remu);
            if (early) { LAS float* scr = (LAS float*)(lds + RING_OFF + wave * 16384);
                for (int r = rank * NWAVES + wave; r < 32 * 32 * 8; r += nE * NWAVES) {
                    const int e = r >> 8, q = r & 255, nb = 4 * (q >> 5) + (q & 3), kb = 2 * ((q >> 3) & 3) + ((q >> 2) & 1);
                    tr_item8(P.wd + (size_t)e * DEXP * DM, DM, 64 * kb, 32 * nb, WD8 + (size_t)e * DM * DEXP, 32 * nb, DEXP, nullptr, WD_SC, scr, lane); } }
        }
        if (BOTH(7)) GRID_BAR();
    }
    if (IN(8)) { REP(8) {
        pg8::SchedMoE<false> S; S.A = (const char*)ACT; S.Bt = (const char*)WD8; S.K = DEXP / 2; S.bstride = (size_t)DM * DEXP; S.G = G; S.c = bx; S.tab = tab;
        pg8::EpiDown E{Y, tab};
        pg8::gemm_phase<pg8::EpiDown, pg8::SchedMoE<false>, false, true>(lds + RING_OFF, DEXP / 2, S, E);
        REPBAR(8); }
        if (BOTH(8)) GRID_BAR();
    }
    if (IN(9)) { REP(9) {
        for (int m0 = gw; m0 < NTOK; m0 += 2 * NGW) {
            bf16x8 hv[2][2]; u32x4 ya[2], yb[2]; float g0[2], g1[2];
#pragma unroll
            for (int t = 0; t < 2; ++t) { int m = m0 + t * NGW; if (m >= NTOK) m = m0;
                g0[t] = GATE[2 * m] * (1.f / Y_SC); g1[t] = GATE[2 * m + 1] * (1.f / Y_SC);
                const bf16* hp = H + (size_t)m * DM + 16 * lane; const unsigned char* y0 = Y + (size_t)(2 * m) * DM + 16 * lane;
                hv[t][0] = *(const bf16x8*)(hp); hv[t][1] = *(const bf16x8*)(hp + 8); ya[t] = *(const u32x4*)(y0); yb[t] = *(const u32x4*)(y0 + DM); }
#pragma unroll
            for (int t = 0; t < 2; ++t) { const int m = m0 + t * NGW; if (m < NTOK) {
                float* op = P.out + (size_t)m * DM + 16 * lane;
#pragma unroll
                for (int q = 0; q < 4; ++q) { const unsigned wa = ya[t][q], wb = yb[t][q];
                    const f32x2_t a0 = __builtin_amdgcn_cvt_pk_f32_fp8((int)wa, false), a1 = __builtin_amdgcn_cvt_pk_f32_fp8((int)wa, true);
                    const f32x2_t b0 = __builtin_amdgcn_cvt_pk_f32_fp8((int)wb, false), b1 = __builtin_amdgcn_cvt_pk_f32_fp8((int)wb, true);
                    const bf16x8 hh = hv[t][q >> 1]; const int e0 = 4 * (q & 1);
                    f32x4 o; o[0] = bf2f(hh[e0]) + g0[t] * a0.x + g1[t] * b0.x; o[1] = bf2f(hh[e0 + 1]) + g0[t] * a0.y + g1[t] * b0.y;
                    o[2] = bf2f(hh[e0 + 2]) + g0[t] * a1.x + g1[t] * b1.x; o[3] = bf2f(hh[e0 + 3]) + g0[t] * a1.y + g1[t] * b1.y;
                    *(f32x4*)(op + 4 * q) = o; } } }
        }
    REPBAR(9); } }
#undef IN
#undef BOTH
}

extern "C" void kernel_launch(void* const* d_in, const int* in_sizes, int n_in, void* d_out, int out_size, void* d_ws, size_t ws_size, hipStream_t stream) {
    static int grid = 0;
    if (grid == 0) {
        if (n_in != 18 || in_sizes[0] != NTOK * DM || out_size != NTOK * DM || ws_size < WS_END) { fprintf(stderr, "kernel_launch: unexpected shapes / workspace (n_in %d, in0 %d, out %d, ws %zu, need %zu)\n", n_in, n_in > 0 ? in_sizes[0] : -1, out_size, ws_size, (size_t)WS_END); grid = -1; return; }
        int dev = 0, cus = 0, per_cu = 0;
        if (hipGetDevice(&dev) != hipSuccess || hipDeviceGetAttribute(&cus, hipDeviceAttributeMultiprocessorCount, dev) != hipSuccess) { grid = -1; return; }
        if (hipFuncSetAttribute((const void*)fwd_kernel, hipFuncAttributeMaxDynamicSharedMemorySize, LDS_BYTES) != hipSuccess) { fprintf(stderr, "kernel_launch: hipFuncSetAttribute failed\n"); grid = -1; return; }
        if (hipOccupancyMaxActiveBlocksPerMultiprocessor(&per_cu, (const void*)fwd_kernel, NWAVES * 64, LDS_BYTES) != hipSuccess || per_cu < 1) fprintf(stderr, "kernel_launch: occupancy query reports %d\n", per_cu);
        (void)hipGetLastError();
        grid = cus;
    }
    if (grid < 0) return;
    if (hipMemsetAsync((char*)d_ws + WS_CTL, 0, CTL_ZERO_BYTES, stream) != hipSuccess) return;
    Args a{};
    const float** pp = (const float**)&a.p;
    for (int i = 0; i < 18; ++i) pp[i] = (const float*)d_in[i];
    a.p.out = (float*)d_out; a.p.ws = (unsigned char*)d_ws;
    if (MK_N_LAUNCHES == 1) { a.ph_lo = 0; a.ph_hi = N_PHASES; hipLaunchKernelGGL(fwd_kernel, dim3(grid), dim3(NWAVES * 64), LDS_BYTES, stream, a); }
    else for (int li = 0; li < N_PHASES; ++li) { a.ph_lo = li; a.ph_hi = li + 1; hipLaunchKernelGGL(fwd_kernel, dim3(grid), dim3(NWAVES * 64), LDS_BYTES, stream, a); }
}
```

```cpp
#include <hip/hip_runtime.h>
#include <cstdio>
#include <cstdint>

#ifndef MK_N_LAUNCHES
#define MK_N_LAUNCHES 1
#endif

#define LAS __attribute__((address_space(3)))
#define GAS __attribute__((address_space(1)))
typedef unsigned short bf16;
typedef short bf16x8 __attribute__((ext_vector_type(8)));
typedef float f32x4 __attribute__((ext_vector_type(4)));
typedef float f32x16 __attribute__((ext_vector_type(16)));
typedef unsigned u32x4 __attribute__((ext_vector_type(4)));
typedef unsigned u32x2 __attribute__((ext_vector_type(2)));
typedef float f32x2_t __attribute__((ext_vector_type(2)));
typedef __bf16 bf16x2_t __attribute__((ext_vector_type(2)));
typedef GAS unsigned gu32;
typedef int v8i __attribute__((ext_vector_type(8)));
typedef int v4i __attribute__((ext_vector_type(4)));
typedef _Float16 f16x8 __attribute__((ext_vector_type(8)));
typedef _Float16 f16x2 __attribute__((ext_vector_type(2)));

constexpr int BATCH = 16, SEQ = 2048, DM = 1024, NTOK = BATCH * SEQ;
constexpr int IN_DIM = 3088;
constexpr int NEXP = 32, DEXP = 512;
constexpr float EPS = 1e-6f;
constexpr float LOG2E = 1.4426950408889634f;
constexpr float WGU_SC = 64.f, WD_SC = 32.f, ACT_SC = 8.f, Y_SC = 8.f;
constexpr int NA = 1792, NB = 1280;
constexpr int NGRP = NTOK / 128;

constexpr size_t MiB = 1u << 20;
constexpr size_t WS_CTL = 0, CTL_ZERO_BYTES = 64 * 1024;
constexpr size_t WS_WA = 2 * MiB;
constexpr size_t WS_WB = 6 * MiB;
constexpr size_t WS_WO = 9 * MiB;
constexpr size_t WS_WR = 11 * MiB;
constexpr size_t WS_W2T = WS_WR + 2 * 48 * 1024 * 2;
constexpr size_t WS_WGU = 12 * MiB;
constexpr size_t WS_WD = 76 * MiB;
constexpr size_t WS_H = 108 * MiB;
constexpr size_t WS_KV = WS_H;
constexpr size_t WS_XB = 44 * MiB;
constexpr size_t WS_MIX = 172 * MiB;
constexpr size_t WS_SQ = 236 * MiB;
constexpr size_t WS_SK = 268 * MiB;
constexpr size_t WS_GQ = 300 * MiB;
constexpr size_t WS_GRS = 316 * MiB;
constexpr size_t WS_TT = 348 * MiB;
constexpr size_t WS_GLR = 428 * MiB;
constexpr size_t WS_ST = 429 * MiB;
constexpr size_t WS_DTOT = 461 * MiB;
constexpr size_t WS_ACT = 236 * MiB;
constexpr size_t WS_H8 = 272 * MiB;
constexpr size_t WS_Y = 308 * MiB;
constexpr size_t WS_LOCL = 462 * MiB;
constexpr size_t WS_CNTS = 467 * MiB;
constexpr size_t WS_GATE = 470 * MiB;
constexpr size_t WS_RSTD = WS_GATE + 512 * 1024;
constexpr size_t WS_RSTD1 = WS_GATE + 768 * 1024;
constexpr size_t WS_END = 472 * MiB;
constexpr int CW_TMO = 0, CW_CODE = 1;
constexpr int CW_BAR = 4096;
constexpr int CW_CNT = 16384;

constexpr int RING_OFF = 0, RING_BYTES = 131072;
constexpr int LDSCTL_OFF = RING_BYTES, MISC_OFF = LDSCTL_OFF + 320;
constexpr int TAB_OFF = LDSCTL_OFF + 1024;
constexpr int LDS_BYTES = 147456;
constexpr int T_CNT = 0, T_TBASE = 128, T_NT = 264, T_TILE_E = 272, T_ROWTAB = 272 + 320 * 4, NU_MAX = 8;
static_assert(TAB_OFF + T_ROWTAB + NU_MAX * 256 * 4 <= LDS_BYTES, "LDS tables");

#define RLX_AGENT __ATOMIC_RELAXED, __HIP_MEMORY_SCOPE_AGENT
#define LDS_WAIT() asm volatile("s_waitcnt lgkmcnt(0)" ::: "memory")
#define VM_WAIT() asm volatile("s_waitcnt vmcnt(0)" ::: "memory")

__device__ __forceinline__ unsigned cvtpk(float lo, float hi) { f32x2_t v = {lo, hi}; bf16x2_t b = __builtin_convertvector(v, bf16x2_t); return __builtin_bit_cast(unsigned, b); }
__device__ __forceinline__ u32x2 pack8_fp8(const float* a) { int lo = __builtin_amdgcn_cvt_pk_fp8_f32(a[0], a[1], 0, false); lo = __builtin_amdgcn_cvt_pk_fp8_f32(a[2], a[3], lo, true);
    int hi = __builtin_amdgcn_cvt_pk_fp8_f32(a[4], a[5], 0, false); hi = __builtin_amdgcn_cvt_pk_fp8_f32(a[6], a[7], hi, true); u32x2 r; r.x = (unsigned)lo; r.y = (unsigned)hi; return r; }
__device__ __forceinline__ float bf2f(short s) { return __uint_as_float(((unsigned)(unsigned short)s) << 16); }
__device__ __forceinline__ bf16x8 pack8(const float* a) { u32x4 p; p.x = cvtpk(a[0], a[1]); p.y = cvtpk(a[2], a[3]); p.z = cvtpk(a[4], a[5]); p.w = cvtpk(a[6], a[7]); return __builtin_bit_cast(bf16x8, p); }
__device__ __forceinline__ int PI32(int i) { return 16 * ((i >> 2) & 1) + (i & 3) + 4 * (i >> 3); }
#define MFMA32(a, b, c) __builtin_amdgcn_mfma_f32_32x32x16_bf16((a), (b), (c), 0, 0, 0)
#define MFMA16(a, b, c) __builtin_amdgcn_mfma_f32_16x16x32_bf16((a), (b), (c), 0, 0, 0)
__device__ __forceinline__ void swap32(float x, float& lo, float& hi) { auto rr = __builtin_amdgcn_permlane32_swap(__float_as_uint(x), __float_as_uint(x), false, false); lo = __uint_as_float(rr[0]); hi = __uint_as_float(rr[1]); }

namespace pg8 {
#define PG8_LAS __attribute__((address_space(3)))
constexpr int BM = 256, BK = 64, HALF = 128, HTB = HALF * BK * 2, STAGE_BYTES = 8 * HTB, NXCD = 8, WGM = 8;
__host__ __device__ __forceinline__ int lds_byte(int r, int c) { const int st = (r >> 4) * 2 + (c >> 5), rr = r & 15, cc = c & 31, ob = rr * 64 + cc * 2; return st * 1024 + (ob ^ (((ob >> 9) & 1) << 5)); }
__host__ __device__ __forceinline__ void stage_rc(int b, int& R, int& C) { const int st = b / 1024, sb = b % 1024, swz = sb ^ (((sb >> 9) & 1) << 5); R = (st >> 1) * 16 + swz / 64; C = (st & 1) * 32 + (swz % 64) / 2; }
__host__ __device__ __forceinline__ int perm32(int rho) { const int n = rho >> 4, i = rho & 15; return 8 * (i >> 2) + 4 * n + (i & 3); }

struct Unit { int pm, pn, e, rt, nv; };

struct SchedDense {
    const char* A; const char* Bt; int K; int nM, nN, nwg, G, c;
    __device__ void init(const void* A_, const void* Bt_, int M, int N, int K_, int G_, int c_) { A = (const char*)A_; Bt = (const char*)Bt_; K = K_; nM = M / BM; nN = N / BM; nwg = nM * nN; G = G_; c = c_; }
    __device__ __forceinline__ bool next(int i, Unit& u) const {
        const long L = (long)i * G + c; if (L >= nwg) return false;
        int wgid = (int)L; { const int q = nwg / NXCD, r = nwg % NXCD, xcd = wgid % NXCD, off = wgid / NXCD; wgid = (xcd < r ? xcd * (q + 1) : r * (q + 1) + (xcd - r) * q) + off; }
        const int nig = WGM * nN, gid = wgid / nig, fm = gid * WGM, gsz = (nM - fm) < WGM ? (nM - fm) : WGM;
        u.pm = fm + ((wgid % nig) % gsz); u.pn = (wgid % nig) / gsz; u.e = 0; u.rt = 0; u.nv = 256; return true;
    }
    __device__ __forceinline__ const char* a_ptr(const Unit& u) const { return A + (size_t)u.pm * BM * K * 2; }
    __device__ __forceinline__ const char* b_ptr(const Unit& u) const { return Bt + (size_t)u.pn * BM * K * 2; }
    __device__ __forceinline__ void a_voff(int, const Unit&, int tid, unsigned (&v)[2][2]) const {
#pragma unroll
        for (int i = 0; i < 2; ++i) { int R, C; stage_rc(tid * 16 + i * 8192, R, C);
#pragma unroll
            for (int h = 0; h < 2; ++h) v[h][i] = (unsigned)((h * HALF + R) * K + C) * 2u; }
    }
};
template <bool GATHER> struct SchedMoE {
    const char* A; const char* Bt; int K; size_t bstride; int G, c;
    const PG8_LAS int* tab;
    __device__ __forceinline__ bool next(int i, Unit& u) const {
        const int L = i * G + c; const int NT = tab[T_NT / 4];
        if (L >= NT * 4) return false;
        const int tile = L >> 2; u.pm = tile; u.pn = L & 3; const int e = tab[T_TILE_E / 4 + tile]; u.e = e;
        u.rt = tile - tab[T_TBASE / 4 + e]; const int rem = tab[T_CNT / 4 + e] - u.rt * 256; u.nv = rem < 256 ? rem : 256; return true;
    }
    __device__ __forceinline__ const char* a_ptr(const Unit& u) const { return GATHER ? A : A + (size_t)u.pm * BM * K * 2; }
    __device__ __forceinline__ const char* b_ptr(const Unit& u) const { return Bt + (size_t)u.e * bstride + (size_t)u.pn * BM * K * 2; }
    __device__ __forceinline__ void a_voff(int ui, const Unit&, int tid, unsigned (&v)[2][2]) const {
        asm volatile("" : "+v"(tid));
#pragma unroll
        for (int i = 0; i < 2; ++i) { int R, C; stage_rc(tid * 16 + i * 8192, R, C);
#pragma unroll
            for (int h = 0; h < 2; ++h) {
                if (GATHER) { const int tok = tab[T_ROWTAB / 4 + ui * 256 + h * HALF + R] >> 1; v[h][i] = (unsigned)(tok * K + C) * 2u; }
                else v[h][i] = (unsigned)((h * HALF + R) * K + C) * 2u; } }
    }
};

template <class Epi, class Sched, bool TAIL = false, bool FP8 = false>
__device__ __forceinline__ void gemm_phase(PG8_LAS unsigned char* lds, const int K, const Sched& S, const Epi& E) {
    const int tid = threadIdx.x, wid = __builtin_amdgcn_readfirstlane(tid >> 6), lane = tid & 63, wr = wid >> 2, wc = wid & 3, fr = lane & 15, fq = lane >> 4;
    const int nt = K / BK;
    unsigned voffB[1][2];
#pragma unroll
    for (int i = 0; i < 2; ++i) { int R, C; stage_rc(tid * 16 + i * 8192, R, C); const int Rb = (R & ~31) + perm32(R & 31);
        voffB[0][i] = (unsigned)(Rb * K + C) * 2u; }
    const size_t hstepB = (size_t)HALF * K * 2;
    const size_t kstep = (size_t)(BK * 2);
    const unsigned ldsw = (unsigned)wid * 1024u;
    const int aoff = lds_byte(wr * 64 + fr, fq * 8), boff = lds_byte(wc * 32 + fr, fq * 8);
#define PG8_SA(b, h) (((b) * 2 + (h)) * HTB)
#define PG8_SB(b, h) ((4 + (b) * 2 + (h)) * HTB)
#define PG8_STAGE(bufoff, gbase, voff) do { _Pragma("unroll") for (int _i = 0; _i < 2; ++_i) \
        __builtin_amdgcn_global_load_lds((const unsigned*)((const char*)(gbase) + (voff)[_i]), (PG8_LAS unsigned*)(lds + (bufoff) + ldsw + _i * 8192), 16, 0, 0); } while (0)
#define PG8_RD16(off) (*(const PG8_LAS v4i*)(lds + (off)))
#define PG8_LDA(dst, b, h) do { _Pragma("unroll") for (int m = 0; m < 4; ++m) { \
        if constexpr (FP8) At8[m] = __builtin_shufflevector(PG8_RD16(PG8_SA(b, h) + aoff + m * 2048), PG8_RD16(PG8_SA(b, h) + aoff + m * 2048 + 1024), 0, 1, 2, 3, 4, 5, 6, 7); \
        else { _Pragma("unroll") for (int k = 0; k < 2; ++k) dst[m][k] = *(const PG8_LAS bf16x8*)(lds + PG8_SA(b, h) + aoff + m * 2048 + k * 1024); } } } while (0)
#define PG8_LDB(dst, b, h) do { _Pragma("unroll") for (int n = 0; n < 2; ++n) { \
        if constexpr (FP8) dst##8[n] = __builtin_shufflevector(PG8_RD16(PG8_SB(b, h) + boff + n * 2048), PG8_RD16(PG8_SB(b, h) + boff + n * 2048 + 1024), 0, 1, 2, 3, 4, 5, 6, 7); \
        else { _Pragma("unroll") for (int k = 0; k < 2; ++k) dst[n][k] = *(const PG8_LAS bf16x8*)(lds + PG8_SB(b, h) + boff + n * 2048 + k * 1024); } } } while (0)
#define PG8_MMA(ai, bj, At, Bt) do { __builtin_amdgcn_s_setprio(1); _Pragma("unroll") for (int m = 0; m < 4; ++m) _Pragma("unroll") for (int n = 0; n < 2; ++n) { \
        if constexpr (FP8) asm volatile("v_mfma_scale_f32_16x16x128_f8f6f4 %0, %1, %2, %0, %3, %3 op_sel_hi:[0,0,0]" : "+v"(acc[ai][bj][m][n]) : "v"(Bt##8[n]), "v"(At8[m]), "v"(sc1)); \
        else { _Pragma("unroll") for (int k = 0; k < 2; ++k) acc[ai][bj][m][n] = __builtin_amdgcn_mfma_f32_16x16x32_bf16(Bt[n][k], At[m][k], acc[ai][bj][m][n], 0, 0, 0); } } \
        __builtin_amdgcn_s_setprio(0); } while (0)
#define PG8_WAIT_V(n) asm volatile("s_waitcnt vmcnt(" #n ")" ::: "memory")
#define PG8_WAIT_L(n) asm volatile("s_waitcnt lgkmcnt(" #n ")" ::: "memory")
#define PG8_BAR __builtin_amdgcn_s_barrier()
#define PG8_SCHED __builtin_amdgcn_sched_barrier(0)
    Unit cur, nxt; int ui = 0;
    if (!S.next(0, cur)) return;
    f32x4 acc[2][2][4][2];
#pragma unroll
    for (int a = 0; a < 2; ++a)
#pragma unroll
        for (int b = 0; b < 2; ++b)
#pragma unroll
            for (int m = 0; m < 4; ++m)
#pragma unroll
                for (int n = 0; n < 2; ++n) acc[a][b][m][n] = (f32x4){0.f, 0.f, 0.f, 0.f};
    bf16x8 At[4][2], B0[2][2], B1[2][2];
    v8i At8[4], B08[2], B18[2];
    int sc1 = 0x7f7f7f7f; asm volatile("" : "+v"(sc1));
    unsigned vc[2][2], vn[2][2];
    S.a_voff(0, cur, tid, vc);
    const char* cA = S.a_ptr(cur); const char* cB = S.b_ptr(cur);
    PG8_STAGE(PG8_SB(0, 0), cB, voffB[0]); PG8_STAGE(PG8_SB(0, 1), (cB) + hstepB, voffB[0]); PG8_STAGE(PG8_SA(0, 0), cA, vc[0]); PG8_STAGE(PG8_SA(0, 1), cA, vc[1]);
    if (wr == 1) PG8_BAR;
    PG8_WAIT_V(2); PG8_BAR;
    PG8_STAGE(PG8_SB(1, 0), cB + kstep, voffB[0]); PG8_STAGE(PG8_SA(1, 0), cA + kstep, vc[0]); PG8_STAGE(PG8_SB(1, 1), (cB + kstep) + hstepB, voffB[0]);
    PG8_WAIT_V(6); PG8_BAR;
    for (;;) {
        const bool has_next = S.next(ui + 1, nxt);
        const char* nA = has_next ? S.a_ptr(nxt) : cA; const char* nB = has_next ? S.b_ptr(nxt) : cB;
        if (has_next) S.a_voff(ui + 1, nxt, tid, vn);
        else {
#pragma unroll
            for (int h = 0; h < 2; ++h)
#pragma unroll
                for (int i = 0; i < 2; ++i) vn[h][i] = vc[h][i]; }
        const bool full_hi = !TAIL || cur.nv > HALF;
        for (int t = 0; t < nt; t += 2) {
            const bool last = (t == nt - 2);
            const char* a1 = cA + (size_t)(t + 1) * kstep;
            const char* a2 = last ? nA : cA + (size_t)(t + 2) * kstep; const char* b2 = last ? nB : cB + (size_t)(t + 2) * kstep;
            const char* a3 = a2 + kstep; const char* b3 = b2 + kstep;
            unsigned w0[2], w1[2];
            w0[0] = last ? vn[0][0] : vc[0][0]; w0[1] = last ? vn[0][1] : vc[0][1]; w1[0] = last ? vn[1][0] : vc[1][0]; w1[1] = last ? vn[1][1] : vc[1][1];
            PG8_LDB(B0, 0, 0); PG8_LDB(B1, 0, 1); PG8_SCHED; PG8_LDA(At, 0, 0); PG8_STAGE(PG8_SA(1, 1), a1, vc[1]);
            PG8_WAIT_V(8); PG8_WAIT_L(0); PG8_BAR; PG8_MMA(0, 0, At, B0); PG8_MMA(0, 1, At, B1); PG8_BAR; PG8_SCHED;
            PG8_LDA(At, 0, 1); PG8_STAGE(PG8_SB(0, 0), b2, voffB[0]); PG8_STAGE(PG8_SB(0, 1), (b2) + hstepB, voffB[0]); PG8_STAGE(PG8_SA(0, 0), a2, w0);
            PG8_WAIT_V(8); PG8_WAIT_L(0); PG8_BAR; if (full_hi) { PG8_MMA(1, 0, At, B0); PG8_MMA(1, 1, At, B1); } PG8_BAR; PG8_SCHED;
            PG8_LDB(B0, 1, 0); PG8_LDB(B1, 1, 1); PG8_SCHED; PG8_LDA(At, 1, 0); PG8_STAGE(PG8_SA(0, 1), a2, w1);
            PG8_WAIT_V(8); PG8_WAIT_L(0); PG8_BAR; PG8_MMA(0, 0, At, B0); PG8_MMA(0, 1, At, B1); PG8_BAR; PG8_SCHED;
            PG8_LDA(At, 1, 1); PG8_STAGE(PG8_SB(1, 0), b3, voffB[0]); PG8_STAGE(PG8_SB(1, 1), (b3) + hstepB, voffB[0]); PG8_STAGE(PG8_SA(1, 0), a3, w0);
            PG8_WAIT_V(8); PG8_WAIT_L(0); PG8_BAR; if (full_hi) { PG8_MMA(1, 0, At, B0); PG8_MMA(1, 1, At, B1); } PG8_BAR; PG8_SCHED;
        }
        if (wr == 0) PG8_BAR;
        if constexpr (FP8) asm volatile("s_nop 15\n\ts_nop 15" ::: "memory");
        { int t2_ = threadIdx.x; asm volatile("" : "+v"(t2_)); E(acc, cur, ui, wr, wc, t2_ & 15, (t2_ >> 4) & 3); }
        if (!has_next) break;
#pragma unroll
        for (int a = 0; a < 2; ++a)
#pragma unroll
            for (int b = 0; b < 2; ++b)
#pragma unroll
                for (int m = 0; m < 4; ++m)
#pragma unroll
                    for (int n = 0; n < 2; ++n) acc[a][b][m][n] = (f32x4){0.f, 0.f, 0.f, 0.f};
        cur = nxt; cA = nA; cB = nB; ++ui;
#pragma unroll
        for (int h = 0; h < 2; ++h)
#pragma unroll
            for (int i = 0; i < 2; ++i) vc[h][i] = vn[h][i];
        if (wr == 1) PG8_BAR;
    }
    PG8_WAIT_V(0);
    PG8_BAR;
#undef PG8_SA
#undef PG8_SB
#undef PG8_STAGE
#undef PG8_LDA
#undef PG8_LDB
#undef PG8_MMA
#undef PG8_RD16
#undef PG8_WAIT_V
#undef PG8_WAIT_L
#undef PG8_BAR
#undef PG8_SCHED
}

struct EpiBf16 {
    bf16* O; int ldc;
    __device__ __forceinline__ void operator()(const f32x4 (&acc)[2][2][4][2], const Unit& u, int, int wr, int wc, int fr, int fq) const {
        const int row0 = u.pm * BM + wr * 64 + fr, col0 = u.pn * BM + wc * 32 + 8 * fq;
#pragma unroll
        for (int ai = 0; ai < 2; ++ai)
#pragma unroll
            for (int m = 0; m < 4; ++m) { bf16* rowp = O + (size_t)(row0 + ai * HALF + m * 16) * ldc + col0;
#pragma unroll
                for (int bj = 0; bj < 2; ++bj) { const f32x4 v0 = acc[ai][bj][m][0], v1 = acc[ai][bj][m][1];
                    u32x4 w; w.x = cvtpk(v0[0], v0[1]); w.y = cvtpk(v0[2], v0[3]); w.z = cvtpk(v1[0], v1[1]); w.w = cvtpk(v1[2], v1[3]);
                    *(u32x4*)(rowp + bj * HALF) = w; } }
    }
};
struct EpiTT {
    bf16* O; const float* RS;
    __device__ __forceinline__ void operator()(const f32x4 (&acc)[2][2][4][2], const Unit& u, int, int wr, int wc, int fr, int fq) const {
        const int row0 = u.pm * BM + wr * 64 + fr, tokb0 = u.pn * 8 + wc;
        f32x4 rs[2][2];
#pragma unroll
        for (int bj = 0; bj < 2; ++bj) { const float* rp = RS + (size_t)(tokb0 + 4 * bj) * 32 + 8 * fq; rs[bj][0] = *(const f32x4*)rp; rs[bj][1] = *(const f32x4*)(rp + 4); }
#pragma unroll
        for (int ai = 0; ai < 2; ++ai)
#pragma unroll
            for (int m = 0; m < 4; ++m) { const int col = row0 + ai * HALF + m * 16;
#pragma unroll
                for (int bj = 0; bj < 2; ++bj) { const f32x4 v0 = acc[ai][bj][m][0] * rs[bj][0], v1 = acc[ai][bj][m][1] * rs[bj][1];
                    u32x4 w; w.x = cvtpk(v0[0], v0[1]); w.y = cvtpk(v0[2], v0[3]); w.z = cvtpk(v1[0], v1[1]); w.w = cvtpk(v1[2], v1[3]);
                    *(u32x4*)(O + ((size_t)(tokb0 + 4 * bj) * 1280 + col) * 32 + 8 * fq) = w; } }
    }
};
struct EpiA {
    bf16 *SQ, *SK, *GQ, *GRS; const float *gq_norm, *gk_norm; const float* RS;
    __device__ __forceinline__ void operator()(const f32x4 (&acc)[2][2][4][2], const Unit& u, int, int wr, int wc, int fr, int fq) const {
        const int pn = u.pn; const int row0 = u.pm * BM + wr * 64 + fr;
        bf16* base; int ldc, colt; int mode;
        float scale = 1.f; const float* gain = nullptr;
        if (pn < 2)      { base = SQ; ldc = 512; colt = pn * 256; mode = 0; gain = gq_norm; scale = 0.125f * LOG2E; }
        else if (pn < 4) { base = SK; ldc = 512; colt = (pn - 2) * 256; mode = 0; gain = gk_norm; scale = 1.f; }
        else if (pn < 5) { base = GQ; ldc = 256; colt = 0; mode = 1; scale = 0.125f; }
        else             { base = GRS; ldc = 512; colt = (pn - 5) * 256; mode = 2; }
        const int col0 = colt + wc * 64 + 8 * fq;
        f32x4 gv[2][2];
#pragma unroll
        for (int bj = 0; bj < 2; ++bj)
#pragma unroll
            for (int n = 0; n < 2; ++n) { if (mode == 0) { gv[bj][n] = *(const f32x4*)(gain + 32 * bj + 8 * fq + 4 * n); gv[bj][n] = gv[bj][n] * scale; } else gv[bj][n] = (f32x4){scale, scale, scale, scale}; }
        float rs1v[2][4];
#pragma unroll
        for (int ai = 0; ai < 2; ++ai)
#pragma unroll
            for (int m = 0; m < 4; ++m) rs1v[ai][m] = RS[row0 + ai * HALF + m * 16];
#pragma unroll
        for (int ai = 0; ai < 2; ++ai)
#pragma unroll
            for (int m = 0; m < 4; ++m) {
                const float rs1 = rs1v[ai][m]; float rs = rs1;
                if (mode == 0) { float s = 0.f;
#pragma unroll
                    for (int bj = 0; bj < 2; ++bj)
#pragma unroll
                        for (int n = 0; n < 2; ++n) { const f32x4 x = acc[ai][bj][m][n]; s += (x[0] * x[0] + x[1] * x[1]) + (x[2] * x[2] + x[3] * x[3]); }
                    s += __shfl_xor(s, 16); s += __shfl_xor(s, 32);
                    rs = rs1 * __builtin_amdgcn_rsqf(rs1 * rs1 * s * (1.f / 64.f) + EPS); }
                bf16* rowp = base + (size_t)(row0 + ai * HALF + m * 16) * ldc + col0;
#pragma unroll
                for (int bj = 0; bj < 2; ++bj) { f32x4 v0 = acc[ai][bj][m][0], v1 = acc[ai][bj][m][1];
                    if (mode == 2) {
#pragma unroll
                        for (int e = 0; e < 4; ++e) { v0[e] *= rs1; v1[e] *= rs1; v0[e] = v0[e] * __builtin_amdgcn_rcpf(1.f + __builtin_amdgcn_exp2f(-v0[e] * LOG2E)); v1[e] = v1[e] * __builtin_amdgcn_rcpf(1.f + __builtin_amdgcn_exp2f(-v1[e] * LOG2E)); }
                    } else { v0 = v0 * rs * gv[bj][0]; v1 = v1 * rs * gv[bj][1]; }
                    u32x4 w; w.x = cvtpk(v0[0], v0[1]); w.y = cvtpk(v0[2], v0[3]); w.z = cvtpk(v1[0], v1[1]); w.w = cvtpk(v1[2], v1[3]);
                    *(u32x4*)(rowp + bj * 32) = w; } }
    }
};
struct EpiH {
    const bf16* XB; bf16* H; unsigned char* H8;
    __device__ __forceinline__ void operator()(const f32x4 (&acc)[2][2][4][2], const Unit& u, int, int wr, int wc, int fr, int fq) const {
        const int row0 = u.pm * BM + wr * 64 + fr, col0 = u.pn * BM + wc * 32 + 8 * fq;
#pragma unroll
        for (int ai = 0; ai < 2; ++ai) {
            bf16x8 xv[4][2];
#pragma unroll
            for (int m = 0; m < 4; ++m) { const size_t off = (size_t)(row0 + ai * HALF + m * 16) * DM + col0;
#pragma unroll
                for (int bj = 0; bj < 2; ++bj) xv[m][bj] = *(const bf16x8*)(XB + off + bj * HALF); }
#pragma unroll
            for (int m = 0; m < 4; ++m) { const size_t off = (size_t)(row0 + ai * HALF + m * 16) * DM + col0;
#pragma unroll
                for (int bj = 0; bj < 2; ++bj) { const bf16x8 xx = xv[m][bj];
                    const f32x4 v0 = acc[ai][bj][m][0] + (f32x4){bf2f(xx[0]), bf2f(xx[1]), bf2f(xx[2]), bf2f(xx[3])}, v1 = acc[ai][bj][m][1] + (f32x4){bf2f(xx[4]), bf2f(xx[5]), bf2f(xx[6]), bf2f(xx[7])};
                    u32x4 w; w.x = cvtpk(v0[0], v0[1]); w.y = cvtpk(v0[2], v0[3]); w.z = cvtpk(v1[0], v1[1]); w.w = cvtpk(v1[2], v1[3]);
                    *(u32x4*)(H + off + bj * HALF) = w;
                    const float f8[8] = {v0[0], v0[1], v0[2], v0[3], v1[0], v1[1], v1[2], v1[3]};
                    *(u32x2*)(H8 + off + bj * HALF) = pack8_fp8(f8); } }
        }
    }
};
struct EpiGU {
    unsigned char* ACT; const float* RSTD; const PG8_LAS int* tab;
    __device__ __forceinline__ void operator()(const f32x4 (&acc)[2][2][4][2], const Unit& u, int ui, int wr, int wc, int fr, int fq) const {
        const int col0 = u.pn * 128 + wc * 32 + 8 * fq;
        float rsv[2][4];
#pragma unroll
        for (int ai = 0; ai < 2; ++ai)
#pragma unroll
            for (int m = 0; m < 4; ++m) { const int rl = ai * HALF + wr * 64 + m * 16 + fr; rsv[ai][m] = RSTD[tab[T_ROWTAB / 4 + ui * 256 + rl] >> 1]; }
#pragma unroll
        for (int ai = 0; ai < 2; ++ai)
#pragma unroll
            for (int m = 0; m < 4; ++m) { const int rl = ai * HALF + wr * 64 + m * 16 + fr;
                if (rl < u.nv) {
                    const float rs = rsv[ai][m] * (1.f / WGU_SC);
                    f32x4 g0 = acc[ai][0][m][0] * rs, g1 = acc[ai][0][m][1] * rs, u0 = acc[ai][1][m][0] * rs, u1 = acc[ai][1][m][1] * rs;
#pragma unroll
                    for (int e = 0; e < 4; ++e) { g0[e] = g0[e] * __builtin_amdgcn_rcpf(1.f + __builtin_amdgcn_exp2f(-g0[e] * LOG2E)) * u0[e]; g1[e] = g1[e] * __builtin_amdgcn_rcpf(1.f + __builtin_amdgcn_exp2f(-g1[e] * LOG2E)) * u1[e]; }
                    float f8[8] = {g0[0] * ACT_SC, g0[1] * ACT_SC, g0[2] * ACT_SC, g0[3] * ACT_SC, g1[0] * ACT_SC, g1[1] * ACT_SC, g1[2] * ACT_SC, g1[3] * ACT_SC};
#pragma unroll
                    for (int e = 0; e < 8; ++e) f8[e] = __builtin_fminf(__builtin_fmaxf(f8[e], -448.f), 448.f);
                    *(u32x2*)(ACT + (size_t)(u.pm * 256 + rl) * DEXP + col0) = pack8_fp8(f8); } }
    }
};
struct EpiDown {
    unsigned char* Y; const PG8_LAS int* tab;
    __device__ __forceinline__ void operator()(const f32x4 (&acc)[2][2][4][2], const Unit& u, int ui, int wr, int wc, int fr, int fq) const {
        const int col0 = u.pn * BM + wc * 32 + 8 * fq; const float sc = Y_SC / (WD_SC * ACT_SC);
#pragma unroll
        for (int ai = 0; ai < 2; ++ai)
#pragma unroll
            for (int m = 0; m < 4; ++m) { const int rl = ai * HALF + wr * 64 + m * 16 + fr;
                if (rl < u.nv) { const unsigned ts = (unsigned)tab[T_ROWTAB / 4 + ui * 256 + rl]; unsigned char* rowp = Y + (size_t)ts * DM + col0;
#pragma unroll
                    for (int bj = 0; bj < 2; ++bj) { const f32x4 v0 = acc[ai][bj][m][0] * sc, v1 = acc[ai][bj][m][1] * sc;
                        const float f8[8] = {v0[0], v0[1], v0[2], v0[3], v1[0], v1[1], v1[2], v1[3]};
                        *(u32x2*)(rowp + bj * HALF) = pack8_fp8(f8); } } }
    }
};
}

#define XB_TMO      128
#define XB_XCNT(j)  (256  + 64 * (j))
#define XB_XSUB(j)  (1280 + 64 * (j))
#define XB_XGEN(j)  (2304 + 64 * (j))
#define XB_TOP      3328
#define XB_TOPGEN   3392
#define XCD_BAR_WORDS 3456
#define XB_SPIN_CAP (1u << 18)
__device__ __forceinline__ unsigned xb_ld(unsigned* p)              { return __hip_atomic_load(p, __ATOMIC_RELAXED, __HIP_MEMORY_SCOPE_AGENT); }
__device__ __forceinline__ unsigned xb_add(unsigned* p, unsigned v) { return __hip_atomic_fetch_add(p, v, __ATOMIC_RELAXED, __HIP_MEMORY_SCOPE_AGENT); }
__device__ __forceinline__ unsigned xb_xcc_id() { return (unsigned)__builtin_amdgcn_s_getreg((3 << 11) | 20) & 0xFu; }
#define XB_SPIN(cond, bar) do { unsigned _sp = 0; while (cond) { __builtin_amdgcn_s_sleep(1); \
    if ((++_sp & 255u) == 0u) { if (xb_ld(&(bar)[XB_TMO])) break; if (_sp > XB_SPIN_CAP) { atomicAdd(&(bar)[XB_TMO], 1u); break; } } } } while (0)
struct XcdBarrier { unsigned* bar; unsigned x; volatile LAS unsigned* st; };
__device__ __forceinline__ XcdBarrier xcd_barrier_post(unsigned* bar, volatile LAS unsigned* st) {
    XcdBarrier b; b.bar = bar; b.x = xb_xcc_id(); b.st = st;
    if (threadIdx.x == 0) (void)xb_add(&bar[XB_XCNT(b.x)], 1u);
    return b;
}
__device__ __forceinline__ void xcd_barrier_complete(unsigned* bar, unsigned x, unsigned& nloc, unsigned& nx) {
    const unsigned G = gridDim.x * gridDim.y * gridDim.z;
    unsigned sum, cnt, mine, sp = 0u;
    for (;;) {
        sum = 0u; cnt = 0u; mine = 0u;
#pragma unroll
        for (unsigned j = 0; j < 16; ++j) { const unsigned c = xb_ld(&bar[XB_XCNT(j)]); sum += c; cnt += (c > 0u) ? 1u : 0u; mine = (j == x) ? c : mine; }
        if (sum == G) break;
        __builtin_amdgcn_s_sleep(1);
        if ((++sp & 255u) == 0u) { if (xb_ld(&bar[XB_TMO])) break; if (sp > XB_SPIN_CAP) { atomicAdd(&bar[XB_TMO], 1u); break; } }
    }
    nloc = mine > 0u ? mine : 1u; nx = cnt > 0u ? cnt : 1u;
}
__device__ __forceinline__ void xcd_barrier(const XcdBarrier& b) {
    asm volatile("s_waitcnt vmcnt(0)" ::: "memory");
    __syncthreads();
    if (threadIdx.x == 0) {
        unsigned* bar = b.bar;
        __builtin_amdgcn_s_waitcnt(0);
        unsigned nloc = b.st[0], nx = b.st[1];
        if (nloc == 0u) { xcd_barrier_complete(bar, b.x, nloc, nx); b.st[0] = nloc; b.st[1] = nx; }
        const unsigned old = xb_add(&bar[XB_XSUB(b.x)], 1u);
        const unsigned gen = old / nloc;
        if (old + 1u == (gen + 1u) * nloc) {
            __builtin_amdgcn_fence(__ATOMIC_RELEASE, "agent");
            asm volatile("s_waitcnt vmcnt(0)" ::: "memory");
            const unsigned og = xb_add(&bar[XB_TOP], 1u);
            const unsigned tg = og / nx;
            if (og + 1u == (tg + 1u) * nx) xb_add(&bar[XB_TOPGEN], 1u);
            else XB_SPIN(xb_ld(&bar[XB_TOPGEN]) == tg, bar);
            __builtin_amdgcn_fence(__ATOMIC_ACQUIRE, "agent");
            xb_add(&bar[XB_XGEN(b.x)], 1u);
            asm volatile("s_waitcnt vmcnt(0)" ::: "memory");
        } else {
            XB_SPIN(xb_ld(&bar[XB_XGEN(b.x)]) == gen, bar);
            __builtin_amdgcn_fence(__ATOMIC_ACQUIRE, "agent");
            asm volatile("s_waitcnt vmcnt(0)" ::: "memory");
        }
    }
    __syncthreads();
}

__device__ __forceinline__ float wave_sum(float v) {
#pragma unroll
    for (int o = 1; o < 64; o <<= 1) v += __shfl_xor(v, o);
    return v;
}
__device__ __forceinline__ void tr_item(const float* src, int srcN, int k0, int n0, bf16* dst, int drow0, int dK, const float* kscale, LAS float* scr, int lane) {
    float w[32];
    const float* sp = src + (size_t)(k0 + (lane >> 5)) * srcN + n0 + (lane & 31);
#pragma unroll
    for (int i = 0; i < 32; ++i) w[i] = __builtin_nontemporal_load(sp + (size_t)(2 * i) * srcN);
    if (kscale) { const float ksv = kscale[k0 + lane];
#pragma unroll
        for (int i = 0; i < 32; ++i) { const float a = __int_as_float(__builtin_amdgcn_readlane(__float_as_int(ksv), 2 * i)), b = __int_as_float(__builtin_amdgcn_readlane(__float_as_int(ksv), 2 * i + 1)); w[i] *= (lane >> 5) ? b : a; } }
#pragma unroll
    for (int i = 0; i < 32; ++i) scr[(2 * i + (lane >> 5)) * 33 + (lane & 31)] = w[i];
    LDS_WAIT(); asm volatile("" ::: "memory");
    const int c = lane & 7;
#pragma unroll
    for (int j = 0; j < 4; ++j) { const int n = (lane >> 3) + 8 * j; const LAS float* s = scr + (8 * c) * 33 + n;
        u32x4 o; o.x = cvtpk(s[0 * 33], s[1 * 33]); o.y = cvtpk(s[2 * 33], s[3 * 33]); o.z = cvtpk(s[4 * 33], s[5 * 33]); o.w = cvtpk(s[6 * 33], s[7 * 33]);
        *(GAS u32x4*)(dst + (size_t)(drow0 + n) * dK + k0 + 8 * c) = o; }
    LDS_WAIT(); asm volatile("" ::: "memory");
}

__device__ __forceinline__ void tr_item8(const float* src, int srcN, int k0, int n0, unsigned char* dst, int drow0, int dK, const float* kscale, float scale, LAS float* scr, int lane) {
    float w[32];
    const float* sp = src + (size_t)(k0 + (lane >> 5)) * srcN + n0 + (lane & 31);
#pragma unroll
    for (int i = 0; i < 32; ++i) w[i] = __builtin_nontemporal_load(sp + (size_t)(2 * i) * srcN);
    float ksv = scale; if (kscale) ksv *= kscale[k0 + lane];
#pragma unroll
    for (int i = 0; i < 32; ++i) { const float a = __int_as_float(__builtin_amdgcn_readlane(__float_as_int(ksv), 2 * i)), b = __int_as_float(__builtin_amdgcn_readlane(__float_as_int(ksv), 2 * i + 1)); w[i] *= (lane >> 5) ? b : a; }
#pragma unroll
    for (int i = 0; i < 32; ++i) scr[(2 * i + (lane >> 5)) * 33 + (lane & 31)] = w[i];
    LDS_WAIT(); asm volatile("" ::: "memory");
#pragma unroll
    for (int j = 0; j < 2; ++j) { const int idx = lane + 64 * j, n = idx >> 2, c = idx & 3; const LAS float* sc_ = scr + (16 * c) * 33 + n;
        float f[16];
#pragma unroll
        for (int i = 0; i < 16; ++i) f[i] = sc_[i * 33];
        const u32x2 lo = pack8_fp8(f), hi = pack8_fp8(f + 8);
        u32x4 o; o.x = lo.x; o.y = lo.y; o.z = hi.x; o.w = hi.y;
        *(GAS u32x4*)(dst + (size_t)(drow0 + n) * dK + k0 + 16 * c) = o; }
    LDS_WAIT(); asm volatile("" ::: "memory");
}

struct Ptrs {
    const float *x, *attn_g, *w_in, *sbq_g, *sbk_g, *sbo_g, *w2, *gate_b, *glan_g, *w_out, *ffn_g, *rg_w, *rg_b, *re_w, *re_b, *wg, *wu, *wd;
    float* out; unsigned char* ws;
};

constexpr int SB_SPAN = 14, SB_VOFF = SB_SPAN * 4096;
__device__ __forceinline__ int sb_keyK(int r) { return ((r >> 1) & 3) | (((r >> 4) & 1) << 2); }
__device__ __forceinline__ int sb_keyV(int r) { return ((r >> 2) & 1) | (((r >> 4) & 1) << 1); }
__device__ __forceinline__ void sb_round(LAS unsigned char* lds, const bf16* SQ, const bf16* SK, const bf16* TT, const float* gout, bf16* MIX, int b, int h, int qg, int tid, int wave, int lane) {
    const int il = lane & 31, hi = lane >> 5, pil = PI32(il);
    const int qt = 8 * qg + wave;
    const size_t row0 = (size_t)b * SEQ + (size_t)qt * 32;
    bf16x8 qf[4];
    { const bf16* qp = SQ + (row0 + il) * 512 + h * 64 + 32 * hi;
#pragma unroll
      for (int s = 0; s < 4; ++s) qf[s] = *(const bf16x8*)(qp + 8 * s); }
    const int lo = (8 * qg - 6) > 0 ? (8 * qg - 6) : 0, nblk = 8 * qg + 8 - lo;
    {
        u32x4 st[SB_SPAN];
        const bool isK = tid < 256; const int q = tid - 256;
        const bf16* src = isK ? SK + ((size_t)b * SEQ + (size_t)lo * 32 + (tid >> 3)) * 512 + h * 64 + 8 * (tid & 7)
                              : TT + ((size_t)(b * (SEQ / 32) + lo) * NB + h * 64 + (q >> 2)) * 32 + 8 * (q & 3);
        const size_t bstep = isK ? (size_t)32 * 512 : (size_t)NB * 32;
#pragma unroll
        for (int i = 0; i < SB_SPAN; ++i) if (i < nblk) st[i] = *(const u32x4*)(src + (size_t)i * bstep);
        const int r = isK ? (tid >> 3) : (q >> 2);
        const unsigned dst = isK ? (unsigned)(r * 128 + (((tid & 7) ^ sb_keyK(r)) << 4)) : (unsigned)(SB_VOFF + r * 64 + (((q & 3) ^ sb_keyV(r & 31)) << 4));
#pragma unroll
        for (int i = 0; i < SB_SPAN; ++i) if (i < nblk) *(LAS u32x4*)(lds + dst + i * 4096) = st[i];
    }
    __syncthreads();
    f32x16 o0, o1;
#pragma unroll
    for (int r = 0; r < 16; ++r) { o0[r] = 0.f; o1[r] = 0.f; }
    float R = 1.f;
#define SB_MATH(KC, VC, kb_) do { \
        f32x16 z; \
        _Pragma("unroll") for (int r = 0; r < 16; ++r) z[r] = 0.f; \
        _Pragma("unroll") for (int s = 0; s < 4; ++s) z = MFMA32(KC[s], qf[s], z); \
        float beta[16], omb[16]; \
        const bool diag = ((kb_) == qt); \
        _Pragma("unroll") for (int r = 0; r < 16; ++r) { \
            const float zz = z[r]; const float t = __builtin_amdgcn_exp2f(-__builtin_fabsf(zz)); const float rr = __builtin_amdgcn_rcpf(1.f + t); const float sm = t * rr; \
            const bool pos = zz >= 0.f; float be = pos ? rr : sm; float om = pos ? sm : rr; \
            if (diag) { const bool valid = (16 * hi + r) < il; be = valid ? be : 0.f; om = valid ? om : 1.f; } \
            beta[r] = be; omb[r] = om; } \
        float e[16]; e[15] = 1.f; \
        _Pragma("unroll") for (int r = 14; r >= 0; --r) e[r] = e[r + 1] * omb[r + 1]; \
        const float P16 = e[0] * omb[0]; \
        float Plo, Phi; swap32(P16, Plo, Phi); \
        const float base = R * (hi ? 1.f : Phi); \
        float a[16]; \
        _Pragma("unroll") for (int r = 0; r < 16; ++r) a[r] = beta[r] * e[r] * base; \
        R = R * (Plo * Phi); \
        const bf16x8 p0 = pack8(a), p1 = pack8(a + 8); \
        o0 = MFMA32(VC[0][0], p0, o0); o0 = MFMA32(VC[0][1], p1, o0); \
        o1 = MFMA32(VC[1][0], p0, o1); o1 = MFMA32(VC[1][1], p1, o1); } while (0)
    bool fin = false;
    {
        const unsigned kbase = (unsigned)(pil * 128), vbase = (unsigned)(SB_VOFF + pil * 64);
        unsigned kx[4], vx[2];
#pragma unroll
        for (int s = 0; s < 4; ++s) kx[s] = (unsigned)(((4 * hi + s) ^ sb_keyK(pil)) << 4);
#pragma unroll
        for (int s = 0; s < 2; ++s) vx[s] = (unsigned)(((2 * hi + s) ^ sb_keyV(pil)) << 4);
        for (int kb = qt; ; --kb) {
            const unsigned so = (unsigned)(kb - lo) * 4096u;
            bf16x8 kf[4], vf[2][2];
#pragma unroll
            for (int s = 0; s < 4; ++s) kf[s] = *(const LAS bf16x8*)(lds + so + kbase + kx[s]);
#pragma unroll
            for (int dt = 0; dt < 2; ++dt)
#pragma unroll
                for (int s = 0; s < 2; ++s) vf[dt][s] = *(const LAS bf16x8*)(lds + so + vbase + dt * 2048 + vx[s]);
            SB_MATH(kf, vf, kb);
            if (kb == 0 || __all(R == 0.f)) { fin = true; break; }
            if (kb == lo) break;
        }
    }
    if (!fin) {
        for (int kb = lo - 1; ; --kb) {
            bf16x8 kf[4], vf[2][2];
            const bf16* kp = SK + ((size_t)b * SEQ + (size_t)kb * 32 + pil) * 512 + h * 64 + 32 * hi;
#pragma unroll
            for (int s = 0; s < 4; ++s) kf[s] = *(const bf16x8*)(kp + 8 * s);
            const bf16* vp = TT + ((size_t)(b * (SEQ / 32) + kb) * NB + h * 64 + pil) * 32 + 16 * hi;
#pragma unroll
            for (int dt = 0; dt < 2; ++dt)
#pragma unroll
                for (int s = 0; s < 2; ++s) vf[dt][s] = *(const bf16x8*)(vp + dt * 32 * 32 + 8 * s);
            SB_MATH(kf, vf, kb);
            if (kb == 0 || __all(R == 0.f)) break;
        }
    }
#undef SB_MATH
    float ss = 0.f;
#pragma unroll
    for (int r = 0; r < 16; ++r) ss += o0[r] * o0[r] + o1[r] * o1[r];
    float slo, shi; swap32(ss, slo, shi);
    const float rstd = __builtin_amdgcn_rsqf((slo + shi) * (1.f / 64.f) + EPS);
    bf16* op = MIX + (row0 + il) * DM + h * 64 + 16 * hi;
#pragma unroll
    for (int dt = 0; dt < 2; ++dt) {
        float v[16];
#pragma unroll
        for (int r4 = 0; r4 < 4; ++r4) { const f32x4 g = *(const f32x4*)(gout + 32 * dt + 16 * hi + 4 * r4);
#pragma unroll
            for (int e2 = 0; e2 < 4; ++e2) v[4 * r4 + e2] = (dt ? o1[4 * r4 + e2] : o0[4 * r4 + e2]) * rstd * g[e2]; }
        *(bf16x8*)(op + 32 * dt) = pack8(v); *(bf16x8*)(op + 32 * dt + 8) = pack8(v + 8);
    }
    __syncthreads();
}

__device__ __forceinline__ void gla_a(const bf16* GLR, const bf16* W2T, const float* gate_b, const bf16* TT, bf16* KV, float* DTOT, int bh, int j, int lane) {
    const int il = lane & 31, hi = lane >> 5, pil = PI32(il);
    const int b = bh >> 2, h = bh & 3;
    const size_t t0 = (size_t)b * SEQ + (size_t)j * 64;
    bf16x8 gf[2], wf[2], gkf[2][2][2], bvf[4][4]; float bias[2];
#pragma unroll
    for (int ch = 0; ch < 2; ++ch) gf[ch] = *(const bf16x8*)(GLR + (t0 + 32 * ch + pil) * 16 + 8 * hi);
#pragma unroll
    for (int kh = 0; kh < 2; ++kh) { const int kcol = 64 * h + 32 * kh + pil; wf[kh] = *(const bf16x8*)(W2T + kcol * 16 + 8 * hi); bias[kh] = gate_b[kcol];
        const bf16* gkp = TT + ((t0 >> 5) * NB + 512 + kcol) * 32 + 16 * hi;
#pragma unroll
        for (int ch = 0; ch < 2; ++ch) { gkf[kh][ch][0] = *(const bf16x8*)(gkp + ch * NB * 32); gkf[kh][ch][1] = *(const bf16x8*)(gkp + ch * NB * 32 + 8); } }
#pragma unroll
    for (int vq = 0; vq < 4; ++vq) { const bf16* vp = TT + ((t0 >> 5) * NB + 768 + 128 * h + 32 * vq + il) * 32 + 16 * hi;
#pragma unroll
        for (int s = 0; s < 4; ++s) bvf[vq][s] = *(const bf16x8*)(vp + (s >> 1) * NB * 32 + 8 * (s & 1)); }
    bf16x8 akf[2][4];
#pragma unroll
    for (int kh = 0; kh < 2; ++kh) {
        const int kcol = 64 * h + 32 * kh + pil;
        float cs[2][16];
#pragma unroll
        for (int ch = 0; ch < 2; ++ch) {
            f32x16 g;
#pragma unroll
            for (int r = 0; r < 16; ++r) g[r] = 0.f;
            g = MFMA32(gf[ch], wf[kh], g);
            if (kh == 0 && ch == 0) asm volatile("" : "+v"(g) :: "memory");
            float run = 0.f;
#pragma unroll
            for (int r = 0; r < 16; ++r) { const float x = g[r] + bias[kh];
                const float ls2 = __builtin_fminf(x, 0.f) * LOG2E - __builtin_amdgcn_logf(1.f + __builtin_amdgcn_exp2f(-__builtin_fabsf(x) * LOG2E));
                run += ls2 * (1.f / 16.f); cs[ch][r] = run; }
        }
        float t0lo, t0hi, t1lo, t1hi; swap32(cs[0][15], t0lo, t0hi); swap32(cs[1][15], t1lo, t1hi);
        const float off0 = hi ? t0lo : 0.f, off1 = (t0lo + t0hi) + (hi ? t1lo : 0.f), total = (t0lo + t0hi) + (t1lo + t1hi);
        if (hi == 0) DTOT[((size_t)bh * 32 + j) * 64 + 32 * kh + pil] = __builtin_amdgcn_exp2f(total);
#pragma unroll
        for (int ch = 0; ch < 2; ++ch) {
            const bf16x8 k0 = gkf[kh][ch][0], k1 = gkf[kh][ch][1];
            float kd[16]; const float off = ch ? off1 : off0;
#pragma unroll
            for (int r = 0; r < 16; ++r) { const float dec = __builtin_amdgcn_exp2f(total - (cs[ch][r] + off)); kd[r] = bf2f(r < 8 ? k0[r] : k1[r - 8]) * dec; }
            akf[kh][2 * ch] = pack8(kd); akf[kh][2 * ch + 1] = pack8(kd + 8);
        }
    }
#pragma unroll
    for (int vq = 0; vq < 4; ++vq) {
#pragma unroll
        for (int kh = 0; kh < 2; ++kh) {
            f32x16 kv;
#pragma unroll
            for (int r = 0; r < 16; ++r) kv[r] = 0.f;
#pragma unroll
            for (int s = 0; s < 4; ++s) kv = MFMA32(akf[kh][s], bvf[vq][s], kv);
            bf16* dst = KV + (((size_t)bh * 32 + j) * 128 + 32 * vq + il) * 64 + 32 * kh + 16 * hi;
            float kvf[16];
#pragma unroll
            for (int r = 0; r < 16; ++r) kvf[r] = kv[r];
            *(bf16x8*)dst = pack8(kvf); *(bf16x8*)(dst + 8) = pack8(kvf + 8);
        }
    }
}
__device__ __forceinline__ void gla_b(const bf16* KV, const float* DTOT, bf16* ST, int task, int lane) {
    const int bh = task >> 5, part = task & 31; const int e0 = part * 256 + lane * 4; const int k = e0 & 63;
    f32x4 S = (f32x4){0.f, 0.f, 0.f, 0.f};
#pragma unroll
    for (int half = 0; half < 2; ++half) {
        u32x2 kvp[16]; f32x4 d[16];
#pragma unroll
        for (int q = 0; q < 16; ++q) { const int j = 16 * half + q;
            kvp[q] = *(const u32x2*)(KV + ((size_t)bh * 32 + j) * 8192 + e0); d[q] = *(const f32x4*)(DTOT + ((size_t)bh * 32 + j) * 64 + k); }
#pragma unroll
        for (int q = 0; q < 16; ++q) { const int j = 16 * half + q;
            const f32x4 kv = (f32x4){__uint_as_float(kvp[q].x << 16), __uint_as_float(kvp[q].x & 0xffff0000u), __uint_as_float(kvp[q].y << 16), __uint_as_float(kvp[q].y & 0xffff0000u)};
            S = d[q] * S + kv;
            u32x2 w; w.x = cvtpk(S[0], S[1]); w.y = cvtpk(S[2], S[3]);
            *(u32x2*)(ST + ((size_t)bh * 32 + j) * 8192 + e0) = w; }
        asm volatile("" ::: "memory");
    }
}
__device__ __forceinline__ void gla_c(LAS unsigned char* wl, const bf16* ST, const bf16* GQ, const bf16* GRS, const float* gn, bf16* MIX, int bh, int j, int lane) {
    const int il = lane & 31, hi = lane >> 5, pil = PI32(il);
    const int b = bh >> 2, h = bh & 3;
    const size_t t0 = (size_t)b * SEQ + (size_t)j * 64;
    const bf16* sp = ST + ((size_t)bh * 32 + j) * 8192 + lane * 8;
    u32x4 st[16];
#pragma unroll
    for (int i = 0; i < 16; ++i) st[i] = *(const u32x4*)(sp + i * 512);
    bf16x8 bq[2][4], gr[2][4][2];
#pragma unroll
    for (int ch = 0; ch < 2; ++ch) { const size_t row = t0 + 32 * ch + il;
#pragma unroll
        for (int s = 0; s < 4; ++s) bq[ch][s] = *(const bf16x8*)(GQ + row * 256 + 64 * h + 16 * s + 8 * hi); }
    { const size_t row = t0 + il;
#pragma unroll
      for (int vt = 0; vt < 4; ++vt) { gr[0][vt][0] = *(const bf16x8*)(GRS + row * 512 + 128 * h + 32 * vt + 16 * hi); gr[0][vt][1] = *(const bf16x8*)(GRS + row * 512 + 128 * h + 32 * vt + 16 * hi + 8); } }
    { const int vr = lane >> 3, c = lane & 7;
#pragma unroll
      for (int i = 0; i < 16; ++i) { const int v = 8 * i + vr; *(LAS u32x4*)(wl + v * 128 + ((c ^ sb_keyK(v & 31)) << 4)) = st[i]; } }
    LDS_WAIT(); asm volatile("" ::: "memory");
    unsigned ax[4];
#pragma unroll
    for (int s = 0; s < 4; ++s) ax[s] = (unsigned)(pil * 128 + (((2 * s + hi) ^ sb_keyK(pil)) << 4));
#pragma unroll
    for (int ch = 0; ch < 2; ++ch) {
        const size_t row = t0 + 32 * ch + il;
        f32x16 O[4]; float ss = 0.f;
#pragma unroll
        for (int vt = 0; vt < 4; ++vt) {
#pragma unroll
            for (int r = 0; r < 16; ++r) O[vt][r] = 0.f;
#pragma unroll
            for (int s = 0; s < 4; ++s) { const bf16x8 af = *(const LAS bf16x8*)(wl + vt * 4096 + ax[s]); O[vt] = MFMA32(af, bq[ch][s], O[vt]); }
            if (ch == 0 && vt == 0) {
                const size_t row1 = t0 + 32 + il;
#pragma unroll
                for (int v2 = 0; v2 < 4; ++v2) { gr[1][v2][0] = *(const bf16x8*)(GRS + row1 * 512 + 128 * h + 32 * v2 + 16 * hi); gr[1][v2][1] = *(const bf16x8*)(GRS + row1 * 512 + 128 * h + 32 * v2 + 16 * hi + 8); }
                asm volatile("" : "+v"(O[0]) :: "memory"); }
#pragma unroll
            for (int r = 0; r < 16; ++r) ss += O[vt][r] * O[vt][r];
        }
        float slo, shi; swap32(ss, slo, shi);
        const float rstd = __builtin_amdgcn_rsqf((slo + shi) * (1.f / 128.f) + EPS);
#pragma unroll
        for (int vt = 0; vt < 4; ++vt) {
            const int vc0 = 32 * vt + 16 * hi;
            float v[16];
#pragma unroll
            for (int r4 = 0; r4 < 4; ++r4) { const f32x4 g = *(const f32x4*)(gn + vc0 + 4 * r4);
#pragma unroll
                for (int e2 = 0; e2 < 4; ++e2) { const int r = 4 * r4 + e2; v[r] = O[vt][r] * rstd * g[e2] * bf2f(r < 8 ? gr[ch][vt][0][r] : gr[ch][vt][1][r - 8]); } }
            bf16* op = MIX + row * DM + 512 + 128 * h + vc0;
            *(bf16x8*)(op) = pack8(v); *(bf16x8*)(op + 8) = pack8(v + 8);
        }
    }
    LDS_WAIT(); asm volatile("" ::: "memory");
}

constexpr int NWAVES = 8;
constexpr int N_PHASES = 10;
struct Args { Ptrs p; int ph_lo, ph_hi; };

__global__ void __launch_bounds__(NWAVES * 64, 2) fwd_kernel(Args args) {
    extern __shared__ __attribute__((aligned(16))) unsigned char lds_raw[];
    LAS unsigned char* lds = (LAS unsigned char*)lds_raw;
    const Ptrs& P = args.p;
    const int tid = threadIdx.x, lane = tid & 63, wave = __builtin_amdgcn_readfirstlane(tid >> 6);
    const int G = gridDim.x; const int bx = blockIdx.x; const int vcu = (G % 8 == 0) ? (bx % 8) * (G / 8) + bx / 8 : bx;
    const int gw = vcu * NWAVES + wave, NGW = G * NWAVES;
    unsigned char* ws = P.ws;
    gu32* ctl = (gu32*)(ws + WS_CTL);
    volatile LAS unsigned* MISC = (volatile LAS unsigned*)(lds + MISC_OFF);
    LAS int* tab = (LAS int*)(lds + TAB_OFF);
    for (int u = tid; u < (LDS_BYTES - LDSCTL_OFF) / 4; u += NWAVES * 64) ((LAS unsigned*)(lds + LDSCTL_OFF))[u] = 0u;
    __syncthreads();
    XcdBarrier bar; bar.bar = (unsigned*)(ctl + CW_BAR); bar.x = 0; bar.st = nullptr;
    if (MK_N_LAUNCHES == 1) bar = xcd_barrier_post((unsigned*)(ctl + CW_BAR), MISC + 8);
#define GRID_BAR() do { if (MK_N_LAUNCHES == 1) xcd_barrier(bar); } while (0)
    const int lo = args.ph_lo, hi_ph = args.ph_hi;
#ifndef PHASE_MASK
#define PHASE_MASK 0x3ff
#endif
#define IN(k) (((PHASE_MASK >> (k)) & 1) && lo <= (k) && (k) < hi_ph)
#define BOTH(k) (IN(k) && IN((k) + 1))
#ifndef PROBE_TWICE
#define PROBE_TWICE -1
#endif
#define REP(k) for (int rep_ = 0; rep_ < ((PROBE_TWICE == (k)) ? 2 : 1); ++rep_)
#define REPBAR(k) do { if (PROBE_TWICE == (k) && rep_ == 0) GRID_BAR(); } while (0)

    bf16* WA = (bf16*)(ws + WS_WA); bf16* WB = (bf16*)(ws + WS_WB); bf16* WO = (bf16*)(ws + WS_WO);
    bf16* WRH = (bf16*)(ws + WS_WR); bf16* WRL = WRH + 48 * 1024; bf16* W2T = (bf16*)(ws + WS_W2T);
    bf16* WGU = (bf16*)(ws + WS_WGU); bf16* WD = (bf16*)(ws + WS_WD);
    bf16* H = (bf16*)(ws + WS_H); bf16* KV = (bf16*)(ws + WS_KV);
    bf16* XB = (bf16*)(ws + WS_XB); bf16* MIX = (bf16*)(ws + WS_MIX); float* RSTD1 = (float*)(ws + WS_RSTD1);
    bf16* SQ = (bf16*)(ws + WS_SQ); bf16* SK = (bf16*)(ws + WS_SK); bf16* GQ = (bf16*)(ws + WS_GQ); bf16* GRS = (bf16*)(ws + WS_GRS);
    bf16* TT = (bf16*)(ws + WS_TT); bf16* GLR = (bf16*)(ws + WS_GLR); bf16* ST = (bf16*)(ws + WS_ST); float* DTOT = (float*)(ws + WS_DTOT);
    unsigned char* ACT = ws + WS_ACT; unsigned char* Y = ws + WS_Y;
    unsigned char* WGU8 = ws + WS_WGU; unsigned char* WD8 = ws + WS_WD; unsigned char* H8 = ws + WS_H8;
    unsigned* LOCL = (unsigned*)(ws + WS_LOCL); unsigned* CNTS = (unsigned*)(ws + WS_CNTS); float* GATE = (float*)(ws + WS_GATE); float* RSTD = (float*)(ws + WS_RSTD);

    if (IN(0)) { REP(0) {
        LAS float* scr = (LAS float*)(lds + RING_OFF + wave * 16384);
        constexpr int I_A = (NA / 32) * 16, I_B = (NB / 32) * 16, I_O = 32 * 16, I_GU = 32 * 32 * 16, I_D = 32 * 32 * 8;
        constexpr int NITEMS = I_A + I_B + I_O + I_GU;
        for (int it = gw; it < NITEMS; it += NGW) {
            int r = it;
            if (r < I_A) { const int ib = r >> 4, kb = r & 15, P0 = 32 * ib; const int pn = P0 >> 8, bj = (P0 >> 7) & 1, wcc = (P0 >> 5) & 3; const int LA = 256 * pn + 64 * wcc + 32 * bj;
                const int sc = LA < 1024 ? LA : (LA < 1280 ? 1536 + (LA - 1024) : 2560 + (LA - 1280));
                tr_item(P.w_in, IN_DIM, 64 * kb, sc, WA, P0, DM, P.attn_g, scr, lane); continue; } r -= I_A;
            if (r < I_B) { const int ib = r >> 4, kb = r & 15, P0 = 32 * ib; const int sc = P0 < 512 ? 1024 + P0 : (P0 < 768 ? 1792 + (P0 - 512) : 2048 + (P0 - 768));
                tr_item(P.w_in, IN_DIM, 64 * kb, sc, WB, P0, DM, P.attn_g, scr, lane); continue; } r -= I_B;
            if (r < I_O) { const int ib = r >> 4, kb = r & 15; tr_item(P.w_out, DM, 64 * kb, 32 * ib, WO, 32 * ib, DM, nullptr, scr, lane); continue; } r -= I_O;
            if (r < I_GU) { const int e = r >> 9, q = r & 511, ib = 4 * (q >> 6) + (q & 3), kb = 2 * ((q >> 3) & 7) + ((q >> 2) & 1), P0 = 32 * ib; const int pn = P0 >> 8, bj = (P0 >> 7) & 1, r0 = P0 & 127;
                const float* src = (bj ? P.wu : P.wg) + (size_t)e * DM * DEXP;
                tr_item8(src, DEXP, 64 * kb, 128 * pn + r0, WGU8 + (size_t)e * DM * DM, P0, DM, P.ffn_g, WGU_SC, scr, lane); continue; }
        }
        (void)I_D;
        for (int idx = gw * 64 + lane; idx < 48 * 1024; idx += NGW * 64) {
            const int rho = idx >> 10, k = idx & 1023, m = rho >> 4, i = rho & 15;
            float v = (m < 2) ? P.re_w[k * 32 + 8 * (i >> 2) + 4 * m + (i & 3)] : P.rg_w[k * 4 + (i & 3)];
            v *= P.ffn_g[k];
            WRH[idx] = __builtin_bit_cast(unsigned short, (_Float16)v);
        }
        for (int idx = gw * 64 + lane; idx < 256 * 16; idx += NGW * 64) { const int kc = idx >> 4, r = idx & 15; W2T[idx] = (bf16)(cvtpk(P.w2[r * 256 + kc], 0.f) & 0xffffu); }
        __syncthreads();
        constexpr int WLP = 1032;
        LAS bf16* wl = (LAS bf16*)(lds + RING_OFF);
        for (int idx = tid; idx < 16 * 1024; idx += NWAVES * 64) { const int c = idx & 15, k = idx >> 4; wl[c * WLP + k] = (bf16)(cvtpk(P.attn_g[k] * P.w_in[(size_t)k * IN_DIM + 3072 + c], 0.f) & 0xffffu); }
        __syncthreads();
        {
            for (int task = gw; task < NTOK / 16; task += NGW) {
                const size_t row0 = (size_t)task * 16;
                f32x4 cur[4], nxt[4]; float rsv = 0.f;
#pragma unroll
                for (int j = 0; j < 4; ++j) { cur[j] = __builtin_nontemporal_load((const GAS f32x4*)(P.x + row0 * DM) + lane + 64 * j); nxt[j] = cur[j]; }
#pragma unroll 2
                for (int r = 0; r < 16; ++r) {
                    if (r < 15) {
#pragma unroll
                        for (int j = 0; j < 4; ++j) nxt[j] = __builtin_nontemporal_load((const GAS f32x4*)(P.x + (row0 + r + 1) * DM) + lane + 64 * j); }
                    float s2 = 0.f;
#pragma unroll
                    for (int j = 0; j < 4; ++j) s2 += (cur[j].x * cur[j].x + cur[j].y * cur[j].y) + (cur[j].z * cur[j].z + cur[j].w * cur[j].w);
                    const float rstd = __builtin_amdgcn_rsqf(wave_sum(s2) * (1.f / DM) + EPS);
                    if ((lane & 15) == r) rsv = rstd;
                    GAS unsigned long long* o8 = (GAS unsigned long long*)(XB + (row0 + r) * DM) + lane;
#pragma unroll
                    for (int j = 0; j < 4; ++j) { const f32x4 v = cur[j];
                        o8[64 * j] = (unsigned long long)cvtpk(v.x, v.y) | ((unsigned long long)cvtpk(v.z, v.w) << 32); }
#pragma unroll
                    for (int j = 0; j < 4; ++j) cur[j] = nxt[j];
                }
                if (lane < 16) RSTD1[row0 + lane] = rsv;
                VM_WAIT();
                const int fr = lane & 15, fq = lane >> 4;
                f32x4 acc = (f32x4){0.f, 0.f, 0.f, 0.f};
                const bf16* up = XB + (row0 + fr) * DM + 8 * fq;
#pragma unroll 8
                for (int ks = 0; ks < 32; ++ks) { const bf16x8 ub = *(const bf16x8*)(up + 32 * ks); const bf16x8 wb = *(const LAS bf16x8*)(wl + fr * WLP + 32 * ks + 8 * fq); acc = MFMA16(wb, ub, acc); }
                u32x2 o; o.x = cvtpk(acc[0] * rsv, acc[1] * rsv); o.y = cvtpk(acc[2] * rsv, acc[3] * rsv);
                *(u32x2*)(GLR + (row0 + fr) * 16 + 4 * fq) = o;
            }
        }
        __syncthreads();
        REPBAR(0); }
        if (BOTH(0)) GRID_BAR();
    }

#define PH1_BODY() do { \
        { pg8::SchedDense S; S.init(XB, WA, NTOK, NA, DM, G, bx); \
          pg8::EpiA E{SQ, SK, GQ, GRS, P.sbq_g, P.sbk_g, RSTD1}; \
          pg8::gemm_phase<pg8::EpiA, pg8::SchedDense>(lds + RING_OFF, DM, S, E); } \
        { pg8::SchedDense S; S.init(WB, XB, NB, NTOK, DM, G, (bx + G / 2) % G); \
          pg8::EpiTT E{TT, RSTD1}; \
          pg8::gemm_phase<pg8::EpiTT, pg8::SchedDense>(lds + RING_OFF, DM, S, E); } } while (0)
    if (IN(1)) {
        if (PROBE_TWICE == 1) { PH1_BODY(); GRID_BAR(); }
        PH1_BODY();
        if (BOTH(1)) GRID_BAR();
    }

#define SB_ROUND(rho_) do { for (int u__ = (rho_) * G + vcu; u__ < 1024; u__ += 4 * G) { const int bh_ = u__ & 127; \
        sb_round(lds + RING_OFF, SQ, SK, TT, P.sbo_g + (bh_ & 7) * 64, MIX, bh_ >> 3, bh_ & 7, u__ >> 7, tid, wave, lane); } } while (0)
#define REPX(code) for (int rx_ = 0; rx_ < ((PROBE_TWICE == (code)) ? 5 : 1); ++rx_)
    if (IN(2)) { REP(2) {
        REPX(20) for (int t = gw; t < 2048; t += NGW) gla_a(GLR, W2T, P.gate_b, TT, KV, DTOT, t >> 5, t & 31, lane);
        REPX(21) SB_ROUND(0);
        REPBAR(2); }
        if (BOTH(2)) GRID_BAR();
    }
    if (IN(3)) { REP(3) {
        REPX(22) for (int t = gw; t < 2048; t += NGW) gla_b(KV, DTOT, ST, t, lane);
        SB_ROUND(1);
        REPBAR(3); }
        if (BOTH(3)) GRID_BAR();
    }
    if (IN(4)) { REP(4) {
        REPX(23) for (int t = gw; t < 2048; t += NGW) gla_c(lds + RING_OFF + wave * 16384, ST, GQ, GRS, P.glan_g, MIX, t >> 5, t & 31, lane);
        __syncthreads();
        SB_ROUND(2); SB_ROUND(3);
        REPBAR(4); }
        if (BOTH(4)) GRID_BAR();
    }

#define PH5_BODY() do { \
        pg8::SchedDense S; S.init(MIX, WO, NTOK, DM, DM, G, bx); \
        pg8::EpiH E{XB, H, H8}; \
        pg8::gemm_phase<pg8::EpiH, pg8::SchedDense>(lds + RING_OFF, DM, S, E); } while (0)
    if (IN(5)) {
        if (PROBE_TWICE == 5) { PH5_BODY(); GRID_BAR(); }
        PH5_BODY();
        if (BOTH(5)) GRID_BAR();
    }

    if (IN(6)) { REP(6) {
        constexpr int WP = 1032;
        LAS unsigned short* wl16 = (LAS unsigned short*)(lds + RING_OFF);
        LAS unsigned* lcount = (LAS unsigned*)(lds + RING_OFF + 48 * WP * 2);
        for (int idx = tid; idx < 48 * 128; idx += NWAVES * 64) { const int row = idx >> 7, c = idx & 127; *(LAS u32x4*)(wl16 + row * WP + 8 * c) = *(const u32x4*)(WRH + row * 1024 + 8 * c); }
        const int fr = lane & 15, fq = lane >> 4;
        for (int it = 0; it * G < NGRP; ++it) {
            const int grp = it * G + vcu;
            const int tile = grp * 8 + wave; const int ntile = NGRP * 8;
            if (tid < 32) lcount[tid] = 0u;
            __syncthreads();
            bool owner = false; int e1 = 0, e2 = 0; unsigned lr1 = 0, lr2 = 0; int tok = 0;
            if (tile < ntile) {
                tok = tile * 16 + fr;
                const bf16* hp = H + (size_t)tok * DM + 8 * fq;
                f32x4 acc[3]; acc[0] = acc[1] = acc[2] = (f32x4){0.f, 0.f, 0.f, 0.f};
                float ssq = 0.f;
#pragma unroll 1
                for (int half = 0; half < 2; ++half) {
                    bf16x8 hb[16];
#pragma unroll
                    for (int q = 0; q < 16; ++q) hb[q] = *(const bf16x8*)(hp + 32 * (16 * half + q));
#pragma unroll
                    for (int q = 0; q < 16; ++q) { const int ks = 16 * half + q;
                        float f[8];
#pragma unroll
                        for (int e = 0; e < 8; ++e) { f[e] = bf2f(hb[q][e]); ssq += f[e] * f[e]; }
                        f16x8 hh;
#pragma unroll
                        for (int e = 0; e < 8; ++e) hh[e] = (_Float16)f[e];
#pragma unroll
                        for (int m = 0; m < 3; ++m) { const f16x8 wv = *(const LAS f16x8*)(wl16 + (16 * m + fr) * WP + 32 * ks + 8 * fq);
                            acc[m] = __builtin_amdgcn_mfma_f32_16x16x32_f16(wv, hh, acc[m], 0, 0, 0); }
                    }
                }
                ssq += __shfl_xor(ssq, 16); ssq += __shfl_xor(ssq, 32);
                const float rstd = __builtin_amdgcn_rsqf(ssq * (1.f / DM) + EPS);
                float gl[4];
#pragma unroll
                for (int r = 0; r < 4; ++r) gl[r] = acc[2][r] * rstd + P.rg_b[r];
                int gsel = 0; float gmax = gl[0];
#pragma unroll
                for (int r = 1; r < 4; ++r) if (gl[r] > gmax) { gmax = gl[r]; gsel = r; }
                float gden = 0.f;
#pragma unroll
                for (int r = 0; r < 4; ++r) gden += __builtin_amdgcn_exp2f((gl[r] - gmax) * LOG2E);
                const float pgrp = 1.f / gden;
                float el[8];
#pragma unroll
                for (int r = 0; r < 4; ++r) { el[r] = acc[0][r] * rstd + P.re_b[8 * fq + r]; el[4 + r] = acc[1][r] * rstd + P.re_b[8 * fq + 4 + r]; }
                int i1 = 0; float l1 = el[0];
#pragma unroll
                for (int r = 1; r < 8; ++r) if (el[r] > l1) { l1 = el[r]; i1 = r; }
                int i2 = -1; float l2 = -3.0e38f;
#pragma unroll
                for (int r = 0; r < 8; ++r) if (r != i1 && el[r] > l2) { l2 = el[r]; i2 = r; }
                const float ex = __builtin_amdgcn_exp2f((l2 - l1) * LOG2E);
                const float p1 = 1.f / (1.f + ex), p2 = ex * p1;
                owner = (fq == gsel);
                if (owner) {
                    e1 = 8 * gsel + i1; e2 = 8 * gsel + i2;
                    lr1 = __hip_atomic_fetch_add(lcount + e1, 1u, __ATOMIC_RELAXED, __HIP_MEMORY_SCOPE_WORKGROUP);
                    lr2 = __hip_atomic_fetch_add(lcount + e2, 1u, __ATOMIC_RELAXED, __HIP_MEMORY_SCOPE_WORKGROUP);
                    RSTD[tok] = rstd; GATE[2 * tok] = pgrp * p1; GATE[2 * tok + 1] = pgrp * p2;
                }
            }
            __syncthreads();
            if (grp < NGRP) {
                if (tid < 32) CNTS[grp * 32 + tid] = lcount[tid];
                if (owner) { LOCL[((size_t)grp * 32 + e1) * 128 + lr1] = 2u * tok; LOCL[((size_t)grp * 32 + e2) * 128 + lr2] = 2u * tok + 1u; }
            }
            __syncthreads();
        }
        REPBAR(6); }
        if (BOTH(6)) GRID_BAR();
    }

    if (IN(7) || IN(8)) {
        LAS int* pre = (LAS int*)(lds + RING_OFF);
        LAS int* segsum = pre + NGRP * 32;
        for (int i = tid; i < NGRP * 32; i += NWAVES * 64) pre[i] = (int)CNTS[i];
        __syncthreads();
        { const int e = tid & 31, seg = tid >> 5; int run = 0;
          for (int g = seg * 16; g < seg * 16 + 16; ++g) { const int c = pre[g * 32 + e]; pre[g * 32 + e] = run; run += c; }
          segsum[seg * 32 + e] = run; }
        __syncthreads();
        { const int e = tid & 31, seg = tid >> 5; int off = 0, tot = 0;
          for (int q = 0; q < 16; ++q) { const int v = segsum[q * 32 + e]; if (q < seg) off += v; tot += v; }
          for (int g = seg * 16; g < seg * 16 + 16; ++g) pre[g * 32 + e] += off;
          if (seg == 0) tab[T_CNT / 4 + e] = tot; }
        __syncthreads();
        if (tid == 0) { int tb = 0; for (int e = 0; e < 32; ++e) { tab[T_TBASE / 4 + e] = tb; tb += (tab[T_CNT / 4 + e] + 255) >> 8; } tab[T_TBASE / 4 + 32] = tb; tab[T_NT / 4] = tb; }
        __syncthreads();
        { const int NT = tab[T_NT / 4];
          for (int t = tid; t < NT; t += NWAVES * 64) { int e = 0; for (int q = 0; q < 32; ++q) if (tab[T_TBASE / 4 + q] <= t && t < tab[T_TBASE / 4 + q + 1]) e = q; tab[T_TILE_E / 4 + t] = e; } }
        __syncthreads();
        { pg8::SchedMoE<false> S0; S0.A = nullptr; S0.Bt = nullptr; S0.K = 0; S0.bstride = 0; S0.G = G; S0.c = vcu; S0.tab = tab;
          const int half = tid >> 8, r = tid & 255; unsigned vals[NU_MAX / 2]; bool ok[NU_MAX / 2];
#pragma unroll
          for (int k = 0; k < NU_MAX / 2; ++k) { const int ui = 2 * k + half; pg8::Unit u; ok[k] = S0.next(ui, u); vals[k] = 0u;
              if (ok[k]) { const int cnt = tab[T_CNT / 4 + u.e], e = u.e; int p = u.rt * 256 + r; if (p > cnt - 1) p = cnt - 1;
                  int lo_ = 0, hi_ = NGRP - 1;
                  while (lo_ < hi_) { const int mid = (lo_ + hi_ + 1) >> 1; if (pre[mid * 32 + e] <= p) lo_ = mid; else hi_ = mid - 1; }
                  vals[k] = LOCL[((size_t)lo_ * 32 + e) * 128 + (p - pre[lo_ * 32 + e])]; } }
#pragma unroll
          for (int k = 0; k < NU_MAX / 2; ++k) if (ok[k]) tab[T_ROWTAB / 4 + (2 * k + half) * 256 + r] = (int)vals[k];
        }
        __syncthreads();
    }
#define PH7_BODY() do { \
        pg8::SchedMoE<true> S; S.A = (const char*)H8; S.Bt = (const char*)WGU8; S.K = DM / 2; S.bstride = (size_t)DM * DM; S.G = G; S.c = vcu; S.tab = tab; \
        pg8::EpiGU E{ACT, RSTD, tab}; \
        pg8::gemm_phase<pg8::EpiGU, pg8::SchedMoE<true>, false, true>(lds + RING_OFF, DM / 2, S, E); } while (0)
    if (IN(7)) {
        if (PROBE_TWICE == 7) { PH7_BODY(); GRID_BAR(); }
        PH7_BODY();
        {
            const int NT4 = tab[T_NT / 4] * 4, remu = NT4 % G;
            const bool early = (remu == 0) || (vcu >= remu); const int nE = (remu == 0) ? G : (G - remu), rank = (remu == 0) ? vcu : (vcu - remu);
            if (early) { LAS float* scr = (LAS float*)(lds + RING_OFF + wave * 16384);
                for (int r = rank * NWAVES + wave; r < 32 * 32 * 8; r += nE * NWAVES) {
                    const int e = r >> 8, q = r & 255, nb = 4 * (q >> 5) + (q & 3), kb = 2 * ((q >> 3) & 3) + ((q >> 2) & 1);
                    tr_item8(P.wd + (size_t)e * DEXP * DM, DM, 64 * kb, 32 * nb, WD8 + (size_t)e * DM * DEXP, 32 * nb, DEXP, nullptr, WD_SC, scr, lane); } }
        }
        if (BOTH(7)) GRID_BAR();
    }
    if (IN(8)) { REP(8) {
        pg8::SchedMoE<false> S; S.A = (const char*)ACT; S.Bt = (const char*)WD8; S.K = DEXP / 2; S.bstride = (size_t)DM * DEXP; S.G = G; S.c = vcu; S.tab = tab;
        pg8::EpiDown E{Y, tab};
        pg8::gemm_phase<pg8::EpiDown, pg8::SchedMoE<false>, false, true>(lds + RING_OFF, DEXP / 2, S, E);
        REPBAR(8); }
        if (BOTH(8)) GRID_BAR();
    }
    if (IN(9)) { REP(9) {
        for (int m0 = gw; m0 < NTOK; m0 += 2 * NGW) {
            bf16x8 hv[2][2]; u32x4 ya[2], yb[2]; float g0[2], g1[2];
#pragma unroll
            for (int t = 0; t < 2; ++t) { int m = m0 + t * NGW; if (m >= NTOK) m = m0;
                g0[t] = GATE[2 * m] * (1.f / Y_SC); g1[t] = GATE[2 * m + 1] * (1.f / Y_SC);
                const bf16* hp = H + (size_t)m * DM + 16 * lane; const unsigned char* y0 = Y + (size_t)(2 * m) * DM + 16 * lane;
                hv[t][0] = *(const bf16x8*)(hp); hv[t][1] = *(const bf16x8*)(hp + 8); ya[t] = *(const u32x4*)(y0); yb[t] = *(const u32x4*)(y0 + DM); }
#pragma unroll
            for (int t = 0; t < 2; ++t) { const int m = m0 + t * NGW; if (m < NTOK) {
                float* op = P.out + (size_t)m * DM + 16 * lane;
#pragma unroll
                for (int q = 0; q < 4; ++q) { const unsigned wa = ya[t][q], wb = yb[t][q];
                    const f32x2_t a0 = __builtin_amdgcn_cvt_pk_f32_fp8((int)wa, false), a1 = __builtin_amdgcn_cvt_pk_f32_fp8((int)wa, true);
                    const f32x2_t b0 = __builtin_amdgcn_cvt_pk_f32_fp8((int)wb, false), b1 = __builtin_amdgcn_cvt_pk_f32_fp8((int)wb, true);
                    const bf16x8 hh = hv[t][q >> 1]; const int e0 = 4 * (q & 1);
                    f32x4 o; o[0] = bf2f(hh[e0]) + g0[t] * a0.x + g1[t] * b0.x; o[1] = bf2f(hh[e0 + 1]) + g0[t] * a0.y + g1[t] * b0.y;
                    o[2] = bf2f(hh[e0 + 2]) + g0[t] * a1.x + g1[t] * b1.x; o[3] = bf2f(hh[e0 + 3]) + g0[t] * a1.y + g1[t] * b1.y;
                    *(f32x4*)(op + 4 * q) = o; } } }
        }
    REPBAR(9); } }
#undef IN
#undef BOTH
}

extern "C" void kernel_launch(void* const* d_in, const int* in_sizes, int n_in, void* d_out, int out_size, void* d_ws, size_t ws_size, hipStream_t stream) {
    static int grid = 0;
    if (grid == 0) {
        if (n_in != 18 || in_sizes[0] != NTOK * DM || out_size != NTOK * DM || ws_size < WS_END) { fprintf(stderr, "kernel_launch: unexpected shapes / workspace (n_in %d, in0 %d, out %d, ws %zu, need %zu)\n", n_in, n_in > 0 ? in_sizes[0] : -1, out_size, ws_size, (size_t)WS_END); grid = -1; return; }
        int dev = 0, cus = 0, per_cu = 0;
        if (hipGetDevice(&dev) != hipSuccess || hipDeviceGetAttribute(&cus, hipDeviceAttributeMultiprocessorCount, dev) != hipSuccess) { grid = -1; return; }
        if (hipFuncSetAttribute((const void*)fwd_kernel, hipFuncAttributeMaxDynamicSharedMemorySize, LDS_BYTES) != hipSuccess) { fprintf(stderr, "kernel_launch: hipFuncSetAttribute failed\n"); grid = -1; return; }
        if (hipOccupancyMaxActiveBlocksPerMultiprocessor(&per_cu, (const void*)fwd_kernel, NWAVES * 64, LDS_BYTES) != hipSuccess || per_cu < 1) fprintf(stderr, "kernel_launch: occupancy query reports %d\n", per_cu);
        (void)hipGetLastError();
        grid = cus;
    }
    if (grid < 0) return;
    if (hipMemsetAsync((char*)d_ws + WS_CTL, 0, CTL_ZERO_BYTES, stream) != hipSuccess) return;
    Args a{};
    const float** pp = (const float**)&a.p;
    for (int i = 0; i < 18; ++i) pp[i] = (const float*)d_in[i];
    a.p.out = (float*)d_out; a.p.ws = (unsigned char*)d_ws;
    if (MK_N_LAUNCHES == 1) { a.ph_lo = 0; a.ph_hi = N_PHASES; hipLaunchKernelGGL(fwd_kernel, dim3(grid), dim3(NWAVES * 64), LDS_BYTES, stream, a); }
    else for (int li = 0; li < N_PHASES; ++li) { a.ph_lo = li; a.ph_hi = li + 1; hipLaunchKernelGGL(fwd_kernel, dim3(grid), dim3(NWAVES * 64), LDS_BYTES, stream, a); }
}
```

```cpp
#include <hip/hip_runtime.h>
#include <cstdio>
#include <cstdint>

#ifndef MK_N_LAUNCHES
#define MK_N_LAUNCHES 1
#endif

#define LAS __attribute__((address_space(3)))
#define GAS __attribute__((address_space(1)))
typedef unsigned short bf16;
typedef short bf16x8 __attribute__((ext_vector_type(8)));
typedef float f32x4 __attribute__((ext_vector_type(4)));
typedef float f32x16 __attribute__((ext_vector_type(16)));
typedef unsigned u32x4 __attribute__((ext_vector_type(4)));
typedef unsigned u32x2 __attribute__((ext_vector_type(2)));
typedef float f32x2_t __attribute__((ext_vector_type(2)));
typedef __bf16 bf16x2_t __attribute__((ext_vector_type(2)));
typedef GAS unsigned gu32;
typedef int v8i __attribute__((ext_vector_type(8)));
typedef int v4i __attribute__((ext_vector_type(4)));
typedef _Float16 f16x8 __attribute__((ext_vector_type(8)));
typedef _Float16 f16x2 __attribute__((ext_vector_type(2)));

constexpr int BATCH = 16, SEQ = 2048, DM = 1024, NTOK = BATCH * SEQ;
constexpr int IN_DIM = 3088;
constexpr int NEXP = 32, DEXP = 512;
constexpr float EPS = 1e-6f;
constexpr float LOG2E = 1.4426950408889634f;
constexpr float WGU_SC = 64.f, WD_SC = 32.f, ACT_SC = 8.f, Y_SC = 8.f;
constexpr int NA = 1792, NB = 1280;
constexpr int NGRP = NTOK / 128;

constexpr size_t MiB = 1u << 20;
constexpr size_t WS_CTL = 0, CTL_ZERO_BYTES = 64 * 1024;
constexpr size_t WS_WA = 2 * MiB;
constexpr size_t WS_WB = 6 * MiB;
constexpr size_t WS_WO = 9 * MiB;
constexpr size_t WS_WR = 11 * MiB;
constexpr size_t WS_W2T = WS_WR + 2 * 48 * 1024 * 2;
constexpr size_t WS_WGU = 12 * MiB;
constexpr size_t WS_WD = 76 * MiB;
constexpr size_t WS_H = 108 * MiB;
constexpr size_t WS_KV = WS_H;
constexpr size_t WS_XB = 44 * MiB;
constexpr size_t WS_MIX = 172 * MiB;
constexpr size_t WS_SQ = 236 * MiB;
constexpr size_t WS_SK = 268 * MiB;
constexpr size_t WS_GQ = 300 * MiB;
constexpr size_t WS_GRS = 316 * MiB;
constexpr size_t WS_TT = 348 * MiB;
constexpr size_t WS_GLR = 428 * MiB;
constexpr size_t WS_ST = 429 * MiB;
constexpr size_t WS_DTOT = 461 * MiB;
constexpr size_t WS_ACT = 236 * MiB;
constexpr size_t WS_H8 = 272 * MiB;
constexpr size_t WS_Y = 308 * MiB;
constexpr size_t WS_LOCL = 462 * MiB;
constexpr size_t WS_CNTS = 467 * MiB;
constexpr size_t WS_GATE = 470 * MiB;
constexpr size_t WS_RSTD = WS_GATE + 512 * 1024;
constexpr size_t WS_RSTD1 = WS_GATE + 768 * 1024;
constexpr size_t WS_END = 472 * MiB;
constexpr int CW_TMO = 0, CW_CODE = 1;
constexpr int CW_BAR = 4096;
constexpr int CW_CNT = 16384;

constexpr int RING_OFF = 0, RING_BYTES = 131072;
constexpr int LDSCTL_OFF = RING_BYTES, MISC_OFF = LDSCTL_OFF + 320;
constexpr int TAB_OFF = LDSCTL_OFF + 1024;
constexpr int LDS_BYTES = 147456;
constexpr int T_CNT = 0, T_TBASE = 128, T_NT = 264, T_TILE_E = 272, T_ROWTAB = 272 + 320 * 4, NU_MAX = 8;
static_assert(TAB_OFF + T_ROWTAB + NU_MAX * 256 * 4 <= LDS_BYTES, "LDS tables");

#define RLX_AGENT __ATOMIC_RELAXED, __HIP_MEMORY_SCOPE_AGENT
#define LDS_WAIT() asm volatile("s_waitcnt lgkmcnt(0)" ::: "memory")
#define VM_WAIT() asm volatile("s_waitcnt vmcnt(0)" ::: "memory")

__device__ __forceinline__ unsigned cvtpk(float lo, float hi) { f32x2_t v = {lo, hi}; bf16x2_t b = __builtin_convertvector(v, bf16x2_t); return __builtin_bit_cast(unsigned, b); }
__device__ __forceinline__ u32x2 pack8_fp8(const float* a) { int lo = __builtin_amdgcn_cvt_pk_fp8_f32(a[0], a[1], 0, false); lo = __builtin_amdgcn_cvt_pk_fp8_f32(a[2], a[3], lo, true);
    int hi = __builtin_amdgcn_cvt_pk_fp8_f32(a[4], a[5], 0, false); hi = __builtin_amdgcn_cvt_pk_fp8_f32(a[6], a[7], hi, true); u32x2 r; r.x = (unsigned)lo; r.y = (unsigned)hi; return r; }
__device__ __forceinline__ float bf2f(short s) { return __uint_as_float(((unsigned)(unsigned short)s) << 16); }
__device__ __forceinline__ bf16x8 pack8(const float* a) { u32x4 p; p.x = cvtpk(a[0], a[1]); p.y = cvtpk(a[2], a[3]); p.z = cvtpk(a[4], a[5]); p.w = cvtpk(a[6], a[7]); return __builtin_bit_cast(bf16x8, p); }
__device__ __forceinline__ int PI32(int i) { return 16 * ((i >> 2) & 1) + (i & 3) + 4 * (i >> 3); }
#define MFMA32(a, b, c) __builtin_amdgcn_mfma_f32_32x32x16_bf16((a), (b), (c), 0, 0, 0)
#define MFMA16(a, b, c) __builtin_amdgcn_mfma_f32_16x16x32_bf16((a), (b), (c), 0, 0, 0)
__device__ __forceinline__ void swap32(float x, float& lo, float& hi) { auto rr = __builtin_amdgcn_permlane32_swap(__float_as_uint(x), __float_as_uint(x), false, false); lo = __uint_as_float(rr[0]); hi = __uint_as_float(rr[1]); }

namespace pg8 {
#define PG8_LAS __attribute__((address_space(3)))
constexpr int BM = 256, BK = 64, HALF = 128, HTB = HALF * BK * 2, STAGE_BYTES = 8 * HTB, NXCD = 8, WGM = 8;
__host__ __device__ __forceinline__ int lds_byte(int r, int c) { const int st = (r >> 4) * 2 + (c >> 5), rr = r & 15, cc = c & 31, ob = rr * 64 + cc * 2; return st * 1024 + (ob ^ (((ob >> 9) & 1) << 5)); }
__host__ __device__ __forceinline__ void stage_rc(int b, int& R, int& C) { const int st = b / 1024, sb = b % 1024, swz = sb ^ (((sb >> 9) & 1) << 5); R = (st >> 1) * 16 + swz / 64; C = (st & 1) * 32 + (swz % 64) / 2; }
__host__ __device__ __forceinline__ int perm32(int rho) { const int n = rho >> 4, i = rho & 15; return 8 * (i >> 2) + 4 * n + (i & 3); }

struct Unit { int pm, pn, e, rt, nv; };

struct SchedDense {
    const char* A; const char* Bt; int K; int nM, nN, nwg, G, c;
    __device__ void init(const void* A_, const void* Bt_, int M, int N, int K_, int G_, int c_) { A = (const char*)A_; Bt = (const char*)Bt_; K = K_; nM = M / BM; nN = N / BM; nwg = nM * nN; G = G_; c = c_; }
    __device__ __forceinline__ bool next(int i, Unit& u) const {
        const long L = (long)i * G + c; if (L >= nwg) return false;
        int wgid = (int)L; { const int q = nwg / NXCD, r = nwg % NXCD, xcd = wgid % NXCD, off = wgid / NXCD; wgid = (xcd < r ? xcd * (q + 1) : r * (q + 1) + (xcd - r) * q) + off; }
        const int nig = WGM * nN, gid = wgid / nig, fm = gid * WGM, gsz = (nM - fm) < WGM ? (nM - fm) : WGM;
        u.pm = fm + ((wgid % nig) % gsz); u.pn = (wgid % nig) / gsz; u.e = 0; u.rt = 0; u.nv = 256; return true;
    }
    __device__ __forceinline__ const char* a_ptr(const Unit& u) const { return A + (size_t)u.pm * BM * K * 2; }
    __device__ __forceinline__ const char* b_ptr(const Unit& u) const { return Bt + (size_t)u.pn * BM * K * 2; }
    __device__ __forceinline__ void a_voff(int, const Unit&, int tid, unsigned (&v)[2][2]) const {
#pragma unroll
        for (int i = 0; i < 2; ++i) { int R, C; stage_rc(tid * 16 + i * 8192, R, C);
#pragma unroll
            for (int h = 0; h < 2; ++h) v[h][i] = (unsigned)((h * HALF + R) * K + C) * 2u; }
    }
};
template <bool GATHER> struct SchedMoE {
    const char* A; const char* Bt; int K; size_t bstride; int G, c;
    const PG8_LAS int* tab;
    __device__ __forceinline__ bool next(int i, Unit& u) const {
        const int L = i * G + c; const int NT = tab[T_NT / 4];
        if (L >= NT * 4) return false;
        const int tile = L >> 2; u.pm = tile; u.pn = L & 3; const int e = tab[T_TILE_E / 4 + tile]; u.e = e;
        u.rt = tile - tab[T_TBASE / 4 + e]; const int rem = tab[T_CNT / 4 + e] - u.rt * 256; u.nv = rem < 256 ? rem : 256; return true;
    }
    __device__ __forceinline__ const char* a_ptr(const Unit& u) const { return GATHER ? A : A + (size_t)u.pm * BM * K * 2; }
    __device__ __forceinline__ const char* b_ptr(const Unit& u) const { return Bt + (size_t)u.e * bstride + (size_t)u.pn * BM * K * 2; }
    __device__ __forceinline__ void a_voff(int ui, const Unit&, int tid, unsigned (&v)[2][2]) const {
        asm volatile("" : "+v"(tid));
#pragma unroll
        for (int i = 0; i < 2; ++i) { int R, C; stage_rc(tid * 16 + i * 8192, R, C);
#pragma unroll
            for (int h = 0; h < 2; ++h) {
                if (GATHER) { const int tok = tab[T_ROWTAB / 4 + ui * 256 + h * HALF + R] >> 1; v[h][i] = (unsigned)(tok * K + C) * 2u; }
                else v[h][i] = (unsigned)((h * HALF + R) * K + C) * 2u; } }
    }
};

template <class Epi, class Sched, bool TAIL = false, bool FP8 = false>
__device__ __forceinline__ void gemm_phase(PG8_LAS unsigned char* lds, const int K, const Sched& S, const Epi& E) {
    const int tid = threadIdx.x, wid = __builtin_amdgcn_readfirstlane(tid >> 6), lane = tid & 63, wr = wid >> 2, wc = wid & 3, fr = lane & 15, fq = lane >> 4;
    const int nt = K / BK;
    unsigned voffB[1][2];
#pragma unroll
    for (int i = 0; i < 2; ++i) { int R, C; stage_rc(tid * 16 + i * 8192, R, C); const int Rb = (R & ~31) + perm32(R & 31);
        voffB[0][i] = (unsigned)(Rb * K + C) * 2u; }
    const size_t hstepB = (size_t)HALF * K * 2;
    const size_t kstep = (size_t)(BK * 2);
    const unsigned ldsw = (unsigned)wid * 1024u;
    const int aoff = lds_byte(wr * 64 + fr, fq * 8), boff = lds_byte(wc * 32 + fr, fq * 8);
#define PG8_SA(b, h) (((b) * 2 + (h)) * HTB)
#define PG8_SB(b, h) ((4 + (b) * 2 + (h)) * HTB)
#define PG8_STAGE(bufoff, gbase, voff) do { _Pragma("unroll") for (int _i = 0; _i < 2; ++_i) \
        __builtin_amdgcn_global_load_lds((const unsigned*)((const char*)(gbase) + (voff)[_i]), (PG8_LAS unsigned*)(lds + (bufoff) + ldsw + _i * 8192), 16, 0, 0); } while (0)
#define PG8_RD16(off) (*(const PG8_LAS v4i*)(lds + (off)))
#define PG8_LDA(dst, b, h) do { _Pragma("unroll") for (int m = 0; m < 4; ++m) { \
        if constexpr (FP8) At8[m] = __builtin_shufflevector(PG8_RD16(PG8_SA(b, h) + aoff + m * 2048), PG8_RD16(PG8_SA(b, h) + aoff + m * 2048 + 1024), 0, 1, 2, 3, 4, 5, 6, 7); \
        else { _Pragma("unroll") for (int k = 0; k < 2; ++k) dst[m][k] = *(const PG8_LAS bf16x8*)(lds + PG8_SA(b, h) + aoff + m * 2048 + k * 1024); } } } while (0)
#define PG8_LDB(dst, b, h) do { _Pragma("unroll") for (int n = 0; n < 2; ++n) { \
        if constexpr (FP8) dst##8[n] = __builtin_shufflevector(PG8_RD16(PG8_SB(b, h) + boff + n * 2048), PG8_RD16(PG8_SB(b, h) + boff + n * 2048 + 1024), 0, 1, 2, 3, 4, 5, 6, 7); \
        else { _Pragma("unroll") for (int k = 0; k < 2; ++k) dst[n][k] = *(const PG8_LAS bf16x8*)(lds + PG8_SB(b, h) + boff + n * 2048 + k * 1024); } } } while (0)
#define PG8_MMA(ai, bj, At, Bt) do { __builtin_amdgcn_s_setprio(1); _Pragma("unroll") for (int m = 0; m < 4; ++m) _Pragma("unroll") for (int n = 0; n < 2; ++n) { \
        if constexpr (FP8) asm volatile("v_mfma_scale_f32_16x16x128_f8f6f4 %0, %1, %2, %0, %3, %3 op_sel_hi:[0,0,0]" : "+v"(acc[ai][bj][m][n]) : "v"(Bt##8[n]), "v"(At8[m]), "v"(sc1)); \
        else { _Pragma("unroll") for (int k = 0; k < 2; ++k) acc[ai][bj][m][n] = __builtin_amdgcn_mfma_f32_16x16x32_bf16(Bt[n][k], At[m][k], acc[ai][bj][m][n], 0, 0, 0); } } \
        __builtin_amdgcn_s_setprio(0); } while (0)
#define PG8_WAIT_V(n) asm volatile("s_waitcnt vmcnt(" #n ")" ::: "memory")
#define PG8_WAIT_L(n) asm volatile("s_waitcnt lgkmcnt(" #n ")" ::: "memory")
#define PG8_BAR __builtin_amdgcn_s_barrier()
#define PG8_SCHED __builtin_amdgcn_sched_barrier(0)
    Unit cur, nxt; int ui = 0;
    if (!S.next(0, cur)) return;
    f32x4 acc[2][2][4][2];
#pragma unroll
    for (int a = 0; a < 2; ++a)
#pragma unroll
        for (int b = 0; b < 2; ++b)
#pragma unroll
            for (int m = 0; m < 4; ++m)
#pragma unroll
                for (int n = 0; n < 2; ++n) acc[a][b][m][n] = (f32x4){0.f, 0.f, 0.f, 0.f};
    bf16x8 At[4][2], B0[2][2], B1[2][2];
    v8i At8[4], B08[2], B18[2];
    int sc1 = 0x7f7f7f7f; asm volatile("" : "+v"(sc1));
    unsigned vc[2][2], vn[2][2];
    S.a_voff(0, cur, tid, vc);
    const char* cA = S.a_ptr(cur); const char* cB = S.b_ptr(cur);
    PG8_STAGE(PG8_SB(0, 0), cB, voffB[0]); PG8_STAGE(PG8_SB(0, 1), (cB) + hstepB, voffB[0]); PG8_STAGE(PG8_SA(0, 0), cA, vc[0]); PG8_STAGE(PG8_SA(0, 1), cA, vc[1]);
    if (wr == 1) PG8_BAR;
    PG8_WAIT_V(2); PG8_BAR;
    PG8_STAGE(PG8_SB(1, 0), cB + kstep, voffB[0]); PG8_STAGE(PG8_SA(1, 0), cA + kstep, vc[0]); PG8_STAGE(PG8_SB(1, 1), (cB + kstep) + hstepB, voffB[0]);
    PG8_WAIT_V(6); PG8_BAR;
    for (;;) {
        const bool has_next = S.next(ui + 1, nxt);
        const char* nA = has_next ? S.a_ptr(nxt) : cA; const char* nB = has_next ? S.b_ptr(nxt) : cB;
        if (has_next) S.a_voff(ui + 1, nxt, tid, vn);
        else {
#pragma unroll
            for (int h = 0; h < 2; ++h)
#pragma unroll
                for (int i = 0; i < 2; ++i) vn[h][i] = vc[h][i]; }
        const bool full_hi = !TAIL || cur.nv > HALF;
        for (int t = 0; t < nt; t += 2) {
            const bool last = (t == nt - 2);
            const char* a1 = cA + (size_t)(t + 1) * kstep;
            const char* a2 = last ? nA : cA + (size_t)(t + 2) * kstep; const char* b2 = last ? nB : cB + (size_t)(t + 2) * kstep;
            const char* a3 = a2 + kstep; const char* b3 = b2 + kstep;
            unsigned w0[2], w1[2];
            w0[0] = last ? vn[0][0] : vc[0][0]; w0[1] = last ? vn[0][1] : vc[0][1]; w1[0] = last ? vn[1][0] : vc[1][0]; w1[1] = last ? vn[1][1] : vc[1][1];
            PG8_LDB(B0, 0, 0); PG8_LDB(B1, 0, 1); PG8_SCHED; PG8_LDA(At, 0, 0); PG8_STAGE(PG8_SA(1, 1), a1, vc[1]);
            PG8_WAIT_V(8); PG8_WAIT_L(0); PG8_BAR; PG8_MMA(0, 0, At, B0); PG8_MMA(0, 1, At, B1); PG8_BAR; PG8_SCHED;
            PG8_LDA(At, 0, 1); PG8_STAGE(PG8_SB(0, 0), b2, voffB[0]); PG8_STAGE(PG8_SB(0, 1), (b2) + hstepB, voffB[0]); PG8_STAGE(PG8_SA(0, 0), a2, w0);
            PG8_WAIT_V(8); PG8_WAIT_L(0); PG8_BAR; if (full_hi) { PG8_MMA(1, 0, At, B0); PG8_MMA(1, 1, At, B1); } PG8_BAR; PG8_SCHED;
            PG8_LDB(B0, 1, 0); PG8_LDB(B1, 1, 1); PG8_SCHED; PG8_LDA(At, 1, 0); PG8_STAGE(PG8_SA(0, 1), a2, w1);
            PG8_WAIT_V(8); PG8_WAIT_L(0); PG8_BAR; PG8_MMA(0, 0, At, B0); PG8_MMA(0, 1, At, B1); PG8_BAR; PG8_SCHED;
            PG8_LDA(At, 1, 1); PG8_STAGE(PG8_SB(1, 0), b3, voffB[0]); PG8_STAGE(PG8_SB(1, 1), (b3) + hstepB, voffB[0]); PG8_STAGE(PG8_SA(1, 0), a3, w0);
            PG8_WAIT_V(8); PG8_WAIT_L(0); PG8_BAR; if (full_hi) { PG8_MMA(1, 0, At, B0); PG8_MMA(1, 1, At, B1); } PG8_BAR; PG8_SCHED;
        }
        if (wr == 0) PG8_BAR;
        if constexpr (FP8) asm volatile("s_nop 15\n\ts_nop 15" ::: "memory");
        { int t2_ = threadIdx.x; asm volatile("" : "+v"(t2_)); E(acc, cur, ui, wr, wc, t2_ & 15, (t2_ >> 4) & 3); }
        if (!has_next) break;
#pragma unroll
        for (int a = 0; a < 2; ++a)
#pragma unroll
            for (int b = 0; b < 2; ++b)
#pragma unroll
                for (int m = 0; m < 4; ++m)
#pragma unroll
                    for (int n = 0; n < 2; ++n) acc[a][b][m][n] = (f32x4){0.f, 0.f, 0.f, 0.f};
        cur = nxt; cA = nA; cB = nB; ++ui;
#pragma unroll
        for (int h = 0; h < 2; ++h)
#pragma unroll
            for (int i = 0; i < 2; ++i) vc[h][i] = vn[h][i];
        if (wr == 1) PG8_BAR;
    }
    PG8_WAIT_V(0);
    PG8_BAR;
#undef PG8_SA
#undef PG8_SB
#undef PG8_STAGE
#undef PG8_LDA
#undef PG8_LDB
#undef PG8_MMA
#undef PG8_RD16
#undef PG8_WAIT_V
#undef PG8_WAIT_L
#undef PG8_BAR
#undef PG8_SCHED
}

struct EpiBf16 {
    bf16* O; int ldc;
    __device__ __forceinline__ void operator()(const f32x4 (&acc)[2][2][4][2], const Unit& u, int, int wr, int wc, int fr, int fq) const {
        const int row0 = u.pm * BM + wr * 64 + fr, col0 = u.pn * BM + wc * 32 + 8 * fq;
#pragma unroll
        for (int ai = 0; ai < 2; ++ai)
#pragma unroll
            for (int m = 0; m < 4; ++m) { bf16* rowp = O + (size_t)(row0 + ai * HALF + m * 16) * ldc + col0;
#pragma unroll
                for (int bj = 0; bj < 2; ++bj) { const f32x4 v0 = acc[ai][bj][m][0], v1 = acc[ai][bj][m][1];
                    u32x4 w; w.x = cvtpk(v0[0], v0[1]); w.y = cvtpk(v0[2], v0[3]); w.z = cvtpk(v1[0], v1[1]); w.w = cvtpk(v1[2], v1[3]);
                    *(u32x4*)(rowp + bj * HALF) = w; } }
    }
};
struct EpiTT {
    bf16* O; const float* RS;
    __device__ __forceinline__ void operator()(const f32x4 (&acc)[2][2][4][2], const Unit& u, int, int wr, int wc, int fr, int fq) const {
        const int row0 = u.pm * BM + wr * 64 + fr, tokb0 = u.pn * 8 + wc;
        f32x4 rs[2][2];
#pragma unroll
        for (int bj = 0; bj < 2; ++bj) { const float* rp = RS + (size_t)(tokb0 + 4 * bj) * 32 + 8 * fq; rs[bj][0] = *(const f32x4*)rp; rs[bj][1] = *(const f32x4*)(rp + 4); }
#pragma unroll
        for (int ai = 0; ai < 2; ++ai)
#pragma unroll
            for (int m = 0; m < 4; ++m) { const int col = row0 + ai * HALF + m * 16;
#pragma unroll
                for (int bj = 0; bj < 2; ++bj) { const f32x4 v0 = acc[ai][bj][m][0] * rs[bj][0], v1 = acc[ai][bj][m][1] * rs[bj][1];
                    u32x4 w; w.x = cvtpk(v0[0], v0[1]); w.y = cvtpk(v0[2], v0[3]); w.z = cvtpk(v1[0], v1[1]); w.w = cvtpk(v1[2], v1[3]);
                    *(u32x4*)(O + ((size_t)(tokb0 + 4 * bj) * 1280 + col) * 32 + 8 * fq) = w; } }
    }
};
struct EpiA {
    bf16 *SQ, *SK, *GQ, *GRS; const float *gq_norm, *gk_norm; const float* RS;
    __device__ __forceinline__ void operator()(const f32x4 (&acc)[2][2][4][2], const Unit& u, int, int wr, int wc, int fr, int fq) const {
        const int pn = u.pn; const int row0 = u.pm * BM + wr * 64 + fr;
        bf16* base; int ldc, colt; int mode;
        float scale = 1.f; const float* gain = nullptr;
        if (pn < 2)      { base = SQ; ldc = 512; colt = pn * 256; mode = 0; gain = gq_norm; scale = 0.125f * LOG2E; }
        else if (pn < 4) { base = SK; ldc = 512; colt = (pn - 2) * 256; mode = 0; gain = gk_norm; scale = 1.f; }
        else if (pn < 5) { base = GQ; ldc = 256; colt = 0; mode = 1; scale = 0.125f; }
        else             { base = GRS; ldc = 512; colt = (pn - 5) * 256; mode = 2; }
        const int col0 = colt + wc * 64 + 8 * fq;
        f32x4 gv[2][2];
#pragma unroll
        for (int bj = 0; bj < 2; ++bj)
#pragma unroll
            for (int n = 0; n < 2; ++n) { if (mode == 0) { gv[bj][n] = *(const f32x4*)(gain + 32 * bj + 8 * fq + 4 * n); gv[bj][n] = gv[bj][n] * scale; } else gv[bj][n] = (f32x4){scale, scale, scale, scale}; }
        float rs1v[2][4];
#pragma unroll
        for (int ai = 0; ai < 2; ++ai)
#pragma unroll
            for (int m = 0; m < 4; ++m) rs1v[ai][m] = RS[row0 + ai * HALF + m * 16];
#pragma unroll
        for (int ai = 0; ai < 2; ++ai)
#pragma unroll
            for (int m = 0; m < 4; ++m) {
                const float rs1 = rs1v[ai][m]; float rs = rs1;
                if (mode == 0) { float s = 0.f;
#pragma unroll
                    for (int bj = 0; bj < 2; ++bj)
#pragma unroll
                        for (int n = 0; n < 2; ++n) { const f32x4 x = acc[ai][bj][m][n]; s += (x[0] * x[0] + x[1] * x[1]) + (x[2] * x[2] + x[3] * x[3]); }
                    s += __shfl_xor(s, 16); s += __shfl_xor(s, 32);
                    rs = rs1 * __builtin_amdgcn_rsqf(rs1 * rs1 * s * (1.f / 64.f) + EPS); }
                bf16* rowp = base + (size_t)(row0 + ai * HALF + m * 16) * ldc + col0;
#pragma unroll
                for (int bj = 0; bj < 2; ++bj) { f32x4 v0 = acc[ai][bj][m][0], v1 = acc[ai][bj][m][1];
                    if (mode == 2) {
#pragma unroll
                        for (int e = 0; e < 4; ++e) { v0[e] *= rs1; v1[e] *= rs1; v0[e] = v0[e] * __builtin_amdgcn_rcpf(1.f + __builtin_amdgcn_exp2f(-v0[e] * LOG2E)); v1[e] = v1[e] * __builtin_amdgcn_rcpf(1.f + __builtin_amdgcn_exp2f(-v1[e] * LOG2E)); }
                    } else { v0 = v0 * rs * gv[bj][0]; v1 = v1 * rs * gv[bj][1]; }
                    u32x4 w; w.x = cvtpk(v0[0], v0[1]); w.y = cvtpk(v0[2], v0[3]); w.z = cvtpk(v1[0], v1[1]); w.w = cvtpk(v1[2], v1[3]);
                    *(u32x4*)(rowp + bj * 32) = w; } }
    }
};
struct EpiH {
    const bf16* XB; bf16* H; unsigned char* H8;
    __device__ __forceinline__ void operator()(const f32x4 (&acc)[2][2][4][2], const Unit& u, int, int wr, int wc, int fr, int fq) const {
        const int row0 = u.pm * BM + wr * 64 + fr, col0 = u.pn * BM + wc * 32 + 8 * fq;
#pragma unroll
        for (int ai = 0; ai < 2; ++ai) {
            bf16x8 xv[4][2];
#pragma unroll
            for (int m = 0; m < 4; ++m) { const size_t off = (size_t)(row0 + ai * HALF + m * 16) * DM + col0;
#pragma unroll
                for (int bj = 0; bj < 2; ++bj) xv[m][bj] = *(const bf16x8*)(XB + off + bj * HALF); }
#pragma unroll
            for (int m = 0; m < 4; ++m) { const size_t off = (size_t)(row0 + ai * HALF + m * 16) * DM + col0;
#pragma unroll
                for (int bj = 0; bj < 2; ++bj) { const bf16x8 xx = xv[m][bj];
                    const f32x4 v0 = acc[ai][bj][m][0] + (f32x4){bf2f(xx[0]), bf2f(xx[1]), bf2f(xx[2]), bf2f(xx[3])}, v1 = acc[ai][bj][m][1] + (f32x4){bf2f(xx[4]), bf2f(xx[5]), bf2f(xx[6]), bf2f(xx[7])};
                    u32x4 w; w.x = cvtpk(v0[0], v0[1]); w.y = cvtpk(v0[2], v0[3]); w.z = cvtpk(v1[0], v1[1]); w.w = cvtpk(v1[2], v1[3]);
                    *(u32x4*)(H + off + bj * HALF) = w;
                    const float f8[8] = {v0[0], v0[1], v0[2], v0[3], v1[0], v1[1], v1[2], v1[3]};
                    *(u32x2*)(H8 + off + bj * HALF) = pack8_fp8(f8); } }
        }
    }
};
struct EpiGU {
    unsigned char* ACT; const float* RSTD; const PG8_LAS int* tab;
    __device__ __forceinline__ void operator()(const f32x4 (&acc)[2][2][4][2], const Unit& u, int ui, int wr, int wc, int fr, int fq) const {
        const int col0 = u.pn * 128 + wc * 32 + 8 * fq;
        float rsv[2][4];
#pragma unroll
        for (int ai = 0; ai < 2; ++ai)
#pragma unroll
            for (int m = 0; m < 4; ++m) { const int rl = ai * HALF + wr * 64 + m * 16 + fr; rsv[ai][m] = RSTD[tab[T_ROWTAB / 4 + ui * 256 + rl] >> 1]; }
#pragma unroll
        for (int ai = 0; ai < 2; ++ai)
#pragma unroll
            for (int m = 0; m < 4; ++m) { const int rl = ai * HALF + wr * 64 + m * 16 + fr;
                if (rl < u.nv) {
                    const float rs = rsv[ai][m] * (1.f / WGU_SC);
                    f32x4 g0 = acc[ai][0][m][0] * rs, g1 = acc[ai][0][m][1] * rs, u0 = acc[ai][1][m][0] * rs, u1 = acc[ai][1][m][1] * rs;
#pragma unroll
                    for (int e = 0; e < 4; ++e) { g0[e] = g0[e] * __builtin_amdgcn_rcpf(1.f + __builtin_amdgcn_exp2f(-g0[e] * LOG2E)) * u0[e]; g1[e] = g1[e] * __builtin_amdgcn_rcpf(1.f + __builtin_amdgcn_exp2f(-g1[e] * LOG2E)) * u1[e]; }
                    float f8[8] = {g0[0] * ACT_SC, g0[1] * ACT_SC, g0[2] * ACT_SC, g0[3] * ACT_SC, g1[0] * ACT_SC, g1[1] * ACT_SC, g1[2] * ACT_SC, g1[3] * ACT_SC};
#pragma unroll
                    for (int e = 0; e < 8; ++e) f8[e] = __builtin_fminf(__builtin_fmaxf(f8[e], -448.f), 448.f);
                    *(u32x2*)(ACT + (size_t)(u.pm * 256 + rl) * DEXP + col0) = pack8_fp8(f8); } }
    }
};
struct EpiDown {
    unsigned char* Y; const PG8_LAS int* tab;
    __device__ __forceinline__ void operator()(const f32x4 (&acc)[2][2][4][2], const Unit& u, int ui, int wr, int wc, int fr, int fq) const {
        const int col0 = u.pn * BM + wc * 32 + 8 * fq; const float sc = Y_SC / (WD_SC * ACT_SC);
#pragma unroll
        for (int ai = 0; ai < 2; ++ai)
#pragma unroll
            for (int m = 0; m < 4; ++m) { const int rl = ai * HALF + wr * 64 + m * 16 + fr;
                if (rl < u.nv) { const unsigned ts = (unsigned)tab[T_ROWTAB / 4 + ui * 256 + rl]; unsigned char* rowp = Y + (size_t)ts * DM + col0;
#pragma unroll
                    for (int bj = 0; bj < 2; ++bj) { const f32x4 v0 = acc[ai][bj][m][0] * sc, v1 = acc[ai][bj][m][1] * sc;
                        const float f8[8] = {v0[0], v0[1], v0[2], v0[3], v1[0], v1[1], v1[2], v1[3]};
                        *(u32x2*)(rowp + bj * HALF) = pack8_fp8(f8); } } }
    }
};
}

#define XB_TMO      128
#define XB_XCNT(j)  (256  + 64 * (j))
#define XB_XSUB(j)  (1280 + 64 * (j))
#define XB_XGEN(j)  (2304 + 64 * (j))
#define XB_TOP      3328
#define XB_TOPGEN   3392
#define XCD_BAR_WORDS 3456
#define XB_SPIN_CAP (1u << 18)
__device__ __forceinline__ unsigned xb_ld(unsigned* p)              { return __hip_atomic_load(p, __ATOMIC_RELAXED, __HIP_MEMORY_SCOPE_AGENT); }
__device__ __forceinline__ unsigned xb_add(unsigned* p, unsigned v) { return __hip_atomic_fetch_add(p, v, __ATOMIC_RELAXED, __HIP_MEMORY_SCOPE_AGENT); }
__device__ __forceinline__ unsigned xb_xcc_id() { return (unsigned)__builtin_amdgcn_s_getreg((3 << 11) | 20) & 0xFu; }
#define XB_SPIN(cond, bar) do { unsigned _sp = 0; while (cond) { __builtin_amdgcn_s_sleep(1); \
    if ((++_sp & 255u) == 0u) { if (xb_ld(&(bar)[XB_TMO])) break; if (_sp > XB_SPIN_CAP) { atomicAdd(&(bar)[XB_TMO], 1u); break; } } } } while (0)
struct XcdBarrier { unsigned* bar; unsigned x; volatile LAS unsigned* st; };
__device__ __forceinline__ XcdBarrier xcd_barrier_post(unsigned* bar, volatile LAS unsigned* st) {
    XcdBarrier b; b.bar = bar; b.x = xb_xcc_id(); b.st = st;
    if (threadIdx.x == 0) (void)xb_add(&bar[XB_XCNT(b.x)], 1u);
    return b;
}
__device__ __forceinline__ void xcd_barrier_complete(unsigned* bar, unsigned x, unsigned& nloc, unsigned& nx) {
    const unsigned G = gridDim.x * gridDim.y * gridDim.z;
    unsigned sum, cnt, mine, sp = 0u;
    for (;;) {
        sum = 0u; cnt = 0u; mine = 0u;
#pragma unroll
        for (unsigned j = 0; j < 16; ++j) { const unsigned c = xb_ld(&bar[XB_XCNT(j)]); sum += c; cnt += (c > 0u) ? 1u : 0u; mine = (j == x) ? c : mine; }
        if (sum == G) break;
        __builtin_amdgcn_s_sleep(1);
        if ((++sp & 255u) == 0u) { if (xb_ld(&bar[XB_TMO])) break; if (sp > XB_SPIN_CAP) { atomicAdd(&bar[XB_TMO], 1u); break; } }
    }
    nloc = mine > 0u ? mine : 1u; nx = cnt > 0u ? cnt : 1u;
}
__device__ __forceinline__ void xcd_barrier(const XcdBarrier& b) {
    asm volatile("s_waitcnt vmcnt(0)" ::: "memory");
    __syncthreads();
    if (threadIdx.x == 0) {
        unsigned* bar = b.bar;
        __builtin_amdgcn_s_waitcnt(0);
        unsigned nloc = b.st[0], nx = b.st[1];
        if (nloc == 0u) { xcd_barrier_complete(bar, b.x, nloc, nx); b.st[0] = nloc; b.st[1] = nx; }
        const unsigned old = xb_add(&bar[XB_XSUB(b.x)], 1u);
        const unsigned gen = old / nloc;
        if (old + 1u == (gen + 1u) * nloc) {
            __builtin_amdgcn_fence(__ATOMIC_RELEASE, "agent");
            asm volatile("s_waitcnt vmcnt(0)" ::: "memory");
            const unsigned og = xb_add(&bar[XB_TOP], 1u);
            const unsigned tg = og / nx;
            if (og + 1u == (tg + 1u) * nx) xb_add(&bar[XB_TOPGEN], 1u);
            else XB_SPIN(xb_ld(&bar[XB_TOPGEN]) == tg, bar);
            __builtin_amdgcn_fence(__ATOMIC_ACQUIRE, "agent");
            xb_add(&bar[XB_XGEN(b.x)], 1u);
            asm volatile("s_waitcnt vmcnt(0)" ::: "memory");
        } else {
            XB_SPIN(xb_ld(&bar[XB_XGEN(b.x)]) == gen, bar);
            __builtin_amdgcn_fence(__ATOMIC_ACQUIRE, "agent");
            asm volatile("s_waitcnt vmcnt(0)" ::: "memory");
        }
    }
    __syncthreads();
}

__device__ __forceinline__ void xcd_barrier_arrive(const XcdBarrier& b, volatile LAS unsigned* sv) {
    asm volatile("s_waitcnt vmcnt(0)" ::: "memory");
    __syncthreads();
    if (threadIdx.x == 0) {
        unsigned* bar = b.bar;
        __builtin_amdgcn_s_waitcnt(0);
        unsigned nloc = b.st[0], nx = b.st[1];
        if (nloc == 0u) { xcd_barrier_complete(bar, b.x, nloc, nx); b.st[0] = nloc; b.st[1] = nx; }
        const unsigned old = xb_add(&bar[XB_XSUB(b.x)], 1u);
        const unsigned gen = old / nloc;
        unsigned role = 0u, tg = 0u;
        if (old + 1u == (gen + 1u) * nloc) {
            __builtin_amdgcn_fence(__ATOMIC_RELEASE, "agent");
            asm volatile("s_waitcnt vmcnt(0)" ::: "memory");
            const unsigned og = xb_add(&bar[XB_TOP], 1u);
            tg = og / nx;
            if (og + 1u == (tg + 1u) * nx) { xb_add(&bar[XB_TOPGEN], 1u); role = 2u; } else role = 1u;
        }
        sv[0] = role; sv[1] = gen; sv[2] = tg;
    }
}
__device__ __forceinline__ void xcd_barrier_wait(const XcdBarrier& b, volatile LAS unsigned* sv) {
    asm volatile("s_waitcnt vmcnt(0)" ::: "memory");
    __syncthreads();
    if (threadIdx.x == 0) {
        unsigned* bar = b.bar; const unsigned role = sv[0], gen = sv[1], tg = sv[2];
        if (role != 0u) {
            if (role == 1u) XB_SPIN(xb_ld(&bar[XB_TOPGEN]) == tg, bar);
            __builtin_amdgcn_fence(__ATOMIC_ACQUIRE, "agent");
            xb_add(&bar[XB_XGEN(b.x)], 1u);
            asm volatile("s_waitcnt vmcnt(0)" ::: "memory");
        } else {
            XB_SPIN(xb_ld(&bar[XB_XGEN(b.x)]) == gen, bar);
            __builtin_amdgcn_fence(__ATOMIC_ACQUIRE, "agent");
            asm volatile("s_waitcnt vmcnt(0)" ::: "memory");
        }
    }
    __syncthreads();
}

__device__ __forceinline__ float wave_sum(float v) {
#pragma unroll
    for (int o = 1; o < 64; o <<= 1) v += __shfl_xor(v, o);
    return v;
}
__device__ __forceinline__ void tr_item(const float* src, int srcN, int k0, int n0, bf16* dst, int drow0, int dK, const float* kscale, LAS float* scr, int lane) {
    float w[32];
    const float* sp = src + (size_t)(k0 + (lane >> 5)) * srcN + n0 + (lane & 31);
#pragma unroll
    for (int i = 0; i < 32; ++i) w[i] = __builtin_nontemporal_load(sp + (size_t)(2 * i) * srcN);
    if (kscale) { const float ksv = kscale[k0 + lane];
#pragma unroll
        for (int i = 0; i < 32; ++i) { const float a = __int_as_float(__builtin_amdgcn_readlane(__float_as_int(ksv), 2 * i)), b = __int_as_float(__builtin_amdgcn_readlane(__float_as_int(ksv), 2 * i + 1)); w[i] *= (lane >> 5) ? b : a; } }
#pragma unroll
    for (int i = 0; i < 32; ++i) scr[(2 * i + (lane >> 5)) * 33 + (lane & 31)] = w[i];
    LDS_WAIT(); asm volatile("" ::: "memory");
    const int c = lane & 7;
#pragma unroll
    for (int j = 0; j < 4; ++j) { const int n = (lane >> 3) + 8 * j; const LAS float* s = scr + (8 * c) * 33 + n;
        u32x4 o; o.x = cvtpk(s[0 * 33], s[1 * 33]); o.y = cvtpk(s[2 * 33], s[3 * 33]); o.z = cvtpk(s[4 * 33], s[5 * 33]); o.w = cvtpk(s[6 * 33], s[7 * 33]);
        *(GAS u32x4*)(dst + (size_t)(drow0 + n) * dK + k0 + 8 * c) = o; }
    LDS_WAIT(); asm volatile("" ::: "memory");
}

__device__ __forceinline__ void tr_item8(const float* src, int srcN, int k0, int n0, unsigned char* dst, int drow0, int dK, const float* kscale, float scale, LAS float* scr, int lane) {
    float w[32];
    const float* sp = src + (size_t)(k0 + (lane >> 5)) * srcN + n0 + (lane & 31);
#pragma unroll
    for (int i = 0; i < 32; ++i) w[i] = __builtin_nontemporal_load(sp + (size_t)(2 * i) * srcN);
    float ksv = scale; if (kscale) ksv *= kscale[k0 + lane];
#pragma unroll
    for (int i = 0; i < 32; ++i) { const float a = __int_as_float(__builtin_amdgcn_readlane(__float_as_int(ksv), 2 * i)), b = __int_as_float(__builtin_amdgcn_readlane(__float_as_int(ksv), 2 * i + 1)); w[i] *= (lane >> 5) ? b : a; }
#pragma unroll
    for (int i = 0; i < 32; ++i) scr[(2 * i + (lane >> 5)) * 33 + (lane & 31)] = w[i];
    LDS_WAIT(); asm volatile("" ::: "memory");
#pragma unroll
    for (int j = 0; j < 2; ++j) { const int idx = lane + 64 * j, n = idx >> 2, c = idx & 3; const LAS float* sc_ = scr + (16 * c) * 33 + n;
        float f[16];
#pragma unroll
        for (int i = 0; i < 16; ++i) f[i] = sc_[i * 33];
        const u32x2 lo = pack8_fp8(f), hi = pack8_fp8(f + 8);
        u32x4 o; o.x = lo.x; o.y = lo.y; o.z = hi.x; o.w = hi.y;
        *(GAS u32x4*)(dst + (size_t)(drow0 + n) * dK + k0 + 16 * c) = o; }
    LDS_WAIT(); asm volatile("" ::: "memory");
}

struct Ptrs {
    const float *x, *attn_g, *w_in, *sbq_g, *sbk_g, *sbo_g, *w2, *gate_b, *glan_g, *w_out, *ffn_g, *rg_w, *rg_b, *re_w, *re_b, *wg, *wu, *wd;
    float* out; unsigned char* ws;
};

constexpr int SB_SPAN = 14, SB_VOFF = SB_SPAN * 4096;
__device__ __forceinline__ int sb_keyK(int r) { return ((r >> 1) & 3) | (((r >> 4) & 1) << 2); }
__device__ __forceinline__ int sb_keyV(int r) { return ((r >> 2) & 1) | (((r >> 4) & 1) << 1); }
__device__ __forceinline__ void sb_round(LAS unsigned char* lds, const bf16* SQ, const bf16* SK, const bf16* TT, const float* gout, bf16* MIX, int b, int h, int qg, int tid, int wave, int lane) {
    const int il = lane & 31, hi = lane >> 5, pil = PI32(il);
    const int qt = 8 * qg + wave;
    const size_t row0 = (size_t)b * SEQ + (size_t)qt * 32;
    bf16x8 qf[4];
    { const bf16* qp = SQ + (row0 + il) * 512 + h * 64 + 32 * hi;
#pragma unroll
      for (int s = 0; s < 4; ++s) qf[s] = *(const bf16x8*)(qp + 8 * s); }
    const int lo = (8 * qg - 6) > 0 ? (8 * qg - 6) : 0, nblk = 8 * qg + 8 - lo;
    {
        u32x4 st[SB_SPAN];
        const bool isK = tid < 256; const int q = tid - 256;
        const bf16* src = isK ? SK + ((size_t)b * SEQ + (size_t)lo * 32 + (tid >> 3)) * 512 + h * 64 + 8 * (tid & 7)
                              : TT + ((size_t)(b * (SEQ / 32) + lo) * NB + h * 64 + (q >> 2)) * 32 + 8 * (q & 3);
        const size_t bstep = isK ? (size_t)32 * 512 : (size_t)NB * 32;
#pragma unroll
        for (int i = 0; i < SB_SPAN; ++i) if (i < nblk) st[i] = *(const u32x4*)(src + (size_t)i * bstep);
        const int r = isK ? (tid >> 3) : (q >> 2);
        const unsigned dst = isK ? (unsigned)(r * 128 + (((tid & 7) ^ sb_keyK(r)) << 4)) : (unsigned)(SB_VOFF + r * 64 + (((q & 3) ^ sb_keyV(r & 31)) << 4));
#pragma unroll
        for (int i = 0; i < SB_SPAN; ++i) if (i < nblk) *(LAS u32x4*)(lds + dst + i * 4096) = st[i];
    }
    __syncthreads();
    f32x16 o0, o1;
#pragma unroll
    for (int r = 0; r < 16; ++r) { o0[r] = 0.f; o1[r] = 0.f; }
    float R = 1.f;
#define SB_MATH(KC, VC, kb_) do { \
        f32x16 z; \
        _Pragma("unroll") for (int r = 0; r < 16; ++r) z[r] = 0.f; \
        _Pragma("unroll") for (int s = 0; s < 4; ++s) z = MFMA32(KC[s], qf[s], z); \
        float beta[16], omb[16]; \
        const bool diag = ((kb_) == qt); \
        _Pragma("unroll") for (int r = 0; r < 16; ++r) { \
            const float zz = z[r]; const float t = __builtin_amdgcn_exp2f(-__builtin_fabsf(zz)); const float rr = __builtin_amdgcn_rcpf(1.f + t); const float sm = t * rr; \
            const bool pos = zz >= 0.f; float be = pos ? rr : sm; float om = pos ? sm : rr; \
            if (diag) { const bool valid = (16 * hi + r) < il; be = valid ? be : 0.f; om = valid ? om : 1.f; } \
            beta[r] = be; omb[r] = om; } \
        float e[16]; e[15] = 1.f; \
        _Pragma("unroll") for (int r = 14; r >= 0; --r) e[r] = e[r + 1] * omb[r + 1]; \
        const float P16 = e[0] * omb[0]; \
        float Plo, Phi; swap32(P16, Plo, Phi); \
        const float base = R * (hi ? 1.f : Phi); \
        float a[16]; \
        _Pragma("unroll") for (int r = 0; r < 16; ++r) a[r] = beta[r] * e[r] * base; \
        R = R * (Plo * Phi); \
        const bf16x8 p0 = pack8(a), p1 = pack8(a + 8); \
        o0 = MFMA32(VC[0][0], p0, o0); o0 = MFMA32(VC[0][1], p1, o0); \
        o1 = MFMA32(VC[1][0], p0, o1); o1 = MFMA32(VC[1][1], p1, o1); } while (0)
    bool fin = false;
    {
        const unsigned kbase = (unsigned)(pil * 128), vbase = (unsigned)(SB_VOFF + pil * 64);
        unsigned kx[4], vx[2];
#pragma unroll
        for (int s = 0; s < 4; ++s) kx[s] = (unsigned)(((4 * hi + s) ^ sb_keyK(pil)) << 4);
#pragma unroll
        for (int s = 0; s < 2; ++s) vx[s] = (unsigned)(((2 * hi + s) ^ sb_keyV(pil)) << 4);
        for (int kb = qt; ; --kb) {
            const unsigned so = (unsigned)(kb - lo) * 4096u;
            bf16x8 kf[4], vf[2][2];
#pragma unroll
            for (int s = 0; s < 4; ++s) kf[s] = *(const LAS bf16x8*)(lds + so + kbase + kx[s]);
#pragma unroll
            for (int dt = 0; dt < 2; ++dt)
#pragma unroll
                for (int s = 0; s < 2; ++s) vf[dt][s] = *(const LAS bf16x8*)(lds + so + vbase + dt * 2048 + vx[s]);
            SB_MATH(kf, vf, kb);
            if (kb == 0 || __all(R == 0.f)) { fin = true; break; }
            if (kb == lo) break;
        }
    }
    if (!fin) {
        for (int kb = lo - 1; ; --kb) {
            bf16x8 kf[4], vf[2][2];
            const bf16* kp = SK + ((size_t)b * SEQ + (size_t)kb * 32 + pil) * 512 + h * 64 + 32 * hi;
#pragma unroll
            for (int s = 0; s < 4; ++s) kf[s] = *(const bf16x8*)(kp + 8 * s);
            const bf16* vp = TT + ((size_t)(b * (SEQ / 32) + kb) * NB + h * 64 + pil) * 32 + 16 * hi;
#pragma unroll
            for (int dt = 0; dt < 2; ++dt)
#pragma unroll
                for (int s = 0; s < 2; ++s) vf[dt][s] = *(const bf16x8*)(vp + dt * 32 * 32 + 8 * s);
            SB_MATH(kf, vf, kb);
            if (kb == 0 || __all(R == 0.f)) break;
        }
    }
#undef SB_MATH
    float ss = 0.f;
#pragma unroll
    for (int r = 0; r < 16; ++r) ss += o0[r] * o0[r] + o1[r] * o1[r];
    float slo, shi; swap32(ss, slo, shi);
    const float rstd = __builtin_amdgcn_rsqf((slo + shi) * (1.f / 64.f) + EPS);
    bf16* op = MIX + (row0 + il) * DM + h * 64 + 16 * hi;
#pragma unroll
    for (int dt = 0; dt < 2; ++dt) {
        float v[16];
#pragma unroll
        for (int r4 = 0; r4 < 4; ++r4) { const f32x4 g = *(const f32x4*)(gout + 32 * dt + 16 * hi + 4 * r4);
#pragma unroll
            for (int e2 = 0; e2 < 4; ++e2) v[4 * r4 + e2] = (dt ? o1[4 * r4 + e2] : o0[4 * r4 + e2]) * rstd * g[e2]; }
        *(bf16x8*)(op + 32 * dt) = pack8(v); *(bf16x8*)(op + 32 * dt + 8) = pack8(v + 8);
    }
    __syncthreads();
}

__device__ __forceinline__ void gla_a(const bf16* GLR, const bf16* W2T, const float* gate_b, const bf16* TT, bf16* KV, float* DTOT, int bh, int j, int lane) {
    const int il = lane & 31, hi = lane >> 5, pil = PI32(il);
    const int b = bh >> 2, h = bh & 3;
    const size_t t0 = (size_t)b * SEQ + (size_t)j * 64;
    bf16x8 gf[2], wf[2], gkf[2][2][2], bvf[4][4]; float bias[2];
#pragma unroll
    for (int ch = 0; ch < 2; ++ch) gf[ch] = *(const bf16x8*)(GLR + (t0 + 32 * ch + pil) * 16 + 8 * hi);
#pragma unroll
    for (int kh = 0; kh < 2; ++kh) { const int kcol = 64 * h + 32 * kh + pil; wf[kh] = *(const bf16x8*)(W2T + kcol * 16 + 8 * hi); bias[kh] = gate_b[kcol];
        const bf16* gkp = TT + ((t0 >> 5) * NB + 512 + kcol) * 32 + 16 * hi;
#pragma unroll
        for (int ch = 0; ch < 2; ++ch) { gkf[kh][ch][0] = *(const bf16x8*)(gkp + ch * NB * 32); gkf[kh][ch][1] = *(const bf16x8*)(gkp + ch * NB * 32 + 8); } }
#pragma unroll
    for (int vq = 0; vq < 4; ++vq) { const bf16* vp = TT + ((t0 >> 5) * NB + 768 + 128 * h + 32 * vq + il) * 32 + 16 * hi;
#pragma unroll
        for (int s = 0; s < 4; ++s) bvf[vq][s] = *(const bf16x8*)(vp + (s >> 1) * NB * 32 + 8 * (s & 1)); }
    bf16x8 akf[2][4];
#pragma unroll
    for (int kh = 0; kh < 2; ++kh) {
        const int kcol = 64 * h + 32 * kh + pil;
        float cs[2][16];
#pragma unroll
        for (int ch = 0; ch < 2; ++ch) {
            f32x16 g;
#pragma unroll
            for (int r = 0; r < 16; ++r) g[r] = 0.f;
            g = MFMA32(gf[ch], wf[kh], g);
            if (kh == 0 && ch == 0) asm volatile("" : "+v"(g) :: "memory");
            float run = 0.f;
#pragma unroll
            for (int r = 0; r < 16; ++r) { const float x = g[r] + bias[kh];
                const float ls2 = __builtin_fminf(x, 0.f) * LOG2E - __builtin_amdgcn_logf(1.f + __builtin_amdgcn_exp2f(-__builtin_fabsf(x) * LOG2E));
                run += ls2 * (1.f / 16.f); cs[ch][r] = run; }
        }
        float t0lo, t0hi, t1lo, t1hi; swap32(cs[0][15], t0lo, t0hi); swap32(cs[1][15], t1lo, t1hi);
        const float off0 = hi ? t0lo : 0.f, off1 = (t0lo + t0hi) + (hi ? t1lo : 0.f), total = (t0lo + t0hi) + (t1lo + t1hi);
        if (hi == 0) DTOT[((size_t)bh * 32 + j) * 64 + 32 * kh + pil] = __builtin_amdgcn_exp2f(total);
#pragma unroll
        for (int ch = 0; ch < 2; ++ch) {
            const bf16x8 k0 = gkf[kh][ch][0], k1 = gkf[kh][ch][1];
            float kd[16]; const float off = ch ? off1 : off0;
#pragma unroll
            for (int r = 0; r < 16; ++r) { const float dec = __builtin_amdgcn_exp2f(total - (cs[ch][r] + off)); kd[r] = bf2f(r < 8 ? k0[r] : k1[r - 8]) * dec; }
            akf[kh][2 * ch] = pack8(kd); akf[kh][2 * ch + 1] = pack8(kd + 8);
        }
    }
#pragma unroll
    for (int vq = 0; vq < 4; ++vq) {
#pragma unroll
        for (int kh = 0; kh < 2; ++kh) {
            f32x16 kv;
#pragma unroll
            for (int r = 0; r < 16; ++r) kv[r] = 0.f;
#pragma unroll
            for (int s = 0; s < 4; ++s) kv = MFMA32(akf[kh][s], bvf[vq][s], kv);
            bf16* dst = KV + (((size_t)bh * 32 + j) * 128 + 32 * vq + il) * 64 + 32 * kh + 16 * hi;
            float kvf[16];
#pragma unroll
            for (int r = 0; r < 16; ++r) kvf[r] = kv[r];
            *(bf16x8*)dst = pack8(kvf); *(bf16x8*)(dst + 8) = pack8(kvf + 8);
        }
    }
}
__device__ __forceinline__ void gla_b(const bf16* KV, const float* DTOT, bf16* ST, int task, int lane) {
    const int bh = task >> 5, part = task & 31; const int e0 = part * 256 + lane * 4; const int k = e0 & 63;
    f32x4 S = (f32x4){0.f, 0.f, 0.f, 0.f};
#pragma unroll
    for (int half = 0; half < 2; ++half) {
        u32x2 kvp[16]; f32x4 d[16];
#pragma unroll
        for (int q = 0; q < 16; ++q) { const int j = 16 * half + q;
            kvp[q] = *(const u32x2*)(KV + ((size_t)bh * 32 + j) * 8192 + e0); d[q] = *(const f32x4*)(DTOT + ((size_t)bh * 32 + j) * 64 + k); }
#pragma unroll
        for (int q = 0; q < 16; ++q) { const int j = 16 * half + q;
            const f32x4 kv = (f32x4){__uint_as_float(kvp[q].x << 16), __uint_as_float(kvp[q].x & 0xffff0000u), __uint_as_float(kvp[q].y << 16), __uint_as_float(kvp[q].y & 0xffff0000u)};
            S = d[q] * S + kv;
            u32x2 w; w.x = cvtpk(S[0], S[1]); w.y = cvtpk(S[2], S[3]);
            *(u32x2*)(ST + ((size_t)bh * 32 + j) * 8192 + e0) = w; }
        asm volatile("" ::: "memory");
    }
}
__device__ __forceinline__ void gla_c(LAS unsigned char* wl, const bf16* ST, const bf16* GQ, const bf16* GRS, const float* gn, bf16* MIX, int bh, int j, int lane) {
    const int il = lane & 31, hi = lane >> 5, pil = PI32(il);
    const int b = bh >> 2, h = bh & 3;
    const size_t t0 = (size_t)b * SEQ + (size_t)j * 64;
    const bf16* sp = ST + ((size_t)bh * 32 + j) * 8192 + lane * 8;
    u32x4 st[16];
#pragma unroll
    for (int i = 0; i < 16; ++i) st[i] = *(const u32x4*)(sp + i * 512);
    bf16x8 bq[2][4], gr[2][4][2];
#pragma unroll
    for (int ch = 0; ch < 2; ++ch) { const size_t row = t0 + 32 * ch + il;
#pragma unroll
        for (int s = 0; s < 4; ++s) bq[ch][s] = *(const bf16x8*)(GQ + row * 256 + 64 * h + 16 * s + 8 * hi); }
    { const size_t row = t0 + il;
#pragma unroll
      for (int vt = 0; vt < 4; ++vt) { gr[0][vt][0] = *(const bf16x8*)(GRS + row * 512 + 128 * h + 32 * vt + 16 * hi); gr[0][vt][1] = *(const bf16x8*)(GRS + row * 512 + 128 * h + 32 * vt + 16 * hi + 8); } }
    { const int vr = lane >> 3, c = lane & 7;
#pragma unroll
      for (int i = 0; i < 16; ++i) { const int v = 8 * i + vr; *(LAS u32x4*)(wl + v * 128 + ((c ^ sb_keyK(v & 31)) << 4)) = st[i]; } }
    LDS_WAIT(); asm volatile("" ::: "memory");
    unsigned ax[4];
#pragma unroll
    for (int s = 0; s < 4; ++s) ax[s] = (unsigned)(pil * 128 + (((2 * s + hi) ^ sb_keyK(pil)) << 4));
#pragma unroll
    for (int ch = 0; ch < 2; ++ch) {
        const size_t row = t0 + 32 * ch + il;
        f32x16 O[4]; float ss = 0.f;
#pragma unroll
        for (int vt = 0; vt < 4; ++vt) {
#pragma unroll
            for (int r = 0; r < 16; ++r) O[vt][r] = 0.f;
#pragma unroll
            for (int s = 0; s < 4; ++s) { const bf16x8 af = *(const LAS bf16x8*)(wl + vt * 4096 + ax[s]); O[vt] = MFMA32(af, bq[ch][s], O[vt]); }
            if (ch == 0 && vt == 0) {
                const size_t row1 = t0 + 32 + il;
#pragma unroll
                for (int v2 = 0; v2 < 4; ++v2) { gr[1][v2][0] = *(const bf16x8*)(GRS + row1 * 512 + 128 * h + 32 * v2 + 16 * hi); gr[1][v2][1] = *(const bf16x8*)(GRS + row1 * 512 + 128 * h + 32 * v2 + 16 * hi + 8); }
                asm volatile("" : "+v"(O[0]) :: "memory"); }
#pragma unroll
            for (int r = 0; r < 16; ++r) ss += O[vt][r] * O[vt][r];
        }
        float slo, shi; swap32(ss, slo, shi);
        const float rstd = __builtin_amdgcn_rsqf((slo + shi) * (1.f / 128.f) + EPS);
#pragma unroll
        for (int vt = 0; vt < 4; ++vt) {
            const int vc0 = 32 * vt + 16 * hi;
            float v[16];
#pragma unroll
            for (int r4 = 0; r4 < 4; ++r4) { const f32x4 g = *(const f32x4*)(gn + vc0 + 4 * r4);
#pragma unroll
                for (int e2 = 0; e2 < 4; ++e2) { const int r = 4 * r4 + e2; v[r] = O[vt][r] * rstd * g[e2] * bf2f(r < 8 ? gr[ch][vt][0][r] : gr[ch][vt][1][r - 8]); } }
            bf16* op = MIX + row * DM + 512 + 128 * h + vc0;
            *(bf16x8*)(op) = pack8(v); *(bf16x8*)(op + 8) = pack8(v + 8);
        }
    }
    LDS_WAIT(); asm volatile("" ::: "memory");
}

constexpr int NWAVES = 8;
constexpr int N_PHASES = 10;
struct Args { Ptrs p; int ph_lo, ph_hi; };

__global__ void __launch_bounds__(NWAVES * 64, 2) fwd_kernel(Args args) {
    extern __shared__ __attribute__((aligned(16))) unsigned char lds_raw[];
    LAS unsigned char* lds = (LAS unsigned char*)lds_raw;
    const Ptrs& P = args.p;
    const int tid = threadIdx.x, lane = tid & 63, wave = __builtin_amdgcn_readfirstlane(tid >> 6);
    const int G = gridDim.x; const int bx = blockIdx.x; const int vcu = (G % 8 == 0) ? (bx % 8) * (G / 8) + bx / 8 : bx;
    const int gw = vcu * NWAVES + wave, NGW = G * NWAVES;
    unsigned char* ws = P.ws;
    gu32* ctl = (gu32*)(ws + WS_CTL);
    volatile LAS unsigned* MISC = (volatile LAS unsigned*)(lds + MISC_OFF);
    LAS int* tab = (LAS int*)(lds + TAB_OFF);
    for (int u = tid; u < (LDS_BYTES - LDSCTL_OFF) / 4; u += NWAVES * 64) ((LAS unsigned*)(lds + LDSCTL_OFF))[u] = 0u;
    __syncthreads();
    XcdBarrier bar; bar.bar = (unsigned*)(ctl + CW_BAR); bar.x = 0; bar.st = nullptr;
    if (MK_N_LAUNCHES == 1) bar = xcd_barrier_post((unsigned*)(ctl + CW_BAR), MISC + 8);
#define GRID_BAR() do { if (MK_N_LAUNCHES == 1) xcd_barrier(bar); } while (0)
    const int lo = args.ph_lo, hi_ph = args.ph_hi;
#ifndef PHASE_MASK
#define PHASE_MASK 0x3ff
#endif
#define IN(k) (((PHASE_MASK >> (k)) & 1) && lo <= (k) && (k) < hi_ph)
#define BOTH(k) (IN(k) && IN((k) + 1))
#ifndef PROBE_TWICE
#define PROBE_TWICE -1
#endif
#define REP(k) for (int rep_ = 0; rep_ < ((PROBE_TWICE == (k)) ? 2 : 1); ++rep_)
#define REPBAR(k) do { if (PROBE_TWICE == (k) && rep_ == 0) GRID_BAR(); } while (0)

    bf16* WA = (bf16*)(ws + WS_WA); bf16* WB = (bf16*)(ws + WS_WB); bf16* WO = (bf16*)(ws + WS_WO);
    bf16* WRH = (bf16*)(ws + WS_WR); bf16* WRL = WRH + 48 * 1024; bf16* W2T = (bf16*)(ws + WS_W2T);
    bf16* WGU = (bf16*)(ws + WS_WGU); bf16* WD = (bf16*)(ws + WS_WD);
    bf16* H = (bf16*)(ws + WS_H); bf16* KV = (bf16*)(ws + WS_KV);
    bf16* XB = (bf16*)(ws + WS_XB); bf16* MIX = (bf16*)(ws + WS_MIX); float* RSTD1 = (float*)(ws + WS_RSTD1);
    bf16* SQ = (bf16*)(ws + WS_SQ); bf16* SK = (bf16*)(ws + WS_SK); bf16* GQ = (bf16*)(ws + WS_GQ); bf16* GRS = (bf16*)(ws + WS_GRS);
    bf16* TT = (bf16*)(ws + WS_TT); bf16* GLR = (bf16*)(ws + WS_GLR); bf16* ST = (bf16*)(ws + WS_ST); float* DTOT = (float*)(ws + WS_DTOT);
    unsigned char* ACT = ws + WS_ACT; unsigned char* Y = ws + WS_Y;
    unsigned char* WGU8 = ws + WS_WGU; unsigned char* WD8 = ws + WS_WD; unsigned char* H8 = ws + WS_H8;
    unsigned* LOCL = (unsigned*)(ws + WS_LOCL); unsigned* CNTS = (unsigned*)(ws + WS_CNTS); float* GATE = (float*)(ws + WS_GATE); float* RSTD = (float*)(ws + WS_RSTD);

    if (IN(0)) { REP(0) {
        LAS float* scr = (LAS float*)(lds + RING_OFF + wave * 16384);
        constexpr int I_A = (NA / 32) * 16, I_B = (NB / 32) * 16, I_O = 32 * 16, I_GU = 32 * 32 * 16, I_D = 32 * 32 * 8;
        constexpr int NITEMS = I_A + I_B + I_O + I_GU;
        for (int it = gw; it < NITEMS; it += NGW) {
            int r = it;
            if (r < I_A) { const int ib = r >> 4, kb = r & 15, P0 = 32 * ib; const int pn = P0 >> 8, bj = (P0 >> 7) & 1, wcc = (P0 >> 5) & 3; const int LA = 256 * pn + 64 * wcc + 32 * bj;
                const int sc = LA < 1024 ? LA : (LA < 1280 ? 1536 + (LA - 1024) : 2560 + (LA - 1280));
                tr_item(P.w_in, IN_DIM, 64 * kb, sc, WA, P0, DM, P.attn_g, scr, lane); continue; } r -= I_A;
            if (r < I_B) { const int ib = r >> 4, kb = r & 15, P0 = 32 * ib; const int sc = P0 < 512 ? 1024 + P0 : (P0 < 768 ? 1792 + (P0 - 512) : 2048 + (P0 - 768));
                tr_item(P.w_in, IN_DIM, 64 * kb, sc, WB, P0, DM, P.attn_g, scr, lane); continue; } r -= I_B;
            if (r < I_O) { const int ib = r >> 4, kb = r & 15; tr_item(P.w_out, DM, 64 * kb, 32 * ib, WO, 32 * ib, DM, nullptr, scr, lane); continue; } r -= I_O;
            if (r < I_GU) { const int e = r >> 9, q = r & 511, ib = 4 * (q >> 6) + (q & 3), kb = 2 * ((q >> 3) & 7) + ((q >> 2) & 1), P0 = 32 * ib; const int pn = P0 >> 8, bj = (P0 >> 7) & 1, r0 = P0 & 127;
                const float* src = (bj ? P.wu : P.wg) + (size_t)e * DM * DEXP;
                tr_item8(src, DEXP, 64 * kb, 128 * pn + r0, WGU8 + (size_t)e * DM * DM, P0, DM, P.ffn_g, WGU_SC, scr, lane); continue; }
        }
        (void)I_D;
        for (int idx = gw * 64 + lane; idx < 48 * 1024; idx += NGW * 64) {
            const int rho = idx >> 10, k = idx & 1023, m = rho >> 4, i = rho & 15;
            float v = (m < 2) ? P.re_w[k * 32 + 8 * (i >> 2) + 4 * m + (i & 3)] : P.rg_w[k * 4 + (i & 3)];
            v *= P.ffn_g[k];
            WRH[idx] = __builtin_bit_cast(unsigned short, (_Float16)v);
        }
        for (int idx = gw * 64 + lane; idx < 256 * 16; idx += NGW * 64) { const int kc = idx >> 4, r = idx & 15; W2T[idx] = (bf16)(cvtpk(P.w2[r * 256 + kc], 0.f) & 0xffffu); }
        __syncthreads();
        constexpr int WLP = 1032;
        LAS bf16* wl = (LAS bf16*)(lds + RING_OFF);
        for (int idx = tid; idx < 16 * 1024; idx += NWAVES * 64) { const int c = idx & 15, k = idx >> 4; wl[c * WLP + k] = (bf16)(cvtpk(P.attn_g[k] * P.w_in[(size_t)k * IN_DIM + 3072 + c], 0.f) & 0xffffu); }
        __syncthreads();
        {
            for (int task = gw; task < NTOK / 16; task += NGW) {
                const size_t row0 = (size_t)task * 16;
                f32x4 cur[4], nxt[4]; float rsv = 0.f;
#pragma unroll
                for (int j = 0; j < 4; ++j) { cur[j] = __builtin_nontemporal_load((const GAS f32x4*)(P.x + row0 * DM) + lane + 64 * j); nxt[j] = cur[j]; }
#pragma unroll 2
                for (int r = 0; r < 16; ++r) {
                    if (r < 15) {
#pragma unroll
                        for (int j = 0; j < 4; ++j) nxt[j] = __builtin_nontemporal_load((const GAS f32x4*)(P.x + (row0 + r + 1) * DM) + lane + 64 * j); }
                    float s2 = 0.f;
#pragma unroll
                    for (int j = 0; j < 4; ++j) s2 += (cur[j].x * cur[j].x + cur[j].y * cur[j].y) + (cur[j].z * cur[j].z + cur[j].w * cur[j].w);
                    const float rstd = __builtin_amdgcn_rsqf(wave_sum(s2) * (1.f / DM) + EPS);
                    if ((lane & 15) == r) rsv = rstd;
                    GAS unsigned long long* o8 = (GAS unsigned long long*)(XB + (row0 + r) * DM) + lane;
#pragma unroll
                    for (int j = 0; j < 4; ++j) { const f32x4 v = cur[j];
                        o8[64 * j] = (unsigned long long)cvtpk(v.x, v.y) | ((unsigned long long)cvtpk(v.z, v.w) << 32); }
#pragma unroll
                    for (int j = 0; j < 4; ++j) cur[j] = nxt[j];
                }
                if (lane < 16) RSTD1[row0 + lane] = rsv;
                VM_WAIT();
                const int fr = lane & 15, fq = lane >> 4;
                f32x4 acc = (f32x4){0.f, 0.f, 0.f, 0.f};
                const bf16* up = XB + (row0 + fr) * DM + 8 * fq;
#pragma unroll 8
                for (int ks = 0; ks < 32; ++ks) { const bf16x8 ub = *(const bf16x8*)(up + 32 * ks); const bf16x8 wb = *(const LAS bf16x8*)(wl + fr * WLP + 32 * ks + 8 * fq); acc = MFMA16(wb, ub, acc); }
                u32x2 o; o.x = cvtpk(acc[0] * rsv, acc[1] * rsv); o.y = cvtpk(acc[2] * rsv, acc[3] * rsv);
                *(u32x2*)(GLR + (row0 + fr) * 16 + 4 * fq) = o;
            }
        }
        __syncthreads();
        REPBAR(0); }
        if (BOTH(0)) GRID_BAR();
    }

#define PH1_BODY() do { \
        { pg8::SchedDense S; S.init(XB, WA, NTOK, NA, DM, G, bx); \
          pg8::EpiA E{SQ, SK, GQ, GRS, P.sbq_g, P.sbk_g, RSTD1}; \
          pg8::gemm_phase<pg8::EpiA, pg8::SchedDense>(lds + RING_OFF, DM, S, E); } \
        { pg8::SchedDense S; S.init(WB, XB, NB, NTOK, DM, G, (bx + G / 2) % G); \
          pg8::EpiTT E{TT, RSTD1}; \
          pg8::gemm_phase<pg8::EpiTT, pg8::SchedDense>(lds + RING_OFF, DM, S, E); } } while (0)
    if (IN(1)) {
        if (PROBE_TWICE == 1) { PH1_BODY(); GRID_BAR(); }
        PH1_BODY();
        if (BOTH(1)) GRID_BAR();
    }

#define SB_ROUND(rho_) do { for (int u__ = (rho_) * G + vcu; u__ < 1024; u__ += 4 * G) { const int bh_ = u__ & 127; \
        sb_round(lds + RING_OFF, SQ, SK, TT, P.sbo_g + (bh_ & 7) * 64, MIX, bh_ >> 3, bh_ & 7, u__ >> 7, tid, wave, lane); } } while (0)
#define REPX(code) for (int rx_ = 0; rx_ < ((PROBE_TWICE == (code)) ? 5 : 1); ++rx_)
#define BAR_ARRIVE() do { if (MK_N_LAUNCHES == 1) xcd_barrier_arrive(bar, MISC + 12); } while (0)
#define BAR_WAIT() do { if (MK_N_LAUNCHES == 1) xcd_barrier_wait(bar, MISC + 12); } while (0)
    if (IN(2)) {
        for (int t = gw; t < 2048; t += NGW) gla_a(GLR, W2T, P.gate_b, TT, KV, DTOT, t >> 5, t & 31, lane);
        if (BOTH(2)) BAR_ARRIVE();
        SB_ROUND(0);
        if (BOTH(2)) BAR_WAIT();
    }
    if (IN(3)) {
        for (int t = gw; t < 2048; t += NGW) gla_b(KV, DTOT, ST, t, lane);
        if (BOTH(3)) BAR_ARRIVE();
        SB_ROUND(1);
        if (BOTH(3)) BAR_WAIT();
    }
    if (IN(4)) {
        for (int t = gw; t < 2048; t += NGW) gla_c(lds + RING_OFF + wave * 16384, ST, GQ, GRS, P.glan_g, MIX, t >> 5, t & 31, lane);
        __syncthreads();
        SB_ROUND(2); SB_ROUND(3);
        if (BOTH(4)) GRID_BAR();
    }

#define PH5_BODY() do { \
        pg8::SchedDense S; S.init(MIX, WO, NTOK, DM, DM, G, bx); \
        pg8::EpiH E{XB, H, H8}; \
        pg8::gemm_phase<pg8::EpiH, pg8::SchedDense>(lds + RING_OFF, DM, S, E); } while (0)
    if (IN(5)) {
        if (PROBE_TWICE == 5) { PH5_BODY(); GRID_BAR(); }
        PH5_BODY();
        if (BOTH(5)) GRID_BAR();
    }

    if (IN(6)) { REP(6) {
        constexpr int WP = 1032;
        LAS unsigned short* wl16 = (LAS unsigned short*)(lds + RING_OFF);
        LAS unsigned* lcount = (LAS unsigned*)(lds + RING_OFF + 48 * WP * 2);
        for (int idx = tid; idx < 48 * 128; idx += NWAVES * 64) { const int row = idx >> 7, c = idx & 127; *(LAS u32x4*)(wl16 + row * WP + 8 * c) = *(const u32x4*)(WRH + row * 1024 + 8 * c); }
        const int fr = lane & 15, fq = lane >> 4;
        for (int it = 0; it * G < NGRP; ++it) {
            const int grp = it * G + vcu;
            const int tile = grp * 8 + wave; const int ntile = NGRP * 8;
            if (tid < 32) lcount[tid] = 0u;
            __syncthreads();
            bool owner = false; int e1 = 0, e2 = 0; unsigned lr1 = 0, lr2 = 0; int tok = 0;
            if (tile < ntile) {
                tok = tile * 16 + fr;
                const bf16* hp = H + (size_t)tok * DM + 8 * fq;
                f32x4 acc[3]; acc[0] = acc[1] = acc[2] = (f32x4){0.f, 0.f, 0.f, 0.f};
                float ssq = 0.f;
#pragma unroll 1
                for (int half = 0; half < 2; ++half) {
                    bf16x8 hb[16];
#pragma unroll
                    for (int q = 0; q < 16; ++q) hb[q] = *(const bf16x8*)(hp + 32 * (16 * half + q));
#pragma unroll
                    for (int q = 0; q < 16; ++q) { const int ks = 16 * half + q;
                        float f[8];
#pragma unroll
                        for (int e = 0; e < 8; ++e) { f[e] = bf2f(hb[q][e]); ssq += f[e] * f[e]; }
                        f16x8 hh;
#pragma unroll
                        for (int e = 0; e < 8; ++e) hh[e] = (_Float16)f[e];
#pragma unroll
                        for (int m = 0; m < 3; ++m) { const f16x8 wv = *(const LAS f16x8*)(wl16 + (16 * m + fr) * WP + 32 * ks + 8 * fq);
                            acc[m] = __builtin_amdgcn_mfma_f32_16x16x32_f16(wv, hh, acc[m], 0, 0, 0); }
                    }
                }
                ssq += __shfl_xor(ssq, 16); ssq += __shfl_xor(ssq, 32);
                const float rstd = __builtin_amdgcn_rsqf(ssq * (1.f / DM) + EPS);
                float gl[4];
#pragma unroll
                for (int r = 0; r < 4; ++r) gl[r] = acc[2][r] * rstd + P.rg_b[r];
                int gsel = 0; float gmax = gl[0];
#pragma unroll
                for (int r = 1; r < 4; ++r) if (gl[r] > gmax) { gmax = gl[r]; gsel = r; }
                float gden = 0.f;
#pragma unroll
                for (int r = 0; r < 4; ++r) gden += __builtin_amdgcn_exp2f((gl[r] - gmax) * LOG2E);
                const float pgrp = 1.f / gden;
                float el[8];
#pragma unroll
                for (int r = 0; r < 4; ++r) { el[r] = acc[0][r] * rstd + P.re_b[8 * fq + r]; el[4 + r] = acc[1][r] * rstd + P.re_b[8 * fq + 4 + r]; }
                int i1 = 0; float l1 = el[0];
#pragma unroll
                for (int r = 1; r < 8; ++r) if (el[r] > l1) { l1 = el[r]; i1 = r; }
                int i2 = -1; float l2 = -3.0e38f;
#pragma unroll
                for (int r = 0; r < 8; ++r) if (r != i1 && el[r] > l2) { l2 = el[r]; i2 = r; }
                const float ex = __builtin_amdgcn_exp2f((l2 - l1) * LOG2E);
                const float p1 = 1.f / (1.f + ex), p2 = ex * p1;
                owner = (fq == gsel);
                if (owner) {
                    e1 = 8 * gsel + i1; e2 = 8 * gsel + i2;
                    lr1 = __hip_atomic_fetch_add(lcount + e1, 1u, __ATOMIC_RELAXED, __HIP_MEMORY_SCOPE_WORKGROUP);
                    lr2 = __hip_atomic_fetch_add(lcount + e2, 1u, __ATOMIC_RELAXED, __HIP_MEMORY_SCOPE_WORKGROUP);
                    RSTD[tok] = rstd; GATE[2 * tok] = pgrp * p1; GATE[2 * tok + 1] = pgrp * p2;
                }
            }
            __syncthreads();
            if (grp < NGRP) {
                if (tid < 32) CNTS[grp * 32 + tid] = lcount[tid];
                if (owner) { LOCL[((size_t)grp * 32 + e1) * 128 + lr1] = 2u * tok; LOCL[((size_t)grp * 32 + e2) * 128 + lr2] = 2u * tok + 1u; }
            }
            __syncthreads();
        }
        REPBAR(6); }
        if (BOTH(6)) GRID_BAR();
    }

    if (IN(7) || IN(8)) {
        LAS int* pre = (LAS int*)(lds + RING_OFF);
        LAS int* segsum = pre + NGRP * 32;
        for (int i = tid; i < NGRP * 32; i += NWAVES * 64) pre[i] = (int)CNTS[i];
        __syncthreads();
        { const int e = tid & 31, seg = tid >> 5; int run = 0;
          for (int g = seg * 16; g < seg * 16 + 16; ++g) { const int c = pre[g * 32 + e]; pre[g * 32 + e] = run; run += c; }
          segsum[seg * 32 + e] = run; }
        __syncthreads();
        { const int e = tid & 31, seg = tid >> 5; int off = 0, tot = 0;
          for (int q = 0; q < 16; ++q) { const int v = segsum[q * 32 + e]; if (q < seg) off += v; tot += v; }
          for (int g = seg * 16; g < seg * 16 + 16; ++g) pre[g * 32 + e] += off;
          if (seg == 0) tab[T_CNT / 4 + e] = tot; }
        __syncthreads();
        if (tid == 0) { int tb = 0; for (int e = 0; e < 32; ++e) { tab[T_TBASE / 4 + e] = tb; tb += (tab[T_CNT / 4 + e] + 255) >> 8; } tab[T_TBASE / 4 + 32] = tb; tab[T_NT / 4] = tb; }
        __syncthreads();
        { const int NT = tab[T_NT / 4];
          for (int t = tid; t < NT; t += NWAVES * 64) { int e = 0; for (int q = 0; q < 32; ++q) if (tab[T_TBASE / 4 + q] <= t && t < tab[T_TBASE / 4 + q + 1]) e = q; tab[T_TILE_E / 4 + t] = e; } }
        __syncthreads();
        { pg8::SchedMoE<false> S0; S0.A = nullptr; S0.Bt = nullptr; S0.K = 0; S0.bstride = 0; S0.G = G; S0.c = vcu; S0.tab = tab;
          const int half = tid >> 8, r = tid & 255; unsigned vals[NU_MAX / 2]; bool ok[NU_MAX / 2];
#pragma unroll
          for (int k = 0; k < NU_MAX / 2; ++k) { const int ui = 2 * k + half; pg8::Unit u; ok[k] = S0.next(ui, u); vals[k] = 0u;
              if (ok[k]) { const int cnt = tab[T_CNT / 4 + u.e], e = u.e; int p = u.rt * 256 + r; if (p > cnt - 1) p = cnt - 1;
                  int lo_ = 0, hi_ = NGRP - 1;
                  while (lo_ < hi_) { const int mid = (lo_ + hi_ + 1) >> 1; if (pre[mid * 32 + e] <= p) lo_ = mid; else hi_ = mid - 1; }
                  vals[k] = LOCL[((size_t)lo_ * 32 + e) * 128 + (p - pre[lo_ * 32 + e])]; } }
#pragma unroll
          for (int k = 0; k < NU_MAX / 2; ++k) if (ok[k]) tab[T_ROWTAB / 4 + (2 * k + half) * 256 + r] = (int)vals[k];
        }
        __syncthreads();
    }
#define PH7_BODY() do { \
        pg8::SchedMoE<true> S; S.A = (const char*)H8; S.Bt = (const char*)WGU8; S.K = DM / 2; S.bstride = (size_t)DM * DM; S.G = G; S.c = vcu; S.tab = tab; \
        pg8::EpiGU E{ACT, RSTD, tab}; \
        pg8::gemm_phase<pg8::EpiGU, pg8::SchedMoE<true>, false, true>(lds + RING_OFF, DM / 2, S, E); } while (0)
    if (IN(7)) {
        if (PROBE_TWICE == 7) { PH7_BODY(); GRID_BAR(); }
        PH7_BODY();
        {
            const int NT4 = tab[T_NT / 4] * 4, remu = NT4 % G;
            const bool early = (remu == 0) || (vcu >= remu); const int nE = (remu == 0) ? G : (G - remu), rank = (remu == 0) ? vcu : (vcu - remu);
            if (early) { LAS float* scr = (LAS float*)(lds + RING_OFF + wave * 16384);
                for (int r = rank * NWAVES + wave; r < 32 * 32 * 8; r += nE * NWAVES) {
                    const int e = r >> 8, q = r & 255, nb = 4 * (q >> 5) + (q & 3), kb = 2 * ((q >> 3) & 3) + ((q >> 2) & 1);
                    tr_item8(P.wd + (size_t)e * DEXP * DM, DM, 64 * kb, 32 * nb, WD8 + (size_t)e * DM * DEXP, 32 * nb, DEXP, nullptr, WD_SC, scr, lane); } }
        }
        if (BOTH(7)) GRID_BAR();
    }
    if (IN(8)) { REP(8) {
        pg8::SchedMoE<false> S; S.A = (const char*)ACT; S.Bt = (const char*)WD8; S.K = DEXP / 2; S.bstride = (size_t)DM * DEXP; S.G = G; S.c = vcu; S.tab = tab;
        pg8::EpiDown E{Y, tab};
        pg8::gemm_phase<pg8::EpiDown, pg8::SchedMoE<false>, false, true>(lds + RING_OFF, DEXP / 2, S, E);
        REPBAR(8); }
        if (BOTH(8)) GRID_BAR();
    }
    if (IN(9)) { REP(9) {
        for (int m0 = gw; m0 < NTOK; m0 += 2 * NGW) {
            bf16x8 hv[2][2]; u32x4 ya[2], yb[2]; float g0[2], g1[2];
#pragma unroll
            for (int t = 0; t < 2; ++t) { int m = m0 + t * NGW; if (m >= NTOK) m = m0;
                g0[t] = GATE[2 * m] * (1.f / Y_SC); g1[t] = GATE[2 * m + 1] * (1.f / Y_SC);
                const bf16* hp = H + (size_t)m * DM + 16 * lane; const unsigned char* y0 = Y + (size_t)(2 * m) * DM + 16 * lane;
                hv[t][0] = *(const bf16x8*)(hp); hv[t][1] = *(const bf16x8*)(hp + 8); ya[t] = *(const u32x4*)(y0); yb[t] = *(const u32x4*)(y0 + DM); }
#pragma unroll
            for (int t = 0; t < 2; ++t) { const int m = m0 + t * NGW; if (m < NTOK) {
                float* op = P.out + (size_t)m * DM + 16 * lane;
#pragma unroll
                for (int q = 0; q < 4; ++q) { const unsigned wa = ya[t][q], wb = yb[t][q];
                    const f32x2_t a0 = __builtin_amdgcn_cvt_pk_f32_fp8((int)wa, false), a1 = __builtin_amdgcn_cvt_pk_f32_fp8((int)wa, true);
                    const f32x2_t b0 = __builtin_amdgcn_cvt_pk_f32_fp8((int)wb, false), b1 = __builtin_amdgcn_cvt_pk_f32_fp8((int)wb, true);
                    const bf16x8 hh = hv[t][q >> 1]; const int e0 = 4 * (q & 1);
                    f32x4 o; o[0] = bf2f(hh[e0]) + g0[t] * a0.x + g1[t] * b0.x; o[1] = bf2f(hh[e0 + 1]) + g0[t] * a0.y + g1[t] * b0.y;
                    o[2] = bf2f(hh[e0 + 2]) + g0[t] * a1.x + g1[t] * b1.x; o[3] = bf2f(hh[e0 + 3]) + g0[t] * a1.y + g1[t] * b1.y;
                    *(f32x4*)(op + 4 * q) = o; } } }
        }
    REPBAR(9); } }
#undef IN
#undef BOTH
}

extern "C" void kernel_launch(void* const* d_in, const int* in_sizes, int n_in, void* d_out, int out_size, void* d_ws, size_t ws_size, hipStream_t stream) {
    static int grid = 0;
    if (grid == 0) {
        if (n_in != 18 || in_sizes[0] != NTOK * DM || out_size != NTOK * DM || ws_size < WS_END) { fprintf(stderr, "kernel_launch: unexpected shapes / workspace (n_in %d, in0 %d, out %d, ws %zu, need %zu)\n", n_in, n_in > 0 ? in_sizes[0] : -1, out_size, ws_size, (size_t)WS_END); grid = -1; return; }
        int dev = 0, cus = 0, per_cu = 0;
        if (hipGetDevice(&dev) != hipSuccess || hipDeviceGetAttribute(&cus, hipDeviceAttributeMultiprocessorCount, dev) != hipSuccess) { grid = -1; return; }
        if (hipFuncSetAttribute((const void*)fwd_kernel, hipFuncAttributeMaxDynamicSharedMemorySize, LDS_BYTES) != hipSuccess) { fprintf(stderr, "kernel_launch: hipFuncSetAttribute failed\n"); grid = -1; return; }
        if (hipOccupancyMaxActiveBlocksPerMultiprocessor(&per_cu, (const void*)fwd_kernel, NWAVES * 64, LDS_BYTES) != hipSuccess || per_cu < 1) fprintf(stderr, "kernel_launch: occupancy query reports %d\n", per_cu);
        (void)hipGetLastError();
        grid = cus;
    }
    if (grid < 0) return;
    if (hipMemsetAsync((char*)d_ws + WS_CTL, 0, CTL_ZERO_BYTES, stream) != hipSuccess) return;
    Args a{};
    const float** pp = (const float**)&a.p;
    for (int i = 0; i < 18; ++i) pp[i] = (const float*)d_in[i];
    a.p.out = (float*)d_out; a.p.ws = (unsigned char*)d_ws;
    if (MK_N_LAUNCHES == 1) { a.ph_lo = 0; a.ph_hi = N_PHASES; hipLaunchKernelGGL(fwd_kernel, dim3(grid), dim3(NWAVES * 64), LDS_BYTES, stream, a); }
    else for (int li = 0; li < N_PHASES; ++li) { a.ph_lo = li; a.ph_hi = li + 1; hipLaunchKernelGGL(fwd_kernel, dim3(grid), dim3(NWAVES * 64), LDS_BYTES, stream, a); }
}
```

```cpp
#include <hip/hip_runtime.h>
#include <cstdio>
#include <cstdint>

#ifndef MK_N_LAUNCHES
#define MK_N_LAUNCHES 1
#endif

#define LAS __attribute__((address_space(3)))
#define GAS __attribute__((address_space(1)))
typedef unsigned short bf16;
typedef short bf16x8 __attribute__((ext_vector_type(8)));
typedef float f32x4 __attribute__((ext_vector_type(4)));
typedef float f32x16 __attribute__((ext_vector_type(16)));
typedef unsigned u32x4 __attribute__((ext_vector_type(4)));
typedef unsigned u32x2 __attribute__((ext_vector_type(2)));
typedef float f32x2_t __attribute__((ext_vector_type(2)));
typedef __bf16 bf16x2_t __attribute__((ext_vector_type(2)));
typedef GAS unsigned gu32;
typedef int v8i __attribute__((ext_vector_type(8)));
typedef int v4i __attribute__((ext_vector_type(4)));
typedef _Float16 f16x8 __attribute__((ext_vector_type(8)));
typedef _Float16 f16x2 __attribute__((ext_vector_type(2)));

constexpr int BATCH = 16, SEQ = 2048, DM = 1024, NTOK = BATCH * SEQ;
constexpr int IN_DIM = 3088;
constexpr int NEXP = 32, DEXP = 512;
constexpr float EPS = 1e-6f;
constexpr float LOG2E = 1.4426950408889634f;
constexpr float WGU_SC = 64.f, WD_SC = 32.f, ACT_SC = 8.f, Y_SC = 8.f;
constexpr int NA = 1792, NB = 1280;
constexpr int NGRP = NTOK / 128;

constexpr size_t MiB = 1u << 20;
constexpr size_t WS_CTL = 0, CTL_ZERO_BYTES = 64 * 1024;
constexpr size_t WS_WA = 2 * MiB;
constexpr size_t WS_WB = 6 * MiB;
constexpr size_t WS_WO = 9 * MiB;
constexpr size_t WS_WR = 11 * MiB;
constexpr size_t WS_W2T = WS_WR + 2 * 48 * 1024 * 2;
constexpr size_t WS_WGU = 12 * MiB;
constexpr size_t WS_WD = 76 * MiB;
constexpr size_t WS_H = 108 * MiB;
constexpr size_t WS_KV = WS_H;
constexpr size_t WS_XB = 44 * MiB;
constexpr size_t WS_MIX = 172 * MiB;
constexpr size_t WS_SQ = 236 * MiB;
constexpr size_t WS_SK = 268 * MiB;
constexpr size_t WS_GQ = 300 * MiB;
constexpr size_t WS_GRS = 316 * MiB;
constexpr size_t WS_TT = 348 * MiB;
constexpr size_t WS_GLR = 428 * MiB;
constexpr size_t WS_ST = 429 * MiB;
constexpr size_t WS_DTOT = 461 * MiB;
constexpr size_t WS_ACT = 236 * MiB;
constexpr size_t WS_H8 = 272 * MiB;
constexpr size_t WS_Y = 308 * MiB;
constexpr size_t WS_LOCL = 462 * MiB;
constexpr size_t WS_CNTS = 467 * MiB;
constexpr size_t WS_GATE = 470 * MiB;
constexpr size_t WS_RSTD = WS_GATE + 512 * 1024;
constexpr size_t WS_RSTD1 = WS_GATE + 768 * 1024;
constexpr size_t WS_END = 472 * MiB;
constexpr int CW_TMO = 0, CW_CODE = 1;
constexpr int CW_BAR = 4096;
constexpr int CW_CNT = 16384;

constexpr int RING_OFF = 0, RING_BYTES = 131072;
constexpr int LDSCTL_OFF = RING_BYTES, MISC_OFF = LDSCTL_OFF + 320;
constexpr int TAB_OFF = LDSCTL_OFF + 1024;
constexpr int LDS_BYTES = 147456;
constexpr int T_CNT = 0, T_TBASE = 128, T_NT = 264, T_TILE_E = 272, T_ROWTAB = 272 + 320 * 4, NU_MAX = 8;
static_assert(TAB_OFF + T_ROWTAB + NU_MAX * 256 * 4 <= LDS_BYTES, "LDS tables");

#define RLX_AGENT __ATOMIC_RELAXED, __HIP_MEMORY_SCOPE_AGENT
#define LDS_WAIT() asm volatile("s_waitcnt lgkmcnt(0)" ::: "memory")
#define VM_WAIT() asm volatile("s_waitcnt vmcnt(0)" ::: "memory")

__device__ __forceinline__ unsigned cvtpk(float lo, float hi) { f32x2_t v = {lo, hi}; bf16x2_t b = __builtin_convertvector(v, bf16x2_t); return __builtin_bit_cast(unsigned, b); }
__device__ __forceinline__ u32x2 pack8_fp8(const float* a) { int lo = __builtin_amdgcn_cvt_pk_fp8_f32(a[0], a[1], 0, false); lo = __builtin_amdgcn_cvt_pk_fp8_f32(a[2], a[3], lo, true);
    int hi = __builtin_amdgcn_cvt_pk_fp8_f32(a[4], a[5], 0, false); hi = __builtin_amdgcn_cvt_pk_fp8_f32(a[6], a[7], hi, true); u32x2 r; r.x = (unsigned)lo; r.y = (unsigned)hi; return r; }
__device__ __forceinline__ float bf2f(short s) { return __uint_as_float(((unsigned)(unsigned short)s) << 16); }
__device__ __forceinline__ bf16x8 pack8(const float* a) { u32x4 p; p.x = cvtpk(a[0], a[1]); p.y = cvtpk(a[2], a[3]); p.z = cvtpk(a[4], a[5]); p.w = cvtpk(a[6], a[7]); return __builtin_bit_cast(bf16x8, p); }
__device__ __forceinline__ int PI32(int i) { return 16 * ((i >> 2) & 1) + (i & 3) + 4 * (i >> 3); }
#define MFMA32(a, b, c) __builtin_amdgcn_mfma_f32_32x32x16_bf16((a), (b), (c), 0, 0, 0)
#define MFMA16(a, b, c) __builtin_amdgcn_mfma_f32_16x16x32_bf16((a), (b), (c), 0, 0, 0)
__device__ __forceinline__ void swap32(float x, float& lo, float& hi) { auto rr = __builtin_amdgcn_permlane32_swap(__float_as_uint(x), __float_as_uint(x), false, false); lo = __uint_as_float(rr[0]); hi = __uint_as_float(rr[1]); }

namespace pg8 {
#define PG8_LAS __attribute__((address_space(3)))
constexpr int BM = 256, BK = 64, HALF = 128, HTB = HALF * BK * 2, STAGE_BYTES = 8 * HTB, NXCD = 8, WGM = 8;
__host__ __device__ __forceinline__ int lds_byte(int r, int c) { const int st = (r >> 4) * 2 + (c >> 5), rr = r & 15, cc = c & 31, ob = rr * 64 + cc * 2; return st * 1024 + (ob ^ (((ob >> 9) & 1) << 5)); }
__host__ __device__ __forceinline__ void stage_rc(int b, int& R, int& C) { const int st = b / 1024, sb = b % 1024, swz = sb ^ (((sb >> 9) & 1) << 5); R = (st >> 1) * 16 + swz / 64; C = (st & 1) * 32 + (swz % 64) / 2; }
__host__ __device__ __forceinline__ int perm32(int rho) { const int n = rho >> 4, i = rho & 15; return 8 * (i >> 2) + 4 * n + (i & 3); }

struct Unit { int pm, pn, e, rt, nv; };

struct SchedDense {
    const char* A; const char* Bt; int K; int nM, nN, nwg, G, c;
    __device__ void init(const void* A_, const void* Bt_, int M, int N, int K_, int G_, int c_) { A = (const char*)A_; Bt = (const char*)Bt_; K = K_; nM = M / BM; nN = N / BM; nwg = nM * nN; G = G_; c = c_; }
    __device__ __forceinline__ bool next(int i, Unit& u) const {
        const long L = (long)i * G + c; if (L >= nwg) return false;
        int wgid = (int)L; { const int q = nwg / NXCD, r = nwg % NXCD, xcd = wgid % NXCD, off = wgid / NXCD; wgid = (xcd < r ? xcd * (q + 1) : r * (q + 1) + (xcd - r) * q) + off; }
        const int nig = WGM * nN, gid = wgid / nig, fm = gid * WGM, gsz = (nM - fm) < WGM ? (nM - fm) : WGM;
        u.pm = fm + ((wgid % nig) % gsz); u.pn = (wgid % nig) / gsz; u.e = 0; u.rt = 0; u.nv = 256; return true;
    }
    __device__ __forceinline__ const char* a_ptr(const Unit& u) const { return A + (size_t)u.pm * BM * K * 2; }
    __device__ __forceinline__ const char* b_ptr(const Unit& u) const { return Bt + (size_t)u.pn * BM * K * 2; }
    __device__ __forceinline__ void a_voff(int, const Unit&, int tid, unsigned (&v)[2][2]) const {
#pragma unroll
        for (int i = 0; i < 2; ++i) { int R, C; stage_rc(tid * 16 + i * 8192, R, C);
#pragma unroll
            for (int h = 0; h < 2; ++h) v[h][i] = (unsigned)((h * HALF + R) * K + C) * 2u; }
    }
};
template <bool GATHER> struct SchedMoE {
    const char* A; const char* Bt; int K; size_t bstride; int G, c;
    const PG8_LAS int* tab;
    __device__ __forceinline__ bool next(int i, Unit& u) const {
        const int L = i * G + c; const int NT = tab[T_NT / 4];
        if (L >= NT * 4) return false;
        const int tile = L >> 2; u.pm = tile; u.pn = L & 3; const int e = tab[T_TILE_E / 4 + tile]; u.e = e;
        u.rt = tile - tab[T_TBASE / 4 + e]; const int rem = tab[T_CNT / 4 + e] - u.rt * 256; u.nv = rem < 256 ? rem : 256; return true;
    }
    __device__ __forceinline__ const char* a_ptr(const Unit& u) const { return GATHER ? A : A + (size_t)u.pm * BM * K * 2; }
    __device__ __forceinline__ const char* b_ptr(const Unit& u) const { return Bt + (size_t)u.e * bstride + (size_t)u.pn * BM * K * 2; }
    __device__ __forceinline__ void a_voff(int ui, const Unit&, int tid, unsigned (&v)[2][2]) const {
        asm volatile("" : "+v"(tid));
#pragma unroll
        for (int i = 0; i < 2; ++i) { int R, C; stage_rc(tid * 16 + i * 8192, R, C);
#pragma unroll
            for (int h = 0; h < 2; ++h) {
                if (GATHER) { const int tok = tab[T_ROWTAB / 4 + ui * 256 + h * HALF + R] >> 1; v[h][i] = (unsigned)(tok * K + C) * 2u; }
                else v[h][i] = (unsigned)((h * HALF + R) * K + C) * 2u; } }
    }
};

template <class Epi, class Sched, bool TAIL = false, bool FP8 = false>
__device__ __forceinline__ void gemm_phase(PG8_LAS unsigned char* lds, const int K, const Sched& S, const Epi& E) {
    const int tid = threadIdx.x, wid = __builtin_amdgcn_readfirstlane(tid >> 6), lane = tid & 63, wr = wid >> 2, wc = wid & 3, fr = lane & 15, fq = lane >> 4;
    const int nt = K / BK;
    unsigned voffB[1][2];
#pragma unroll
    for (int i = 0; i < 2; ++i) { int R, C; stage_rc(tid * 16 + i * 8192, R, C); const int Rb = (R & ~31) + perm32(R & 31);
        voffB[0][i] = (unsigned)(Rb * K + C) * 2u; }
    const size_t hstepB = (size_t)HALF * K * 2;
    const size_t kstep = (size_t)(BK * 2);
    const unsigned ldsw = (unsigned)wid * 1024u;
    const int aoff = lds_byte(wr * 64 + fr, fq * 8), boff = lds_byte(wc * 32 + fr, fq * 8);
#define PG8_SA(b, h) (((b) * 2 + (h)) * HTB)
#define PG8_SB(b, h) ((4 + (b) * 2 + (h)) * HTB)
#define PG8_STAGE(bufoff, gbase, voff) do { _Pragma("unroll") for (int _i = 0; _i < 2; ++_i) \
        __builtin_amdgcn_global_load_lds((const unsigned*)((const char*)(gbase) + (voff)[_i]), (PG8_LAS unsigned*)(lds + (bufoff) + ldsw + _i * 8192), 16, 0, 0); } while (0)
#define PG8_RD16(off) (*(const PG8_LAS v4i*)(lds + (off)))
#define PG8_LDA(dst, b, h) do { _Pragma("unroll") for (int m = 0; m < 4; ++m) { \
        if constexpr (FP8) At8[m] = __builtin_shufflevector(PG8_RD16(PG8_SA(b, h) + aoff + m * 2048), PG8_RD16(PG8_SA(b, h) + aoff + m * 2048 + 1024), 0, 1, 2, 3, 4, 5, 6, 7); \
        else { _Pragma("unroll") for (int k = 0; k < 2; ++k) dst[m][k] = *(const PG8_LAS bf16x8*)(lds + PG8_SA(b, h) + aoff + m * 2048 + k * 1024); } } } while (0)
#define PG8_LDB(dst, b, h) do { _Pragma("unroll") for (int n = 0; n < 2; ++n) { \
        if constexpr (FP8) dst##8[n] = __builtin_shufflevector(PG8_RD16(PG8_SB(b, h) + boff + n * 2048), PG8_RD16(PG8_SB(b, h) + boff + n * 2048 + 1024), 0, 1, 2, 3, 4, 5, 6, 7); \
        else { _Pragma("unroll") for (int k = 0; k < 2; ++k) dst[n][k] = *(const PG8_LAS bf16x8*)(lds + PG8_SB(b, h) + boff + n * 2048 + k * 1024); } } } while (0)
#define PG8_MMA(ai, bj, At, Bt) do { __builtin_amdgcn_s_setprio(1); _Pragma("unroll") for (int m = 0; m < 4; ++m) _Pragma("unroll") for (int n = 0; n < 2; ++n) { \
        if constexpr (FP8) asm volatile("v_mfma_scale_f32_16x16x128_f8f6f4 %0, %1, %2, %0, %3, %3 op_sel_hi:[0,0,0]" : "+v"(acc[ai][bj][m][n]) : "v"(Bt##8[n]), "v"(At8[m]), "v"(sc1)); \
        else { _Pragma("unroll") for (int k = 0; k < 2; ++k) acc[ai][bj][m][n] = __builtin_amdgcn_mfma_f32_16x16x32_bf16(Bt[n][k], At[m][k], acc[ai][bj][m][n], 0, 0, 0); } } \
        __builtin_amdgcn_s_setprio(0); } while (0)
#define PG8_WAIT_V(n) asm volatile("s_waitcnt vmcnt(" #n ")" ::: "memory")
#define PG8_WAIT_L(n) asm volatile("s_waitcnt lgkmcnt(" #n ")" ::: "memory")
#define PG8_BAR __builtin_amdgcn_s_barrier()
#define PG8_SCHED __builtin_amdgcn_sched_barrier(0)
    Unit cur, nxt; int ui = 0;
    if (!S.next(0, cur)) return;
    f32x4 acc[2][2][4][2];
#pragma unroll
    for (int a = 0; a < 2; ++a)
#pragma unroll
        for (int b = 0; b < 2; ++b)
#pragma unroll
            for (int m = 0; m < 4; ++m)
#pragma unroll
                for (int n = 0; n < 2; ++n) acc[a][b][m][n] = (f32x4){0.f, 0.f, 0.f, 0.f};
    bf16x8 At[4][2], B0[2][2], B1[2][2];
    v8i At8[4], B08[2], B18[2];
    int sc1 = 0x7f7f7f7f; asm volatile("" : "+v"(sc1));
    unsigned vc[2][2], vn[2][2];
    S.a_voff(0, cur, tid, vc);
    const char* cA = S.a_ptr(cur); const char* cB = S.b_ptr(cur);
    PG8_STAGE(PG8_SB(0, 0), cB, voffB[0]); PG8_STAGE(PG8_SB(0, 1), (cB) + hstepB, voffB[0]); PG8_STAGE(PG8_SA(0, 0), cA, vc[0]); PG8_STAGE(PG8_SA(0, 1), cA, vc[1]);
    if (wr == 1) PG8_BAR;
    PG8_WAIT_V(2); PG8_BAR;
    PG8_STAGE(PG8_SB(1, 0), cB + kstep, voffB[0]); PG8_STAGE(PG8_SA(1, 0), cA + kstep, vc[0]); PG8_STAGE(PG8_SB(1, 1), (cB + kstep) + hstepB, voffB[0]);
    PG8_WAIT_V(6); PG8_BAR;
    for (;;) {
        const bool has_next = S.next(ui + 1, nxt);
        const char* nA = has_next ? S.a_ptr(nxt) : cA; const char* nB = has_next ? S.b_ptr(nxt) : cB;
        if (has_next) S.a_voff(ui + 1, nxt, tid, vn);
        else {
#pragma unroll
            for (int h = 0; h < 2; ++h)
#pragma unroll
                for (int i = 0; i < 2; ++i) vn[h][i] = vc[h][i]; }
        const bool full_hi = !TAIL || cur.nv > HALF;
        for (int t = 0; t < nt; t += 2) {
            const bool last = (t == nt - 2);
            const char* a1 = cA + (size_t)(t + 1) * kstep;
            const char* a2 = last ? nA : cA + (size_t)(t + 2) * kstep; const char* b2 = last ? nB : cB + (size_t)(t + 2) * kstep;
            const char* a3 = a2 + kstep; const char* b3 = b2 + kstep;
            unsigned w0[2], w1[2];
            w0[0] = last ? vn[0][0] : vc[0][0]; w0[1] = last ? vn[0][1] : vc[0][1]; w1[0] = last ? vn[1][0] : vc[1][0]; w1[1] = last ? vn[1][1] : vc[1][1];
            PG8_LDB(B0, 0, 0); PG8_LDB(B1, 0, 1); PG8_SCHED; PG8_LDA(At, 0, 0); PG8_STAGE(PG8_SA(1, 1), a1, vc[1]);
            PG8_WAIT_V(8); PG8_WAIT_L(0); PG8_BAR; PG8_MMA(0, 0, At, B0); PG8_MMA(0, 1, At, B1); PG8_BAR; PG8_SCHED;
            PG8_LDA(At, 0, 1); PG8_STAGE(PG8_SB(0, 0), b2, voffB[0]); PG8_STAGE(PG8_SB(0, 1), (b2) + hstepB, voffB[0]); PG8_STAGE(PG8_SA(0, 0), a2, w0);
            PG8_WAIT_V(8); PG8_WAIT_L(0); PG8_BAR; if (full_hi) { PG8_MMA(1, 0, At, B0); PG8_MMA(1, 1, At, B1); } PG8_BAR; PG8_SCHED;
            PG8_LDB(B0, 1, 0); PG8_LDB(B1, 1, 1); PG8_SCHED; PG8_LDA(At, 1, 0); PG8_STAGE(PG8_SA(0, 1), a2, w1);
            PG8_WAIT_V(8); PG8_WAIT_L(0); PG8_BAR; PG8_MMA(0, 0, At, B0); PG8_MMA(0, 1, At, B1); PG8_BAR; PG8_SCHED;
            PG8_LDA(At, 1, 1); PG8_STAGE(PG8_SB(1, 0), b3, voffB[0]); PG8_STAGE(PG8_SB(1, 1), (b3) + hstepB, voffB[0]); PG8_STAGE(PG8_SA(1, 0), a3, w0);
            PG8_WAIT_V(8); PG8_WAIT_L(0); PG8_BAR; if (full_hi) { PG8_MMA(1, 0, At, B0); PG8_MMA(1, 1, At, B1); } PG8_BAR; PG8_SCHED;
        }
        if (wr == 0) PG8_BAR;
        if constexpr (FP8) asm volatile("s_nop 15\n\ts_nop 15" ::: "memory");
        { int t2_ = threadIdx.x; asm volatile("" : "+v"(t2_)); E(acc, cur, ui, wr, wc, t2_ & 15, (t2_ >> 4) & 3); }
        if (!has_next) break;
#pragma unroll
        for (int a = 0; a < 2; ++a)
#pragma unroll
            for (int b = 0; b < 2; ++b)
#pragma unroll
                for (int m = 0; m < 4; ++m)
#pragma unroll
                    for (int n = 0; n < 2; ++n) acc[a][b][m][n] = (f32x4){0.f, 0.f, 0.f, 0.f};
        cur = nxt; cA = nA; cB = nB; ++ui;
#pragma unroll
        for (int h = 0; h < 2; ++h)
#pragma unroll
            for (int i = 0; i < 2; ++i) vc[h][i] = vn[h][i];
        if (wr == 1) PG8_BAR;
    }
    PG8_WAIT_V(0);
    PG8_BAR;
#undef PG8_SA
#undef PG8_SB
#undef PG8_STAGE
#undef PG8_LDA
#undef PG8_LDB
#undef PG8_MMA
#undef PG8_RD16
#undef PG8_WAIT_V
#undef PG8_WAIT_L
#undef PG8_BAR
#undef PG8_SCHED
}

struct EpiBf16 {
    bf16* O; int ldc;
    __device__ __forceinline__ void operator()(const f32x4 (&acc)[2][2][4][2], const Unit& u, int, int wr, int wc, int fr, int fq) const {
        const int row0 = u.pm * BM + wr * 64 + fr, col0 = u.pn * BM + wc * 32 + 8 * fq;
#pragma unroll
        for (int ai = 0; ai < 2; ++ai)
#pragma unroll
            for (int m = 0; m < 4; ++m) { bf16* rowp = O + (size_t)(row0 + ai * HALF + m * 16) * ldc + col0;
#pragma unroll
                for (int bj = 0; bj < 2; ++bj) { const f32x4 v0 = acc[ai][bj][m][0], v1 = acc[ai][bj][m][1];
                    u32x4 w; w.x = cvtpk(v0[0], v0[1]); w.y = cvtpk(v0[2], v0[3]); w.z = cvtpk(v1[0], v1[1]); w.w = cvtpk(v1[2], v1[3]);
                    *(u32x4*)(rowp + bj * HALF) = w; } }
    }
};
struct EpiTT {
    bf16* O; const float* RS;
    __device__ __forceinline__ void operator()(const f32x4 (&acc)[2][2][4][2], const Unit& u, int, int wr, int wc, int fr, int fq) const {
        const int row0 = u.pm * BM + wr * 64 + fr, tokb0 = u.pn * 8 + wc;
        f32x4 rs[2][2];
#pragma unroll
        for (int bj = 0; bj < 2; ++bj) { const float* rp = RS + (size_t)(tokb0 + 4 * bj) * 32 + 8 * fq; rs[bj][0] = *(const f32x4*)rp; rs[bj][1] = *(const f32x4*)(rp + 4); }
#pragma unroll
        for (int ai = 0; ai < 2; ++ai)
#pragma unroll
            for (int m = 0; m < 4; ++m) { const int col = row0 + ai * HALF + m * 16;
#pragma unroll
                for (int bj = 0; bj < 2; ++bj) { const f32x4 v0 = acc[ai][bj][m][0] * rs[bj][0], v1 = acc[ai][bj][m][1] * rs[bj][1];
                    u32x4 w; w.x = cvtpk(v0[0], v0[1]); w.y = cvtpk(v0[2], v0[3]); w.z = cvtpk(v1[0], v1[1]); w.w = cvtpk(v1[2], v1[3]);
                    *(u32x4*)(O + ((size_t)(tokb0 + 4 * bj) * 1280 + col) * 32 + 8 * fq) = w; } }
    }
};
struct EpiA {
    bf16 *SQ, *SK, *GQ, *GRS; const float *gq_norm, *gk_norm; const float* RS;
    __device__ __forceinline__ void operator()(const f32x4 (&acc)[2][2][4][2], const Unit& u, int, int wr, int wc, int fr, int fq) const {
        const int pn = u.pn; const int row0 = u.pm * BM + wr * 64 + fr;
        bf16* base; int ldc, colt; int mode;
        float scale = 1.f; const float* gain = nullptr;
        if (pn < 2)      { base = SQ; ldc = 512; colt = pn * 256; mode = 0; gain = gq_norm; scale = 0.125f * LOG2E; }
        else if (pn < 4) { base = SK; ldc = 512; colt = (pn - 2) * 256; mode = 0; gain = gk_norm; scale = 1.f; }
        else if (pn < 5) { base = GQ; ldc = 256; colt = 0; mode = 1; scale = 0.125f; }
        else             { base = GRS; ldc = 512; colt = (pn - 5) * 256; mode = 2; }
        const int col0 = colt + wc * 64 + 8 * fq;
        f32x4 gv[2][2];
#pragma unroll
        for (int bj = 0; bj < 2; ++bj)
#pragma unroll
            for (int n = 0; n < 2; ++n) { if (mode == 0) { gv[bj][n] = *(const f32x4*)(gain + 32 * bj + 8 * fq + 4 * n); gv[bj][n] = gv[bj][n] * scale; } else gv[bj][n] = (f32x4){scale, scale, scale, scale}; }
        float rs1v[2][4];
#pragma unroll
        for (int ai = 0; ai < 2; ++ai)
#pragma unroll
            for (int m = 0; m < 4; ++m) rs1v[ai][m] = RS[row0 + ai * HALF + m * 16];
#pragma unroll
        for (int ai = 0; ai < 2; ++ai)
#pragma unroll
            for (int m = 0; m < 4; ++m) {
                const float rs1 = rs1v[ai][m]; float rs = rs1;
                if (mode == 0) { float s = 0.f;
#pragma unroll
                    for (int bj = 0; bj < 2; ++bj)
#pragma unroll
                        for (int n = 0; n < 2; ++n) { const f32x4 x = acc[ai][bj][m][n]; s += (x[0] * x[0] + x[1] * x[1]) + (x[2] * x[2] + x[3] * x[3]); }
                    s += __shfl_xor(s, 16); s += __shfl_xor(s, 32);
                    rs = rs1 * __builtin_amdgcn_rsqf(rs1 * rs1 * s * (1.f / 64.f) + EPS); }
                bf16* rowp = base + (size_t)(row0 + ai * HALF + m * 16) * ldc + col0;
#pragma unroll
                for (int bj = 0; bj < 2; ++bj) { f32x4 v0 = acc[ai][bj][m][0], v1 = acc[ai][bj][m][1];
                    if (mode == 2) {
#pragma unroll
                        for (int e = 0; e < 4; ++e) { v0[e] *= rs1; v1[e] *= rs1; v0[e] = v0[e] * __builtin_amdgcn_rcpf(1.f + __builtin_amdgcn_exp2f(-v0[e] * LOG2E)); v1[e] = v1[e] * __builtin_amdgcn_rcpf(1.f + __builtin_amdgcn_exp2f(-v1[e] * LOG2E)); }
                    } else { v0 = v0 * rs * gv[bj][0]; v1 = v1 * rs * gv[bj][1]; }
                    u32x4 w; w.x = cvtpk(v0[0], v0[1]); w.y = cvtpk(v0[2], v0[3]); w.z = cvtpk(v1[0], v1[1]); w.w = cvtpk(v1[2], v1[3]);
                    *(u32x4*)(rowp + bj * 32) = w; } }
    }
};
struct EpiH {
    const bf16* XB; bf16* H; unsigned char* H8;
    __device__ __forceinline__ void operator()(const f32x4 (&acc)[2][2][4][2], const Unit& u, int, int wr, int wc, int fr, int fq) const {
        const int row0 = u.pm * BM + wr * 64 + fr, col0 = u.pn * BM + wc * 32 + 8 * fq;
#pragma unroll
        for (int ai = 0; ai < 2; ++ai) {
            u32x2 h8[4][2];
            bf16x8 xv[4][2];
#pragma unroll
            for (int m = 0; m < 4; ++m) { const size_t off = (size_t)(row0 + ai * HALF + m * 16) * DM + col0;
#pragma unroll
                for (int bj = 0; bj < 2; ++bj) xv[m][bj] = *(const bf16x8*)(XB + off + bj * HALF); }
#pragma unroll
            for (int m = 0; m < 4; ++m) { const size_t off = (size_t)(row0 + ai * HALF + m * 16) * DM + col0;
#pragma unroll
                for (int bj = 0; bj < 2; ++bj) { const bf16x8 xx = xv[m][bj];
                    const f32x4 v0 = acc[ai][bj][m][0] + (f32x4){bf2f(xx[0]), bf2f(xx[1]), bf2f(xx[2]), bf2f(xx[3])}, v1 = acc[ai][bj][m][1] + (f32x4){bf2f(xx[4]), bf2f(xx[5]), bf2f(xx[6]), bf2f(xx[7])};
                    u32x4 w; w.x = cvtpk(v0[0], v0[1]); w.y = cvtpk(v0[2], v0[3]); w.z = cvtpk(v1[0], v1[1]); w.w = cvtpk(v1[2], v1[3]);
                    *(u32x4*)(H + off + bj * HALF) = w;
                    const float f8[8] = {v0[0], v0[1], v0[2], v0[3], v1[0], v1[1], v1[2], v1[3]};
                    h8[m][bj] = pack8_fp8(f8); } }
#pragma unroll
            for (int mp = 0; mp < 2; ++mp)
#pragma unroll
                for (int bj = 0; bj < 2; ++bj) {
                    const auto r0 = __builtin_amdgcn_permlane16_swap(h8[2 * mp][bj].x, h8[2 * mp + 1][bj].x, false, false);
                    const auto r1 = __builtin_amdgcn_permlane16_swap(h8[2 * mp][bj].y, h8[2 * mp + 1][bj].y, false, false);
                    u32x4 w8; w8.x = r0[0]; w8.y = r1[0]; w8.z = r0[1]; w8.w = r1[1];
                    const size_t off8 = (size_t)(row0 + ai * HALF + (2 * mp + (fq & 1)) * 16) * DM + u.pn * BM + wc * 32 + 8 * (fq & ~1) + bj * HALF;
                    *(u32x4*)(H8 + off8) = w8; }
        }
    }
};
struct EpiGU {
    unsigned char* ACT; const float* RSTD; const PG8_LAS int* tab;
    __device__ __forceinline__ void operator()(const f32x4 (&acc)[2][2][4][2], const Unit& u, int ui, int wr, int wc, int fr, int fq) const {
        const int col0 = u.pn * 128 + wc * 32 + 8 * (fq & ~1); const int odd = fq & 1;
        float rsv[2][4];
#pragma unroll
        for (int ai = 0; ai < 2; ++ai)
#pragma unroll
            for (int m = 0; m < 4; ++m) { const int rl = ai * HALF + wr * 64 + m * 16 + fr; rsv[ai][m] = RSTD[tab[T_ROWTAB / 4 + ui * 256 + rl] >> 1] * (1.f / WGU_SC); }
#pragma unroll
        for (int ai = 0; ai < 2; ++ai)
#pragma unroll
            for (int mp = 0; mp < 2; ++mp) {
                u32x2 pk[2];
#pragma unroll
                for (int q = 0; q < 2; ++q) { const int m = 2 * mp + q; const float rs = rsv[ai][m];
                    f32x4 g0 = acc[ai][0][m][0] * rs, g1 = acc[ai][0][m][1] * rs, u0 = acc[ai][1][m][0] * rs, u1 = acc[ai][1][m][1] * rs;
#pragma unroll
                    for (int e = 0; e < 4; ++e) { g0[e] = g0[e] * __builtin_amdgcn_rcpf(1.f + __builtin_amdgcn_exp2f(-g0[e] * LOG2E)) * u0[e]; g1[e] = g1[e] * __builtin_amdgcn_rcpf(1.f + __builtin_amdgcn_exp2f(-g1[e] * LOG2E)) * u1[e]; }
                    float f8[8] = {g0[0] * ACT_SC, g0[1] * ACT_SC, g0[2] * ACT_SC, g0[3] * ACT_SC, g1[0] * ACT_SC, g1[1] * ACT_SC, g1[2] * ACT_SC, g1[3] * ACT_SC};
#pragma unroll
                    for (int e = 0; e < 8; ++e) f8[e] = __builtin_fminf(__builtin_fmaxf(f8[e], -448.f), 448.f);
                    pk[q] = pack8_fp8(f8); }
                const auto r0 = __builtin_amdgcn_permlane16_swap(pk[0].x, pk[1].x, false, false);
                const auto r1 = __builtin_amdgcn_permlane16_swap(pk[0].y, pk[1].y, false, false);
                u32x4 w; w.x = r0[0]; w.y = r1[0]; w.z = r0[1]; w.w = r1[1];
                const int rl = ai * HALF + wr * 64 + (2 * mp + odd) * 16 + fr;
                if (rl < u.nv) *(u32x4*)(ACT + (size_t)(u.pm * 256 + rl) * DEXP + col0) = w; }
    }
};
struct EpiDown {
    unsigned char* Y; const PG8_LAS int* tab;
    __device__ __forceinline__ void operator()(const f32x4 (&acc)[2][2][4][2], const Unit& u, int ui, int wr, int wc, int fr, int fq) const {
        const int col0 = u.pn * BM + wc * 32 + 8 * (fq & ~1); const float sc = Y_SC / (WD_SC * ACT_SC); const int odd = fq & 1;
#pragma unroll
        for (int ai = 0; ai < 2; ++ai)
#pragma unroll
            for (int mp = 0; mp < 2; ++mp) { const int rl = ai * HALF + wr * 64 + (2 * mp + odd) * 16 + fr;
                const bool ok = rl < u.nv; const unsigned ts = (unsigned)tab[T_ROWTAB / 4 + ui * 256 + (ok ? rl : 0)];
                unsigned char* rowp = Y + (size_t)ts * DM + col0;
#pragma unroll
                for (int bj = 0; bj < 2; ++bj) {
                    u32x2 pk[2];
#pragma unroll
                    for (int q = 0; q < 2; ++q) { const f32x4 v0 = acc[ai][bj][2 * mp + q][0] * sc, v1 = acc[ai][bj][2 * mp + q][1] * sc;
                        const float f8[8] = {v0[0], v0[1], v0[2], v0[3], v1[0], v1[1], v1[2], v1[3]}; pk[q] = pack8_fp8(f8); }
                    const auto r0 = __builtin_amdgcn_permlane16_swap(pk[0].x, pk[1].x, false, false);
                    const auto r1 = __builtin_amdgcn_permlane16_swap(pk[0].y, pk[1].y, false, false);
                    u32x4 w; w.x = r0[0]; w.y = r1[0]; w.z = r0[1]; w.w = r1[1];
                    if (ok) *(u32x4*)(rowp + bj * HALF) = w; } }
    }
};
}

#define XB_TMO      128
#define XB_XCNT(j)  (256  + 64 * (j))
#define XB_XSUB(j)  (1280 + 64 * (j))
#define XB_XGEN(j)  (2304 + 64 * (j))
#define XB_TOP      3328
#define XB_TOPGEN   3392
#define XCD_BAR_WORDS 3456
#define XB_SPIN_CAP (1u << 18)
__device__ __forceinline__ unsigned xb_ld(unsigned* p)              { return __hip_atomic_load(p, __ATOMIC_RELAXED, __HIP_MEMORY_SCOPE_AGENT); }
__device__ __forceinline__ unsigned xb_add(unsigned* p, unsigned v) { return __hip_atomic_fetch_add(p, v, __ATOMIC_RELAXED, __HIP_MEMORY_SCOPE_AGENT); }
__device__ __forceinline__ unsigned xb_xcc_id() { return (unsigned)__builtin_amdgcn_s_getreg((3 << 11) | 20) & 0xFu; }
#define XB_SPIN(cond, bar) do { unsigned _sp = 0; while (cond) { __builtin_amdgcn_s_sleep(1); \
    if ((++_sp & 255u) == 0u) { if (xb_ld(&(bar)[XB_TMO])) break; if (_sp > XB_SPIN_CAP) { atomicAdd(&(bar)[XB_TMO], 1u); break; } } } } while (0)
struct XcdBarrier { unsigned* bar; unsigned x; volatile LAS unsigned* st; };
__device__ __forceinline__ XcdBarrier xcd_barrier_post(unsigned* bar, volatile LAS unsigned* st) {
    XcdBarrier b; b.bar = bar; b.x = xb_xcc_id(); b.st = st;
    if (threadIdx.x == 0) (void)xb_add(&bar[XB_XCNT(b.x)], 1u);
    return b;
}
__device__ __forceinline__ void xcd_barrier_complete(unsigned* bar, unsigned x, unsigned& nloc, unsigned& nx) {
    const unsigned G = gridDim.x * gridDim.y * gridDim.z;
    unsigned sum, cnt, mine, sp = 0u;
    for (;;) {
        sum = 0u; cnt = 0u; mine = 0u;
#pragma unroll
        for (unsigned j = 0; j < 16; ++j) { const unsigned c = xb_ld(&bar[XB_XCNT(j)]); sum += c; cnt += (c > 0u) ? 1u : 0u; mine = (j == x) ? c : mine; }
        if (sum == G) break;
        __builtin_amdgcn_s_sleep(1);
        if ((++sp & 255u) == 0u) { if (xb_ld(&bar[XB_TMO])) break; if (sp > XB_SPIN_CAP) { atomicAdd(&bar[XB_TMO], 1u); break; } }
    }
    nloc = mine > 0u ? mine : 1u; nx = cnt > 0u ? cnt : 1u;
}
__device__ __forceinline__ void xcd_barrier(const XcdBarrier& b) {
    asm volatile("s_waitcnt vmcnt(0)" ::: "memory");
    __syncthreads();
    if (threadIdx.x == 0) {
        unsigned* bar = b.bar;
        __builtin_amdgcn_s_waitcnt(0);
        unsigned nloc = b.st[0], nx = b.st[1];
        if (nloc == 0u) { xcd_barrier_complete(bar, b.x, nloc, nx); b.st[0] = nloc; b.st[1] = nx; }
        const unsigned old = xb_add(&bar[XB_XSUB(b.x)], 1u);
        const unsigned gen = old / nloc;
        if (old + 1u == (gen + 1u) * nloc) {
            __builtin_amdgcn_fence(__ATOMIC_RELEASE, "agent");
            asm volatile("s_waitcnt vmcnt(0)" ::: "memory");
            const unsigned og = xb_add(&bar[XB_TOP], 1u);
            const unsigned tg = og / nx;
            if (og + 1u == (tg + 1u) * nx) xb_add(&bar[XB_TOPGEN], 1u);
            else XB_SPIN(xb_ld(&bar[XB_TOPGEN]) == tg, bar);
            __builtin_amdgcn_fence(__ATOMIC_ACQUIRE, "agent");
            xb_add(&bar[XB_XGEN(b.x)], 1u);
            asm volatile("s_waitcnt vmcnt(0)" ::: "memory");
        } else {
            XB_SPIN(xb_ld(&bar[XB_XGEN(b.x)]) == gen, bar);
            __builtin_amdgcn_fence(__ATOMIC_ACQUIRE, "agent");
            asm volatile("s_waitcnt vmcnt(0)" ::: "memory");
        }
    }
    __syncthreads();
}

__device__ __forceinline__ void xcd_barrier_arrive(const XcdBarrier& b, volatile LAS unsigned* sv) {
    asm volatile("s_waitcnt vmcnt(0)" ::: "memory");
    __syncthreads();
    if (threadIdx.x == 0) {
        unsigned* bar = b.bar;
        __builtin_amdgcn_s_waitcnt(0);
        unsigned nloc = b.st[0], nx = b.st[1];
        if (nloc == 0u) { xcd_barrier_complete(bar, b.x, nloc, nx); b.st[0] = nloc; b.st[1] = nx; }
        const unsigned old = xb_add(&bar[XB_XSUB(b.x)], 1u);
        const unsigned gen = old / nloc;
        unsigned role = 0u, tg = 0u;
        if (old + 1u == (gen + 1u) * nloc) {
            __builtin_amdgcn_fence(__ATOMIC_RELEASE, "agent");
            asm volatile("s_waitcnt vmcnt(0)" ::: "memory");
            const unsigned og = xb_add(&bar[XB_TOP], 1u);
            tg = og / nx;
            if (og + 1u == (tg + 1u) * nx) { xb_add(&bar[XB_TOPGEN], 1u); role = 2u; } else role = 1u;
        }
        sv[0] = role; sv[1] = gen; sv[2] = tg;
    }
}
__device__ __forceinline__ void xcd_barrier_wait(const XcdBarrier& b, volatile LAS unsigned* sv) {
    asm volatile("s_waitcnt vmcnt(0)" ::: "memory");
    __syncthreads();
    if (threadIdx.x == 0) {
        unsigned* bar = b.bar; const unsigned role = sv[0], gen = sv[1], tg = sv[2];
        if (role != 0u) {
            if (role == 1u) XB_SPIN(xb_ld(&bar[XB_TOPGEN]) == tg, bar);
            __builtin_amdgcn_fence(__ATOMIC_ACQUIRE, "agent");
            xb_add(&bar[XB_XGEN(b.x)], 1u);
            asm volatile("s_waitcnt vmcnt(0)" ::: "memory");
        } else {
            XB_SPIN(xb_ld(&bar[XB_XGEN(b.x)]) == gen, bar);
            __builtin_amdgcn_fence(__ATOMIC_ACQUIRE, "agent");
            asm volatile("s_waitcnt vmcnt(0)" ::: "memory");
        }
    }
    __syncthreads();
}

__device__ __forceinline__ float wave_sum(float v) {
#pragma unroll
    for (int o = 1; o < 64; o <<= 1) v += __shfl_xor(v, o);
    return v;
}
__device__ __forceinline__ void tr_item(const float* src, int srcN, int k0, int n0, bf16* dst, int drow0, int dK, const float* kscale, LAS float* scr, int lane) {
    float w[32];
    const float* sp = src + (size_t)(k0 + (lane >> 5)) * srcN + n0 + (lane & 31);
#pragma unroll
    for (int i = 0; i < 32; ++i) w[i] = __builtin_nontemporal_load(sp + (size_t)(2 * i) * srcN);
    if (kscale) { const float ksv = kscale[k0 + lane];
#pragma unroll
        for (int i = 0; i < 32; ++i) { const float a = __int_as_float(__builtin_amdgcn_readlane(__float_as_int(ksv), 2 * i)), b = __int_as_float(__builtin_amdgcn_readlane(__float_as_int(ksv), 2 * i + 1)); w[i] *= (lane >> 5) ? b : a; } }
#pragma unroll
    for (int i = 0; i < 32; ++i) scr[(2 * i + (lane >> 5)) * 33 + (lane & 31)] = w[i];
    LDS_WAIT(); asm volatile("" ::: "memory");
    const int c = lane & 7;
#pragma unroll
    for (int j = 0; j < 4; ++j) { const int n = (lane >> 3) + 8 * j; const LAS float* s = scr + (8 * c) * 33 + n;
        u32x4 o; o.x = cvtpk(s[0 * 33], s[1 * 33]); o.y = cvtpk(s[2 * 33], s[3 * 33]); o.z = cvtpk(s[4 * 33], s[5 * 33]); o.w = cvtpk(s[6 * 33], s[7 * 33]);
        *(GAS u32x4*)(dst + (size_t)(drow0 + n) * dK + k0 + 8 * c) = o; }
    LDS_WAIT(); asm volatile("" ::: "memory");
}

__device__ __forceinline__ void tr_item8(const float* src, int srcN, int k0, int n0, unsigned char* dst, int drow0, int dK, const float* kscale, float scale, LAS float* scr, int lane) {
    float w[32];
    const float* sp = src + (size_t)(k0 + (lane >> 5)) * srcN + n0 + (lane & 31);
#pragma unroll
    for (int i = 0; i < 32; ++i) w[i] = __builtin_nontemporal_load(sp + (size_t)(2 * i) * srcN);
    float ksv = scale; if (kscale) ksv *= kscale[k0 + lane];
#pragma unroll
    for (int i = 0; i < 32; ++i) { const float a = __int_as_float(__builtin_amdgcn_readlane(__float_as_int(ksv), 2 * i)), b = __int_as_float(__builtin_amdgcn_readlane(__float_as_int(ksv), 2 * i + 1)); w[i] *= (lane >> 5) ? b : a; }
#pragma unroll
    for (int i = 0; i < 32; ++i) scr[(2 * i + (lane >> 5)) * 33 + (lane & 31)] = w[i];
    LDS_WAIT(); asm volatile("" ::: "memory");
#pragma unroll
    for (int j = 0; j < 2; ++j) { const int idx = lane + 64 * j, n = idx >> 2, c = idx & 3; const LAS float* sc_ = scr + (16 * c) * 33 + n;
        float f[16];
#pragma unroll
        for (int i = 0; i < 16; ++i) f[i] = sc_[i * 33];
        const u32x2 lo = pack8_fp8(f), hi = pack8_fp8(f + 8);
        u32x4 o; o.x = lo.x; o.y = lo.y; o.z = hi.x; o.w = hi.y;
        *(GAS u32x4*)(dst + (size_t)(drow0 + n) * dK + k0 + 16 * c) = o; }
    LDS_WAIT(); asm volatile("" ::: "memory");
}

struct Ptrs {
    const float *x, *attn_g, *w_in, *sbq_g, *sbk_g, *sbo_g, *w2, *gate_b, *glan_g, *w_out, *ffn_g, *rg_w, *rg_b, *re_w, *re_b, *wg, *wu, *wd;
    float* out; unsigned char* ws;
};

constexpr int SB_SPAN = 14, SB_VOFF = SB_SPAN * 4096;
__device__ __forceinline__ int sb_keyK(int r) { return ((r >> 1) & 3) | (((r >> 4) & 1) << 2); }
__device__ __forceinline__ int sb_keyV(int r) { return ((r >> 2) & 1) | (((r >> 4) & 1) << 1); }
__device__ __forceinline__ void sb_round(LAS unsigned char* lds, const bf16* SQ, const bf16* SK, const bf16* TT, const float* gout, bf16* MIX, int b, int h, int qg, int tid, int wave, int lane) {
    const int il = lane & 31, hi = lane >> 5, pil = PI32(il);
    const int qt = 8 * qg + wave;
    const size_t row0 = (size_t)b * SEQ + (size_t)qt * 32;
    bf16x8 qf[4];
    { const bf16* qp = SQ + (row0 + il) * 512 + h * 64 + 32 * hi;
#pragma unroll
      for (int s = 0; s < 4; ++s) qf[s] = *(const bf16x8*)(qp + 8 * s); }
    const int lo = (8 * qg - 6) > 0 ? (8 * qg - 6) : 0, nblk = 8 * qg + 8 - lo;
    {
        u32x4 st[SB_SPAN];
        const bool isK = tid < 256; const int q = tid - 256;
        const bf16* src = isK ? SK + ((size_t)b * SEQ + (size_t)lo * 32 + (tid >> 3)) * 512 + h * 64 + 8 * (tid & 7)
                              : TT + ((size_t)(b * (SEQ / 32) + lo) * NB + h * 64 + (q >> 2)) * 32 + 8 * (q & 3);
        const size_t bstep = isK ? (size_t)32 * 512 : (size_t)NB * 32;
#pragma unroll
        for (int i = 0; i < SB_SPAN; ++i) if (i < nblk) st[i] = *(const u32x4*)(src + (size_t)i * bstep);
        const int r = isK ? (tid >> 3) : (q >> 2);
        const unsigned dst = isK ? (unsigned)(r * 128 + (((tid & 7) ^ sb_keyK(r)) << 4)) : (unsigned)(SB_VOFF + r * 64 + (((q & 3) ^ sb_keyV(r & 31)) << 4));
#pragma unroll
        for (int i = 0; i < SB_SPAN; ++i) if (i < nblk) *(LAS u32x4*)(lds + dst + i * 4096) = st[i];
    }
    __syncthreads();
    f32x16 o0, o1;
#pragma unroll
    for (int r = 0; r < 16; ++r) { o0[r] = 0.f; o1[r] = 0.f; }
    float R = 1.f;
#define SB_MATH(KC, VC, kb_) do { \
        f32x16 z; \
        _Pragma("unroll") for (int r = 0; r < 16; ++r) z[r] = 0.f; \
        _Pragma("unroll") for (int s = 0; s < 4; ++s) z = MFMA32(KC[s], qf[s], z); \
        float beta[16], omb[16]; \
        const bool diag = ((kb_) == qt); \
        _Pragma("unroll") for (int r = 0; r < 16; ++r) { \
            const float zz = z[r]; const float t = __builtin_amdgcn_exp2f(-__builtin_fabsf(zz)); const float rr = __builtin_amdgcn_rcpf(1.f + t); const float sm = t * rr; \
            const bool pos = zz >= 0.f; float be = pos ? rr : sm; float om = pos ? sm : rr; \
            if (diag) { const bool valid = (16 * hi + r) < il; be = valid ? be : 0.f; om = valid ? om : 1.f; } \
            beta[r] = be; omb[r] = om; } \
        float e[16]; e[15] = 1.f; \
        _Pragma("unroll") for (int r = 14; r >= 0; --r) e[r] = e[r + 1] * omb[r + 1]; \
        const float P16 = e[0] * omb[0]; \
        float Plo, Phi; swap32(P16, Plo, Phi); \
        const float base = R * (hi ? 1.f : Phi); \
        float a[16]; \
        _Pragma("unroll") for (int r = 0; r < 16; ++r) a[r] = beta[r] * e[r] * base; \
        R = R * (Plo * Phi); \
        const bf16x8 p0 = pack8(a), p1 = pack8(a + 8); \
        o0 = MFMA32(VC[0][0], p0, o0); o0 = MFMA32(VC[0][1], p1, o0); \
        o1 = MFMA32(VC[1][0], p0, o1); o1 = MFMA32(VC[1][1], p1, o1); } while (0)
    bool fin = false;
    {
        const unsigned kbase = (unsigned)(pil * 128), vbase = (unsigned)(SB_VOFF + pil * 64);
        unsigned kx[4], vx[2];
#pragma unroll
        for (int s = 0; s < 4; ++s) kx[s] = (unsigned)(((4 * hi + s) ^ sb_keyK(pil)) << 4);
#pragma unroll
        for (int s = 0; s < 2; ++s) vx[s] = (unsigned)(((2 * hi + s) ^ sb_keyV(pil)) << 4);
        for (int kb = qt; ; --kb) {
            const unsigned so = (unsigned)(kb - lo) * 4096u;
            bf16x8 kf[4], vf[2][2];
#pragma unroll
            for (int s = 0; s < 4; ++s) kf[s] = *(const LAS bf16x8*)(lds + so + kbase + kx[s]);
#pragma unroll
            for (int dt = 0; dt < 2; ++dt)
#pragma unroll
                for (int s = 0; s < 2; ++s) vf[dt][s] = *(const LAS bf16x8*)(lds + so + vbase + dt * 2048 + vx[s]);
            SB_MATH(kf, vf, kb);
            if (kb == 0 || __all(R == 0.f)) { fin = true; break; }
            if (kb == lo) break;
        }
    }
    if (!fin) {
        for (int kb = lo - 1; ; --kb) {
            bf16x8 kf[4], vf[2][2];
            const bf16* kp = SK + ((size_t)b * SEQ + (size_t)kb * 32 + pil) * 512 + h * 64 + 32 * hi;
#pragma unroll
            for (int s = 0; s < 4; ++s) kf[s] = *(const bf16x8*)(kp + 8 * s);
            const bf16* vp = TT + ((size_t)(b * (SEQ / 32) + kb) * NB + h * 64 + pil) * 32 + 16 * hi;
#pragma unroll
            for (int dt = 0; dt < 2; ++dt)
#pragma unroll
                for (int s = 0; s < 2; ++s) vf[dt][s] = *(const bf16x8*)(vp + dt * 32 * 32 + 8 * s);
            SB_MATH(kf, vf, kb);
            if (kb == 0 || __all(R == 0.f)) break;
        }
    }
#undef SB_MATH
    float ss = 0.f;
#pragma unroll
    for (int r = 0; r < 16; ++r) ss += o0[r] * o0[r] + o1[r] * o1[r];
    float slo, shi; swap32(ss, slo, shi);
    const float rstd = __builtin_amdgcn_rsqf((slo + shi) * (1.f / 64.f) + EPS);
    bf16* op = MIX + (row0 + il) * DM + h * 64 + 16 * hi;
#pragma unroll
    for (int dt = 0; dt < 2; ++dt) {
        float v[16];
#pragma unroll
        for (int r4 = 0; r4 < 4; ++r4) { const f32x4 g = *(const f32x4*)(gout + 32 * dt + 16 * hi + 4 * r4);
#pragma unroll
            for (int e2 = 0; e2 < 4; ++e2) v[4 * r4 + e2] = (dt ? o1[4 * r4 + e2] : o0[4 * r4 + e2]) * rstd * g[e2]; }
        *(bf16x8*)(op + 32 * dt) = pack8(v); *(bf16x8*)(op + 32 * dt + 8) = pack8(v + 8);
    }
    __syncthreads();
}

__device__ __forceinline__ void gla_a(const bf16* GLR, const bf16* W2T, const float* gate_b, const bf16* TT, bf16* KV, float* DTOT, int bh, int j, int lane) {
    const int il = lane & 31, hi = lane >> 5, pil = PI32(il);
    const int b = bh >> 2, h = bh & 3;
    const size_t t0 = (size_t)b * SEQ + (size_t)j * 64;
    bf16x8 gf[2], wf[2], gkf[2][2][2], bvf[4][4]; float bias[2];
#pragma unroll
    for (int ch = 0; ch < 2; ++ch) gf[ch] = *(const bf16x8*)(GLR + (t0 + 32 * ch + pil) * 16 + 8 * hi);
#pragma unroll
    for (int kh = 0; kh < 2; ++kh) { const int kcol = 64 * h + 32 * kh + pil; wf[kh] = *(const bf16x8*)(W2T + kcol * 16 + 8 * hi); bias[kh] = gate_b[kcol];
        const bf16* gkp = TT + ((t0 >> 5) * NB + 512 + kcol) * 32 + 16 * hi;
#pragma unroll
        for (int ch = 0; ch < 2; ++ch) { gkf[kh][ch][0] = *(const bf16x8*)(gkp + ch * NB * 32); gkf[kh][ch][1] = *(const bf16x8*)(gkp + ch * NB * 32 + 8); } }
#pragma unroll
    for (int vq = 0; vq < 4; ++vq) { const bf16* vp = TT + ((t0 >> 5) * NB + 768 + 128 * h + 32 * vq + il) * 32 + 16 * hi;
#pragma unroll
        for (int s = 0; s < 4; ++s) bvf[vq][s] = *(const bf16x8*)(vp + (s >> 1) * NB * 32 + 8 * (s & 1)); }
    bf16x8 akf[2][4];
#pragma unroll
    for (int kh = 0; kh < 2; ++kh) {
        const int kcol = 64 * h + 32 * kh + pil;
        float cs[2][16];
#pragma unroll
        for (int ch = 0; ch < 2; ++ch) {
            f32x16 g;
#pragma unroll
            for (int r = 0; r < 16; ++r) g[r] = 0.f;
            g = MFMA32(gf[ch], wf[kh], g);
            if (kh == 0 && ch == 0) asm volatile("" : "+v"(g) :: "memory");
            float run = 0.f;
#pragma unroll
            for (int r = 0; r < 16; ++r) { const float x = g[r] + bias[kh];
                const float ls2 = __builtin_fminf(x, 0.f) * LOG2E - __builtin_amdgcn_logf(1.f + __builtin_amdgcn_exp2f(-__builtin_fabsf(x) * LOG2E));
                run += ls2 * (1.f / 16.f); cs[ch][r] = run; }
        }
        float t0lo, t0hi, t1lo, t1hi; swap32(cs[0][15], t0lo, t0hi); swap32(cs[1][15], t1lo, t1hi);
        const float off0 = hi ? t0lo : 0.f, off1 = (t0lo + t0hi) + (hi ? t1lo : 0.f), total = (t0lo + t0hi) + (t1lo + t1hi);
        if (hi == 0) DTOT[((size_t)bh * 32 + j) * 64 + 32 * kh + pil] = __builtin_amdgcn_exp2f(total);
#pragma unroll
        for (int ch = 0; ch < 2; ++ch) {
            const bf16x8 k0 = gkf[kh][ch][0], k1 = gkf[kh][ch][1];
            float kd[16]; const float off = ch ? off1 : off0;
#pragma unroll
            for (int r = 0; r < 16; ++r) { const float dec = __builtin_amdgcn_exp2f(total - (cs[ch][r] + off)); kd[r] = bf2f(r < 8 ? k0[r] : k1[r - 8]) * dec; }
            akf[kh][2 * ch] = pack8(kd); akf[kh][2 * ch + 1] = pack8(kd + 8);
        }
    }
#pragma unroll
    for (int vq = 0; vq < 4; ++vq) {
#pragma unroll
        for (int kh = 0; kh < 2; ++kh) {
            f32x16 kv;
#pragma unroll
            for (int r = 0; r < 16; ++r) kv[r] = 0.f;
#pragma unroll
            for (int s = 0; s < 4; ++s) kv = MFMA32(akf[kh][s], bvf[vq][s], kv);
            bf16* dst = KV + (((size_t)bh * 32 + j) * 128 + 32 * vq + il) * 64 + 32 * kh + 16 * hi;
            float kvf[16];
#pragma unroll
            for (int r = 0; r < 16; ++r) kvf[r] = kv[r];
            *(bf16x8*)dst = pack8(kvf); *(bf16x8*)(dst + 8) = pack8(kvf + 8);
        }
    }
}
__device__ __forceinline__ void gla_b(const bf16* KV, const float* DTOT, bf16* ST, int task, int lane) {
    const int bh = task >> 5, part = task & 31; const int e0 = part * 256 + lane * 4; const int k = e0 & 63;
    f32x4 S = (f32x4){0.f, 0.f, 0.f, 0.f};
#pragma unroll
    for (int half = 0; half < 2; ++half) {
        u32x2 kvp[16]; f32x4 d[16];
#pragma unroll
        for (int q = 0; q < 16; ++q) { const int j = 16 * half + q;
            kvp[q] = *(const u32x2*)(KV + ((size_t)bh * 32 + j) * 8192 + e0); d[q] = *(const f32x4*)(DTOT + ((size_t)bh * 32 + j) * 64 + k); }
#pragma unroll
        for (int q = 0; q < 16; ++q) { const int j = 16 * half + q;
            const f32x4 kv = (f32x4){__uint_as_float(kvp[q].x << 16), __uint_as_float(kvp[q].x & 0xffff0000u), __uint_as_float(kvp[q].y << 16), __uint_as_float(kvp[q].y & 0xffff0000u)};
            S = d[q] * S + kv;
            u32x2 w; w.x = cvtpk(S[0], S[1]); w.y = cvtpk(S[2], S[3]);
            *(u32x2*)(ST + ((size_t)bh * 32 + j) * 8192 + e0) = w; }
        asm volatile("" ::: "memory");
    }
}
__device__ __forceinline__ void gla_c(LAS unsigned char* wl, const bf16* ST, const bf16* GQ, const bf16* GRS, const float* gn, bf16* MIX, int bh, int j, int lane) {
    const int il = lane & 31, hi = lane >> 5, pil = PI32(il);
    const int b = bh >> 2, h = bh & 3;
    const size_t t0 = (size_t)b * SEQ + (size_t)j * 64;
    const bf16* sp = ST + ((size_t)bh * 32 + j) * 8192 + lane * 8;
    u32x4 st[16];
#pragma unroll
    for (int i = 0; i < 16; ++i) st[i] = *(const u32x4*)(sp + i * 512);
    bf16x8 bq[2][4], gr[2][4][2];
#pragma unroll
    for (int ch = 0; ch < 2; ++ch) { const size_t row = t0 + 32 * ch + il;
#pragma unroll
        for (int s = 0; s < 4; ++s) bq[ch][s] = *(const bf16x8*)(GQ + row * 256 + 64 * h + 16 * s + 8 * hi); }
    { const size_t row = t0 + il;
#pragma unroll
      for (int vt = 0; vt < 4; ++vt) { gr[0][vt][0] = *(const bf16x8*)(GRS + row * 512 + 128 * h + 32 * vt + 16 * hi); gr[0][vt][1] = *(const bf16x8*)(GRS + row * 512 + 128 * h + 32 * vt + 16 * hi + 8); } }
    { const int vr = lane >> 3, c = lane & 7;
#pragma unroll
      for (int i = 0; i < 16; ++i) { const int v = 8 * i + vr; *(LAS u32x4*)(wl + v * 128 + ((c ^ sb_keyK(v & 31)) << 4)) = st[i]; } }
    LDS_WAIT(); asm volatile("" ::: "memory");
    unsigned ax[4];
#pragma unroll
    for (int s = 0; s < 4; ++s) ax[s] = (unsigned)(pil * 128 + (((2 * s + hi) ^ sb_keyK(pil)) << 4));
#pragma unroll
    for (int ch = 0; ch < 2; ++ch) {
        const size_t row = t0 + 32 * ch + il;
        f32x16 O[4]; float ss = 0.f;
#pragma unroll
        for (int vt = 0; vt < 4; ++vt) {
#pragma unroll
            for (int r = 0; r < 16; ++r) O[vt][r] = 0.f;
#pragma unroll
            for (int s = 0; s < 4; ++s) { const bf16x8 af = *(const LAS bf16x8*)(wl + vt * 4096 + ax[s]); O[vt] = MFMA32(af, bq[ch][s], O[vt]); }
            if (ch == 0 && vt == 0) {
                const size_t row1 = t0 + 32 + il;
#pragma unroll
                for (int v2 = 0; v2 < 4; ++v2) { gr[1][v2][0] = *(const bf16x8*)(GRS + row1 * 512 + 128 * h + 32 * v2 + 16 * hi); gr[1][v2][1] = *(const bf16x8*)(GRS + row1 * 512 + 128 * h + 32 * v2 + 16 * hi + 8); }
                asm volatile("" : "+v"(O[0]) :: "memory"); }
#pragma unroll
            for (int r = 0; r < 16; ++r) ss += O[vt][r] * O[vt][r];
        }
        float slo, shi; swap32(ss, slo, shi);
        const float rstd = __builtin_amdgcn_rsqf((slo + shi) * (1.f / 128.f) + EPS);
#pragma unroll
        for (int vt = 0; vt < 4; ++vt) {
            const int vc0 = 32 * vt + 16 * hi;
            float v[16];
#pragma unroll
            for (int r4 = 0; r4 < 4; ++r4) { const f32x4 g = *(const f32x4*)(gn + vc0 + 4 * r4);
#pragma unroll
                for (int e2 = 0; e2 < 4; ++e2) { const int r = 4 * r4 + e2; v[r] = O[vt][r] * rstd * g[e2] * bf2f(r < 8 ? gr[ch][vt][0][r] : gr[ch][vt][1][r - 8]); } }
            bf16* op = MIX + row * DM + 512 + 128 * h + vc0;
            *(bf16x8*)(op) = pack8(v); *(bf16x8*)(op + 8) = pack8(v + 8);
        }
    }
    LDS_WAIT(); asm volatile("" ::: "memory");
}

constexpr int NWAVES = 8;
constexpr int N_PHASES = 10;
struct Args { Ptrs p; int ph_lo, ph_hi; };

__global__ void __launch_bounds__(NWAVES * 64, 2) fwd_kernel(Args args) {
    extern __shared__ __attribute__((aligned(16))) unsigned char lds_raw[];
    LAS unsigned char* lds = (LAS unsigned char*)lds_raw;
    const Ptrs& P = args.p;
    const int tid = threadIdx.x, lane = tid & 63, wave = __builtin_amdgcn_readfirstlane(tid >> 6);
    const int G = gridDim.x; const int bx = blockIdx.x; const int vcu = (G % 8 == 0) ? (bx % 8) * (G / 8) + bx / 8 : bx;
    const int gw = vcu * NWAVES + wave, NGW = G * NWAVES;
    unsigned char* ws = P.ws;
    gu32* ctl = (gu32*)(ws + WS_CTL);
    volatile LAS unsigned* MISC = (volatile LAS unsigned*)(lds + MISC_OFF);
    LAS int* tab = (LAS int*)(lds + TAB_OFF);
    for (int u = tid; u < (LDS_BYTES - LDSCTL_OFF) / 4; u += NWAVES * 64) ((LAS unsigned*)(lds + LDSCTL_OFF))[u] = 0u;
    __syncthreads();
    XcdBarrier bar; bar.bar = (unsigned*)(ctl + CW_BAR); bar.x = 0; bar.st = nullptr;
    if (MK_N_LAUNCHES == 1) bar = xcd_barrier_post((unsigned*)(ctl + CW_BAR), MISC + 8);
#define GRID_BAR() do { if (MK_N_LAUNCHES == 1) xcd_barrier(bar); } while (0)
    const int lo = args.ph_lo, hi_ph = args.ph_hi;
#ifndef PHASE_MASK
#define PHASE_MASK 0x3ff
#endif
#define IN(k) (((PHASE_MASK >> (k)) & 1) && lo <= (k) && (k) < hi_ph)
#define BOTH(k) (IN(k) && IN((k) + 1))
#ifndef PROBE_TWICE
#define PROBE_TWICE -1
#endif
#define REP(k) for (int rep_ = 0; rep_ < ((PROBE_TWICE == (k)) ? 2 : 1); ++rep_)
#define REPBAR(k) do { if (PROBE_TWICE == (k) && rep_ == 0) GRID_BAR(); } while (0)

    bf16* WA = (bf16*)(ws + WS_WA); bf16* WB = (bf16*)(ws + WS_WB); bf16* WO = (bf16*)(ws + WS_WO);
    bf16* WRH = (bf16*)(ws + WS_WR); bf16* WRL = WRH + 48 * 1024; bf16* W2T = (bf16*)(ws + WS_W2T);
    bf16* WGU = (bf16*)(ws + WS_WGU); bf16* WD = (bf16*)(ws + WS_WD);
    bf16* H = (bf16*)(ws + WS_H); bf16* KV = (bf16*)(ws + WS_KV);
    bf16* XB = (bf16*)(ws + WS_XB); bf16* MIX = (bf16*)(ws + WS_MIX); float* RSTD1 = (float*)(ws + WS_RSTD1);
    bf16* SQ = (bf16*)(ws + WS_SQ); bf16* SK = (bf16*)(ws + WS_SK); bf16* GQ = (bf16*)(ws + WS_GQ); bf16* GRS = (bf16*)(ws + WS_GRS);
    bf16* TT = (bf16*)(ws + WS_TT); bf16* GLR = (bf16*)(ws + WS_GLR); bf16* ST = (bf16*)(ws + WS_ST); float* DTOT = (float*)(ws + WS_DTOT);
    unsigned char* ACT = ws + WS_ACT; unsigned char* Y = ws + WS_Y;
    unsigned char* WGU8 = ws + WS_WGU; unsigned char* WD8 = ws + WS_WD; unsigned char* H8 = ws + WS_H8;
    unsigned* LOCL = (unsigned*)(ws + WS_LOCL); unsigned* CNTS = (unsigned*)(ws + WS_CNTS); float* GATE = (float*)(ws + WS_GATE); float* RSTD = (float*)(ws + WS_RSTD);

    if (IN(0)) { REP(0) {
        LAS float* scr = (LAS float*)(lds + RING_OFF + wave * 16384);
        constexpr int I_A = (NA / 32) * 16, I_B = (NB / 32) * 16, I_O = 32 * 16, I_GU = 32 * 32 * 16, I_D = 32 * 32 * 8;
        constexpr int NITEMS = I_A + I_B + I_O + I_GU;
        for (int it = gw; it < NITEMS; it += NGW) {
            int r = it;
            if (r < I_A) { const int ib = r >> 4, kb = r & 15, P0 = 32 * ib; const int pn = P0 >> 8, bj = (P0 >> 7) & 1, wcc = (P0 >> 5) & 3; const int LA = 256 * pn + 64 * wcc + 32 * bj;
                const int sc = LA < 1024 ? LA : (LA < 1280 ? 1536 + (LA - 1024) : 2560 + (LA - 1280));
                tr_item(P.w_in, IN_DIM, 64 * kb, sc, WA, P0, DM, P.attn_g, scr, lane); continue; } r -= I_A;
            if (r < I_B) { const int ib = r >> 4, kb = r & 15, P0 = 32 * ib; const int sc = P0 < 512 ? 1024 + P0 : (P0 < 768 ? 1792 + (P0 - 512) : 2048 + (P0 - 768));
                tr_item(P.w_in, IN_DIM, 64 * kb, sc, WB, P0, DM, P.attn_g, scr, lane); continue; } r -= I_B;
            if (r < I_O) { const int ib = r >> 4, kb = r & 15; tr_item(P.w_out, DM, 64 * kb, 32 * ib, WO, 32 * ib, DM, nullptr, scr, lane); continue; } r -= I_O;
            if (r < I_GU) { const int e = r >> 9, q = r & 511, ib = 4 * (q >> 6) + (q & 3), kb = 2 * ((q >> 3) & 7) + ((q >> 2) & 1), P0 = 32 * ib; const int pn = P0 >> 8, bj = (P0 >> 7) & 1, r0 = P0 & 127;
                const float* src = (bj ? P.wu : P.wg) + (size_t)e * DM * DEXP;
                tr_item8(src, DEXP, 64 * kb, 128 * pn + r0, WGU8 + (size_t)e * DM * DM, P0, DM, P.ffn_g, WGU_SC, scr, lane); continue; }
        }
        (void)I_D;
        for (int idx = gw * 64 + lane; idx < 48 * 1024; idx += NGW * 64) {
            const int rho = idx >> 10, k = idx & 1023, m = rho >> 4, i = rho & 15;
            float v = (m < 2) ? P.re_w[k * 32 + 8 * (i >> 2) + 4 * m + (i & 3)] : P.rg_w[k * 4 + (i & 3)];
            v *= P.ffn_g[k];
            WRH[idx] = __builtin_bit_cast(unsigned short, (_Float16)v);
        }
        for (int idx = gw * 64 + lane; idx < 256 * 16; idx += NGW * 64) { const int kc = idx >> 4, r = idx & 15; W2T[idx] = (bf16)(cvtpk(P.w2[r * 256 + kc], 0.f) & 0xffffu); }
        __syncthreads();
        constexpr int WLP = 1032;
        LAS bf16* wl = (LAS bf16*)(lds + RING_OFF);
        for (int idx = tid; idx < 16 * 1024; idx += NWAVES * 64) { const int c = idx & 15, k = idx >> 4; wl[c * WLP + k] = (bf16)(cvtpk(P.attn_g[k] * P.w_in[(size_t)k * IN_DIM + 3072 + c], 0.f) & 0xffffu); }
        __syncthreads();
        {
            for (int task = gw; task < NTOK / 16; task += NGW) {
                const size_t row0 = (size_t)task * 16;
                f32x4 cur[4], nxt[4]; float rsv = 0.f;
#pragma unroll
                for (int j = 0; j < 4; ++j) { cur[j] = __builtin_nontemporal_load((const GAS f32x4*)(P.x + row0 * DM) + lane + 64 * j); nxt[j] = cur[j]; }
#pragma unroll 2
                for (int r = 0; r < 16; ++r) {
                    if (r < 15) {
#pragma unroll
                        for (int j = 0; j < 4; ++j) nxt[j] = __builtin_nontemporal_load((const GAS f32x4*)(P.x + (row0 + r + 1) * DM) + lane + 64 * j); }
                    float s2 = 0.f;
#pragma unroll
                    for (int j = 0; j < 4; ++j) s2 += (cur[j].x * cur[j].x + cur[j].y * cur[j].y) + (cur[j].z * cur[j].z + cur[j].w * cur[j].w);
                    const float rstd = __builtin_amdgcn_rsqf(wave_sum(s2) * (1.f / DM) + EPS);
                    if ((lane & 15) == r) rsv = rstd;
                    GAS unsigned long long* o8 = (GAS unsigned long long*)(XB + (row0 + r) * DM) + lane;
#pragma unroll
                    for (int j = 0; j < 4; ++j) { const f32x4 v = cur[j];
                        o8[64 * j] = (unsigned long long)cvtpk(v.x, v.y) | ((unsigned long long)cvtpk(v.z, v.w) << 32); }
#pragma unroll
                    for (int j = 0; j < 4; ++j) cur[j] = nxt[j];
                }
                if (lane < 16) RSTD1[row0 + lane] = rsv;
                VM_WAIT();
                const int fr = lane & 15, fq = lane >> 4;
                f32x4 acc = (f32x4){0.f, 0.f, 0.f, 0.f};
                const bf16* up = XB + (row0 + fr) * DM + 8 * fq;
#pragma unroll 8
                for (int ks = 0; ks < 32; ++ks) { const bf16x8 ub = *(const bf16x8*)(up + 32 * ks); const bf16x8 wb = *(const LAS bf16x8*)(wl + fr * WLP + 32 * ks + 8 * fq); acc = MFMA16(wb, ub, acc); }
                u32x2 o; o.x = cvtpk(acc[0] * rsv, acc[1] * rsv); o.y = cvtpk(acc[2] * rsv, acc[3] * rsv);
                *(u32x2*)(GLR + (row0 + fr) * 16 + 4 * fq) = o;
            }
        }
        __syncthreads();
        REPBAR(0); }
        if (BOTH(0)) GRID_BAR();
    }

#define PH1_BODY() do { \
        { pg8::SchedDense S; S.init(XB, WA, NTOK, NA, DM, G, bx); \
          pg8::EpiA E{SQ, SK, GQ, GRS, P.sbq_g, P.sbk_g, RSTD1}; \
          pg8::gemm_phase<pg8::EpiA, pg8::SchedDense>(lds + RING_OFF, DM, S, E); } \
        { pg8::SchedDense S; S.init(WB, XB, NB, NTOK, DM, G, (bx + G / 2) % G); \
          pg8::EpiTT E{TT, RSTD1}; \
          pg8::gemm_phase<pg8::EpiTT, pg8::SchedDense>(lds + RING_OFF, DM, S, E); } } while (0)
    if (IN(1)) {
        if (PROBE_TWICE == 1) { PH1_BODY(); GRID_BAR(); }
        PH1_BODY();
        if (BOTH(1)) GRID_BAR();
    }

#define SB_ROUND(rho_) do { for (int u__ = (rho_) * G + vcu; u__ < 1024; u__ += 4 * G) { const int bh_ = u__ & 127; \
        sb_round(lds + RING_OFF, SQ, SK, TT, P.sbo_g + (bh_ & 7) * 64, MIX, bh_ >> 3, bh_ & 7, u__ >> 7, tid, wave, lane); } } while (0)
#define REPX(code) for (int rx_ = 0; rx_ < ((PROBE_TWICE == (code)) ? 5 : 1); ++rx_)
#define BAR_ARRIVE() do { if (MK_N_LAUNCHES == 1) xcd_barrier_arrive(bar, MISC + 12); } while (0)
#define BAR_WAIT() do { if (MK_N_LAUNCHES == 1) xcd_barrier_wait(bar, MISC + 12); } while (0)
    if (IN(2)) {
        for (int t = gw; t < 2048; t += NGW) gla_a(GLR, W2T, P.gate_b, TT, KV, DTOT, t >> 5, t & 31, lane);
        if (BOTH(2)) BAR_ARRIVE();
        SB_ROUND(0);
        if (BOTH(2)) BAR_WAIT();
    }
    if (IN(3)) {
        for (int t = gw; t < 2048; t += NGW) gla_b(KV, DTOT, ST, t, lane);
        if (BOTH(3)) BAR_ARRIVE();
        SB_ROUND(1);
        if (BOTH(3)) BAR_WAIT();
    }
    if (IN(4)) {
        for (int t = gw; t < 2048; t += NGW) gla_c(lds + RING_OFF + wave * 16384, ST, GQ, GRS, P.glan_g, MIX, t >> 5, t & 31, lane);
        __syncthreads();
        SB_ROUND(2); SB_ROUND(3);
        if (BOTH(4)) GRID_BAR();
    }

#define PH5_BODY() do { \
        pg8::SchedDense S; S.init(MIX, WO, NTOK, DM, DM, G, bx); \
        pg8::EpiH E{XB, H, H8}; \
        pg8::gemm_phase<pg8::EpiH, pg8::SchedDense>(lds + RING_OFF, DM, S, E); } while (0)
    if (IN(5)) {
        if (PROBE_TWICE == 5) { PH5_BODY(); GRID_BAR(); }
        PH5_BODY();
        if (BOTH(5)) GRID_BAR();
    }

    if (IN(6)) { REP(6) {
        constexpr int WP = 1032;
        LAS unsigned short* wl16 = (LAS unsigned short*)(lds + RING_OFF);
        LAS unsigned* lcount = (LAS unsigned*)(lds + RING_OFF + 48 * WP * 2);
        for (int idx = tid; idx < 48 * 128; idx += NWAVES * 64) { const int row = idx >> 7, c = idx & 127; *(LAS u32x4*)(wl16 + row * WP + 8 * c) = *(const u32x4*)(WRH + row * 1024 + 8 * c); }
        const int fr = lane & 15, fq = lane >> 4;
        for (int it = 0; it * G < NGRP; ++it) {
            const int grp = it * G + vcu;
            const int tile = grp * 8 + wave; const int ntile = NGRP * 8;
            if (tid < 32) lcount[tid] = 0u;
            __syncthreads();
            bool owner = false; int e1 = 0, e2 = 0; unsigned lr1 = 0, lr2 = 0; int tok = 0;
            if (tile < ntile) {
                tok = tile * 16 + fr;
                const bf16* hp = H + (size_t)tok * DM + 8 * fq;
                f32x4 acc[3]; acc[0] = acc[1] = acc[2] = (f32x4){0.f, 0.f, 0.f, 0.f};
                float ssq = 0.f;
#pragma unroll 1
                for (int half = 0; half < 2; ++half) {
                    bf16x8 hb[16];
#pragma unroll
                    for (int q = 0; q < 16; ++q) hb[q] = *(const bf16x8*)(hp + 32 * (16 * half + q));
#pragma unroll
                    for (int q = 0; q < 16; ++q) { const int ks = 16 * half + q;
                        float f[8];
#pragma unroll
                        for (int e = 0; e < 8; ++e) { f[e] = bf2f(hb[q][e]); ssq += f[e] * f[e]; }
                        f16x8 hh;
#pragma unroll
                        for (int e = 0; e < 8; ++e) hh[e] = (_Float16)f[e];
#pragma unroll
                        for (int m = 0; m < 3; ++m) { const f16x8 wv = *(const LAS f16x8*)(wl16 + (16 * m + fr) * WP + 32 * ks + 8 * fq);
                            acc[m] = __builtin_amdgcn_mfma_f32_16x16x32_f16(wv, hh, acc[m], 0, 0, 0); }
                    }
                }
                ssq += __shfl_xor(ssq, 16); ssq += __shfl_xor(ssq, 32);
                const float rstd = __builtin_amdgcn_rsqf(ssq * (1.f / DM) + EPS);
                float gl[4];
#pragma unroll
                for (int r = 0; r < 4; ++r) gl[r] = acc[2][r] * rstd + P.rg_b[r];
                int gsel = 0; float gmax = gl[0];
#pragma unroll
                for (int r = 1; r < 4; ++r) if (gl[r] > gmax) { gmax = gl[r]; gsel = r; }
                float gden = 0.f;
#pragma unroll
                for (int r = 0; r < 4; ++r) gden += __builtin_amdgcn_exp2f((gl[r] - gmax) * LOG2E);
                const float pgrp = 1.f / gden;
                float el[8];
#pragma unroll
                for (int r = 0; r < 4; ++r) { el[r] = acc[0][r] * rstd + P.re_b[8 * fq + r]; el[4 + r] = acc[1][r] * rstd + P.re_b[8 * fq + 4 + r]; }
                int i1 = 0; float l1 = el[0];
#pragma unroll
                for (int r = 1; r < 8; ++r) if (el[r] > l1) { l1 = el[r]; i1 = r; }
                int i2 = -1; float l2 = -3.0e38f;
#pragma unroll
                for (int r = 0; r < 8; ++r) if (r != i1 && el[r] > l2) { l2 = el[r]; i2 = r; }
                const float ex = __builtin_amdgcn_exp2f((l2 - l1) * LOG2E);
                const float p1 = 1.f / (1.f + ex), p2 = ex * p1;
                owner = (fq == gsel);
                if (owner) {
                    e1 = 8 * gsel + i1; e2 = 8 * gsel + i2;
                    lr1 = __hip_atomic_fetch_add(lcount + e1, 1u, __ATOMIC_RELAXED, __HIP_MEMORY_SCOPE_WORKGROUP);
                    lr2 = __hip_atomic_fetch_add(lcount + e2, 1u, __ATOMIC_RELAXED, __HIP_MEMORY_SCOPE_WORKGROUP);
                    RSTD[tok] = rstd; GATE[2 * tok] = pgrp * p1; GATE[2 * tok + 1] = pgrp * p2;
                }
            }
            __syncthreads();
            if (grp < NGRP) {
                if (tid < 32) CNTS[grp * 32 + tid] = lcount[tid];
                if (owner) { LOCL[((size_t)grp * 32 + e1) * 128 + lr1] = 2u * tok; LOCL[((size_t)grp * 32 + e2) * 128 + lr2] = 2u * tok + 1u; }
            }
            __syncthreads();
        }
        REPBAR(6); }
        if (BOTH(6)) GRID_BAR();
    }

    if (IN(7) || IN(8)) {
        LAS int* pre = (LAS int*)(lds + RING_OFF);
        LAS int* segsum = pre + NGRP * 32;
        for (int i = tid; i < NGRP * 32; i += NWAVES * 64) pre[i] = (int)CNTS[i];
        __syncthreads();
        { const int e = tid & 31, seg = tid >> 5; int run = 0;
          for (int g = seg * 16; g < seg * 16 + 16; ++g) { const int c = pre[g * 32 + e]; pre[g * 32 + e] = run; run += c; }
          segsum[seg * 32 + e] = run; }
        __syncthreads();
        { const int e = tid & 31, seg = tid >> 5; int off = 0, tot = 0;
          for (int q = 0; q < 16; ++q) { const int v = segsum[q * 32 + e]; if (q < seg) off += v; tot += v; }
          for (int g = seg * 16; g < seg * 16 + 16; ++g) pre[g * 32 + e] += off;
          if (seg == 0) tab[T_CNT / 4 + e] = tot; }
        __syncthreads();
        if (tid == 0) { int tb = 0; for (int e = 0; e < 32; ++e) { tab[T_TBASE / 4 + e] = tb; tb += (tab[T_CNT / 4 + e] + 255) >> 8; } tab[T_TBASE / 4 + 32] = tb; tab[T_NT / 4] = tb; }
        __syncthreads();
        { const int NT = tab[T_NT / 4];
          for (int t = tid; t < NT; t += NWAVES * 64) { int e = 0; for (int q = 0; q < 32; ++q) if (tab[T_TBASE / 4 + q] <= t && t < tab[T_TBASE / 4 + q + 1]) e = q; tab[T_TILE_E / 4 + t] = e; } }
        __syncthreads();
        { pg8::SchedMoE<false> S0; S0.A = nullptr; S0.Bt = nullptr; S0.K = 0; S0.bstride = 0; S0.G = G; S0.c = vcu; S0.tab = tab;
          const int half = tid >> 8, r = tid & 255; unsigned vals[NU_MAX / 2]; bool ok[NU_MAX / 2];
#pragma unroll
          for (int k = 0; k < NU_MAX / 2; ++k) { const int ui = 2 * k + half; pg8::Unit u; ok[k] = S0.next(ui, u); vals[k] = 0u;
              if (ok[k]) { const int cnt = tab[T_CNT / 4 + u.e], e = u.e; int p = u.rt * 256 + r; if (p > cnt - 1) p = cnt - 1;
                  int lo_ = 0, hi_ = NGRP - 1;
                  while (lo_ < hi_) { const int mid = (lo_ + hi_ + 1) >> 1; if (pre[mid * 32 + e] <= p) lo_ = mid; else hi_ = mid - 1; }
                  vals[k] = LOCL[((size_t)lo_ * 32 + e) * 128 + (p - pre[lo_ * 32 + e])]; } }
#pragma unroll
          for (int k = 0; k < NU_MAX / 2; ++k) if (ok[k]) tab[T_ROWTAB / 4 + (2 * k + half) * 256 + r] = (int)vals[k];
        }
        __syncthreads();
    }
#define PH7_BODY() do { \
        pg8::SchedMoE<true> S; S.A = (const char*)H8; S.Bt = (const char*)WGU8; S.K = DM / 2; S.bstride = (size_t)DM * DM; S.G = G; S.c = vcu; S.tab = tab; \
        pg8::EpiGU E{ACT, RSTD, tab}; \
        pg8::gemm_phase<pg8::EpiGU, pg8::SchedMoE<true>, false, true>(lds + RING_OFF, DM / 2, S, E); } while (0)
    if (IN(7)) {
        if (PROBE_TWICE == 7) { PH7_BODY(); GRID_BAR(); }
        PH7_BODY();
        {
            const int NT4 = tab[T_NT / 4] * 4, remu = NT4 % G;
            const bool early = (remu == 0) || (vcu >= remu); const int nE = (remu == 0) ? G : (G - remu), rank = (remu == 0) ? vcu : (vcu - remu);
            if (early) { LAS float* scr = (LAS float*)(lds + RING_OFF + wave * 16384);
                for (int r = rank * NWAVES + wave; r < 32 * 32 * 8; r += nE * NWAVES) {
                    const int e = r >> 8, q = r & 255, nb = 4 * (q >> 5) + (q & 3), kb = 2 * ((q >> 3) & 3) + ((q >> 2) & 1);
                    tr_item8(P.wd + (size_t)e * DEXP * DM, DM, 64 * kb, 32 * nb, WD8 + (size_t)e * DM * DEXP, 32 * nb, DEXP, nullptr, WD_SC, scr, lane); } }
        }
        if (BOTH(7)) GRID_BAR();
    }
    if (IN(8)) { REP(8) {
        pg8::SchedMoE<false> S; S.A = (const char*)ACT; S.Bt = (const char*)WD8; S.K = DEXP / 2; S.bstride = (size_t)DM * DEXP; S.G = G; S.c = vcu; S.tab = tab;
        pg8::EpiDown E{Y, tab};
        pg8::gemm_phase<pg8::EpiDown, pg8::SchedMoE<false>, false, true>(lds + RING_OFF, DEXP / 2, S, E);
        REPBAR(8); }
        if (BOTH(8)) GRID_BAR();
    }
    if (IN(9)) { REP(9) {
        for (int m0 = gw; m0 < NTOK; m0 += 2 * NGW) {
            bf16x8 hv[2][2]; u32x4 ya[2], yb[2]; float g0[2], g1[2];
#pragma unroll
            for (int t = 0; t < 2; ++t) { int m = m0 + t * NGW; if (m >= NTOK) m = m0;
                g0[t] = GATE[2 * m] * (1.f / Y_SC); g1[t] = GATE[2 * m + 1] * (1.f / Y_SC);
                const bf16* hp = H + (size_t)m * DM + 16 * lane; const unsigned char* y0 = Y + (size_t)(2 * m) * DM + 16 * lane;
                hv[t][0] = *(const bf16x8*)(hp); hv[t][1] = *(const bf16x8*)(hp + 8); ya[t] = *(const u32x4*)(y0); yb[t] = *(const u32x4*)(y0 + DM); }
#pragma unroll
            for (int t = 0; t < 2; ++t) { const int m = m0 + t * NGW; if (m < NTOK) {
                float* op = P.out + (size_t)m * DM + 16 * lane;
#pragma unroll
                for (int q = 0; q < 4; ++q) { const unsigned wa = ya[t][q], wb = yb[t][q];
                    const f32x2_t a0 = __builtin_amdgcn_cvt_pk_f32_fp8((int)wa, false), a1 = __builtin_amdgcn_cvt_pk_f32_fp8((int)wa, true);
                    const f32x2_t b0 = __builtin_amdgcn_cvt_pk_f32_fp8((int)wb, false), b1 = __builtin_amdgcn_cvt_pk_f32_fp8((int)wb, true);
                    const bf16x8 hh = hv[t][q >> 1]; const int e0 = 4 * (q & 1);
                    f32x4 o; o[0] = bf2f(hh[e0]) + g0[t] * a0.x + g1[t] * b0.x; o[1] = bf2f(hh[e0 + 1]) + g0[t] * a0.y + g1[t] * b0.y;
                    o[2] = bf2f(hh[e0 + 2]) + g0[t] * a1.x + g1[t] * b1.x; o[3] = bf2f(hh[e0 + 3]) + g0[t] * a1.y + g1[t] * b1.y;
                    *(f32x4*)(op + 4 * q) = o; } } }
        }
    REPBAR(9); } }
#undef IN
#undef BOTH
}

extern "C" void kernel_launch(void* const* d_in, const int* in_sizes, int n_in, void* d_out, int out_size, void* d_ws, size_t ws_size, hipStream_t stream) {
    static int grid = 0;
    if (grid == 0) {
        if (n_in != 18 || in_sizes[0] != NTOK * DM || out_size != NTOK * DM || ws_size < WS_END) { fprintf(stderr, "kernel_launch: unexpected shapes / workspace (n_in %d, in0 %d, out %d, ws %zu, need %zu)\n", n_in, n_in > 0 ? in_sizes[0] : -1, out_size, ws_size, (size_t)WS_END); grid = -1; return; }
        int dev = 0, cus = 0, per_cu = 0;
        if (hipGetDevice(&dev) != hipSuccess || hipDeviceGetAttribute(&cus, hipDeviceAttributeMultiprocessorCount, dev) != hipSuccess) { grid = -1; return; }
        if (hipFuncSetAttribute((const void*)fwd_kernel, hipFuncAttributeMaxDynamicSharedMemorySize, LDS_BYTES) != hipSuccess) { fprintf(stderr, "kernel_launch: hipFuncSetAttribute failed\n"); grid = -1; return; }
        if (hipOccupancyMaxActiveBlocksPerMultiprocessor(&per_cu, (const void*)fwd_kernel, NWAVES * 64, LDS_BYTES) != hipSuccess || per_cu < 1) fprintf(stderr, "kernel_launch: occupancy query reports %d\n", per_cu);
        (void)hipGetLastError();
        grid = cus;
    }
    if (grid < 0) return;
    if (hipMemsetAsync((char*)d_ws + WS_CTL, 0, CTL_ZERO_BYTES, stream) != hipSuccess) return;
    Args a{};
    const float** pp = (const float**)&a.p;
    for (int i = 0; i < 18; ++i) pp[i] = (const float*)d_in[i];
    a.p.out = (float*)d_out; a.p.ws = (unsigned char*)d_ws;
    if (MK_N_LAUNCHES == 1) { a.ph_lo = 0; a.ph_hi = N_PHASES; hipLaunchKernelGGL(fwd_kernel, dim3(grid), dim3(NWAVES * 64), LDS_BYTES, stream, a); }
    else for (int li = 0; li < N_PHASES; ++li) { a.ph_lo = li; a.ph_hi = li + 1; hipLaunchKernelGGL(fwd_kernel, dim3(grid), dim3(NWAVES * 64), LDS_BYTES, stream, a); }
}
```

```cpp
#include <hip/hip_runtime.h>
#include <cstdio>
#include <cstdint>

#ifndef MK_N_LAUNCHES
#define MK_N_LAUNCHES 1
#endif

#define LAS __attribute__((address_space(3)))
#define GAS __attribute__((address_space(1)))
typedef unsigned short bf16;
typedef short bf16x8 __attribute__((ext_vector_type(8)));
typedef float f32x4 __attribute__((ext_vector_type(4)));
typedef float f32x16 __attribute__((ext_vector_type(16)));
typedef unsigned u32x4 __attribute__((ext_vector_type(4)));
typedef unsigned u32x2 __attribute__((ext_vector_type(2)));
typedef float f32x2_t __attribute__((ext_vector_type(2)));
typedef __bf16 bf16x2_t __attribute__((ext_vector_type(2)));
typedef GAS unsigned gu32;
typedef int v8i __attribute__((ext_vector_type(8)));
typedef int v4i __attribute__((ext_vector_type(4)));
typedef _Float16 f16x8 __attribute__((ext_vector_type(8)));
typedef _Float16 f16x2 __attribute__((ext_vector_type(2)));

constexpr int BATCH = 16, SEQ = 2048, DM = 1024, NTOK = BATCH * SEQ;
constexpr int IN_DIM = 3088;
constexpr int NEXP = 32, DEXP = 512;
constexpr float EPS = 1e-6f;
constexpr float LOG2E = 1.4426950408889634f;
constexpr float WGU_SC = 64.f, WD_SC = 32.f, ACT_SC = 8.f, Y_SC = 8.f;
constexpr int NA = 1792, NB = 1280;
constexpr int NGRP = NTOK / 128;

constexpr size_t MiB = 1u << 20;
constexpr size_t WS_CTL = 0, CTL_ZERO_BYTES = 64 * 1024;
constexpr size_t WS_WA = 2 * MiB;
constexpr size_t WS_WB = 6 * MiB;
constexpr size_t WS_WO = 9 * MiB;
constexpr size_t WS_WR = 11 * MiB;
constexpr size_t WS_W2T = WS_WR + 2 * 48 * 1024 * 2;
constexpr size_t WS_WGU = 12 * MiB;
constexpr size_t WS_WD = 76 * MiB;
constexpr size_t WS_H = 108 * MiB;
constexpr size_t WS_KV = WS_H;
constexpr size_t WS_XB = 44 * MiB;
constexpr size_t WS_MIX = 172 * MiB;
constexpr size_t WS_SQ = 236 * MiB;
constexpr size_t WS_SK = 268 * MiB;
constexpr size_t WS_GQ = 300 * MiB;
constexpr size_t WS_GRS = 316 * MiB;
constexpr size_t WS_TT = 348 * MiB;
constexpr size_t WS_GLR = 428 * MiB;
constexpr size_t WS_ST = 429 * MiB;
constexpr size_t WS_DTOT = 461 * MiB;
constexpr size_t WS_ACT = 236 * MiB;
constexpr size_t WS_H8 = 272 * MiB;
constexpr size_t WS_Y = 308 * MiB;
constexpr size_t WS_LOCL = 462 * MiB;
constexpr size_t WS_CNTS = 467 * MiB;
constexpr size_t WS_GATE = 470 * MiB;
constexpr size_t WS_RSTD = WS_GATE + 512 * 1024;
constexpr size_t WS_RSTD1 = WS_GATE + 768 * 1024;
constexpr size_t WS_END = 472 * MiB;
constexpr int CW_TMO = 0, CW_CODE = 1;
constexpr int CW_BAR = 4096;
constexpr int CW_CNT = 16384;

constexpr int RING_OFF = 0, RING_BYTES = 131072;
constexpr int LDSCTL_OFF = RING_BYTES, MISC_OFF = LDSCTL_OFF + 320;
constexpr int TAB_OFF = LDSCTL_OFF + 1024;
constexpr int LDS_BYTES = 147456;
constexpr int T_CNT = 0, T_TBASE = 128, T_NT = 264, T_TILE_E = 272, T_ROWTAB = 272 + 320 * 4, NU_MAX = 6;
constexpr int T_RSTAB = T_ROWTAB + NU_MAX * 1024;
static_assert(TAB_OFF + T_RSTAB + NU_MAX * 256 * 4 <= LDS_BYTES, "LDS tables");

#define RLX_AGENT __ATOMIC_RELAXED, __HIP_MEMORY_SCOPE_AGENT
#define LDS_WAIT() asm volatile("s_waitcnt lgkmcnt(0)" ::: "memory")
#define VM_WAIT() asm volatile("s_waitcnt vmcnt(0)" ::: "memory")

__device__ __forceinline__ unsigned cvtpk(float lo, float hi) { f32x2_t v = {lo, hi}; bf16x2_t b = __builtin_convertvector(v, bf16x2_t); return __builtin_bit_cast(unsigned, b); }
__device__ __forceinline__ u32x2 pack8_fp8(const float* a) { int lo = __builtin_amdgcn_cvt_pk_fp8_f32(a[0], a[1], 0, false); lo = __builtin_amdgcn_cvt_pk_fp8_f32(a[2], a[3], lo, true);
    int hi = __builtin_amdgcn_cvt_pk_fp8_f32(a[4], a[5], 0, false); hi = __builtin_amdgcn_cvt_pk_fp8_f32(a[6], a[7], hi, true); u32x2 r; r.x = (unsigned)lo; r.y = (unsigned)hi; return r; }
__device__ __forceinline__ float bf2f(short s) { return __uint_as_float(((unsigned)(unsigned short)s) << 16); }
__device__ __forceinline__ bf16x8 pack8(const float* a) { u32x4 p; p.x = cvtpk(a[0], a[1]); p.y = cvtpk(a[2], a[3]); p.z = cvtpk(a[4], a[5]); p.w = cvtpk(a[6], a[7]); return __builtin_bit_cast(bf16x8, p); }
__device__ __forceinline__ int PI32(int i) { return 16 * ((i >> 2) & 1) + (i & 3) + 4 * (i >> 3); }
#define MFMA32(a, b, c) __builtin_amdgcn_mfma_f32_32x32x16_bf16((a), (b), (c), 0, 0, 0)
#define MFMA16(a, b, c) __builtin_amdgcn_mfma_f32_16x16x32_bf16((a), (b), (c), 0, 0, 0)
__device__ __forceinline__ void swap32(float x, float& lo, float& hi) { auto rr = __builtin_amdgcn_permlane32_swap(__float_as_uint(x), __float_as_uint(x), false, false); lo = __uint_as_float(rr[0]); hi = __uint_as_float(rr[1]); }

namespace pg8 {
#define PG8_LAS __attribute__((address_space(3)))
constexpr int BM = 256, BK = 64, HALF = 128, HTB = HALF * BK * 2, STAGE_BYTES = 8 * HTB, NXCD = 8, WGM = 8;
__host__ __device__ __forceinline__ int lds_byte(int r, int c) { const int st = (r >> 4) * 2 + (c >> 5), rr = r & 15, cc = c & 31, ob = rr * 64 + cc * 2; return st * 1024 + (ob ^ (((ob >> 9) & 1) << 5)); }
__host__ __device__ __forceinline__ void stage_rc(int b, int& R, int& C) { const int st = b / 1024, sb = b % 1024, swz = sb ^ (((sb >> 9) & 1) << 5); R = (st >> 1) * 16 + swz / 64; C = (st & 1) * 32 + (swz % 64) / 2; }
__host__ __device__ __forceinline__ int perm32(int rho) { const int n = rho >> 4, i = rho & 15; return 8 * (i >> 2) + 4 * n + (i & 3); }

struct Unit { int pm, pn, e, rt, nv; };

struct SchedDense {
    const char* A; const char* Bt; int K; int nM, nN, nwg, G, c;
    __device__ void init(const void* A_, const void* Bt_, int M, int N, int K_, int G_, int c_) { A = (const char*)A_; Bt = (const char*)Bt_; K = K_; nM = M / BM; nN = N / BM; nwg = nM * nN; G = G_; c = c_; }
    __device__ __forceinline__ bool next(int i, Unit& u) const {
        const long L = (long)i * G + c; if (L >= nwg) return false;
        int wgid = (int)L; { const int q = nwg / NXCD, r = nwg % NXCD, xcd = wgid % NXCD, off = wgid / NXCD; wgid = (xcd < r ? xcd * (q + 1) : r * (q + 1) + (xcd - r) * q) + off; }
        const int nig = WGM * nN, gid = wgid / nig, fm = gid * WGM, gsz = (nM - fm) < WGM ? (nM - fm) : WGM;
        u.pm = fm + ((wgid % nig) % gsz); u.pn = (wgid % nig) / gsz; u.e = 0; u.rt = 0; u.nv = 256; return true;
    }
    __device__ __forceinline__ const char* a_ptr(const Unit& u) const { return A + (size_t)u.pm * BM * K * 2; }
    __device__ __forceinline__ const char* b_ptr(const Unit& u) const { return Bt + (size_t)u.pn * BM * K * 2; }
    __device__ __forceinline__ void a_voff(int, const Unit&, int tid, unsigned (&v)[2][2]) const {
#pragma unroll
        for (int i = 0; i < 2; ++i) { int R, C; stage_rc(tid * 16 + i * 8192, R, C);
#pragma unroll
            for (int h = 0; h < 2; ++h) v[h][i] = (unsigned)((h * HALF + R) * K + C) * 2u; }
    }
};
template <bool GATHER> struct SchedMoE {
    const char* A; const char* Bt; int K; size_t bstride; int G, c;
    const PG8_LAS int* tab;
    __device__ __forceinline__ bool next(int i, Unit& u) const {
        const int L = i * G + c; const int NT = tab[T_NT / 4];
        if (L >= NT * 4) return false;
        const int tile = L >> 2; u.pm = tile; u.pn = L & 3; const int e = tab[T_TILE_E / 4 + tile]; u.e = e;
        u.rt = tile - tab[T_TBASE / 4 + e]; const int rem = tab[T_CNT / 4 + e] - u.rt * 256; u.nv = rem < 256 ? rem : 256; return true;
    }
    __device__ __forceinline__ const char* a_ptr(const Unit& u) const { return GATHER ? A : A + (size_t)u.pm * BM * K * 2; }
    __device__ __forceinline__ const char* b_ptr(const Unit& u) const { return Bt + (size_t)u.e * bstride + (size_t)u.pn * BM * K * 2; }
    __device__ __forceinline__ void a_voff(int ui, const Unit&, int tid, unsigned (&v)[2][2]) const {
        asm volatile("" : "+v"(tid));
#pragma unroll
        for (int i = 0; i < 2; ++i) { int R, C; stage_rc(tid * 16 + i * 8192, R, C);
#pragma unroll
            for (int h = 0; h < 2; ++h) {
                if (GATHER) { const int tok = tab[T_ROWTAB / 4 + ui * 256 + h * HALF + R] >> 1; v[h][i] = (unsigned)(tok * K + C) * 2u; }
                else v[h][i] = (unsigned)((h * HALF + R) * K + C) * 2u; } }
    }
};

template <class Epi, class Sched, bool TAIL = false, bool FP8 = false>
__device__ __forceinline__ void gemm_phase(PG8_LAS unsigned char* lds, const int K, const Sched& S, const Epi& E) {
    const int tid = threadIdx.x, wid = __builtin_amdgcn_readfirstlane(tid >> 6), lane = tid & 63, wr = wid >> 2, wc = wid & 3, fr = lane & 15, fq = lane >> 4;
    const int nt = K / BK;
    unsigned voffB[1][2];
#pragma unroll
    for (int i = 0; i < 2; ++i) { int R, C; stage_rc(tid * 16 + i * 8192, R, C); const int Rb = (R & ~31) + perm32(R & 31);
        voffB[0][i] = (unsigned)(Rb * K + C) * 2u; }
    const size_t hstepB = (size_t)HALF * K * 2;
    const size_t kstep = (size_t)(BK * 2);
    const unsigned ldsw = (unsigned)wid * 1024u;
    const int aoff = lds_byte(wr * 64 + fr, fq * 8), boff = lds_byte(wc * 32 + fr, fq * 8);
#define PG8_SA(b, h) (((b) * 2 + (h)) * HTB)
#define PG8_SB(b, h) ((4 + (b) * 2 + (h)) * HTB)
#define PG8_STAGE(bufoff, gbase, voff) do { _Pragma("unroll") for (int _i = 0; _i < 2; ++_i) \
        __builtin_amdgcn_global_load_lds((const unsigned*)((const char*)(gbase) + (voff)[_i]), (PG8_LAS unsigned*)(lds + (bufoff) + ldsw + _i * 8192), 16, 0, 0); } while (0)
#define PG8_RD16(off) (*(const PG8_LAS v4i*)(lds + (off)))
#define PG8_LDA(dst, b, h) do { _Pragma("unroll") for (int m = 0; m < 4; ++m) { \
        if constexpr (FP8) At8[m] = __builtin_shufflevector(PG8_RD16(PG8_SA(b, h) + aoff + m * 2048), PG8_RD16(PG8_SA(b, h) + aoff + m * 2048 + 1024), 0, 1, 2, 3, 4, 5, 6, 7); \
        else { _Pragma("unroll") for (int k = 0; k < 2; ++k) dst[m][k] = *(const PG8_LAS bf16x8*)(lds + PG8_SA(b, h) + aoff + m * 2048 + k * 1024); } } } while (0)
#define PG8_LDB(dst, b, h) do { _Pragma("unroll") for (int n = 0; n < 2; ++n) { \
        if constexpr (FP8) dst##8[n] = __builtin_shufflevector(PG8_RD16(PG8_SB(b, h) + boff + n * 2048), PG8_RD16(PG8_SB(b, h) + boff + n * 2048 + 1024), 0, 1, 2, 3, 4, 5, 6, 7); \
        else { _Pragma("unroll") for (int k = 0; k < 2; ++k) dst[n][k] = *(const PG8_LAS bf16x8*)(lds + PG8_SB(b, h) + boff + n * 2048 + k * 1024); } } } while (0)
#define PG8_MMA(ai, bj, At, Bt) do { __builtin_amdgcn_s_setprio(1); _Pragma("unroll") for (int m = 0; m < 4; ++m) _Pragma("unroll") for (int n = 0; n < 2; ++n) { \
        if constexpr (FP8) asm volatile("v_mfma_scale_f32_16x16x128_f8f6f4 %0, %1, %2, %0, %3, %3 op_sel_hi:[0,0,0]" : "+v"(acc[ai][bj][m][n]) : "v"(Bt##8[n]), "v"(At8[m]), "v"(sc1)); \
        else { _Pragma("unroll") for (int k = 0; k < 2; ++k) acc[ai][bj][m][n] = __builtin_amdgcn_mfma_f32_16x16x32_bf16(Bt[n][k], At[m][k], acc[ai][bj][m][n], 0, 0, 0); } } \
        __builtin_amdgcn_s_setprio(0); } while (0)
#define PG8_WAIT_V(n) asm volatile("s_waitcnt vmcnt(" #n ")" ::: "memory")
#define PG8_WAIT_L(n) asm volatile("s_waitcnt lgkmcnt(" #n ")" ::: "memory")
#define PG8_BAR __builtin_amdgcn_s_barrier()
#define PG8_SCHED __builtin_amdgcn_sched_barrier(0)
    Unit cur, nxt; int ui = 0;
    if (!S.next(0, cur)) return;
    f32x4 acc[2][2][4][2];
#pragma unroll
    for (int a = 0; a < 2; ++a)
#pragma unroll
        for (int b = 0; b < 2; ++b)
#pragma unroll
            for (int m = 0; m < 4; ++m)
#pragma unroll
                for (int n = 0; n < 2; ++n) acc[a][b][m][n] = (f32x4){0.f, 0.f, 0.f, 0.f};
    bf16x8 At[4][2], B0[2][2], B1[2][2];
    v8i At8[4], B08[2], B18[2];
    int sc1 = 0x7f7f7f7f; asm volatile("" : "+v"(sc1));
    unsigned vc[2][2], vn[2][2];
    S.a_voff(0, cur, tid, vc);
    const char* cA = S.a_ptr(cur); const char* cB = S.b_ptr(cur);
    PG8_STAGE(PG8_SB(0, 0), cB, voffB[0]); PG8_STAGE(PG8_SB(0, 1), (cB) + hstepB, voffB[0]); PG8_STAGE(PG8_SA(0, 0), cA, vc[0]); PG8_STAGE(PG8_SA(0, 1), cA, vc[1]);
    if (wr == 1) PG8_BAR;
    PG8_WAIT_V(2); PG8_BAR;
    PG8_STAGE(PG8_SB(1, 0), cB + kstep, voffB[0]); PG8_STAGE(PG8_SA(1, 0), cA + kstep, vc[0]); PG8_STAGE(PG8_SB(1, 1), (cB + kstep) + hstepB, voffB[0]);
    PG8_WAIT_V(6); PG8_BAR;
    for (;;) {
        const bool has_next = S.next(ui + 1, nxt);
        const char* nA = has_next ? S.a_ptr(nxt) : cA; const char* nB = has_next ? S.b_ptr(nxt) : cB;
        if (has_next) S.a_voff(ui + 1, nxt, tid, vn);
        else {
#pragma unroll
            for (int h = 0; h < 2; ++h)
#pragma unroll
                for (int i = 0; i < 2; ++i) vn[h][i] = vc[h][i]; }
        const bool full_hi = !TAIL || cur.nv > HALF;
        for (int t = 0; t < nt; t += 2) {
            const bool last = (t == nt - 2);
            const char* a1 = cA + (size_t)(t + 1) * kstep;
            const char* a2 = last ? nA : cA + (size_t)(t + 2) * kstep; const char* b2 = last ? nB : cB + (size_t)(t + 2) * kstep;
            const char* a3 = a2 + kstep; const char* b3 = b2 + kstep;
            unsigned w0[2], w1[2];
            w0[0] = last ? vn[0][0] : vc[0][0]; w0[1] = last ? vn[0][1] : vc[0][1]; w1[0] = last ? vn[1][0] : vc[1][0]; w1[1] = last ? vn[1][1] : vc[1][1];
            PG8_LDB(B0, 0, 0); PG8_LDB(B1, 0, 1); PG8_SCHED; PG8_LDA(At, 0, 0); PG8_STAGE(PG8_SA(1, 1), a1, vc[1]);
            PG8_WAIT_V(8); PG8_WAIT_L(0); PG8_BAR; PG8_MMA(0, 0, At, B0); PG8_MMA(0, 1, At, B1); PG8_BAR; PG8_SCHED;
            PG8_LDA(At, 0, 1); PG8_STAGE(PG8_SB(0, 0), b2, voffB[0]); PG8_STAGE(PG8_SB(0, 1), (b2) + hstepB, voffB[0]); PG8_STAGE(PG8_SA(0, 0), a2, w0);
            PG8_WAIT_V(8); PG8_WAIT_L(0); PG8_BAR; if (full_hi) { PG8_MMA(1, 0, At, B0); PG8_MMA(1, 1, At, B1); } PG8_BAR; PG8_SCHED;
            PG8_LDB(B0, 1, 0); PG8_LDB(B1, 1, 1); PG8_SCHED; PG8_LDA(At, 1, 0); PG8_STAGE(PG8_SA(0, 1), a2, w1);
            PG8_WAIT_V(8); PG8_WAIT_L(0); PG8_BAR; PG8_MMA(0, 0, At, B0); PG8_MMA(0, 1, At, B1); PG8_BAR; PG8_SCHED;
            PG8_LDA(At, 1, 1); PG8_STAGE(PG8_SB(1, 0), b3, voffB[0]); PG8_STAGE(PG8_SB(1, 1), (b3) + hstepB, voffB[0]); PG8_STAGE(PG8_SA(1, 0), a3, w0);
            PG8_WAIT_V(8); PG8_WAIT_L(0); PG8_BAR; if (full_hi) { PG8_MMA(1, 0, At, B0); PG8_MMA(1, 1, At, B1); } PG8_BAR; PG8_SCHED;
        }
        if (wr == 0) PG8_BAR;
        if constexpr (FP8) asm volatile("s_nop 15\n\ts_nop 15" ::: "memory");
        { int t2_ = threadIdx.x; asm volatile("" : "+v"(t2_)); E(acc, cur, ui, wr, wc, t2_ & 15, (t2_ >> 4) & 3); }
        if (!has_next) break;
#pragma unroll
        for (int a = 0; a < 2; ++a)
#pragma unroll
            for (int b = 0; b < 2; ++b)
#pragma unroll
                for (int m = 0; m < 4; ++m)
#pragma unroll
                    for (int n = 0; n < 2; ++n) acc[a][b][m][n] = (f32x4){0.f, 0.f, 0.f, 0.f};
        cur = nxt; cA = nA; cB = nB; ++ui;
#pragma unroll
        for (int h = 0; h < 2; ++h)
#pragma unroll
            for (int i = 0; i < 2; ++i) vc[h][i] = vn[h][i];
        if (wr == 1) PG8_BAR;
    }
    PG8_WAIT_V(0);
    PG8_BAR;
#undef PG8_SA
#undef PG8_SB
#undef PG8_STAGE
#undef PG8_LDA
#undef PG8_LDB
#undef PG8_MMA
#undef PG8_RD16
#undef PG8_WAIT_V
#undef PG8_WAIT_L
#undef PG8_BAR
#undef PG8_SCHED
}

struct EpiBf16 {
    bf16* O; int ldc;
    __device__ __forceinline__ void operator()(const f32x4 (&acc)[2][2][4][2], const Unit& u, int, int wr, int wc, int fr, int fq) const {
        const int row0 = u.pm * BM + wr * 64 + fr, col0 = u.pn * BM + wc * 32 + 8 * fq;
#pragma unroll
        for (int ai = 0; ai < 2; ++ai)
#pragma unroll
            for (int m = 0; m < 4; ++m) { bf16* rowp = O + (size_t)(row0 + ai * HALF + m * 16) * ldc + col0;
#pragma unroll
                for (int bj = 0; bj < 2; ++bj) { const f32x4 v0 = acc[ai][bj][m][0], v1 = acc[ai][bj][m][1];
                    u32x4 w; w.x = cvtpk(v0[0], v0[1]); w.y = cvtpk(v0[2], v0[3]); w.z = cvtpk(v1[0], v1[1]); w.w = cvtpk(v1[2], v1[3]);
                    *(u32x4*)(rowp + bj * HALF) = w; } }
    }
};
struct EpiTT {
    bf16* O; const float* RS;
    __device__ __forceinline__ void operator()(const f32x4 (&acc)[2][2][4][2], const Unit& u, int, int wr, int wc, int fr, int fq) const {
        const int row0 = u.pm * BM + wr * 64 + fr, tokb0 = u.pn * 8 + wc;
        f32x4 rs[2][2];
#pragma unroll
        for (int bj = 0; bj < 2; ++bj) { const float* rp = RS + (size_t)(tokb0 + 4 * bj) * 32 + 8 * fq; rs[bj][0] = *(const f32x4*)rp; rs[bj][1] = *(const f32x4*)(rp + 4); }
#pragma unroll
        for (int ai = 0; ai < 2; ++ai)
#pragma unroll
            for (int m = 0; m < 4; ++m) { const int col = row0 + ai * HALF + m * 16;
#pragma unroll
                for (int bj = 0; bj < 2; ++bj) { const f32x4 v0 = acc[ai][bj][m][0] * rs[bj][0], v1 = acc[ai][bj][m][1] * rs[bj][1];
                    u32x4 w; w.x = cvtpk(v0[0], v0[1]); w.y = cvtpk(v0[2], v0[3]); w.z = cvtpk(v1[0], v1[1]); w.w = cvtpk(v1[2], v1[3]);
                    *(u32x4*)(O + ((size_t)(tokb0 + 4 * bj) * 1280 + col) * 32 + 8 * fq) = w; } }
    }
};
struct EpiA {
    bf16 *SQ, *SK, *GQ, *GRS; const float *gq_norm, *gk_norm; const float* RS;
    __device__ __forceinline__ void operator()(const f32x4 (&acc)[2][2][4][2], const Unit& u, int, int wr, int wc, int fr, int fq) const {
        const int pn = u.pn; const int row0 = u.pm * BM + wr * 64 + fr;
        bf16* base; int ldc, colt; int mode;
        float scale = 1.f; const float* gain = nullptr;
        if (pn < 2)      { base = SQ; ldc = 512; colt = pn * 256; mode = 0; gain = gq_norm; scale = 0.125f * LOG2E; }
        else if (pn < 4) { base = SK; ldc = 512; colt = (pn - 2) * 256; mode = 0; gain = gk_norm; scale = 1.f; }
        else if (pn < 5) { base = GQ; ldc = 256; colt = 0; mode = 1; scale = 0.125f; }
        else             { base = GRS; ldc = 512; colt = (pn - 5) * 256; mode = 2; }
        const int col0 = colt + wc * 64 + 8 * fq;
        f32x4 gv[2][2];
#pragma unroll
        for (int bj = 0; bj < 2; ++bj)
#pragma unroll
            for (int n = 0; n < 2; ++n) { if (mode == 0) { gv[bj][n] = *(const f32x4*)(gain + 32 * bj + 8 * fq + 4 * n); gv[bj][n] = gv[bj][n] * scale; } else gv[bj][n] = (f32x4){scale, scale, scale, scale}; }
        float rs1v[2][4];
#pragma unroll
        for (int ai = 0; ai < 2; ++ai)
#pragma unroll
            for (int m = 0; m < 4; ++m) rs1v[ai][m] = RS[row0 + ai * HALF + m * 16];
#pragma unroll
        for (int ai = 0; ai < 2; ++ai)
#pragma unroll
            for (int m = 0; m < 4; ++m) {
                const float rs1 = rs1v[ai][m]; float rs = rs1;
                if (mode == 0) { float s = 0.f;
#pragma unroll
                    for (int bj = 0; bj < 2; ++bj)
#pragma unroll
                        for (int n = 0; n < 2; ++n) { const f32x4 x = acc[ai][bj][m][n]; s += (x[0] * x[0] + x[1] * x[1]) + (x[2] * x[2] + x[3] * x[3]); }
                    s += __shfl_xor(s, 16); s += __shfl_xor(s, 32);
                    rs = rs1 * __builtin_amdgcn_rsqf(rs1 * rs1 * s * (1.f / 64.f) + EPS); }
                bf16* rowp = base + (size_t)(row0 + ai * HALF + m * 16) * ldc + col0;
#pragma unroll
                for (int bj = 0; bj < 2; ++bj) { f32x4 v0 = acc[ai][bj][m][0], v1 = acc[ai][bj][m][1];
                    if (mode == 2) {
#pragma unroll
                        for (int e = 0; e < 4; ++e) { v0[e] *= rs1; v1[e] *= rs1; v0[e] = v0[e] * __builtin_amdgcn_rcpf(1.f + __builtin_amdgcn_exp2f(-v0[e] * LOG2E)); v1[e] = v1[e] * __builtin_amdgcn_rcpf(1.f + __builtin_amdgcn_exp2f(-v1[e] * LOG2E)); }
                    } else { v0 = v0 * rs * gv[bj][0]; v1 = v1 * rs * gv[bj][1]; }
                    u32x4 w; w.x = cvtpk(v0[0], v0[1]); w.y = cvtpk(v0[2], v0[3]); w.z = cvtpk(v1[0], v1[1]); w.w = cvtpk(v1[2], v1[3]);
                    *(u32x4*)(rowp + bj * 32) = w; } }
    }
};
struct EpiH {
    const bf16* XB; bf16* H; unsigned char* H8;
    __device__ __forceinline__ void operator()(const f32x4 (&acc)[2][2][4][2], const Unit& u, int, int wr, int wc, int fr, int fq) const {
        const int row0 = u.pm * BM + wr * 64 + fr, col0 = u.pn * BM + wc * 32 + 8 * fq;
#pragma unroll
        for (int ai = 0; ai < 2; ++ai) {
            u32x2 h8[4][2];
            bf16x8 xv[4][2];
#pragma unroll
            for (int m = 0; m < 4; ++m) { const size_t off = (size_t)(row0 + ai * HALF + m * 16) * DM + col0;
#pragma unroll
                for (int bj = 0; bj < 2; ++bj) xv[m][bj] = *(const bf16x8*)(XB + off + bj * HALF); }
#pragma unroll
            for (int m = 0; m < 4; ++m) { const size_t off = (size_t)(row0 + ai * HALF + m * 16) * DM + col0;
#pragma unroll
                for (int bj = 0; bj < 2; ++bj) { const bf16x8 xx = xv[m][bj];
                    const f32x4 v0 = acc[ai][bj][m][0] + (f32x4){bf2f(xx[0]), bf2f(xx[1]), bf2f(xx[2]), bf2f(xx[3])}, v1 = acc[ai][bj][m][1] + (f32x4){bf2f(xx[4]), bf2f(xx[5]), bf2f(xx[6]), bf2f(xx[7])};
                    u32x4 w; w.x = cvtpk(v0[0], v0[1]); w.y = cvtpk(v0[2], v0[3]); w.z = cvtpk(v1[0], v1[1]); w.w = cvtpk(v1[2], v1[3]);
                    *(u32x4*)(H + off + bj * HALF) = w;
                    const float f8[8] = {v0[0], v0[1], v0[2], v0[3], v1[0], v1[1], v1[2], v1[3]};
                    h8[m][bj] = pack8_fp8(f8); } }
#pragma unroll
            for (int mp = 0; mp < 2; ++mp)
#pragma unroll
                for (int bj = 0; bj < 2; ++bj) {
                    const auto r0 = __builtin_amdgcn_permlane16_swap(h8[2 * mp][bj].x, h8[2 * mp + 1][bj].x, false, false);
                    const auto r1 = __builtin_amdgcn_permlane16_swap(h8[2 * mp][bj].y, h8[2 * mp + 1][bj].y, false, false);
                    u32x4 w8; w8.x = r0[0]; w8.y = r1[0]; w8.z = r0[1]; w8.w = r1[1];
                    const size_t off8 = (size_t)(row0 + ai * HALF + (2 * mp + (fq & 1)) * 16) * DM + u.pn * BM + wc * 32 + 8 * (fq & ~1) + bj * HALF;
                    *(u32x4*)(H8 + off8) = w8; }
        }
    }
};
struct EpiGU {
    unsigned char* ACT; const float* RSTD; const PG8_LAS int* tab;
    __device__ __forceinline__ void operator()(const f32x4 (&acc)[2][2][4][2], const Unit& u, int ui, int wr, int wc, int fr, int fq) const {
        const int col0 = u.pn * 128 + wc * 32 + 8 * (fq & ~1); const int odd = fq & 1;
        float rsv[2][4];
#pragma unroll
        for (int ai = 0; ai < 2; ++ai)
#pragma unroll
            for (int m = 0; m < 4; ++m) { const int rl = ai * HALF + wr * 64 + m * 16 + fr; rsv[ai][m] = ((const PG8_LAS float*)tab)[T_RSTAB / 4 + ui * 256 + rl] * (1.f / WGU_SC); }
#pragma unroll
        for (int ai = 0; ai < 2; ++ai)
#pragma unroll
            for (int mp = 0; mp < 2; ++mp) {
                u32x2 pk[2];
#pragma unroll
                for (int q = 0; q < 2; ++q) { const int m = 2 * mp + q; const float rs = rsv[ai][m];
                    f32x4 g0 = acc[ai][0][m][0] * rs, g1 = acc[ai][0][m][1] * rs, u0 = acc[ai][1][m][0] * rs, u1 = acc[ai][1][m][1] * rs;
#pragma unroll
                    for (int e = 0; e < 4; ++e) { g0[e] = g0[e] * __builtin_amdgcn_rcpf(1.f + __builtin_amdgcn_exp2f(-g0[e] * LOG2E)) * u0[e]; g1[e] = g1[e] * __builtin_amdgcn_rcpf(1.f + __builtin_amdgcn_exp2f(-g1[e] * LOG2E)) * u1[e]; }
                    float f8[8] = {g0[0] * ACT_SC, g0[1] * ACT_SC, g0[2] * ACT_SC, g0[3] * ACT_SC, g1[0] * ACT_SC, g1[1] * ACT_SC, g1[2] * ACT_SC, g1[3] * ACT_SC};
#pragma unroll
                    for (int e = 0; e < 8; ++e) f8[e] = __builtin_fminf(__builtin_fmaxf(f8[e], -448.f), 448.f);
                    pk[q] = pack8_fp8(f8); }
                const auto r0 = __builtin_amdgcn_permlane16_swap(pk[0].x, pk[1].x, false, false);
                const auto r1 = __builtin_amdgcn_permlane16_swap(pk[0].y, pk[1].y, false, false);
                u32x4 w; w.x = r0[0]; w.y = r1[0]; w.z = r0[1]; w.w = r1[1];
                const int rl = ai * HALF + wr * 64 + (2 * mp + odd) * 16 + fr;
                if (rl < u.nv) *(u32x4*)(ACT + (size_t)(u.pm * 256 + rl) * DEXP + col0) = w; }
    }
};
struct EpiDown {
    unsigned char* Y; const PG8_LAS int* tab;
    __device__ __forceinline__ void operator()(const f32x4 (&acc)[2][2][4][2], const Unit& u, int ui, int wr, int wc, int fr, int fq) const {
        const int col0 = u.pn * BM + wc * 32 + 8 * (fq & ~1); const float sc = Y_SC / (WD_SC * ACT_SC); const int odd = fq & 1;
#pragma unroll
        for (int ai = 0; ai < 2; ++ai)
#pragma unroll
            for (int mp = 0; mp < 2; ++mp) { const int rl = ai * HALF + wr * 64 + (2 * mp + odd) * 16 + fr;
                const bool ok = rl < u.nv; const unsigned ts = (unsigned)tab[T_ROWTAB / 4 + ui * 256 + (ok ? rl : 0)];
                unsigned char* rowp = Y + (size_t)ts * DM + col0;
#pragma unroll
                for (int bj = 0; bj < 2; ++bj) {
                    u32x2 pk[2];
#pragma unroll
                    for (int q = 0; q < 2; ++q) { const f32x4 v0 = acc[ai][bj][2 * mp + q][0] * sc, v1 = acc[ai][bj][2 * mp + q][1] * sc;
                        const float f8[8] = {v0[0], v0[1], v0[2], v0[3], v1[0], v1[1], v1[2], v1[3]}; pk[q] = pack8_fp8(f8); }
                    const auto r0 = __builtin_amdgcn_permlane16_swap(pk[0].x, pk[1].x, false, false);
                    const auto r1 = __builtin_amdgcn_permlane16_swap(pk[0].y, pk[1].y, false, false);
                    u32x4 w; w.x = r0[0]; w.y = r1[0]; w.z = r0[1]; w.w = r1[1];
                    if (ok) *(u32x4*)(rowp + bj * HALF) = w; } }
    }
};
}

#define XB_TMO      128
#define XB_XCNT(j)  (256  + 64 * (j))
#define XB_XSUB(j)  (1280 + 64 * (j))
#define XB_XGEN(j)  (2304 + 64 * (j))
#define XB_TOP      3328
#define XB_TOPGEN   3392
#define XCD_BAR_WORDS 3456
#define XB_SPIN_CAP (1u << 18)
__device__ __forceinline__ unsigned xb_ld(unsigned* p)              { return __hip_atomic_load(p, __ATOMIC_RELAXED, __HIP_MEMORY_SCOPE_AGENT); }
__device__ __forceinline__ unsigned xb_add(unsigned* p, unsigned v) { return __hip_atomic_fetch_add(p, v, __ATOMIC_RELAXED, __HIP_MEMORY_SCOPE_AGENT); }
__device__ __forceinline__ unsigned xb_xcc_id() { return (unsigned)__builtin_amdgcn_s_getreg((3 << 11) | 20) & 0xFu; }
#define XB_SPIN(cond, bar) do { unsigned _sp = 0; while (cond) { __builtin_amdgcn_s_sleep(1); \
    if ((++_sp & 255u) == 0u) { if (xb_ld(&(bar)[XB_TMO])) break; if (_sp > XB_SPIN_CAP) { atomicAdd(&(bar)[XB_TMO], 1u); break; } } } } while (0)
struct XcdBarrier { unsigned* bar; unsigned x; volatile LAS unsigned* st; };
__device__ __forceinline__ XcdBarrier xcd_barrier_post(unsigned* bar, volatile LAS unsigned* st) {
    XcdBarrier b; b.bar = bar; b.x = xb_xcc_id(); b.st = st;
    if (threadIdx.x == 0) (void)xb_add(&bar[XB_XCNT(b.x)], 1u);
    return b;
}
__device__ __forceinline__ void xcd_barrier_complete(unsigned* bar, unsigned x, unsigned& nloc, unsigned& nx) {
    const unsigned G = gridDim.x * gridDim.y * gridDim.z;
    unsigned sum, cnt, mine, sp = 0u;
    for (;;) {
        sum = 0u; cnt = 0u; mine = 0u;
#pragma unroll
        for (unsigned j = 0; j < 16; ++j) { const unsigned c = xb_ld(&bar[XB_XCNT(j)]); sum += c; cnt += (c > 0u) ? 1u : 0u; mine = (j == x) ? c : mine; }
        if (sum == G) break;
        __builtin_amdgcn_s_sleep(1);
        if ((++sp & 255u) == 0u) { if (xb_ld(&bar[XB_TMO])) break; if (sp > XB_SPIN_CAP) { atomicAdd(&bar[XB_TMO], 1u); break; } }
    }
    nloc = mine > 0u ? mine : 1u; nx = cnt > 0u ? cnt : 1u;
}
__device__ __forceinline__ void xcd_barrier(const XcdBarrier& b) {
    asm volatile("s_waitcnt vmcnt(0)" ::: "memory");
    __syncthreads();
    if (threadIdx.x == 0) {
        unsigned* bar = b.bar;
        __builtin_amdgcn_s_waitcnt(0);
        unsigned nloc = b.st[0], nx = b.st[1];
        if (nloc == 0u) { xcd_barrier_complete(bar, b.x, nloc, nx); b.st[0] = nloc; b.st[1] = nx; }
        const unsigned old = xb_add(&bar[XB_XSUB(b.x)], 1u);
        const unsigned gen = old / nloc;
        if (old + 1u == (gen + 1u) * nloc) {
            __builtin_amdgcn_fence(__ATOMIC_RELEASE, "agent");
            asm volatile("s_waitcnt vmcnt(0)" ::: "memory");
            const unsigned og = xb_add(&bar[XB_TOP], 1u);
            const unsigned tg = og / nx;
            if (og + 1u == (tg + 1u) * nx) xb_add(&bar[XB_TOPGEN], 1u);
            else XB_SPIN(xb_ld(&bar[XB_TOPGEN]) == tg, bar);
            __builtin_amdgcn_fence(__ATOMIC_ACQUIRE, "agent");
            xb_add(&bar[XB_XGEN(b.x)], 1u);
            asm volatile("s_waitcnt vmcnt(0)" ::: "memory");
        } else {
            XB_SPIN(xb_ld(&bar[XB_XGEN(b.x)]) == gen, bar);
            __builtin_amdgcn_fence(__ATOMIC_ACQUIRE, "agent");
            asm volatile("s_waitcnt vmcnt(0)" ::: "memory");
        }
    }
    __syncthreads();
}

__device__ __forceinline__ void xcd_barrier_arrive(const XcdBarrier& b, volatile LAS unsigned* sv) {
    asm volatile("s_waitcnt vmcnt(0)" ::: "memory");
    __syncthreads();
    if (threadIdx.x == 0) {
        unsigned* bar = b.bar;
        __builtin_amdgcn_s_waitcnt(0);
        unsigned nloc = b.st[0], nx = b.st[1];
        if (nloc == 0u) { xcd_barrier_complete(bar, b.x, nloc, nx); b.st[0] = nloc; b.st[1] = nx; }
        const unsigned old = xb_add(&bar[XB_XSUB(b.x)], 1u);
        const unsigned gen = old / nloc;
        unsigned role = 0u, tg = 0u;
        if (old + 1u == (gen + 1u) * nloc) {
            __builtin_amdgcn_fence(__ATOMIC_RELEASE, "agent");
            asm volatile("s_waitcnt vmcnt(0)" ::: "memory");
            const unsigned og = xb_add(&bar[XB_TOP], 1u);
            tg = og / nx;
            if (og + 1u == (tg + 1u) * nx) { xb_add(&bar[XB_TOPGEN], 1u); role = 2u; } else role = 1u;
        }
        sv[0] = role; sv[1] = gen; sv[2] = tg;
    }
}
__device__ __forceinline__ void xcd_barrier_wait(const XcdBarrier& b, volatile LAS unsigned* sv) {
    asm volatile("s_waitcnt vmcnt(0)" ::: "memory");
    __syncthreads();
    if (threadIdx.x == 0) {
        unsigned* bar = b.bar; const unsigned role = sv[0], gen = sv[1], tg = sv[2];
        if (role != 0u) {
            if (role == 1u) XB_SPIN(xb_ld(&bar[XB_TOPGEN]) == tg, bar);
            __builtin_amdgcn_fence(__ATOMIC_ACQUIRE, "agent");
            xb_add(&bar[XB_XGEN(b.x)], 1u);
            asm volatile("s_waitcnt vmcnt(0)" ::: "memory");
        } else {
            XB_SPIN(xb_ld(&bar[XB_XGEN(b.x)]) == gen, bar);
            __builtin_amdgcn_fence(__ATOMIC_ACQUIRE, "agent");
            asm volatile("s_waitcnt vmcnt(0)" ::: "memory");
        }
    }
    __syncthreads();
}

__device__ __forceinline__ float wave_sum(float v) {
#pragma unroll
    for (int o = 1; o < 64; o <<= 1) v += __shfl_xor(v, o);
    return v;
}
__device__ __forceinline__ void tr_item(const float* src, int srcN, int k0, int n0, bf16* dst, int drow0, int dK, const float* kscale, LAS float* scr, int lane) {
    float w[32];
    const float* sp = src + (size_t)(k0 + (lane >> 5)) * srcN + n0 + (lane & 31);
#pragma unroll
    for (int i = 0; i < 32; ++i) w[i] = __builtin_nontemporal_load(sp + (size_t)(2 * i) * srcN);
    if (kscale) { const float ksv = kscale[k0 + lane];
#pragma unroll
        for (int i = 0; i < 32; ++i) { const float a = __int_as_float(__builtin_amdgcn_readlane(__float_as_int(ksv), 2 * i)), b = __int_as_float(__builtin_amdgcn_readlane(__float_as_int(ksv), 2 * i + 1)); w[i] *= (lane >> 5) ? b : a; } }
#pragma unroll
    for (int i = 0; i < 32; ++i) scr[(2 * i + (lane >> 5)) * 33 + (lane & 31)] = w[i];
    LDS_WAIT(); asm volatile("" ::: "memory");
    const int c = lane & 7;
#pragma unroll
    for (int j = 0; j < 4; ++j) { const int n = (lane >> 3) + 8 * j; const LAS float* s = scr + (8 * c) * 33 + n;
        u32x4 o; o.x = cvtpk(s[0 * 33], s[1 * 33]); o.y = cvtpk(s[2 * 33], s[3 * 33]); o.z = cvtpk(s[4 * 33], s[5 * 33]); o.w = cvtpk(s[6 * 33], s[7 * 33]);
        *(GAS u32x4*)(dst + (size_t)(drow0 + n) * dK + k0 + 8 * c) = o; }
    LDS_WAIT(); asm volatile("" ::: "memory");
}

__device__ __forceinline__ void tr_item8(const float* src, int srcN, int k0, int n0, unsigned char* dst, int drow0, int dK, const float* kscale, float scale, LAS float* scr, int lane) {
    float w[32];
    const float* sp = src + (size_t)(k0 + (lane >> 5)) * srcN + n0 + (lane & 31);
#pragma unroll
    for (int i = 0; i < 32; ++i) w[i] = __builtin_nontemporal_load(sp + (size_t)(2 * i) * srcN);
    float ksv = scale; if (kscale) ksv *= kscale[k0 + lane];
#pragma unroll
    for (int i = 0; i < 32; ++i) { const float a = __int_as_float(__builtin_amdgcn_readlane(__float_as_int(ksv), 2 * i)), b = __int_as_float(__builtin_amdgcn_readlane(__float_as_int(ksv), 2 * i + 1)); w[i] *= (lane >> 5) ? b : a; }
#pragma unroll
    for (int i = 0; i < 32; ++i) scr[(2 * i + (lane >> 5)) * 33 + (lane & 31)] = w[i];
    LDS_WAIT(); asm volatile("" ::: "memory");
#pragma unroll
    for (int j = 0; j < 2; ++j) { const int idx = lane + 64 * j, n = idx >> 2, c = idx & 3; const LAS float* sc_ = scr + (16 * c) * 33 + n;
        float f[16];
#pragma unroll
        for (int i = 0; i < 16; ++i) f[i] = sc_[i * 33];
        const u32x2 lo = pack8_fp8(f), hi = pack8_fp8(f + 8);
        u32x4 o; o.x = lo.x; o.y = lo.y; o.z = hi.x; o.w = hi.y;
        *(GAS u32x4*)(dst + (size_t)(drow0 + n) * dK + k0 + 16 * c) = o; }
    LDS_WAIT(); asm volatile("" ::: "memory");
}

struct Ptrs {
    const float *x, *attn_g, *w_in, *sbq_g, *sbk_g, *sbo_g, *w2, *gate_b, *glan_g, *w_out, *ffn_g, *rg_w, *rg_b, *re_w, *re_b, *wg, *wu, *wd;
    float* out; unsigned char* ws;
};

constexpr int SB_SPAN = 14, SB_VOFF = SB_SPAN * 4096;
__device__ __forceinline__ int sb_keyK(int r) { return ((r >> 1) & 3) | (((r >> 4) & 1) << 2); }
__device__ __forceinline__ int sb_keyV(int r) { return ((r >> 2) & 1) | (((r >> 4) & 1) << 1); }
__device__ __forceinline__ void sb_round(LAS unsigned char* lds, const bf16* SQ, const bf16* SK, const bf16* TT, const float* gout, bf16* MIX, int b, int h, int qg, int tid, int wave, int lane) {
    const int il = lane & 31, hi = lane >> 5, pil = PI32(il);
    const int qt = 8 * qg + wave;
    const size_t row0 = (size_t)b * SEQ + (size_t)qt * 32;
    bf16x8 qf[4];
    { const bf16* qp = SQ + (row0 + il) * 512 + h * 64 + 32 * hi;
#pragma unroll
      for (int s = 0; s < 4; ++s) qf[s] = *(const bf16x8*)(qp + 8 * s); }
    const int lo = (8 * qg - 6) > 0 ? (8 * qg - 6) : 0, nblk = 8 * qg + 8 - lo;
    {
        u32x4 st[SB_SPAN];
        const bool isK = tid < 256; const int q = tid - 256;
        const bf16* src = isK ? SK + ((size_t)b * SEQ + (size_t)lo * 32 + (tid >> 3)) * 512 + h * 64 + 8 * (tid & 7)
                              : TT + ((size_t)(b * (SEQ / 32) + lo) * NB + h * 64 + (q >> 2)) * 32 + 8 * (q & 3);
        const size_t bstep = isK ? (size_t)32 * 512 : (size_t)NB * 32;
#pragma unroll
        for (int i = 0; i < SB_SPAN; ++i) if (i < nblk) st[i] = *(const u32x4*)(src + (size_t)i * bstep);
        const int r = isK ? (tid >> 3) : (q >> 2);
        const unsigned dst = isK ? (unsigned)(r * 128 + (((tid & 7) ^ sb_keyK(r)) << 4)) : (unsigned)(SB_VOFF + r * 64 + (((q & 3) ^ sb_keyV(r & 31)) << 4));
#pragma unroll
        for (int i = 0; i < SB_SPAN; ++i) if (i < nblk) *(LAS u32x4*)(lds + dst + i * 4096) = st[i];
    }
    __syncthreads();
    f32x16 o0, o1;
#pragma unroll
    for (int r = 0; r < 16; ++r) { o0[r] = 0.f; o1[r] = 0.f; }
    float R = 1.f;
#define SB_MATH(KC, VC, kb_) do { \
        f32x16 z; \
        _Pragma("unroll") for (int r = 0; r < 16; ++r) z[r] = 0.f; \
        _Pragma("unroll") for (int s = 0; s < 4; ++s) z = MFMA32(KC[s], qf[s], z); \
        float beta[16], omb[16]; \
        const bool diag = ((kb_) == qt); \
        _Pragma("unroll") for (int r = 0; r < 16; ++r) { \
            const float zz = z[r]; const float t = __builtin_amdgcn_exp2f(-__builtin_fabsf(zz)); const float rr = __builtin_amdgcn_rcpf(1.f + t); const float sm = t * rr; \
            const bool pos = zz >= 0.f; float be = pos ? rr : sm; float om = pos ? sm : rr; \
            if (diag) { const bool valid = (16 * hi + r) < il; be = valid ? be : 0.f; om = valid ? om : 1.f; } \
            beta[r] = be; omb[r] = om; } \
        float e[16]; e[15] = 1.f; \
        _Pragma("unroll") for (int r = 14; r >= 0; --r) e[r] = e[r + 1] * omb[r + 1]; \
        const float P16 = e[0] * omb[0]; \
        float Plo, Phi; swap32(P16, Plo, Phi); \
        const float base = R * (hi ? 1.f : Phi); \
        float a[16]; \
        _Pragma("unroll") for (int r = 0; r < 16; ++r) a[r] = beta[r] * e[r] * base; \
        R = R * (Plo * Phi); \
        const bf16x8 p0 = pack8(a), p1 = pack8(a + 8); \
        o0 = MFMA32(VC[0][0], p0, o0); o0 = MFMA32(VC[0][1], p1, o0); \
        o1 = MFMA32(VC[1][0], p0, o1); o1 = MFMA32(VC[1][1], p1, o1); } while (0)
    bool fin = false;
    {
        const unsigned kbase = (unsigned)(pil * 128), vbase = (unsigned)(SB_VOFF + pil * 64);
        unsigned kx[4], vx[2];
#pragma unroll
        for (int s = 0; s < 4; ++s) kx[s] = (unsigned)(((4 * hi + s) ^ sb_keyK(pil)) << 4);
#pragma unroll
        for (int s = 0; s < 2; ++s) vx[s] = (unsigned)(((2 * hi + s) ^ sb_keyV(pil)) << 4);
        for (int kb = qt; ; --kb) {
            const unsigned so = (unsigned)(kb - lo) * 4096u;
            bf16x8 kf[4], vf[2][2];
#pragma unroll
            for (int s = 0; s < 4; ++s) kf[s] = *(const LAS bf16x8*)(lds + so + kbase + kx[s]);
#pragma unroll
            for (int dt = 0; dt < 2; ++dt)
#pragma unroll
                for (int s = 0; s < 2; ++s) vf[dt][s] = *(const LAS bf16x8*)(lds + so + vbase + dt * 2048 + vx[s]);
            SB_MATH(kf, vf, kb);
            if (kb == 0 || __all(R == 0.f)) { fin = true; break; }
            if (kb == lo) break;
        }
    }
    if (!fin) {
        for (int kb = lo - 1; ; --kb) {
            bf16x8 kf[4], vf[2][2];
            const bf16* kp = SK + ((size_t)b * SEQ + (size_t)kb * 32 + pil) * 512 + h * 64 + 32 * hi;
#pragma unroll
            for (int s = 0; s < 4; ++s) kf[s] = *(const bf16x8*)(kp + 8 * s);
            const bf16* vp = TT + ((size_t)(b * (SEQ / 32) + kb) * NB + h * 64 + pil) * 32 + 16 * hi;
#pragma unroll
            for (int dt = 0; dt < 2; ++dt)
#pragma unroll
                for (int s = 0; s < 2; ++s) vf[dt][s] = *(const bf16x8*)(vp + dt * 32 * 32 + 8 * s);
            SB_MATH(kf, vf, kb);
            if (kb == 0 || __all(R == 0.f)) break;
        }
    }
#undef SB_MATH
    float ss = 0.f;
#pragma unroll
    for (int r = 0; r < 16; ++r) ss += o0[r] * o0[r] + o1[r] * o1[r];
    float slo, shi; swap32(ss, slo, shi);
    const float rstd = __builtin_amdgcn_rsqf((slo + shi) * (1.f / 64.f) + EPS);
    bf16* op = MIX + (row0 + il) * DM + h * 64 + 16 * hi;
#pragma unroll
    for (int dt = 0; dt < 2; ++dt) {
        float v[16];
#pragma unroll
        for (int r4 = 0; r4 < 4; ++r4) { const f32x4 g = *(const f32x4*)(gout + 32 * dt + 16 * hi + 4 * r4);
#pragma unroll
            for (int e2 = 0; e2 < 4; ++e2) v[4 * r4 + e2] = (dt ? o1[4 * r4 + e2] : o0[4 * r4 + e2]) * rstd * g[e2]; }
        *(bf16x8*)(op + 32 * dt) = pack8(v); *(bf16x8*)(op + 32 * dt + 8) = pack8(v + 8);
    }
    __syncthreads();
}

__device__ __forceinline__ void gla_a(const bf16* GLR, const bf16* W2T, const float* gate_b, const bf16* TT, bf16* KV, float* DTOT, int bh, int j, int lane) {
    const int il = lane & 31, hi = lane >> 5, pil = PI32(il);
    const int b = bh >> 2, h = bh & 3;
    const size_t t0 = (size_t)b * SEQ + (size_t)j * 64;
    bf16x8 gf[2], wf[2], gkf[2][2][2], bvf[4][4]; float bias[2];
#pragma unroll
    for (int ch = 0; ch < 2; ++ch) gf[ch] = *(const bf16x8*)(GLR + (t0 + 32 * ch + pil) * 16 + 8 * hi);
#pragma unroll
    for (int kh = 0; kh < 2; ++kh) { const int kcol = 64 * h + 32 * kh + pil; wf[kh] = *(const bf16x8*)(W2T + kcol * 16 + 8 * hi); bias[kh] = gate_b[kcol];
        const bf16* gkp = TT + ((t0 >> 5) * NB + 512 + kcol) * 32 + 16 * hi;
#pragma unroll
        for (int ch = 0; ch < 2; ++ch) { gkf[kh][ch][0] = *(const bf16x8*)(gkp + ch * NB * 32); gkf[kh][ch][1] = *(const bf16x8*)(gkp + ch * NB * 32 + 8); } }
#pragma unroll
    for (int vq = 0; vq < 4; ++vq) { const bf16* vp = TT + ((t0 >> 5) * NB + 768 + 128 * h + 32 * vq + il) * 32 + 16 * hi;
#pragma unroll
        for (int s = 0; s < 4; ++s) bvf[vq][s] = *(const bf16x8*)(vp + (s >> 1) * NB * 32 + 8 * (s & 1)); }
    bf16x8 akf[2][4];
#pragma unroll
    for (int kh = 0; kh < 2; ++kh) {
        const int kcol = 64 * h + 32 * kh + pil;
        float cs[2][16];
#pragma unroll
        for (int ch = 0; ch < 2; ++ch) {
            f32x16 g;
#pragma unroll
            for (int r = 0; r < 16; ++r) g[r] = 0.f;
            g = MFMA32(gf[ch], wf[kh], g);
            if (kh == 0 && ch == 0) asm volatile("" : "+v"(g) :: "memory");
            float run = 0.f;
#pragma unroll
            for (int r = 0; r < 16; ++r) { const float x = g[r] + bias[kh];
                const float ls2 = __builtin_fminf(x, 0.f) * LOG2E - __builtin_amdgcn_logf(1.f + __builtin_amdgcn_exp2f(-__builtin_fabsf(x) * LOG2E));
                run += ls2 * (1.f / 16.f); cs[ch][r] = run; }
        }
        float t0lo, t0hi, t1lo, t1hi; swap32(cs[0][15], t0lo, t0hi); swap32(cs[1][15], t1lo, t1hi);
        const float off0 = hi ? t0lo : 0.f, off1 = (t0lo + t0hi) + (hi ? t1lo : 0.f), total = (t0lo + t0hi) + (t1lo + t1hi);
        if (hi == 0) DTOT[((size_t)bh * 32 + j) * 64 + 32 * kh + pil] = __builtin_amdgcn_exp2f(total);
#pragma unroll
        for (int ch = 0; ch < 2; ++ch) {
            const bf16x8 k0 = gkf[kh][ch][0], k1 = gkf[kh][ch][1];
            float kd[16]; const float off = ch ? off1 : off0;
#pragma unroll
            for (int r = 0; r < 16; ++r) { const float dec = __builtin_amdgcn_exp2f(total - (cs[ch][r] + off)); kd[r] = bf2f(r < 8 ? k0[r] : k1[r - 8]) * dec; }
            akf[kh][2 * ch] = pack8(kd); akf[kh][2 * ch + 1] = pack8(kd + 8);
        }
    }
#pragma unroll
    for (int vq = 0; vq < 4; ++vq) {
#pragma unroll
        for (int kh = 0; kh < 2; ++kh) {
            f32x16 kv;
#pragma unroll
            for (int r = 0; r < 16; ++r) kv[r] = 0.f;
#pragma unroll
            for (int s = 0; s < 4; ++s) kv = MFMA32(akf[kh][s], bvf[vq][s], kv);
            bf16* dst = KV + (((size_t)bh * 32 + j) * 128 + 32 * vq + il) * 64 + 32 * kh + 16 * hi;
            float kvf[16];
#pragma unroll
            for (int r = 0; r < 16; ++r) kvf[r] = kv[r];
            *(bf16x8*)dst = pack8(kvf); *(bf16x8*)(dst + 8) = pack8(kvf + 8);
        }
    }
}
__device__ __forceinline__ void gla_b(const bf16* KV, const float* DTOT, bf16* ST, int task, int lane) {
    const int bh = task >> 5, part = task & 31; const int e0 = part * 256 + lane * 4; const int k = e0 & 63;
    f32x4 S = (f32x4){0.f, 0.f, 0.f, 0.f};
#pragma unroll
    for (int half = 0; half < 2; ++half) {
        u32x2 kvp[16]; f32x4 d[16];
#pragma unroll
        for (int q = 0; q < 16; ++q) { const int j = 16 * half + q;
            kvp[q] = *(const u32x2*)(KV + ((size_t)bh * 32 + j) * 8192 + e0); d[q] = *(const f32x4*)(DTOT + ((size_t)bh * 32 + j) * 64 + k); }
#pragma unroll
        for (int q = 0; q < 16; ++q) { const int j = 16 * half + q;
            const f32x4 kv = (f32x4){__uint_as_float(kvp[q].x << 16), __uint_as_float(kvp[q].x & 0xffff0000u), __uint_as_float(kvp[q].y << 16), __uint_as_float(kvp[q].y & 0xffff0000u)};
            S = d[q] * S + kv;
            u32x2 w; w.x = cvtpk(S[0], S[1]); w.y = cvtpk(S[2], S[3]);
            *(u32x2*)(ST + ((size_t)bh * 32 + j) * 8192 + e0) = w; }
        asm volatile("" ::: "memory");
    }
}
__device__ __forceinline__ void gla_c(LAS unsigned char* wl, const bf16* ST, const bf16* GQ, const bf16* GRS, const float* gn, bf16* MIX, int bh, int j, int lane) {
    const int il = lane & 31, hi = lane >> 5, pil = PI32(il);
    const int b = bh >> 2, h = bh & 3;
    const size_t t0 = (size_t)b * SEQ + (size_t)j * 64;
    const bf16* sp = ST + ((size_t)bh * 32 + j) * 8192 + lane * 8;
    u32x4 st[16];
#pragma unroll
    for (int i = 0; i < 16; ++i) st[i] = *(const u32x4*)(sp + i * 512);
    bf16x8 bq[2][4], gr[2][4][2];
#pragma unroll
    for (int ch = 0; ch < 2; ++ch) { const size_t row = t0 + 32 * ch + il;
#pragma unroll
        for (int s = 0; s < 4; ++s) bq[ch][s] = *(const bf16x8*)(GQ + row * 256 + 64 * h + 16 * s + 8 * hi); }
    { const size_t row = t0 + il;
#pragma unroll
      for (int vt = 0; vt < 4; ++vt) { gr[0][vt][0] = *(const bf16x8*)(GRS + row * 512 + 128 * h + 32 * vt + 16 * hi); gr[0][vt][1] = *(const bf16x8*)(GRS + row * 512 + 128 * h + 32 * vt + 16 * hi + 8); } }
    { const int vr = lane >> 3, c = lane & 7;
#pragma unroll
      for (int i = 0; i < 16; ++i) { const int v = 8 * i + vr; *(LAS u32x4*)(wl + v * 128 + ((c ^ sb_keyK(v & 31)) << 4)) = st[i]; } }
    LDS_WAIT(); asm volatile("" ::: "memory");
    unsigned ax[4];
#pragma unroll
    for (int s = 0; s < 4; ++s) ax[s] = (unsigned)(pil * 128 + (((2 * s + hi) ^ sb_keyK(pil)) << 4));
#pragma unroll
    for (int ch = 0; ch < 2; ++ch) {
        const size_t row = t0 + 32 * ch + il;
        f32x16 O[4]; float ss = 0.f;
#pragma unroll
        for (int vt = 0; vt < 4; ++vt) {
#pragma unroll
            for (int r = 0; r < 16; ++r) O[vt][r] = 0.f;
#pragma unroll
            for (int s = 0; s < 4; ++s) { const bf16x8 af = *(const LAS bf16x8*)(wl + vt * 4096 + ax[s]); O[vt] = MFMA32(af, bq[ch][s], O[vt]); }
            if (ch == 0 && vt == 0) {
                const size_t row1 = t0 + 32 + il;
#pragma unroll
                for (int v2 = 0; v2 < 4; ++v2) { gr[1][v2][0] = *(const bf16x8*)(GRS + row1 * 512 + 128 * h + 32 * v2 + 16 * hi); gr[1][v2][1] = *(const bf16x8*)(GRS + row1 * 512 + 128 * h + 32 * v2 + 16 * hi + 8); }
                asm volatile("" : "+v"(O[0]) :: "memory"); }
#pragma unroll
            for (int r = 0; r < 16; ++r) ss += O[vt][r] * O[vt][r];
        }
        float slo, shi; swap32(ss, slo, shi);
        const float rstd = __builtin_amdgcn_rsqf((slo + shi) * (1.f / 128.f) + EPS);
#pragma unroll
        for (int vt = 0; vt < 4; ++vt) {
            const int vc0 = 32 * vt + 16 * hi;
            float v[16];
#pragma unroll
            for (int r4 = 0; r4 < 4; ++r4) { const f32x4 g = *(const f32x4*)(gn + vc0 + 4 * r4);
#pragma unroll
                for (int e2 = 0; e2 < 4; ++e2) { const int r = 4 * r4 + e2; v[r] = O[vt][r] * rstd * g[e2] * bf2f(r < 8 ? gr[ch][vt][0][r] : gr[ch][vt][1][r - 8]); } }
            bf16* op = MIX + row * DM + 512 + 128 * h + vc0;
            *(bf16x8*)(op) = pack8(v); *(bf16x8*)(op + 8) = pack8(v + 8);
        }
    }
    LDS_WAIT(); asm volatile("" ::: "memory");
}

constexpr int NWAVES = 8;
constexpr int N_PHASES = 10;
struct Args { Ptrs p; int ph_lo, ph_hi; };

__global__ void __launch_bounds__(NWAVES * 64, 2) fwd_kernel(Args args) {
    extern __shared__ __attribute__((aligned(16))) unsigned char lds_raw[];
    LAS unsigned char* lds = (LAS unsigned char*)lds_raw;
    const Ptrs& P = args.p;
    const int tid = threadIdx.x, lane = tid & 63, wave = __builtin_amdgcn_readfirstlane(tid >> 6);
    const int G = gridDim.x; const int bx = blockIdx.x; const int vcu = (G % 8 == 0) ? (bx % 8) * (G / 8) + bx / 8 : bx;
    const int gw = vcu * NWAVES + wave, NGW = G * NWAVES;
    unsigned char* ws = P.ws;
    gu32* ctl = (gu32*)(ws + WS_CTL);
    volatile LAS unsigned* MISC = (volatile LAS unsigned*)(lds + MISC_OFF);
    LAS int* tab = (LAS int*)(lds + TAB_OFF);
    for (int u = tid; u < (LDS_BYTES - LDSCTL_OFF) / 4; u += NWAVES * 64) ((LAS unsigned*)(lds + LDSCTL_OFF))[u] = 0u;
    __syncthreads();
    XcdBarrier bar; bar.bar = (unsigned*)(ctl + CW_BAR); bar.x = 0; bar.st = nullptr;
    if (MK_N_LAUNCHES == 1) bar = xcd_barrier_post((unsigned*)(ctl + CW_BAR), MISC + 8);
#define GRID_BAR() do { if (MK_N_LAUNCHES == 1) xcd_barrier(bar); } while (0)
    const int lo = args.ph_lo, hi_ph = args.ph_hi;
#ifndef PHASE_MASK
#define PHASE_MASK 0x3ff
#endif
#define IN(k) (((PHASE_MASK >> (k)) & 1) && lo <= (k) && (k) < hi_ph)
#define BOTH(k) (IN(k) && IN((k) + 1))
#ifndef PROBE_TWICE
#define PROBE_TWICE -1
#endif
#define REP(k) for (int rep_ = 0; rep_ < ((PROBE_TWICE == (k)) ? 2 : 1); ++rep_)
#define REPBAR(k) do { if (PROBE_TWICE == (k) && rep_ == 0) GRID_BAR(); } while (0)

    bf16* WA = (bf16*)(ws + WS_WA); bf16* WB = (bf16*)(ws + WS_WB); bf16* WO = (bf16*)(ws + WS_WO);
    bf16* WRH = (bf16*)(ws + WS_WR); bf16* WRL = WRH + 48 * 1024; bf16* W2T = (bf16*)(ws + WS_W2T);
    bf16* WGU = (bf16*)(ws + WS_WGU); bf16* WD = (bf16*)(ws + WS_WD);
    bf16* H = (bf16*)(ws + WS_H); bf16* KV = (bf16*)(ws + WS_KV);
    bf16* XB = (bf16*)(ws + WS_XB); bf16* MIX = (bf16*)(ws + WS_MIX); float* RSTD1 = (float*)(ws + WS_RSTD1);
    bf16* SQ = (bf16*)(ws + WS_SQ); bf16* SK = (bf16*)(ws + WS_SK); bf16* GQ = (bf16*)(ws + WS_GQ); bf16* GRS = (bf16*)(ws + WS_GRS);
    bf16* TT = (bf16*)(ws + WS_TT); bf16* GLR = (bf16*)(ws + WS_GLR); bf16* ST = (bf16*)(ws + WS_ST); float* DTOT = (float*)(ws + WS_DTOT);
    unsigned char* ACT = ws + WS_ACT; unsigned char* Y = ws + WS_Y;
    unsigned char* WGU8 = ws + WS_WGU; unsigned char* WD8 = ws + WS_WD; unsigned char* H8 = ws + WS_H8;
    unsigned* LOCL = (unsigned*)(ws + WS_LOCL); unsigned* CNTS = (unsigned*)(ws + WS_CNTS); float* GATE = (float*)(ws + WS_GATE); float* RSTD = (float*)(ws + WS_RSTD);

    if (IN(0)) { REP(0) {
        LAS float* scr = (LAS float*)(lds + RING_OFF + wave * 16384);
        constexpr int I_A = (NA / 32) * 16, I_B = (NB / 32) * 16, I_O = 32 * 16, I_GU = 32 * 32 * 16, I_D = 32 * 32 * 8;
        constexpr int NITEMS = I_A + I_B + I_O + I_GU;
        for (int it = gw; it < NITEMS; it += NGW) {
            int r = it;
            if (r < I_A) { const int ib = r >> 4, kb = r & 15, P0 = 32 * ib; const int pn = P0 >> 8, bj = (P0 >> 7) & 1, wcc = (P0 >> 5) & 3; const int LA = 256 * pn + 64 * wcc + 32 * bj;
                const int sc = LA < 1024 ? LA : (LA < 1280 ? 1536 + (LA - 1024) : 2560 + (LA - 1280));
                tr_item(P.w_in, IN_DIM, 64 * kb, sc, WA, P0, DM, P.attn_g, scr, lane); continue; } r -= I_A;
            if (r < I_B) { const int ib = r >> 4, kb = r & 15, P0 = 32 * ib; const int sc = P0 < 512 ? 1024 + P0 : (P0 < 768 ? 1792 + (P0 - 512) : 2048 + (P0 - 768));
                tr_item(P.w_in, IN_DIM, 64 * kb, sc, WB, P0, DM, P.attn_g, scr, lane); continue; } r -= I_B;
            if (r < I_O) { const int ib = r >> 4, kb = r & 15; tr_item(P.w_out, DM, 64 * kb, 32 * ib, WO, 32 * ib, DM, nullptr, scr, lane); continue; } r -= I_O;
            if (r < I_GU) { const int e = r >> 9, q = r & 511, ib = 4 * (q >> 6) + (q & 3), kb = 2 * ((q >> 3) & 7) + ((q >> 2) & 1), P0 = 32 * ib; const int pn = P0 >> 8, bj = (P0 >> 7) & 1, r0 = P0 & 127;
                const float* src = (bj ? P.wu : P.wg) + (size_t)e * DM * DEXP;
                tr_item8(src, DEXP, 64 * kb, 128 * pn + r0, WGU8 + (size_t)e * DM * DM, P0, DM, P.ffn_g, WGU_SC, scr, lane); continue; }
        }
        (void)I_D;
        for (int idx = gw * 64 + lane; idx < 48 * 1024; idx += NGW * 64) {
            const int rho = idx >> 10, k = idx & 1023, m = rho >> 4, i = rho & 15;
            float v = (m < 2) ? P.re_w[k * 32 + 8 * (i >> 2) + 4 * m + (i & 3)] : P.rg_w[k * 4 + (i & 3)];
            v *= P.ffn_g[k];
            WRH[idx] = __builtin_bit_cast(unsigned short, (_Float16)v);
        }
        for (int idx = gw * 64 + lane; idx < 256 * 16; idx += NGW * 64) { const int kc = idx >> 4, r = idx & 15; W2T[idx] = (bf16)(cvtpk(P.w2[r * 256 + kc], 0.f) & 0xffffu); }
        __syncthreads();
        constexpr int WLP = 1032;
        LAS bf16* wl = (LAS bf16*)(lds + RING_OFF);
        for (int idx = tid; idx < 16 * 1024; idx += NWAVES * 64) { const int c = idx & 15, k = idx >> 4; wl[c * WLP + k] = (bf16)(cvtpk(P.attn_g[k] * P.w_in[(size_t)k * IN_DIM + 3072 + c], 0.f) & 0xffffu); }
        __syncthreads();
        {
            for (int task = gw; task < NTOK / 16; task += NGW) {
                const size_t row0 = (size_t)task * 16;
                f32x4 cur[4], nxt[4]; float rsv = 0.f;
#pragma unroll
                for (int j = 0; j < 4; ++j) { cur[j] = __builtin_nontemporal_load((const GAS f32x4*)(P.x + row0 * DM) + lane + 64 * j); nxt[j] = cur[j]; }
#pragma unroll 2
                for (int r = 0; r < 16; ++r) {
                    if (r < 15) {
#pragma unroll
                        for (int j = 0; j < 4; ++j) nxt[j] = __builtin_nontemporal_load((const GAS f32x4*)(P.x + (row0 + r + 1) * DM) + lane + 64 * j); }
                    float s2 = 0.f;
#pragma unroll
                    for (int j = 0; j < 4; ++j) s2 += (cur[j].x * cur[j].x + cur[j].y * cur[j].y) + (cur[j].z * cur[j].z + cur[j].w * cur[j].w);
                    const float rstd = __builtin_amdgcn_rsqf(wave_sum(s2) * (1.f / DM) + EPS);
                    if ((lane & 15) == r) rsv = rstd;
                    GAS unsigned long long* o8 = (GAS unsigned long long*)(XB + (row0 + r) * DM) + lane;
#pragma unroll
                    for (int j = 0; j < 4; ++j) { const f32x4 v = cur[j];
                        o8[64 * j] = (unsigned long long)cvtpk(v.x, v.y) | ((unsigned long long)cvtpk(v.z, v.w) << 32); }
#pragma unroll
                    for (int j = 0; j < 4; ++j) cur[j] = nxt[j];
                }
                if (lane < 16) RSTD1[row0 + lane] = rsv;
                VM_WAIT();
                const int fr = lane & 15, fq = lane >> 4;
                f32x4 acc = (f32x4){0.f, 0.f, 0.f, 0.f};
                const bf16* up = XB + (row0 + fr) * DM + 8 * fq;
#pragma unroll 8
                for (int ks = 0; ks < 32; ++ks) { const bf16x8 ub = *(const bf16x8*)(up + 32 * ks); const bf16x8 wb = *(const LAS bf16x8*)(wl + fr * WLP + 32 * ks + 8 * fq); acc = MFMA16(wb, ub, acc); }
                u32x2 o; o.x = cvtpk(acc[0] * rsv, acc[1] * rsv); o.y = cvtpk(acc[2] * rsv, acc[3] * rsv);
                *(u32x2*)(GLR + (row0 + fr) * 16 + 4 * fq) = o;
            }
        }
        __syncthreads();
        REPBAR(0); }
        if (BOTH(0)) GRID_BAR();
    }

#define PH1_BODY() do { \
        { pg8::SchedDense S; S.init(XB, WA, NTOK, NA, DM, G, bx); \
          pg8::EpiA E{SQ, SK, GQ, GRS, P.sbq_g, P.sbk_g, RSTD1}; \
          pg8::gemm_phase<pg8::EpiA, pg8::SchedDense>(lds + RING_OFF, DM, S, E); } \
        { pg8::SchedDense S; S.init(WB, XB, NB, NTOK, DM, G, (bx + G / 2) % G); \
          pg8::EpiTT E{TT, RSTD1}; \
          pg8::gemm_phase<pg8::EpiTT, pg8::SchedDense>(lds + RING_OFF, DM, S, E); } } while (0)
    if (IN(1)) {
        if (PROBE_TWICE == 1) { PH1_BODY(); GRID_BAR(); }
        PH1_BODY();
        if (BOTH(1)) GRID_BAR();
    }

#define SB_ROUND(rho_) do { for (int u__ = (rho_) * G + vcu; u__ < 1024; u__ += 4 * G) { const int bh_ = u__ & 127; \
        sb_round(lds + RING_OFF, SQ, SK, TT, P.sbo_g + (bh_ & 7) * 64, MIX, bh_ >> 3, bh_ & 7, u__ >> 7, tid, wave, lane); } } while (0)
#define REPX(code) for (int rx_ = 0; rx_ < ((PROBE_TWICE == (code)) ? 5 : 1); ++rx_)
#define BAR_ARRIVE() do { if (MK_N_LAUNCHES == 1) xcd_barrier_arrive(bar, MISC + 12); } while (0)
#define BAR_WAIT() do { if (MK_N_LAUNCHES == 1) xcd_barrier_wait(bar, MISC + 12); } while (0)
    if (IN(2)) {
        for (int t = gw; t < 2048; t += NGW) gla_a(GLR, W2T, P.gate_b, TT, KV, DTOT, t >> 5, t & 31, lane);
        if (BOTH(2)) BAR_ARRIVE();
        SB_ROUND(0);
        if (BOTH(2)) BAR_WAIT();
    }
    if (IN(3)) {
        for (int t = gw; t < 2048; t += NGW) gla_b(KV, DTOT, ST, t, lane);
        if (BOTH(3)) BAR_ARRIVE();
        SB_ROUND(1);
        if (BOTH(3)) BAR_WAIT();
    }
    if (IN(4)) {
        for (int t = gw; t < 2048; t += NGW) gla_c(lds + RING_OFF + wave * 16384, ST, GQ, GRS, P.glan_g, MIX, t >> 5, t & 31, lane);
        __syncthreads();
        SB_ROUND(2); SB_ROUND(3);
        if (BOTH(4)) GRID_BAR();
    }

#define PH5_BODY() do { \
        pg8::SchedDense S; S.init(MIX, WO, NTOK, DM, DM, G, bx); \
        pg8::EpiH E{XB, H, H8}; \
        pg8::gemm_phase<pg8::EpiH, pg8::SchedDense>(lds + RING_OFF, DM, S, E); } while (0)
    if (IN(5)) {
        if (PROBE_TWICE == 5) { PH5_BODY(); GRID_BAR(); }
        PH5_BODY();
        if (BOTH(5)) GRID_BAR();
    }

    if (IN(6)) { REP(6) {
        constexpr int WP = 1032;
        LAS unsigned short* wl16 = (LAS unsigned short*)(lds + RING_OFF);
        LAS unsigned* lcount = (LAS unsigned*)(lds + RING_OFF + 48 * WP * 2);
        for (int idx = tid; idx < 48 * 128; idx += NWAVES * 64) { const int row = idx >> 7, c = idx & 127; *(LAS u32x4*)(wl16 + row * WP + 8 * c) = *(const u32x4*)(WRH + row * 1024 + 8 * c); }
        const int fr = lane & 15, fq = lane >> 4;
        for (int it = 0; it * G < NGRP; ++it) {
            const int grp = it * G + vcu;
            const int tile = grp * 8 + wave; const int ntile = NGRP * 8;
            if (tid < 32) lcount[tid] = 0u;
            __syncthreads();
            bool owner = false; int e1 = 0, e2 = 0; unsigned lr1 = 0, lr2 = 0; int tok = 0;
            if (tile < ntile) {
                tok = tile * 16 + fr;
                const bf16* hp = H + (size_t)tok * DM + 8 * fq;
                f32x4 acc[3]; acc[0] = acc[1] = acc[2] = (f32x4){0.f, 0.f, 0.f, 0.f};
                float ssq = 0.f;
#pragma unroll 1
                for (int half = 0; half < 2; ++half) {
                    bf16x8 hb[16];
#pragma unroll
                    for (int q = 0; q < 16; ++q) hb[q] = *(const bf16x8*)(hp + 32 * (16 * half + q));
#pragma unroll
                    for (int q = 0; q < 16; ++q) { const int ks = 16 * half + q;
                        float f[8];
#pragma unroll
                        for (int e = 0; e < 8; ++e) { f[e] = bf2f(hb[q][e]); ssq += f[e] * f[e]; }
                        f16x8 hh;
#pragma unroll
                        for (int e = 0; e < 8; ++e) hh[e] = (_Float16)f[e];
#pragma unroll
                        for (int m = 0; m < 3; ++m) { const f16x8 wv = *(const LAS f16x8*)(wl16 + (16 * m + fr) * WP + 32 * ks + 8 * fq);
                            acc[m] = __builtin_amdgcn_mfma_f32_16x16x32_f16(wv, hh, acc[m], 0, 0, 0); }
                    }
                }
                ssq += __shfl_xor(ssq, 16); ssq += __shfl_xor(ssq, 32);
                const float rstd = __builtin_amdgcn_rsqf(ssq * (1.f / DM) + EPS);
                float gl[4];
#pragma unroll
                for (int r = 0; r < 4; ++r) gl[r] = acc[2][r] * rstd + P.rg_b[r];
                int gsel = 0; float gmax = gl[0];
#pragma unroll
                for (int r = 1; r < 4; ++r) if (gl[r] > gmax) { gmax = gl[r]; gsel = r; }
                float gden = 0.f;
#pragma unroll
                for (int r = 0; r < 4; ++r) gden += __builtin_amdgcn_exp2f((gl[r] - gmax) * LOG2E);
                const float pgrp = 1.f / gden;
                float el[8];
#pragma unroll
                for (int r = 0; r < 4; ++r) { el[r] = acc[0][r] * rstd + P.re_b[8 * fq + r]; el[4 + r] = acc[1][r] * rstd + P.re_b[8 * fq + 4 + r]; }
                int i1 = 0; float l1 = el[0];
#pragma unroll
                for (int r = 1; r < 8; ++r) if (el[r] > l1) { l1 = el[r]; i1 = r; }
                int i2 = -1; float l2 = -3.0e38f;
#pragma unroll
                for (int r = 0; r < 8; ++r) if (r != i1 && el[r] > l2) { l2 = el[r]; i2 = r; }
                const float ex = __builtin_amdgcn_exp2f((l2 - l1) * LOG2E);
                const float p1 = 1.f / (1.f + ex), p2 = ex * p1;
                owner = (fq == gsel);
                if (owner) {
                    e1 = 8 * gsel + i1; e2 = 8 * gsel + i2;
                    lr1 = __hip_atomic_fetch_add(lcount + e1, 1u, __ATOMIC_RELAXED, __HIP_MEMORY_SCOPE_WORKGROUP);
                    lr2 = __hip_atomic_fetch_add(lcount + e2, 1u, __ATOMIC_RELAXED, __HIP_MEMORY_SCOPE_WORKGROUP);
                    RSTD[tok] = rstd; GATE[2 * tok] = pgrp * p1; GATE[2 * tok + 1] = pgrp * p2;
                }
            }
            __syncthreads();
            if (grp < NGRP) {
                if (tid < 32) CNTS[grp * 32 + tid] = lcount[tid];
                if (owner) { LOCL[((size_t)grp * 32 + e1) * 128 + lr1] = 2u * tok; LOCL[((size_t)grp * 32 + e2) * 128 + lr2] = 2u * tok + 1u; }
            }
            __syncthreads();
        }
        REPBAR(6); }
        if (BOTH(6)) GRID_BAR();
    }

    if (IN(7) || IN(8)) {
        LAS int* pre = (LAS int*)(lds + RING_OFF);
        LAS int* segsum = pre + NGRP * 32;
        for (int i = tid; i < NGRP * 32; i += NWAVES * 64) pre[i] = (int)CNTS[i];
        __syncthreads();
        { const int e = tid & 31, seg = tid >> 5; int run = 0;
          for (int g = seg * 16; g < seg * 16 + 16; ++g) { const int c = pre[g * 32 + e]; pre[g * 32 + e] = run; run += c; }
          segsum[seg * 32 + e] = run; }
        __syncthreads();
        { const int e = tid & 31, seg = tid >> 5; int off = 0, tot = 0;
          for (int q = 0; q < 16; ++q) { const int v = segsum[q * 32 + e]; if (q < seg) off += v; tot += v; }
          for (int g = seg * 16; g < seg * 16 + 16; ++g) pre[g * 32 + e] += off;
          if (seg == 0) tab[T_CNT / 4 + e] = tot; }
        __syncthreads();
        if (tid == 0) { int tb = 0; for (int e = 0; e < 32; ++e) { tab[T_TBASE / 4 + e] = tb; tb += (tab[T_CNT / 4 + e] + 255) >> 8; } tab[T_TBASE / 4 + 32] = tb; tab[T_NT / 4] = tb; }
        __syncthreads();
        { const int NT = tab[T_NT / 4];
          for (int t = tid; t < NT; t += NWAVES * 64) { int e = 0; for (int q = 0; q < 32; ++q) if (tab[T_TBASE / 4 + q] <= t && t < tab[T_TBASE / 4 + q + 1]) e = q; tab[T_TILE_E / 4 + t] = e; } }
        __syncthreads();
        { pg8::SchedMoE<false> S0; S0.A = nullptr; S0.Bt = nullptr; S0.K = 0; S0.bstride = 0; S0.G = G; S0.c = vcu; S0.tab = tab;
          const int half = tid >> 8, r = tid & 255; unsigned vals[NU_MAX / 2]; bool ok[NU_MAX / 2];
#pragma unroll
          for (int k = 0; k < NU_MAX / 2; ++k) { const int ui = 2 * k + half; pg8::Unit u; ok[k] = S0.next(ui, u); vals[k] = 0u;
              if (ok[k]) { const int cnt = tab[T_CNT / 4 + u.e], e = u.e; int p = u.rt * 256 + r; if (p > cnt - 1) p = cnt - 1;
                  int lo_ = 0, hi_ = NGRP - 1;
                  while (lo_ < hi_) { const int mid = (lo_ + hi_ + 1) >> 1; if (pre[mid * 32 + e] <= p) lo_ = mid; else hi_ = mid - 1; }
                  vals[k] = LOCL[((size_t)lo_ * 32 + e) * 128 + (p - pre[lo_ * 32 + e])]; } }
          float rsl[NU_MAX / 2];
#pragma unroll
          for (int k = 0; k < NU_MAX / 2; ++k) rsl[k] = ok[k] ? RSTD[vals[k] >> 1] : 0.f;
#pragma unroll
          for (int k = 0; k < NU_MAX / 2; ++k) if (ok[k]) { tab[T_ROWTAB / 4 + (2 * k + half) * 256 + r] = (int)vals[k]; ((LAS float*)tab)[T_RSTAB / 4 + (2 * k + half) * 256 + r] = rsl[k]; }
        }
        __syncthreads();
    }
#define PH7_BODY() do { \
        pg8::SchedMoE<true> S; S.A = (const char*)H8; S.Bt = (const char*)WGU8; S.K = DM / 2; S.bstride = (size_t)DM * DM; S.G = G; S.c = vcu; S.tab = tab; \
        pg8::EpiGU E{ACT, RSTD, tab}; \
        pg8::gemm_phase<pg8::EpiGU, pg8::SchedMoE<true>, false, true>(lds + RING_OFF, DM / 2, S, E); } while (0)
    if (IN(7)) {
        if (PROBE_TWICE == 7) { PH7_BODY(); GRID_BAR(); }
        PH7_BODY();
        {
            const int NT4 = tab[T_NT / 4] * 4, remu = NT4 % G;
            const bool early = (remu == 0) || (vcu >= remu); const int nE = (remu == 0) ? G : (G - remu), rank = (remu == 0) ? vcu : (vcu - remu);
            if (early) { LAS float* scr = (LAS float*)(lds + RING_OFF + wave * 16384);
                for (int r = rank * NWAVES + wave; r < 32 * 32 * 8; r += nE * NWAVES) {
                    const int e = r >> 8, q = r & 255, nb = 4 * (q >> 5) + (q & 3), kb = 2 * ((q >> 3) & 3) + ((q >> 2) & 1);
                    tr_item8(P.wd + (size_t)e * DEXP * DM, DM, 64 * kb, 32 * nb, WD8 + (size_t)e * DM * DEXP, 32 * nb, DEXP, nullptr, WD_SC, scr, lane); } }
        }
        if (BOTH(7)) GRID_BAR();
    }
    if (IN(8)) { REP(8) {
        pg8::SchedMoE<false> S; S.A = (const char*)ACT; S.Bt = (const char*)WD8; S.K = DEXP / 2; S.bstride = (size_t)DM * DEXP; S.G = G; S.c = vcu; S.tab = tab;
        pg8::EpiDown E{Y, tab};
        pg8::gemm_phase<pg8::EpiDown, pg8::SchedMoE<false>, false, true>(lds + RING_OFF, DEXP / 2, S, E);
        REPBAR(8); }
        if (BOTH(8)) GRID_BAR();
    }
    if (IN(9)) { REP(9) {
        for (int m0 = gw; m0 < NTOK; m0 += 2 * NGW) {
            bf16x8 hv[2][2]; u32x4 ya[2], yb[2]; float g0[2], g1[2];
#pragma unroll
            for (int t = 0; t < 2; ++t) { int m = m0 + t * NGW; if (m >= NTOK) m = m0;
                g0[t] = GATE[2 * m] * (1.f / Y_SC); g1[t] = GATE[2 * m + 1] * (1.f / Y_SC);
                const bf16* hp = H + (size_t)m * DM + 16 * lane; const unsigned char* y0 = Y + (size_t)(2 * m) * DM + 16 * lane;
                hv[t][0] = *(const bf16x8*)(hp); hv[t][1] = *(const bf16x8*)(hp + 8); ya[t] = *(const u32x4*)(y0); yb[t] = *(const u32x4*)(y0 + DM); }
#pragma unroll
            for (int t = 0; t < 2; ++t) { const int m = m0 + t * NGW; if (m < NTOK) {
                float* op = P.out + (size_t)m * DM + 16 * lane;
#pragma unroll
                for (int q = 0; q < 4; ++q) { const unsigned wa = ya[t][q], wb = yb[t][q];
                    const f32x2_t a0 = __builtin_amdgcn_cvt_pk_f32_fp8((int)wa, false), a1 = __builtin_amdgcn_cvt_pk_f32_fp8((int)wa, true);
                    const f32x2_t b0 = __builtin_amdgcn_cvt_pk_f32_fp8((int)wb, false), b1 = __builtin_amdgcn_cvt_pk_f32_fp8((int)wb, true);
                    const bf16x8 hh = hv[t][q >> 1]; const int e0 = 4 * (q & 1);
                    f32x4 o; o[0] = bf2f(hh[e0]) + g0[t] * a0.x + g1[t] * b0.x; o[1] = bf2f(hh[e0 + 1]) + g0[t] * a0.y + g1[t] * b0.y;
                    o[2] = bf2f(hh[e0 + 2]) + g0[t] * a1.x + g1[t] * b1.x; o[3] = bf2f(hh[e0 + 3]) + g0[t] * a1.y + g1[t] * b1.y;
                    *(f32x4*)(op + 4 * q) = o; } } }
        }
    REPBAR(9); } }
#undef IN
#undef BOTH
}

extern "C" void kernel_launch(void* const* d_in, const int* in_sizes, int n_in, void* d_out, int out_size, void* d_ws, size_t ws_size, hipStream_t stream) {
    static int grid = 0;
    if (grid == 0) {
        if (n_in != 18 || in_sizes[0] != NTOK * DM || out_size != NTOK * DM || ws_size < WS_END) { fprintf(stderr, "kernel_launch: unexpected shapes / workspace (n_in %d, in0 %d, out %d, ws %zu, need %zu)\n", n_in, n_in > 0 ? in_sizes[0] : -1, out_size, ws_size, (size_t)WS_END); grid = -1; return; }
        int dev = 0, cus = 0, per_cu = 0;
        if (hipGetDevice(&dev) != hipSuccess || hipDeviceGetAttribute(&cus, hipDeviceAttributeMultiprocessorCount, dev) != hipSuccess) { grid = -1; return; }
        if (hipFuncSetAttribute((const void*)fwd_kernel, hipFuncAttributeMaxDynamicSharedMemorySize, LDS_BYTES) != hipSuccess) { fprintf(stderr, "kernel_launch: hipFuncSetAttribute failed\n"); grid = -1; return; }
        if (hipOccupancyMaxActiveBlocksPerMultiprocessor(&per_cu, (const void*)fwd_kernel, NWAVES * 64, LDS_BYTES) != hipSuccess || per_cu < 1) fprintf(stderr, "kernel_launch: occupancy query reports %d\n", per_cu);
        (void)hipGetLastError();
        grid = cus;
    }
    if (grid < 0) return;
    if (hipMemsetAsync((char*)d_ws + WS_CTL, 0, CTL_ZERO_BYTES, stream) != hipSuccess) return;
    Args a{};
    const float** pp = (const float**)&a.p;
    for (int i = 0; i < 18; ++i) pp[i] = (const float*)d_in[i];
    a.p.out = (float*)d_out; a.p.ws = (unsigned char*)d_ws;
    if (MK_N_LAUNCHES == 1) { a.ph_lo = 0; a.ph_hi = N_PHASES; hipLaunchKernelGGL(fwd_kernel, dim3(grid), dim3(NWAVES * 64), LDS_BYTES, stream, a); }
    else for (int li = 0; li < N_PHASES; ++li) { a.ph_lo = li; a.ph_hi = li + 1; hipLaunchKernelGGL(fwd_kernel, dim3(grid), dim3(NWAVES * 64), LDS_BYTES, stream, a); }
}
```

```cpp
#include <hip/hip_runtime.h>
#include <cstdio>
#include <cstdint>

#ifndef MK_N_LAUNCHES
#define MK_N_LAUNCHES 1
#endif

#define LAS __attribute__((address_space(3)))
#define GAS __attribute__((address_space(1)))
typedef unsigned short bf16;
typedef short bf16x8 __attribute__((ext_vector_type(8)));
typedef float f32x4 __attribute__((ext_vector_type(4)));
typedef float f32x16 __attribute__((ext_vector_type(16)));
typedef unsigned u32x4 __attribute__((ext_vector_type(4)));
typedef unsigned u32x2 __attribute__((ext_vector_type(2)));
typedef float f32x2_t __attribute__((ext_vector_type(2)));
typedef __bf16 bf16x2_t __attribute__((ext_vector_type(2)));
typedef GAS unsigned gu32;
typedef int v8i __attribute__((ext_vector_type(8)));
typedef int v4i __attribute__((ext_vector_type(4)));
typedef _Float16 f16x8 __attribute__((ext_vector_type(8)));
typedef _Float16 f16x2 __attribute__((ext_vector_type(2)));

constexpr int BATCH = 16, SEQ = 2048, DM = 1024, NTOK = BATCH * SEQ;
constexpr int IN_DIM = 3088;
constexpr int NEXP = 32, DEXP = 512;
constexpr float EPS = 1e-6f;
constexpr float LOG2E = 1.4426950408889634f;
constexpr float WGU_SC = 64.f, WD_SC = 32.f, ACT_SC = 8.f, Y_SC = 8.f;
constexpr int NA = 1792, NB = 1280;
constexpr int NGRP = NTOK / 128;

constexpr size_t MiB = 1u << 20;
constexpr size_t WS_CTL = 0, CTL_ZERO_BYTES = 64 * 1024;
constexpr size_t WS_WA = 2 * MiB;
constexpr size_t WS_WB = 6 * MiB;
constexpr size_t WS_WO = 9 * MiB;
constexpr size_t WS_WR = 11 * MiB;
constexpr size_t WS_W2T = WS_WR + 2 * 48 * 1024 * 2;
constexpr size_t WS_WGU = 12 * MiB;
constexpr size_t WS_WD = 76 * MiB;
constexpr size_t WS_H = 108 * MiB;
constexpr size_t WS_KV = WS_H;
constexpr size_t WS_XB = 44 * MiB;
constexpr size_t WS_MIX = 172 * MiB;
constexpr size_t WS_SQ = 236 * MiB;
constexpr size_t WS_SK = 268 * MiB;
constexpr size_t WS_GQ = 300 * MiB;
constexpr size_t WS_GRS = 316 * MiB;
constexpr size_t WS_TT = 348 * MiB;
constexpr size_t WS_GLR = 428 * MiB;
constexpr size_t WS_ST = 429 * MiB;
constexpr size_t WS_DTOT = 461 * MiB;
constexpr size_t WS_ACT = 236 * MiB;
constexpr size_t WS_H8 = 272 * MiB;
constexpr size_t WS_Y = 308 * MiB;
constexpr size_t WS_LOCL = 462 * MiB;
constexpr size_t WS_CNTS = 467 * MiB;
constexpr size_t WS_GATE = 470 * MiB;
constexpr size_t WS_RSTD = WS_GATE + 512 * 1024;
constexpr size_t WS_RSTD1 = WS_GATE + 768 * 1024;
constexpr size_t WS_END = 472 * MiB;
constexpr int CW_TMO = 0, CW_CODE = 1;
constexpr int CW_BAR = 4096;
constexpr int CW_CNT = 16384;

constexpr int RING_OFF = 0, RING_BYTES = 131072;
constexpr int LDSCTL_OFF = RING_BYTES, MISC_OFF = LDSCTL_OFF + 320;
constexpr int TAB_OFF = LDSCTL_OFF + 1024;
constexpr int LDS_BYTES = 147456;
constexpr int T_CNT = 0, T_TBASE = 128, T_NT = 264, T_TILE_E = 272, T_ROWTAB = 272 + 320 * 4, NU_MAX = 6;
constexpr int T_RSTAB = T_ROWTAB + NU_MAX * 1024;
static_assert(TAB_OFF + T_RSTAB + NU_MAX * 256 * 4 <= LDS_BYTES, "LDS tables");

#define RLX_AGENT __ATOMIC_RELAXED, __HIP_MEMORY_SCOPE_AGENT
#define LDS_WAIT() asm volatile("s_waitcnt lgkmcnt(0)" ::: "memory")
#define VM_WAIT() asm volatile("s_waitcnt vmcnt(0)" ::: "memory")

__device__ __forceinline__ unsigned cvtpk(float lo, float hi) { f32x2_t v = {lo, hi}; bf16x2_t b = __builtin_convertvector(v, bf16x2_t); return __builtin_bit_cast(unsigned, b); }
__device__ __forceinline__ u32x2 pack8_fp8(const float* a) { int lo = __builtin_amdgcn_cvt_pk_fp8_f32(a[0], a[1], 0, false); lo = __builtin_amdgcn_cvt_pk_fp8_f32(a[2], a[3], lo, true);
    int hi = __builtin_amdgcn_cvt_pk_fp8_f32(a[4], a[5], 0, false); hi = __builtin_amdgcn_cvt_pk_fp8_f32(a[6], a[7], hi, true); u32x2 r; r.x = (unsigned)lo; r.y = (unsigned)hi; return r; }
__device__ __forceinline__ float bf2f(short s) { return __uint_as_float(((unsigned)(unsigned short)s) << 16); }
__device__ __forceinline__ bf16x8 pack8(const float* a) { u32x4 p; p.x = cvtpk(a[0], a[1]); p.y = cvtpk(a[2], a[3]); p.z = cvtpk(a[4], a[5]); p.w = cvtpk(a[6], a[7]); return __builtin_bit_cast(bf16x8, p); }
__device__ __forceinline__ int PI32(int i) { return 16 * ((i >> 2) & 1) + (i & 3) + 4 * (i >> 3); }
#define MFMA32(a, b, c) __builtin_amdgcn_mfma_f32_32x32x16_bf16((a), (b), (c), 0, 0, 0)
#define MFMA16(a, b, c) __builtin_amdgcn_mfma_f32_16x16x32_bf16((a), (b), (c), 0, 0, 0)
__device__ __forceinline__ void swap32(float x, float& lo, float& hi) { auto rr = __builtin_amdgcn_permlane32_swap(__float_as_uint(x), __float_as_uint(x), false, false); lo = __uint_as_float(rr[0]); hi = __uint_as_float(rr[1]); }

namespace pg8 {
#define PG8_LAS __attribute__((address_space(3)))
constexpr int BM = 256, BK = 64, HALF = 128, HTB = HALF * BK * 2, STAGE_BYTES = 8 * HTB, NXCD = 8, WGM = 8;
__host__ __device__ __forceinline__ int lds_byte(int r, int c) { const int st = (r >> 4) * 2 + (c >> 5), rr = r & 15, cc = c & 31, ob = rr * 64 + cc * 2; return st * 1024 + (ob ^ (((ob >> 9) & 1) << 5)); }
__host__ __device__ __forceinline__ void stage_rc(int b, int& R, int& C) { const int st = b / 1024, sb = b % 1024, swz = sb ^ (((sb >> 9) & 1) << 5); R = (st >> 1) * 16 + swz / 64; C = (st & 1) * 32 + (swz % 64) / 2; }
__host__ __device__ __forceinline__ int perm32(int rho) { const int n = rho >> 4, i = rho & 15; return 8 * (i >> 2) + 4 * n + (i & 3); }

struct Unit { int pm, pn, e, rt, nv; };

struct SchedDense {
    const char* A; const char* Bt; int K; int nM, nN, nwg, G, c;
    __device__ void init(const void* A_, const void* Bt_, int M, int N, int K_, int G_, int c_) { A = (const char*)A_; Bt = (const char*)Bt_; K = K_; nM = M / BM; nN = N / BM; nwg = nM * nN; G = G_; c = c_; }
    __device__ __forceinline__ bool next(int i, Unit& u) const {
        const long L = (long)i * G + c; if (L >= nwg) return false;
        int wgid = (int)L; { const int q = nwg / NXCD, r = nwg % NXCD, xcd = wgid % NXCD, off = wgid / NXCD; wgid = (xcd < r ? xcd * (q + 1) : r * (q + 1) + (xcd - r) * q) + off; }
        const int nig = WGM * nN, gid = wgid / nig, fm = gid * WGM, gsz = (nM - fm) < WGM ? (nM - fm) : WGM;
        u.pm = fm + ((wgid % nig) % gsz); u.pn = (wgid % nig) / gsz; u.e = 0; u.rt = 0; u.nv = 256; return true;
    }
    __device__ __forceinline__ const char* a_ptr(const Unit& u) const { return A + (size_t)u.pm * BM * K * 2; }
    __device__ __forceinline__ const char* b_ptr(const Unit& u) const { return Bt + (size_t)u.pn * BM * K * 2; }
    __device__ __forceinline__ void a_voff(int, const Unit&, int tid, unsigned (&v)[2][2]) const {
#pragma unroll
        for (int i = 0; i < 2; ++i) { int R, C; stage_rc(tid * 16 + i * 8192, R, C);
#pragma unroll
            for (int h = 0; h < 2; ++h) v[h][i] = (unsigned)((h * HALF + R) * K + C) * 2u; }
    }
};
template <bool GATHER> struct SchedMoE {
    const char* A; const char* Bt; int K; size_t bstride; int G, c;
    const PG8_LAS int* tab;
    __device__ __forceinline__ bool next(int i, Unit& u) const {
        const int L = i * G + c; const int NT = tab[T_NT / 4];
        if (L >= NT * 4) return false;
        const int tile = L >> 2; u.pm = tile; u.pn = L & 3; const int e = tab[T_TILE_E / 4 + tile]; u.e = e;
        u.rt = tile - tab[T_TBASE / 4 + e]; const int rem = tab[T_CNT / 4 + e] - u.rt * 256; u.nv = rem < 256 ? rem : 256; return true;
    }
    __device__ __forceinline__ const char* a_ptr(const Unit& u) const { return GATHER ? A : A + (size_t)u.pm * BM * K * 2; }
    __device__ __forceinline__ const char* b_ptr(const Unit& u) const { return Bt + (size_t)u.e * bstride + (size_t)u.pn * BM * K * 2; }
    __device__ __forceinline__ void a_voff(int ui, const Unit&, int tid, unsigned (&v)[2][2]) const {
        asm volatile("" : "+v"(tid));
#pragma unroll
        for (int i = 0; i < 2; ++i) { int R, C; stage_rc(tid * 16 + i * 8192, R, C);
#pragma unroll
            for (int h = 0; h < 2; ++h) {
                if (GATHER) { const int tok = tab[T_ROWTAB / 4 + ui * 256 + h * HALF + R] >> 1; v[h][i] = (unsigned)(tok * K + C) * 2u; }
                else v[h][i] = (unsigned)((h * HALF + R) * K + C) * 2u; } }
    }
};

template <class Epi, class Sched, bool TAIL = false, bool FP8 = false>
__device__ __forceinline__ void gemm_phase(PG8_LAS unsigned char* lds, const int K, const Sched& S, const Epi& E) {
    const int tid = threadIdx.x, wid = __builtin_amdgcn_readfirstlane(tid >> 6), lane = tid & 63, wr = wid >> 2, wc = wid & 3, fr = lane & 15, fq = lane >> 4;
    const int nt = K / BK;
    constexpr bool EARLY = !FP8;
    unsigned voffB[1][2];
#pragma unroll
    for (int i = 0; i < 2; ++i) { int R, C; stage_rc(tid * 16 + i * 8192, R, C); const int Rb = (R & ~31) + perm32(R & 31);
        voffB[0][i] = (unsigned)(Rb * K + C) * 2u; }
    const size_t hstepB = (size_t)HALF * K * 2;
    const size_t kstep = (size_t)(BK * 2);
    const unsigned ldsw = (unsigned)wid * 1024u;
    const int aoff = lds_byte(wr * 64 + fr, fq * 8), boff = lds_byte(wc * 32 + fr, fq * 8);
#define PG8_SA(b, h) (((b) * 2 + (h)) * HTB)
#define PG8_SB(b, h) ((4 + (b) * 2 + (h)) * HTB)
#define PG8_STAGE(bufoff, gbase, voff) do { _Pragma("unroll") for (int _i = 0; _i < 2; ++_i) \
        __builtin_amdgcn_global_load_lds((const unsigned*)((const char*)(gbase) + (voff)[_i]), (PG8_LAS unsigned*)(lds + (bufoff) + ldsw + _i * 8192), 16, 0, 0); } while (0)
#define PG8_RD16(off) (*(const PG8_LAS v4i*)(lds + (off)))
#define PG8_LDA(dst, b, h) do { _Pragma("unroll") for (int m = 0; m < 4; ++m) { \
        if constexpr (FP8) At8[m] = __builtin_shufflevector(PG8_RD16(PG8_SA(b, h) + aoff + m * 2048), PG8_RD16(PG8_SA(b, h) + aoff + m * 2048 + 1024), 0, 1, 2, 3, 4, 5, 6, 7); \
        else { _Pragma("unroll") for (int k = 0; k < 2; ++k) dst[m][k] = *(const PG8_LAS bf16x8*)(lds + PG8_SA(b, h) + aoff + m * 2048 + k * 1024); } } } while (0)
#define PG8_LDB(dst, b, h) do { _Pragma("unroll") for (int n = 0; n < 2; ++n) { \
        if constexpr (FP8) dst##8[n] = __builtin_shufflevector(PG8_RD16(PG8_SB(b, h) + boff + n * 2048), PG8_RD16(PG8_SB(b, h) + boff + n * 2048 + 1024), 0, 1, 2, 3, 4, 5, 6, 7); \
        else { _Pragma("unroll") for (int k = 0; k < 2; ++k) dst[n][k] = *(const PG8_LAS bf16x8*)(lds + PG8_SB(b, h) + boff + n * 2048 + k * 1024); } } } while (0)
#define PG8_MMA(ai, bj, At, Bt) do { __builtin_amdgcn_s_setprio(1); _Pragma("unroll") for (int m = 0; m < 4; ++m) _Pragma("unroll") for (int n = 0; n < 2; ++n) { \
        if constexpr (FP8) asm volatile("v_mfma_scale_f32_16x16x128_f8f6f4 %0, %1, %2, %0, %3, %3 op_sel_hi:[0,0,0]" : "+v"(acc[ai][bj][m][n]) : "v"(Bt##8[n]), "v"(At8[m]), "v"(sc1)); \
        else { _Pragma("unroll") for (int k = 0; k < 2; ++k) acc[ai][bj][m][n] = __builtin_amdgcn_mfma_f32_16x16x32_bf16(Bt[n][k], At[m][k], acc[ai][bj][m][n], 0, 0, 0); } } \
        __builtin_amdgcn_s_setprio(0); } while (0)
#define PG8_WAIT_V(n) asm volatile("s_waitcnt vmcnt(" #n ")" ::: "memory")
#define PG8_WAIT_L(n) asm volatile("s_waitcnt lgkmcnt(" #n ")" ::: "memory")
#define PG8_BAR __builtin_amdgcn_s_barrier()
#define PG8_SCHED __builtin_amdgcn_sched_barrier(0)
    Unit cur, nxt; int ui = 0;
    if (!S.next(0, cur)) return;
    f32x4 acc[2][2][4][2];
#pragma unroll
    for (int a = 0; a < 2; ++a)
#pragma unroll
        for (int b = 0; b < 2; ++b)
#pragma unroll
            for (int m = 0; m < 4; ++m)
#pragma unroll
                for (int n = 0; n < 2; ++n) acc[a][b][m][n] = (f32x4){0.f, 0.f, 0.f, 0.f};
    bf16x8 At[4][2], B0[2][2], B1[2][2];
    v8i At8[4], B08[2], B18[2];
    int sc1 = 0x7f7f7f7f; asm volatile("" : "+v"(sc1));
    unsigned vc[2][2], vn[2][2];
    S.a_voff(0, cur, tid, vc);
    const char* cA = S.a_ptr(cur); const char* cB = S.b_ptr(cur);
    PG8_STAGE(PG8_SB(0, 0), cB, voffB[0]); PG8_STAGE(PG8_SB(0, 1), (cB) + hstepB, voffB[0]); PG8_STAGE(PG8_SA(0, 0), cA, vc[0]); PG8_STAGE(PG8_SA(0, 1), cA, vc[1]);
    if (wr == 1) PG8_BAR;
    PG8_WAIT_V(2); PG8_BAR;
    PG8_STAGE(PG8_SB(1, 0), cB + kstep, voffB[0]); PG8_STAGE(PG8_SA(1, 0), cA + kstep, vc[0]); PG8_STAGE(PG8_SB(1, 1), (cB + kstep) + hstepB, voffB[0]);
    PG8_WAIT_V(6); PG8_BAR;
    for (;;) {
        const bool has_next = S.next(ui + 1, nxt);
        const char* nA = has_next ? S.a_ptr(nxt) : cA; const char* nB = has_next ? S.b_ptr(nxt) : cB;
        if (has_next) S.a_voff(ui + 1, nxt, tid, vn);
        else {
#pragma unroll
            for (int h = 0; h < 2; ++h)
#pragma unroll
                for (int i = 0; i < 2; ++i) vn[h][i] = vc[h][i]; }
        const bool full_hi = !TAIL || cur.nv > HALF;
        for (int t = 0; t < nt; t += 2) {
            const bool last = (t == nt - 2);
            int fl_ = __builtin_amdgcn_readfirstlane(EARLY ? (t | (ui == 0)) : 1); asm volatile("" : "+s"(fl_));
            const bool fresh = (fl_ == 0);
            const char* a1 = cA + (size_t)(t + 1) * kstep;
            const char* a2 = last ? nA : cA + (size_t)(t + 2) * kstep; const char* b2 = last ? nB : cB + (size_t)(t + 2) * kstep;
            const char* a3 = a2 + kstep; const char* b3 = b2 + kstep;
            unsigned w0[2], w1[2];
            w0[0] = last ? vn[0][0] : vc[0][0]; w0[1] = last ? vn[0][1] : vc[0][1]; w1[0] = last ? vn[1][0] : vc[1][0]; w1[1] = last ? vn[1][1] : vc[1][1];
            PG8_LDB(B0, 0, 0); PG8_LDB(B1, 0, 1); PG8_SCHED; PG8_LDA(At, 0, 0); if (!fresh) { PG8_STAGE(PG8_SA(1, 1), a1, vc[1]); PG8_WAIT_V(8); }
            PG8_WAIT_L(0); PG8_BAR; PG8_MMA(0, 0, At, B0); PG8_MMA(0, 1, At, B1); PG8_BAR; PG8_SCHED;
            PG8_LDA(At, 0, 1); PG8_STAGE(PG8_SB(0, 0), b2, voffB[0]); PG8_STAGE(PG8_SB(0, 1), (b2) + hstepB, voffB[0]); PG8_STAGE(PG8_SA(0, 0), a2, w0);
            if (!fresh) PG8_WAIT_V(8); PG8_WAIT_L(0); PG8_BAR; if (full_hi) { PG8_MMA(1, 0, At, B0); PG8_MMA(1, 1, At, B1); } PG8_BAR; PG8_SCHED;
            PG8_LDB(B0, 1, 0); PG8_LDB(B1, 1, 1); PG8_SCHED; PG8_LDA(At, 1, 0); PG8_STAGE(PG8_SA(0, 1), a2, w1);
            if (!fresh) PG8_WAIT_V(8); PG8_WAIT_L(0); PG8_BAR; PG8_MMA(0, 0, At, B0); PG8_MMA(0, 1, At, B1); PG8_BAR; PG8_SCHED;
            PG8_LDA(At, 1, 1); PG8_STAGE(PG8_SB(1, 0), b3, voffB[0]); PG8_STAGE(PG8_SB(1, 1), (b3) + hstepB, voffB[0]); PG8_STAGE(PG8_SA(1, 0), a3, w0);
            PG8_WAIT_V(8); PG8_WAIT_L(0); PG8_BAR; if (full_hi) { PG8_MMA(1, 0, At, B0); PG8_MMA(1, 1, At, B1); } PG8_BAR; PG8_SCHED;
        }
        if (wr == 0) PG8_BAR;
        if constexpr (EARLY) {
            PG8_STAGE(PG8_SA(1, 1), nA + kstep, vn[1]);
            PG8_WAIT_V(0); }
        if constexpr (FP8) asm volatile("s_nop 15\n\ts_nop 15" ::: "memory");
        { int t2_ = threadIdx.x; asm volatile("" : "+v"(t2_)); E(acc, cur, ui, wr, wc, t2_ & 15, (t2_ >> 4) & 3); }
        if (!has_next) break;
#pragma unroll
        for (int a = 0; a < 2; ++a)
#pragma unroll
            for (int b = 0; b < 2; ++b)
#pragma unroll
                for (int m = 0; m < 4; ++m)
#pragma unroll
                    for (int n = 0; n < 2; ++n) acc[a][b][m][n] = (f32x4){0.f, 0.f, 0.f, 0.f};
        cur = nxt; cA = nA; cB = nB; ++ui;
#pragma unroll
        for (int h = 0; h < 2; ++h)
#pragma unroll
            for (int i = 0; i < 2; ++i) vc[h][i] = vn[h][i];
        if (wr == 1) PG8_BAR;
    }
    PG8_WAIT_V(0);
    PG8_BAR;
#undef PG8_SA
#undef PG8_SB
#undef PG8_STAGE
#undef PG8_LDA
#undef PG8_LDB
#undef PG8_MMA
#undef PG8_RD16
#undef PG8_WAIT_V
#undef PG8_WAIT_L
#undef PG8_BAR
#undef PG8_SCHED
}

struct EpiBf16 {
    bf16* O; int ldc;
    __device__ __forceinline__ void operator()(const f32x4 (&acc)[2][2][4][2], const Unit& u, int, int wr, int wc, int fr, int fq) const {
        const int row0 = u.pm * BM + wr * 64 + fr, col0 = u.pn * BM + wc * 32 + 8 * fq;
#pragma unroll
        for (int ai = 0; ai < 2; ++ai)
#pragma unroll
            for (int m = 0; m < 4; ++m) { bf16* rowp = O + (size_t)(row0 + ai * HALF + m * 16) * ldc + col0;
#pragma unroll
                for (int bj = 0; bj < 2; ++bj) { const f32x4 v0 = acc[ai][bj][m][0], v1 = acc[ai][bj][m][1];
                    u32x4 w; w.x = cvtpk(v0[0], v0[1]); w.y = cvtpk(v0[2], v0[3]); w.z = cvtpk(v1[0], v1[1]); w.w = cvtpk(v1[2], v1[3]);
                    *(u32x4*)(rowp + bj * HALF) = w; } }
    }
};
struct EpiTT {
    bf16* O; const float* RS;
    __device__ __forceinline__ void operator()(const f32x4 (&acc)[2][2][4][2], const Unit& u, int, int wr, int wc, int fr, int fq) const {
        const int row0 = u.pm * BM + wr * 64 + fr, tokb0 = u.pn * 8 + wc;
        f32x4 rs[2][2];
#pragma unroll
        for (int bj = 0; bj < 2; ++bj) { const float* rp = RS + (size_t)(tokb0 + 4 * bj) * 32 + 8 * fq; rs[bj][0] = *(const f32x4*)rp; rs[bj][1] = *(const f32x4*)(rp + 4); }
#pragma unroll
        for (int ai = 0; ai < 2; ++ai)
#pragma unroll
            for (int m = 0; m < 4; ++m) { const int col = row0 + ai * HALF + m * 16;
#pragma unroll
                for (int bj = 0; bj < 2; ++bj) { const f32x4 v0 = acc[ai][bj][m][0] * rs[bj][0], v1 = acc[ai][bj][m][1] * rs[bj][1];
                    u32x4 w; w.x = cvtpk(v0[0], v0[1]); w.y = cvtpk(v0[2], v0[3]); w.z = cvtpk(v1[0], v1[1]); w.w = cvtpk(v1[2], v1[3]);
                    *(u32x4*)(O + ((size_t)(tokb0 + 4 * bj) * 1280 + col) * 32 + 8 * fq) = w; } }
    }
};
struct EpiA {
    bf16 *SQ, *SK, *GQ, *GRS; const float *gq_norm, *gk_norm; const float* RS;
    __device__ __forceinline__ void operator()(const f32x4 (&acc)[2][2][4][2], const Unit& u, int, int wr, int wc, int fr, int fq) const {
        const int pn = u.pn; const int row0 = u.pm * BM + wr * 64 + fr;
        bf16* base; int ldc, colt; int mode;
        float scale = 1.f; const float* gain = nullptr;
        if (pn < 2)      { base = SQ; ldc = 512; colt = pn * 256; mode = 0; gain = gq_norm; scale = 0.125f * LOG2E; }
        else if (pn < 4) { base = SK; ldc = 512; colt = (pn - 2) * 256; mode = 0; gain = gk_norm; scale = 1.f; }
        else if (pn < 5) { base = GQ; ldc = 256; colt = 0; mode = 1; scale = 0.125f; }
        else             { base = GRS; ldc = 512; colt = (pn - 5) * 256; mode = 2; }
        const int col0 = colt + wc * 64 + 8 * fq;
        f32x4 gv[2][2];
#pragma unroll
        for (int bj = 0; bj < 2; ++bj)
#pragma unroll
            for (int n = 0; n < 2; ++n) { if (mode == 0) { gv[bj][n] = *(const f32x4*)(gain + 32 * bj + 8 * fq + 4 * n); gv[bj][n] = gv[bj][n] * scale; } else gv[bj][n] = (f32x4){scale, scale, scale, scale}; }
        float rs1v[2][4];
#pragma unroll
        for (int ai = 0; ai < 2; ++ai)
#pragma unroll
            for (int m = 0; m < 4; ++m) rs1v[ai][m] = RS[row0 + ai * HALF + m * 16];
#pragma unroll
        for (int ai = 0; ai < 2; ++ai)
#pragma unroll
            for (int m = 0; m < 4; ++m) {
                const float rs1 = rs1v[ai][m]; float rs = rs1;
                if (mode == 0) { float s = 0.f;
#pragma unroll
                    for (int bj = 0; bj < 2; ++bj)
#pragma unroll
                        for (int n = 0; n < 2; ++n) { const f32x4 x = acc[ai][bj][m][n]; s += (x[0] * x[0] + x[1] * x[1]) + (x[2] * x[2] + x[3] * x[3]); }
                    s += __shfl_xor(s, 16); s += __shfl_xor(s, 32);
                    rs = rs1 * __builtin_amdgcn_rsqf(rs1 * rs1 * s * (1.f / 64.f) + EPS); }
                bf16* rowp = base + (size_t)(row0 + ai * HALF + m * 16) * ldc + col0;
#pragma unroll
                for (int bj = 0; bj < 2; ++bj) { f32x4 v0 = acc[ai][bj][m][0], v1 = acc[ai][bj][m][1];
                    if (mode == 2) {
#pragma unroll
                        for (int e = 0; e < 4; ++e) { v0[e] *= rs1; v1[e] *= rs1; v0[e] = v0[e] * __builtin_amdgcn_rcpf(1.f + __builtin_amdgcn_exp2f(-v0[e] * LOG2E)); v1[e] = v1[e] * __builtin_amdgcn_rcpf(1.f + __builtin_amdgcn_exp2f(-v1[e] * LOG2E)); }
                    } else { v0 = v0 * rs * gv[bj][0]; v1 = v1 * rs * gv[bj][1]; }
                    u32x4 w; w.x = cvtpk(v0[0], v0[1]); w.y = cvtpk(v0[2], v0[3]); w.z = cvtpk(v1[0], v1[1]); w.w = cvtpk(v1[2], v1[3]);
                    *(u32x4*)(rowp + bj * 32) = w; } }
    }
};
struct EpiH {
    const bf16* XB; bf16* H; unsigned char* H8;
    __device__ __forceinline__ void operator()(const f32x4 (&acc)[2][2][4][2], const Unit& u, int, int wr, int wc, int fr, int fq) const {
        const int row0 = u.pm * BM + wr * 64 + fr, col0 = u.pn * BM + wc * 32 + 8 * fq;
#pragma unroll
        for (int ai = 0; ai < 2; ++ai) {
            u32x2 h8[4][2];
            bf16x8 xv[4][2];
#pragma unroll
            for (int m = 0; m < 4; ++m) { const size_t off = (size_t)(row0 + ai * HALF + m * 16) * DM + col0;
#pragma unroll
                for (int bj = 0; bj < 2; ++bj) xv[m][bj] = *(const bf16x8*)(XB + off + bj * HALF); }
#pragma unroll
            for (int m = 0; m < 4; ++m) { const size_t off = (size_t)(row0 + ai * HALF + m * 16) * DM + col0;
#pragma unroll
                for (int bj = 0; bj < 2; ++bj) { const bf16x8 xx = xv[m][bj];
                    const f32x4 v0 = acc[ai][bj][m][0] + (f32x4){bf2f(xx[0]), bf2f(xx[1]), bf2f(xx[2]), bf2f(xx[3])}, v1 = acc[ai][bj][m][1] + (f32x4){bf2f(xx[4]), bf2f(xx[5]), bf2f(xx[6]), bf2f(xx[7])};
                    u32x4 w; w.x = cvtpk(v0[0], v0[1]); w.y = cvtpk(v0[2], v0[3]); w.z = cvtpk(v1[0], v1[1]); w.w = cvtpk(v1[2], v1[3]);
                    *(u32x4*)(H + off + bj * HALF) = w;
                    const float f8[8] = {v0[0], v0[1], v0[2], v0[3], v1[0], v1[1], v1[2], v1[3]};
                    h8[m][bj] = pack8_fp8(f8); } }
#pragma unroll
            for (int mp = 0; mp < 2; ++mp)
#pragma unroll
                for (int bj = 0; bj < 2; ++bj) {
                    const auto r0 = __builtin_amdgcn_permlane16_swap(h8[2 * mp][bj].x, h8[2 * mp + 1][bj].x, false, false);
                    const auto r1 = __builtin_amdgcn_permlane16_swap(h8[2 * mp][bj].y, h8[2 * mp + 1][bj].y, false, false);
                    u32x4 w8; w8.x = r0[0]; w8.y = r1[0]; w8.z = r0[1]; w8.w = r1[1];
                    const size_t off8 = (size_t)(row0 + ai * HALF + (2 * mp + (fq & 1)) * 16) * DM + u.pn * BM + wc * 32 + 8 * (fq & ~1) + bj * HALF;
                    *(u32x4*)(H8 + off8) = w8; }
        }
    }
};
struct EpiGU {
    unsigned char* ACT; const float* RSTD; const PG8_LAS int* tab;
    __device__ __forceinline__ void operator()(const f32x4 (&acc)[2][2][4][2], const Unit& u, int ui, int wr, int wc, int fr, int fq) const {
        const int col0 = u.pn * 128 + wc * 32 + 8 * (fq & ~1); const int odd = fq & 1;
        float rsv[2][4];
#pragma unroll
        for (int ai = 0; ai < 2; ++ai)
#pragma unroll
            for (int m = 0; m < 4; ++m) { const int rl = ai * HALF + wr * 64 + m * 16 + fr; rsv[ai][m] = ((const PG8_LAS float*)tab)[T_RSTAB / 4 + ui * 256 + rl] * (1.f / WGU_SC); }
#pragma unroll
        for (int ai = 0; ai < 2; ++ai)
#pragma unroll
            for (int mp = 0; mp < 2; ++mp) {
                u32x2 pk[2];
#pragma unroll
                for (int q = 0; q < 2; ++q) { const int m = 2 * mp + q; const float rs = rsv[ai][m];
                    f32x4 g0 = acc[ai][0][m][0] * rs, g1 = acc[ai][0][m][1] * rs, u0 = acc[ai][1][m][0] * rs, u1 = acc[ai][1][m][1] * rs;
#pragma unroll
                    for (int e = 0; e < 4; ++e) { g0[e] = g0[e] * __builtin_amdgcn_rcpf(1.f + __builtin_amdgcn_exp2f(-g0[e] * LOG2E)) * u0[e]; g1[e] = g1[e] * __builtin_amdgcn_rcpf(1.f + __builtin_amdgcn_exp2f(-g1[e] * LOG2E)) * u1[e]; }
                    float f8[8] = {g0[0] * ACT_SC, g0[1] * ACT_SC, g0[2] * ACT_SC, g0[3] * ACT_SC, g1[0] * ACT_SC, g1[1] * ACT_SC, g1[2] * ACT_SC, g1[3] * ACT_SC};
#pragma unroll
                    for (int e = 0; e < 8; ++e) f8[e] = __builtin_fminf(__builtin_fmaxf(f8[e], -448.f), 448.f);
                    pk[q] = pack8_fp8(f8); }
                const auto r0 = __builtin_amdgcn_permlane16_swap(pk[0].x, pk[1].x, false, false);
                const auto r1 = __builtin_amdgcn_permlane16_swap(pk[0].y, pk[1].y, false, false);
                u32x4 w; w.x = r0[0]; w.y = r1[0]; w.z = r0[1]; w.w = r1[1];
                const int rl = ai * HALF + wr * 64 + (2 * mp + odd) * 16 + fr;
                if (rl < u.nv) *(u32x4*)(ACT + (size_t)(u.pm * 256 + rl) * DEXP + col0) = w; }
    }
};
struct EpiDown {
    unsigned char* Y; const PG8_LAS int* tab;
    __device__ __forceinline__ void operator()(const f32x4 (&acc)[2][2][4][2], const Unit& u, int ui, int wr, int wc, int fr, int fq) const {
        const int col0 = u.pn * BM + wc * 32 + 8 * (fq & ~1); const float sc = Y_SC / (WD_SC * ACT_SC); const int odd = fq & 1;
#pragma unroll
        for (int ai = 0; ai < 2; ++ai)
#pragma unroll
            for (int mp = 0; mp < 2; ++mp) { const int rl = ai * HALF + wr * 64 + (2 * mp + odd) * 16 + fr;
                const bool ok = rl < u.nv; const unsigned ts = (unsigned)tab[T_ROWTAB / 4 + ui * 256 + (ok ? rl : 0)];
                unsigned char* rowp = Y + (size_t)ts * DM + col0;
#pragma unroll
                for (int bj = 0; bj < 2; ++bj) {
                    u32x2 pk[2];
#pragma unroll
                    for (int q = 0; q < 2; ++q) { const f32x4 v0 = acc[ai][bj][2 * mp + q][0] * sc, v1 = acc[ai][bj][2 * mp + q][1] * sc;
                        const float f8[8] = {v0[0], v0[1], v0[2], v0[3], v1[0], v1[1], v1[2], v1[3]}; pk[q] = pack8_fp8(f8); }
                    const auto r0 = __builtin_amdgcn_permlane16_swap(pk[0].x, pk[1].x, false, false);
                    const auto r1 = __builtin_amdgcn_permlane16_swap(pk[0].y, pk[1].y, false, false);
                    u32x4 w; w.x = r0[0]; w.y = r1[0]; w.z = r0[1]; w.w = r1[1];
                    if (ok) *(u32x4*)(rowp + bj * HALF) = w; } }
    }
};
}

#define XB_TMO      128
#define XB_XCNT(j)  (256  + 64 * (j))
#define XB_XSUB(j)  (1280 + 64 * (j))
#define XB_XGEN(j)  (2304 + 64 * (j))
#define XB_TOP      3328
#define XB_TOPGEN   3392
#define XCD_BAR_WORDS 3456
#define XB_SPIN_CAP (1u << 18)
__device__ __forceinline__ unsigned xb_ld(unsigned* p)              { return __hip_atomic_load(p, __ATOMIC_RELAXED, __HIP_MEMORY_SCOPE_AGENT); }
__device__ __forceinline__ unsigned xb_add(unsigned* p, unsigned v) { return __hip_atomic_fetch_add(p, v, __ATOMIC_RELAXED, __HIP_MEMORY_SCOPE_AGENT); }
__device__ __forceinline__ unsigned xb_xcc_id() { return (unsigned)__builtin_amdgcn_s_getreg((3 << 11) | 20) & 0xFu; }
#define XB_SPIN(cond, bar) do { unsigned _sp = 0; while (cond) { __builtin_amdgcn_s_sleep(1); \
    if ((++_sp & 255u) == 0u) { if (xb_ld(&(bar)[XB_TMO])) break; if (_sp > XB_SPIN_CAP) { atomicAdd(&(bar)[XB_TMO], 1u); break; } } } } while (0)
struct XcdBarrier { unsigned* bar; unsigned x; volatile LAS unsigned* st; };
__device__ __forceinline__ XcdBarrier xcd_barrier_post(unsigned* bar, volatile LAS unsigned* st) {
    XcdBarrier b; b.bar = bar; b.x = xb_xcc_id(); b.st = st;
    if (threadIdx.x == 0) (void)xb_add(&bar[XB_XCNT(b.x)], 1u);
    return b;
}
__device__ __forceinline__ void xcd_barrier_complete(unsigned* bar, unsigned x, unsigned& nloc, unsigned& nx) {
    const unsigned G = gridDim.x * gridDim.y * gridDim.z;
    unsigned sum, cnt, mine, sp = 0u;
    for (;;) {
        sum = 0u; cnt = 0u; mine = 0u;
#pragma unroll
        for (unsigned j = 0; j < 16; ++j) { const unsigned c = xb_ld(&bar[XB_XCNT(j)]); sum += c; cnt += (c > 0u) ? 1u : 0u; mine = (j == x) ? c : mine; }
        if (sum == G) break;
        __builtin_amdgcn_s_sleep(1);
        if ((++sp & 255u) == 0u) { if (xb_ld(&bar[XB_TMO])) break; if (sp > XB_SPIN_CAP) { atomicAdd(&bar[XB_TMO], 1u); break; } }
    }
    nloc = mine > 0u ? mine : 1u; nx = cnt > 0u ? cnt : 1u;
}
__device__ __forceinline__ void xcd_barrier(const XcdBarrier& b) {
    asm volatile("s_waitcnt vmcnt(0)" ::: "memory");
    __syncthreads();
    if (threadIdx.x == 0) {
        unsigned* bar = b.bar;
        __builtin_amdgcn_s_waitcnt(0);
        unsigned nloc = b.st[0], nx = b.st[1];
        if (nloc == 0u) { xcd_barrier_complete(bar, b.x, nloc, nx); b.st[0] = nloc; b.st[1] = nx; }
        const unsigned old = xb_add(&bar[XB_XSUB(b.x)], 1u);
        const unsigned gen = old / nloc;
        if (old + 1u == (gen + 1u) * nloc) {
            __builtin_amdgcn_fence(__ATOMIC_RELEASE, "agent");
            asm volatile("s_waitcnt vmcnt(0)" ::: "memory");
            const unsigned og = xb_add(&bar[XB_TOP], 1u);
            const unsigned tg = og / nx;
            if (og + 1u == (tg + 1u) * nx) xb_add(&bar[XB_TOPGEN], 1u);
            else XB_SPIN(xb_ld(&bar[XB_TOPGEN]) == tg, bar);
            __builtin_amdgcn_fence(__ATOMIC_ACQUIRE, "agent");
            xb_add(&bar[XB_XGEN(b.x)], 1u);
            asm volatile("s_waitcnt vmcnt(0)" ::: "memory");
        } else {
            XB_SPIN(xb_ld(&bar[XB_XGEN(b.x)]) == gen, bar);
            __builtin_amdgcn_fence(__ATOMIC_ACQUIRE, "agent");
            asm volatile("s_waitcnt vmcnt(0)" ::: "memory");
        }
    }
    __syncthreads();
}

__device__ __forceinline__ void xcd_barrier_arrive(const XcdBarrier& b, volatile LAS unsigned* sv) {
    asm volatile("s_waitcnt vmcnt(0)" ::: "memory");
    __syncthreads();
    if (threadIdx.x == 0) {
        unsigned* bar = b.bar;
        __builtin_amdgcn_s_waitcnt(0);
        unsigned nloc = b.st[0], nx = b.st[1];
        if (nloc == 0u) { xcd_barrier_complete(bar, b.x, nloc, nx); b.st[0] = nloc; b.st[1] = nx; }
        const unsigned old = xb_add(&bar[XB_XSUB(b.x)], 1u);
        const unsigned gen = old / nloc;
        unsigned role = 0u, tg = 0u;
        if (old + 1u == (gen + 1u) * nloc) {
            __builtin_amdgcn_fence(__ATOMIC_RELEASE, "agent");
            asm volatile("s_waitcnt vmcnt(0)" ::: "memory");
            const unsigned og = xb_add(&bar[XB_TOP], 1u);
            tg = og / nx;
            if (og + 1u == (tg + 1u) * nx) { xb_add(&bar[XB_TOPGEN], 1u); role = 2u; } else role = 1u;
        }
        sv[0] = role; sv[1] = gen; sv[2] = tg;
    }
}
__device__ __forceinline__ void xcd_barrier_wait(const XcdBarrier& b, volatile LAS unsigned* sv) {
    asm volatile("s_waitcnt vmcnt(0)" ::: "memory");
    __syncthreads();
    if (threadIdx.x == 0) {
        unsigned* bar = b.bar; const unsigned role = sv[0], gen = sv[1], tg = sv[2];
        if (role != 0u) {
            if (role == 1u) XB_SPIN(xb_ld(&bar[XB_TOPGEN]) == tg, bar);
            __builtin_amdgcn_fence(__ATOMIC_ACQUIRE, "agent");
            xb_add(&bar[XB_XGEN(b.x)], 1u);
            asm volatile("s_waitcnt vmcnt(0)" ::: "memory");
        } else {
            XB_SPIN(xb_ld(&bar[XB_XGEN(b.x)]) == gen, bar);
            __builtin_amdgcn_fence(__ATOMIC_ACQUIRE, "agent");
            asm volatile("s_waitcnt vmcnt(0)" ::: "memory");
        }
    }
    __syncthreads();
}

__device__ __forceinline__ float wave_sum(float v) {
#pragma unroll
    for (int o = 1; o < 64; o <<= 1) v += __shfl_xor(v, o);
    return v;
}
__device__ __forceinline__ void tr_item(const float* src, int srcN, int k0, int n0, bf16* dst, int drow0, int dK, const float* kscale, LAS float* scr, int lane) {
    float w[32];
    const float* sp = src + (size_t)(k0 + (lane >> 5)) * srcN + n0 + (lane & 31);
#pragma unroll
    for (int i = 0; i < 32; ++i) w[i] = __builtin_nontemporal_load(sp + (size_t)(2 * i) * srcN);
    if (kscale) { const float ksv = kscale[k0 + lane];
#pragma unroll
        for (int i = 0; i < 32; ++i) { const float a = __int_as_float(__builtin_amdgcn_readlane(__float_as_int(ksv), 2 * i)), b = __int_as_float(__builtin_amdgcn_readlane(__float_as_int(ksv), 2 * i + 1)); w[i] *= (lane >> 5) ? b : a; } }
#pragma unroll
    for (int i = 0; i < 32; ++i) scr[(2 * i + (lane >> 5)) * 33 + (lane & 31)] = w[i];
    LDS_WAIT(); asm volatile("" ::: "memory");
    const int c = lane & 7;
#pragma unroll
    for (int j = 0; j < 4; ++j) { const int n = (lane >> 3) + 8 * j; const LAS float* s = scr + (8 * c) * 33 + n;
        u32x4 o; o.x = cvtpk(s[0 * 33], s[1 * 33]); o.y = cvtpk(s[2 * 33], s[3 * 33]); o.z = cvtpk(s[4 * 33], s[5 * 33]); o.w = cvtpk(s[6 * 33], s[7 * 33]);
        *(GAS u32x4*)(dst + (size_t)(drow0 + n) * dK + k0 + 8 * c) = o; }
    LDS_WAIT(); asm volatile("" ::: "memory");
}

__device__ __forceinline__ void tr_item8(const float* src, int srcN, int k0, int n0, unsigned char* dst, int drow0, int dK, const float* kscale, float scale, LAS float* scr, int lane) {
    float w[32];
    const float* sp = src + (size_t)(k0 + (lane >> 5)) * srcN + n0 + (lane & 31);
#pragma unroll
    for (int i = 0; i < 32; ++i) w[i] = __builtin_nontemporal_load(sp + (size_t)(2 * i) * srcN);
    float ksv = scale; if (kscale) ksv *= kscale[k0 + lane];
#pragma unroll
    for (int i = 0; i < 32; ++i) { const float a = __int_as_float(__builtin_amdgcn_readlane(__float_as_int(ksv), 2 * i)), b = __int_as_float(__builtin_amdgcn_readlane(__float_as_int(ksv), 2 * i + 1)); w[i] *= (lane >> 5) ? b : a; }
#pragma unroll
    for (int i = 0; i < 32; ++i) scr[(2 * i + (lane >> 5)) * 33 + (lane & 31)] = w[i];
    LDS_WAIT(); asm volatile("" ::: "memory");
#pragma unroll
    for (int j = 0; j < 2; ++j) { const int idx = lane + 64 * j, n = idx >> 2, c = idx & 3; const LAS float* sc_ = scr + (16 * c) * 33 + n;
        float f[16];
#pragma unroll
        for (int i = 0; i < 16; ++i) f[i] = sc_[i * 33];
        const u32x2 lo = pack8_fp8(f), hi = pack8_fp8(f + 8);
        u32x4 o; o.x = lo.x; o.y = lo.y; o.z = hi.x; o.w = hi.y;
        *(GAS u32x4*)(dst + (size_t)(drow0 + n) * dK + k0 + 16 * c) = o; }
    LDS_WAIT(); asm volatile("" ::: "memory");
}

struct Ptrs {
    const float *x, *attn_g, *w_in, *sbq_g, *sbk_g, *sbo_g, *w2, *gate_b, *glan_g, *w_out, *ffn_g, *rg_w, *rg_b, *re_w, *re_b, *wg, *wu, *wd;
    float* out; unsigned char* ws;
};

constexpr int SB_SPAN = 14, SB_VOFF = SB_SPAN * 4096;
__device__ __forceinline__ int sb_keyK(int r) { return ((r >> 1) & 3) | (((r >> 4) & 1) << 2); }
__device__ __forceinline__ int sb_keyV(int r) { return ((r >> 2) & 1) | (((r >> 4) & 1) << 1); }
__device__ __forceinline__ void sb_round(LAS unsigned char* lds, const bf16* SQ, const bf16* SK, const bf16* TT, const float* gout, bf16* MIX, int b, int h, int qg, int tid, int wave, int lane) {
    const int il = lane & 31, hi = lane >> 5, pil = PI32(il);
    const int qt = 8 * qg + wave;
    const size_t row0 = (size_t)b * SEQ + (size_t)qt * 32;
    bf16x8 qf[4];
    { const bf16* qp = SQ + (row0 + il) * 512 + h * 64 + 32 * hi;
#pragma unroll
      for (int s = 0; s < 4; ++s) qf[s] = *(const bf16x8*)(qp + 8 * s); }
    const int lo = (8 * qg - 6) > 0 ? (8 * qg - 6) : 0, nblk = 8 * qg + 8 - lo;
    {
        u32x4 st[SB_SPAN];
        const bool isK = tid < 256; const int q = tid - 256;
        const bf16* src = isK ? SK + ((size_t)b * SEQ + (size_t)lo * 32 + (tid >> 3)) * 512 + h * 64 + 8 * (tid & 7)
                              : TT + ((size_t)(b * (SEQ / 32) + lo) * NB + h * 64 + (q >> 2)) * 32 + 8 * (q & 3);
        const size_t bstep = isK ? (size_t)32 * 512 : (size_t)NB * 32;
#pragma unroll
        for (int i = 0; i < SB_SPAN; ++i) if (i < nblk) st[i] = *(const u32x4*)(src + (size_t)i * bstep);
        const int r = isK ? (tid >> 3) : (q >> 2);
        const unsigned dst = isK ? (unsigned)(r * 128 + (((tid & 7) ^ sb_keyK(r)) << 4)) : (unsigned)(SB_VOFF + r * 64 + (((q & 3) ^ sb_keyV(r & 31)) << 4));
#pragma unroll
        for (int i = 0; i < SB_SPAN; ++i) if (i < nblk) *(LAS u32x4*)(lds + dst + i * 4096) = st[i];
    }
    __syncthreads();
    f32x16 o0, o1;
#pragma unroll
    for (int r = 0; r < 16; ++r) { o0[r] = 0.f; o1[r] = 0.f; }
    float R = 1.f;
#define SB_MATH(KC, VC, kb_) do { \
        f32x16 z; \
        _Pragma("unroll") for (int r = 0; r < 16; ++r) z[r] = 0.f; \
        _Pragma("unroll") for (int s = 0; s < 4; ++s) z = MFMA32(KC[s], qf[s], z); \
        float beta[16], omb[16]; \
        const bool diag = ((kb_) == qt); \
        _Pragma("unroll") for (int r = 0; r < 16; ++r) { \
            const float zz = z[r]; const float t = __builtin_amdgcn_exp2f(-__builtin_fabsf(zz)); const float rr = __builtin_amdgcn_rcpf(1.f + t); const float sm = t * rr; \
            const bool pos = zz >= 0.f; float be = pos ? rr : sm; float om = pos ? sm : rr; \
            if (diag) { const bool valid = (16 * hi + r) < il; be = valid ? be : 0.f; om = valid ? om : 1.f; } \
            beta[r] = be; omb[r] = om; } \
        float e[16]; e[15] = 1.f; \
        _Pragma("unroll") for (int r = 14; r >= 0; --r) e[r] = e[r + 1] * omb[r + 1]; \
        const float P16 = e[0] * omb[0]; \
        float Plo, Phi; swap32(P16, Plo, Phi); \
        const float base = R * (hi ? 1.f : Phi); \
        float a[16]; \
        _Pragma("unroll") for (int r = 0; r < 16; ++r) a[r] = beta[r] * e[r] * base; \
        R = R * (Plo * Phi); \
        const bf16x8 p0 = pack8(a), p1 = pack8(a + 8); \
        o0 = MFMA32(VC[0][0], p0, o0); o0 = MFMA32(VC[0][1], p1, o0); \
        o1 = MFMA32(VC[1][0], p0, o1); o1 = MFMA32(VC[1][1], p1, o1); } while (0)
    bool fin = false;
    {
        const unsigned kbase = (unsigned)(pil * 128), vbase = (unsigned)(SB_VOFF + pil * 64);
        unsigned kx[4], vx[2];
#pragma unroll
        for (int s = 0; s < 4; ++s) kx[s] = (unsigned)(((4 * hi + s) ^ sb_keyK(pil)) << 4);
#pragma unroll
        for (int s = 0; s < 2; ++s) vx[s] = (unsigned)(((2 * hi + s) ^ sb_keyV(pil)) << 4);
        for (int kb = qt; ; --kb) {
            const unsigned so = (unsigned)(kb - lo) * 4096u;
            bf16x8 kf[4], vf[2][2];
#pragma unroll
            for (int s = 0; s < 4; ++s) kf[s] = *(const LAS bf16x8*)(lds + so + kbase + kx[s]);
#pragma unroll
            for (int dt = 0; dt < 2; ++dt)
#pragma unroll
                for (int s = 0; s < 2; ++s) vf[dt][s] = *(const LAS bf16x8*)(lds + so + vbase + dt * 2048 + vx[s]);
            SB_MATH(kf, vf, kb);
            if (kb == 0 || __all(R == 0.f)) { fin = true; break; }
            if (kb == lo) break;
        }
    }
    if (!fin) {
        for (int kb = lo - 1; ; --kb) {
            bf16x8 kf[4], vf[2][2];
            const bf16* kp = SK + ((size_t)b * SEQ + (size_t)kb * 32 + pil) * 512 + h * 64 + 32 * hi;
#pragma unroll
            for (int s = 0; s < 4; ++s) kf[s] = *(const bf16x8*)(kp + 8 * s);
            const bf16* vp = TT + ((size_t)(b * (SEQ / 32) + kb) * NB + h * 64 + pil) * 32 + 16 * hi;
#pragma unroll
            for (int dt = 0; dt < 2; ++dt)
#pragma unroll
                for (int s = 0; s < 2; ++s) vf[dt][s] = *(const bf16x8*)(vp + dt * 32 * 32 + 8 * s);
            SB_MATH(kf, vf, kb);
            if (kb == 0 || __all(R == 0.f)) break;
        }
    }
#undef SB_MATH
    float ss = 0.f;
#pragma unroll
    for (int r = 0; r < 16; ++r) ss += o0[r] * o0[r] + o1[r] * o1[r];
    float slo, shi; swap32(ss, slo, shi);
    const float rstd = __builtin_amdgcn_rsqf((slo + shi) * (1.f / 64.f) + EPS);
    bf16* op = MIX + (row0 + il) * DM + h * 64 + 16 * hi;
#pragma unroll
    for (int dt = 0; dt < 2; ++dt) {
        float v[16];
#pragma unroll
        for (int r4 = 0; r4 < 4; ++r4) { const f32x4 g = *(const f32x4*)(gout + 32 * dt + 16 * hi + 4 * r4);
#pragma unroll
            for (int e2 = 0; e2 < 4; ++e2) v[4 * r4 + e2] = (dt ? o1[4 * r4 + e2] : o0[4 * r4 + e2]) * rstd * g[e2]; }
        *(bf16x8*)(op + 32 * dt) = pack8(v); *(bf16x8*)(op + 32 * dt + 8) = pack8(v + 8);
    }
    __syncthreads();
}

__device__ __forceinline__ void gla_a(const bf16* GLR, const bf16* W2T, const float* gate_b, const bf16* TT, bf16* KV, float* DTOT, int bh, int j, int lane) {
    const int il = lane & 31, hi = lane >> 5, pil = PI32(il);
    const int b = bh >> 2, h = bh & 3;
    const size_t t0 = (size_t)b * SEQ + (size_t)j * 64;
    bf16x8 gf[2], wf[2], gkf[2][2][2], bvf[4][4]; float bias[2];
#pragma unroll
    for (int ch = 0; ch < 2; ++ch) gf[ch] = *(const bf16x8*)(GLR + (t0 + 32 * ch + pil) * 16 + 8 * hi);
#pragma unroll
    for (int kh = 0; kh < 2; ++kh) { const int kcol = 64 * h + 32 * kh + pil; wf[kh] = *(const bf16x8*)(W2T + kcol * 16 + 8 * hi); bias[kh] = gate_b[kcol];
        const bf16* gkp = TT + ((t0 >> 5) * NB + 512 + kcol) * 32 + 16 * hi;
#pragma unroll
        for (int ch = 0; ch < 2; ++ch) { gkf[kh][ch][0] = *(const bf16x8*)(gkp + ch * NB * 32); gkf[kh][ch][1] = *(const bf16x8*)(gkp + ch * NB * 32 + 8); } }
#pragma unroll
    for (int vq = 0; vq < 4; ++vq) { const bf16* vp = TT + ((t0 >> 5) * NB + 768 + 128 * h + 32 * vq + il) * 32 + 16 * hi;
#pragma unroll
        for (int s = 0; s < 4; ++s) bvf[vq][s] = *(const bf16x8*)(vp + (s >> 1) * NB * 32 + 8 * (s & 1)); }
    bf16x8 akf[2][4];
#pragma unroll
    for (int kh = 0; kh < 2; ++kh) {
        const int kcol = 64 * h + 32 * kh + pil;
        float cs[2][16];
#pragma unroll
        for (int ch = 0; ch < 2; ++ch) {
            f32x16 g;
#pragma unroll
            for (int r = 0; r < 16; ++r) g[r] = 0.f;
            g = MFMA32(gf[ch], wf[kh], g);
            if (kh == 0 && ch == 0) asm volatile("" : "+v"(g) :: "memory");
            float run = 0.f;
#pragma unroll
            for (int r = 0; r < 16; ++r) { const float x = g[r] + bias[kh];
                const float ls2 = __builtin_fminf(x, 0.f) * LOG2E - __builtin_amdgcn_logf(1.f + __builtin_amdgcn_exp2f(-__builtin_fabsf(x) * LOG2E));
                run += ls2 * (1.f / 16.f); cs[ch][r] = run; }
        }
        float t0lo, t0hi, t1lo, t1hi; swap32(cs[0][15], t0lo, t0hi); swap32(cs[1][15], t1lo, t1hi);
        const float off0 = hi ? t0lo : 0.f, off1 = (t0lo + t0hi) + (hi ? t1lo : 0.f), total = (t0lo + t0hi) + (t1lo + t1hi);
        if (hi == 0) DTOT[((size_t)bh * 32 + j) * 64 + 32 * kh + pil] = __builtin_amdgcn_exp2f(total);
#pragma unroll
        for (int ch = 0; ch < 2; ++ch) {
            const bf16x8 k0 = gkf[kh][ch][0], k1 = gkf[kh][ch][1];
            float kd[16]; const float off = ch ? off1 : off0;
#pragma unroll
            for (int r = 0; r < 16; ++r) { const float dec = __builtin_amdgcn_exp2f(total - (cs[ch][r] + off)); kd[r] = bf2f(r < 8 ? k0[r] : k1[r - 8]) * dec; }
            akf[kh][2 * ch] = pack8(kd); akf[kh][2 * ch + 1] = pack8(kd + 8);
        }
    }
#pragma unroll
    for (int vq = 0; vq < 4; ++vq) {
#pragma unroll
        for (int kh = 0; kh < 2; ++kh) {
            f32x16 kv;
#pragma unroll
            for (int r = 0; r < 16; ++r) kv[r] = 0.f;
#pragma unroll
            for (int s = 0; s < 4; ++s) kv = MFMA32(akf[kh][s], bvf[vq][s], kv);
            bf16* dst = KV + (((size_t)bh * 32 + j) * 128 + 32 * vq + il) * 64 + 32 * kh + 16 * hi;
            float kvf[16];
#pragma unroll
            for (int r = 0; r < 16; ++r) kvf[r] = kv[r];
            *(bf16x8*)dst = pack8(kvf); *(bf16x8*)(dst + 8) = pack8(kvf + 8);
        }
    }
}
__device__ __forceinline__ void gla_b(const bf16* KV, const float* DTOT, bf16* ST, int task, int lane) {
    const int bh = task >> 5, part = task & 31; const int e0 = part * 256 + lane * 4; const int k = e0 & 63;
    f32x4 S = (f32x4){0.f, 0.f, 0.f, 0.f};
#pragma unroll
    for (int half = 0; half < 2; ++half) {
        u32x2 kvp[16]; f32x4 d[16];
#pragma unroll
        for (int q = 0; q < 16; ++q) { const int j = 16 * half + q;
            kvp[q] = *(const u32x2*)(KV + ((size_t)bh * 32 + j) * 8192 + e0); d[q] = *(const f32x4*)(DTOT + ((size_t)bh * 32 + j) * 64 + k); }
#pragma unroll
        for (int q = 0; q < 16; ++q) { const int j = 16 * half + q;
            const f32x4 kv = (f32x4){__uint_as_float(kvp[q].x << 16), __uint_as_float(kvp[q].x & 0xffff0000u), __uint_as_float(kvp[q].y << 16), __uint_as_float(kvp[q].y & 0xffff0000u)};
            S = d[q] * S + kv;
            u32x2 w; w.x = cvtpk(S[0], S[1]); w.y = cvtpk(S[2], S[3]);
            *(u32x2*)(ST + ((size_t)bh * 32 + j) * 8192 + e0) = w; }
        asm volatile("" ::: "memory");
    }
}
__device__ __forceinline__ void gla_c(LAS unsigned char* wl, const bf16* ST, const bf16* GQ, const bf16* GRS, const float* gn, bf16* MIX, int bh, int j, int lane) {
    const int il = lane & 31, hi = lane >> 5, pil = PI32(il);
    const int b = bh >> 2, h = bh & 3;
    const size_t t0 = (size_t)b * SEQ + (size_t)j * 64;
    const bf16* sp = ST + ((size_t)bh * 32 + j) * 8192 + lane * 8;
    u32x4 st[16];
#pragma unroll
    for (int i = 0; i < 16; ++i) st[i] = *(const u32x4*)(sp + i * 512);
    bf16x8 bq[2][4], gr[2][4][2];
#pragma unroll
    for (int ch = 0; ch < 2; ++ch) { const size_t row = t0 + 32 * ch + il;
#pragma unroll
        for (int s = 0; s < 4; ++s) bq[ch][s] = *(const bf16x8*)(GQ + row * 256 + 64 * h + 16 * s + 8 * hi); }
    { const size_t row = t0 + il;
#pragma unroll
      for (int vt = 0; vt < 4; ++vt) { gr[0][vt][0] = *(const bf16x8*)(GRS + row * 512 + 128 * h + 32 * vt + 16 * hi); gr[0][vt][1] = *(const bf16x8*)(GRS + row * 512 + 128 * h + 32 * vt + 16 * hi + 8); } }
    { const int vr = lane >> 3, c = lane & 7;
#pragma unroll
      for (int i = 0; i < 16; ++i) { const int v = 8 * i + vr; *(LAS u32x4*)(wl + v * 128 + ((c ^ sb_keyK(v & 31)) << 4)) = st[i]; } }
    LDS_WAIT(); asm volatile("" ::: "memory");
    unsigned ax[4];
#pragma unroll
    for (int s = 0; s < 4; ++s) ax[s] = (unsigned)(pil * 128 + (((2 * s + hi) ^ sb_keyK(pil)) << 4));
#pragma unroll
    for (int ch = 0; ch < 2; ++ch) {
        const size_t row = t0 + 32 * ch + il;
        f32x16 O[4]; float ss = 0.f;
#pragma unroll
        for (int vt = 0; vt < 4; ++vt) {
#pragma unroll
            for (int r = 0; r < 16; ++r) O[vt][r] = 0.f;
#pragma unroll
            for (int s = 0; s < 4; ++s) { const bf16x8 af = *(const LAS bf16x8*)(wl + vt * 4096 + ax[s]); O[vt] = MFMA32(af, bq[ch][s], O[vt]); }
            if (ch == 0 && vt == 0) {
                const size_t row1 = t0 + 32 + il;
#pragma unroll
                for (int v2 = 0; v2 < 4; ++v2) { gr[1][v2][0] = *(const bf16x8*)(GRS + row1 * 512 + 128 * h + 32 * v2 + 16 * hi); gr[1][v2][1] = *(const bf16x8*)(GRS + row1 * 512 + 128 * h + 32 * v2 + 16 * hi + 8); }
                asm volatile("" : "+v"(O[0]) :: "memory"); }
#pragma unroll
            for (int r = 0; r < 16; ++r) ss += O[vt][r] * O[vt][r];
        }
        float slo, shi; swap32(ss, slo, shi);
        const float rstd = __builtin_amdgcn_rsqf((slo + shi) * (1.f / 128.f) + EPS);
#pragma unroll
        for (int vt = 0; vt < 4; ++vt) {
            const int vc0 = 32 * vt + 16 * hi;
            float v[16];
#pragma unroll
            for (int r4 = 0; r4 < 4; ++r4) { const f32x4 g = *(const f32x4*)(gn + vc0 + 4 * r4);
#pragma unroll
                for (int e2 = 0; e2 < 4; ++e2) { const int r = 4 * r4 + e2; v[r] = O[vt][r] * rstd * g[e2] * bf2f(r < 8 ? gr[ch][vt][0][r] : gr[ch][vt][1][r - 8]); } }
            bf16* op = MIX + row * DM + 512 + 128 * h + vc0;
            *(bf16x8*)(op) = pack8(v); *(bf16x8*)(op + 8) = pack8(v + 8);
        }
    }
    LDS_WAIT(); asm volatile("" ::: "memory");
}

constexpr int NWAVES = 8;
constexpr int N_PHASES = 10;
struct Args { Ptrs p; int ph_lo, ph_hi; };

__global__ void __launch_bounds__(NWAVES * 64, 2) fwd_kernel(Args args) {
    extern __shared__ __attribute__((aligned(16))) unsigned char lds_raw[];
    LAS unsigned char* lds = (LAS unsigned char*)lds_raw;
    const Ptrs& P = args.p;
    const int tid = threadIdx.x, lane = tid & 63, wave = __builtin_amdgcn_readfirstlane(tid >> 6);
    const int G = gridDim.x; const int bx = blockIdx.x; const int vcu = (G % 8 == 0) ? (bx % 8) * (G / 8) + bx / 8 : bx;
    const int gw = vcu * NWAVES + wave, NGW = G * NWAVES;
    unsigned char* ws = P.ws;
    gu32* ctl = (gu32*)(ws + WS_CTL);
    volatile LAS unsigned* MISC = (volatile LAS unsigned*)(lds + MISC_OFF);
    LAS int* tab = (LAS int*)(lds + TAB_OFF);
    for (int u = tid; u < (LDS_BYTES - LDSCTL_OFF) / 4; u += NWAVES * 64) ((LAS unsigned*)(lds + LDSCTL_OFF))[u] = 0u;
    __syncthreads();
    XcdBarrier bar; bar.bar = (unsigned*)(ctl + CW_BAR); bar.x = 0; bar.st = nullptr;
    if (MK_N_LAUNCHES == 1) bar = xcd_barrier_post((unsigned*)(ctl + CW_BAR), MISC + 8);
#define GRID_BAR() do { if (MK_N_LAUNCHES == 1) xcd_barrier(bar); } while (0)
#define BAR_ARRIVE() do { if (MK_N_LAUNCHES == 1) xcd_barrier_arrive(bar, MISC + 12); } while (0)
#define BAR_WAIT() do { if (MK_N_LAUNCHES == 1) xcd_barrier_wait(bar, MISC + 12); } while (0)
    const int lo = args.ph_lo, hi_ph = args.ph_hi;
#ifndef PHASE_MASK
#define PHASE_MASK 0x3ff
#endif
#define IN(k) (((PHASE_MASK >> (k)) & 1) && lo <= (k) && (k) < hi_ph)
#define BOTH(k) (IN(k) && IN((k) + 1))
#ifndef PROBE_TWICE
#define PROBE_TWICE -1
#endif
#define REP(k) for (int rep_ = 0; rep_ < ((PROBE_TWICE == (k)) ? 2 : 1); ++rep_)
#define REPBAR(k) do { if (PROBE_TWICE == (k) && rep_ == 0) GRID_BAR(); } while (0)

    bf16* WA = (bf16*)(ws + WS_WA); bf16* WB = (bf16*)(ws + WS_WB); bf16* WO = (bf16*)(ws + WS_WO);
    bf16* WRH = (bf16*)(ws + WS_WR); bf16* WRL = WRH + 48 * 1024; bf16* W2T = (bf16*)(ws + WS_W2T);
    bf16* WGU = (bf16*)(ws + WS_WGU); bf16* WD = (bf16*)(ws + WS_WD);
    bf16* H = (bf16*)(ws + WS_H); bf16* KV = (bf16*)(ws + WS_KV);
    bf16* XB = (bf16*)(ws + WS_XB); bf16* MIX = (bf16*)(ws + WS_MIX); float* RSTD1 = (float*)(ws + WS_RSTD1);
    bf16* SQ = (bf16*)(ws + WS_SQ); bf16* SK = (bf16*)(ws + WS_SK); bf16* GQ = (bf16*)(ws + WS_GQ); bf16* GRS = (bf16*)(ws + WS_GRS);
    bf16* TT = (bf16*)(ws + WS_TT); bf16* GLR = (bf16*)(ws + WS_GLR); bf16* ST = (bf16*)(ws + WS_ST); float* DTOT = (float*)(ws + WS_DTOT);
    unsigned char* ACT = ws + WS_ACT; unsigned char* Y = ws + WS_Y;
    unsigned char* WGU8 = ws + WS_WGU; unsigned char* WD8 = ws + WS_WD; unsigned char* H8 = ws + WS_H8;
    unsigned* LOCL = (unsigned*)(ws + WS_LOCL); unsigned* CNTS = (unsigned*)(ws + WS_CNTS); float* GATE = (float*)(ws + WS_GATE); float* RSTD = (float*)(ws + WS_RSTD);

#define WGU_PIECE(q_) do { LAS float* scr_ = (LAS float*)(lds + RING_OFF + wave * 16384); \
        for (int r = (q_) * 4096 + gw; r < ((q_) + 1) * 4096; r += NGW) { \
            const int e = r >> 9, q = r & 511, ib = 4 * (q >> 6) + (q & 3), kb = 2 * ((q >> 3) & 7) + ((q >> 2) & 1), P0 = 32 * ib; const int pn = P0 >> 8, bj = (P0 >> 7) & 1, r0 = P0 & 127; \
            const float* src = (bj ? P.wu : P.wg) + (size_t)e * DM * DEXP; \
            tr_item8(src, DEXP, 64 * kb, 128 * pn + r0, WGU8 + (size_t)e * DM * DM, P0, DM, P.ffn_g, WGU_SC, scr_, lane); } } while (0)
    if (IN(0)) { REP(0) {
        LAS float* scr = (LAS float*)(lds + RING_OFF + wave * 16384);
        constexpr int I_A = (NA / 32) * 16, I_B = (NB / 32) * 16, I_O = 32 * 16, I_GU = 32 * 32 * 16, I_D = 32 * 32 * 8;
        constexpr int NITEMS = I_A + I_B + I_O;
        for (int it = gw; it < NITEMS; it += NGW) {
            int r = it;
            if (r < I_A) { const int ib = r >> 4, kb = r & 15, P0 = 32 * ib; const int pn = P0 >> 8, bj = (P0 >> 7) & 1, wcc = (P0 >> 5) & 3; const int LA = 256 * pn + 64 * wcc + 32 * bj;
                const int sc = LA < 1024 ? LA : (LA < 1280 ? 1536 + (LA - 1024) : 2560 + (LA - 1280));
                tr_item(P.w_in, IN_DIM, 64 * kb, sc, WA, P0, DM, P.attn_g, scr, lane); continue; } r -= I_A;
            if (r < I_B) { const int ib = r >> 4, kb = r & 15, P0 = 32 * ib; const int sc = P0 < 512 ? 1024 + P0 : (P0 < 768 ? 1792 + (P0 - 512) : 2048 + (P0 - 768));
                tr_item(P.w_in, IN_DIM, 64 * kb, sc, WB, P0, DM, P.attn_g, scr, lane); continue; } r -= I_B;
            if (r < I_O) { const int ib = r >> 4, kb = r & 15; tr_item(P.w_out, DM, 64 * kb, 32 * ib, WO, 32 * ib, DM, nullptr, scr, lane); continue; } r -= I_O;
        }
        (void)I_D; (void)I_GU;
        for (int idx = gw * 64 + lane; idx < 48 * 1024; idx += NGW * 64) {
            const int rho = idx >> 10, k = idx & 1023, m = rho >> 4, i = rho & 15;
            float v = (m < 2) ? P.re_w[k * 32 + 8 * (i >> 2) + 4 * m + (i & 3)] : P.rg_w[k * 4 + (i & 3)];
            v *= P.ffn_g[k];
            WRH[idx] = __builtin_bit_cast(unsigned short, (_Float16)v);
        }
        for (int idx = gw * 64 + lane; idx < 256 * 16; idx += NGW * 64) { const int kc = idx >> 4, r = idx & 15; W2T[idx] = (bf16)(cvtpk(P.w2[r * 256 + kc], 0.f) & 0xffffu); }
        __syncthreads();
        constexpr int WLP = 1032;
        LAS bf16* wl = (LAS bf16*)(lds + RING_OFF);
        for (int idx = tid; idx < 16 * 1024; idx += NWAVES * 64) { const int c = idx & 15, k = idx >> 4; wl[c * WLP + k] = (bf16)(cvtpk(P.attn_g[k] * P.w_in[(size_t)k * IN_DIM + 3072 + c], 0.f) & 0xffffu); }
        __syncthreads();
        {
            for (int task = gw; task < NTOK / 16; task += NGW) {
                const size_t row0 = (size_t)task * 16;
                f32x4 cur[4], nxt[4]; float rsv = 0.f;
#pragma unroll
                for (int j = 0; j < 4; ++j) { cur[j] = __builtin_nontemporal_load((const GAS f32x4*)(P.x + row0 * DM) + lane + 64 * j); nxt[j] = cur[j]; }
#pragma unroll 2
                for (int r = 0; r < 16; ++r) {
                    if (r < 15) {
#pragma unroll
                        for (int j = 0; j < 4; ++j) nxt[j] = __builtin_nontemporal_load((const GAS f32x4*)(P.x + (row0 + r + 1) * DM) + lane + 64 * j); }
                    float s2 = 0.f;
#pragma unroll
                    for (int j = 0; j < 4; ++j) s2 += (cur[j].x * cur[j].x + cur[j].y * cur[j].y) + (cur[j].z * cur[j].z + cur[j].w * cur[j].w);
                    const float rstd = __builtin_amdgcn_rsqf(wave_sum(s2) * (1.f / DM) + EPS);
                    if ((lane & 15) == r) rsv = rstd;
                    GAS unsigned long long* o8 = (GAS unsigned long long*)(XB + (row0 + r) * DM) + lane;
#pragma unroll
                    for (int j = 0; j < 4; ++j) { const f32x4 v = cur[j];
                        o8[64 * j] = (unsigned long long)cvtpk(v.x, v.y) | ((unsigned long long)cvtpk(v.z, v.w) << 32); }
#pragma unroll
                    for (int j = 0; j < 4; ++j) cur[j] = nxt[j];
                }
                if (lane < 16) RSTD1[row0 + lane] = rsv;
                VM_WAIT();
                const int fr = lane & 15, fq = lane >> 4;
                f32x4 acc = (f32x4){0.f, 0.f, 0.f, 0.f};
                const bf16* up = XB + (row0 + fr) * DM + 8 * fq;
#pragma unroll 8
                for (int ks = 0; ks < 32; ++ks) { const bf16x8 ub = *(const bf16x8*)(up + 32 * ks); const bf16x8 wb = *(const LAS bf16x8*)(wl + fr * WLP + 32 * ks + 8 * fq); acc = MFMA16(wb, ub, acc); }
                u32x2 o; o.x = cvtpk(acc[0] * rsv, acc[1] * rsv); o.y = cvtpk(acc[2] * rsv, acc[3] * rsv);
                *(u32x2*)(GLR + (row0 + fr) * 16 + 4 * fq) = o;
            }
        }
        __syncthreads();
        REPBAR(0); }
        if (BOTH(0)) BAR_ARRIVE();
        WGU_PIECE(0);
        if (BOTH(0)) BAR_WAIT();
    }

#define PH1_BODY() do { \
        { pg8::SchedDense S; S.init(XB, WA, NTOK, NA, DM, G, bx); \
          pg8::EpiA E{SQ, SK, GQ, GRS, P.sbq_g, P.sbk_g, RSTD1}; \
          pg8::gemm_phase<pg8::EpiA, pg8::SchedDense>(lds + RING_OFF, DM, S, E); } \
        { pg8::SchedDense S; S.init(WB, XB, NB, NTOK, DM, G, (bx + G / 2) % G); \
          pg8::EpiTT E{TT, RSTD1}; \
          pg8::gemm_phase<pg8::EpiTT, pg8::SchedDense>(lds + RING_OFF, DM, S, E); } } while (0)
    if (IN(1)) {
        if (PROBE_TWICE == 1) { PH1_BODY(); GRID_BAR(); }
        PH1_BODY();
        if (BOTH(1)) BAR_ARRIVE();
        WGU_PIECE(1);
        if (BOTH(1)) BAR_WAIT();
    }

#define SB_ROUND(rho_) do { for (int u__ = (rho_) * G + vcu; u__ < 1024; u__ += 4 * G) { const int bh_ = u__ & 127; \
        sb_round(lds + RING_OFF, SQ, SK, TT, P.sbo_g + (bh_ & 7) * 64, MIX, bh_ >> 3, bh_ & 7, u__ >> 7, tid, wave, lane); } } while (0)
#define REPX(code) for (int rx_ = 0; rx_ < ((PROBE_TWICE == (code)) ? 5 : 1); ++rx_)
    if (IN(2)) {
        for (int t = gw; t < 2048; t += NGW) gla_a(GLR, W2T, P.gate_b, TT, KV, DTOT, t >> 5, t & 31, lane);
        if (BOTH(2)) BAR_ARRIVE();
        SB_ROUND(0);
        if (BOTH(2)) BAR_WAIT();
    }
    if (IN(3)) {
        for (int t = gw; t < 2048; t += NGW) gla_b(KV, DTOT, ST, t, lane);
        if (BOTH(3)) BAR_ARRIVE();
        SB_ROUND(1);
        if (BOTH(3)) BAR_WAIT();
    }
    if (IN(4)) {
        for (int t = gw; t < 2048; t += NGW) gla_c(lds + RING_OFF + wave * 16384, ST, GQ, GRS, P.glan_g, MIX, t >> 5, t & 31, lane);
        __syncthreads();
        SB_ROUND(2); SB_ROUND(3);
        if (BOTH(4)) BAR_ARRIVE();
        WGU_PIECE(2);
        if (BOTH(4)) BAR_WAIT();
    }

#define PH5_BODY() do { \
        pg8::SchedDense S; S.init(MIX, WO, NTOK, DM, DM, G, bx); \
        pg8::EpiH E{XB, H, H8}; \
        pg8::gemm_phase<pg8::EpiH, pg8::SchedDense>(lds + RING_OFF, DM, S, E); } while (0)
    if (IN(5)) {
        if (PROBE_TWICE == 5) { PH5_BODY(); GRID_BAR(); }
        PH5_BODY();
        if (BOTH(5)) BAR_ARRIVE();
        WGU_PIECE(3);
        if (BOTH(5)) BAR_WAIT();
    }

    if (IN(6)) { REP(6) {
        constexpr int WP = 1032;
        LAS unsigned short* wl16 = (LAS unsigned short*)(lds + RING_OFF);
        LAS unsigned* lcount = (LAS unsigned*)(lds + RING_OFF + 48 * WP * 2);
        for (int idx = tid; idx < 48 * 128; idx += NWAVES * 64) { const int row = idx >> 7, c = idx & 127; *(LAS u32x4*)(wl16 + row * WP + 8 * c) = *(const u32x4*)(WRH + row * 1024 + 8 * c); }
        const int fr = lane & 15, fq = lane >> 4;
        for (int it = 0; it * G < NGRP; ++it) {
            const int grp = it * G + vcu;
            const int tile = grp * 8 + wave; const int ntile = NGRP * 8;
            if (tid < 32) lcount[tid] = 0u;
            __syncthreads();
            bool owner = false; int e1 = 0, e2 = 0; unsigned lr1 = 0, lr2 = 0; int tok = 0;
            if (tile < ntile) {
                tok = tile * 16 + fr;
                const bf16* hp = H + (size_t)tok * DM + 8 * fq;
                f32x4 acc[3]; acc[0] = acc[1] = acc[2] = (f32x4){0.f, 0.f, 0.f, 0.f};
                float ssq = 0.f;
#pragma unroll 1
                for (int half = 0; half < 2; ++half) {
                    bf16x8 hb[16];
#pragma unroll
                    for (int q = 0; q < 16; ++q) hb[q] = *(const bf16x8*)(hp + 32 * (16 * half + q));
#pragma unroll
                    for (int q = 0; q < 16; ++q) { const int ks = 16 * half + q;
                        float f[8];
#pragma unroll
                        for (int e = 0; e < 8; ++e) { f[e] = bf2f(hb[q][e]); ssq += f[e] * f[e]; }
                        f16x8 hh;
#pragma unroll
                        for (int e = 0; e < 8; ++e) hh[e] = (_Float16)f[e];
#pragma unroll
                        for (int m = 0; m < 3; ++m) { const f16x8 wv = *(const LAS f16x8*)(wl16 + (16 * m + fr) * WP + 32 * ks + 8 * fq);
                            acc[m] = __builtin_amdgcn_mfma_f32_16x16x32_f16(wv, hh, acc[m], 0, 0, 0); }
                    }
                }
                ssq += __shfl_xor(ssq, 16); ssq += __shfl_xor(ssq, 32);
                const float rstd = __builtin_amdgcn_rsqf(ssq * (1.f / DM) + EPS);
                float gl[4];
#pragma unroll
                for (int r = 0; r < 4; ++r) gl[r] = acc[2][r] * rstd + P.rg_b[r];
                int gsel = 0; float gmax = gl[0];
#pragma unroll
                for (int r = 1; r < 4; ++r) if (gl[r] > gmax) { gmax = gl[r]; gsel = r; }
                float gden = 0.f;
#pragma unroll
                for (int r = 0; r < 4; ++r) gden += __builtin_amdgcn_exp2f((gl[r] - gmax) * LOG2E);
                const float pgrp = 1.f / gden;
                float el[8];
#pragma unroll
                for (int r = 0; r < 4; ++r) { el[r] = acc[0][r] * rstd + P.re_b[8 * fq + r]; el[4 + r] = acc[1][r] * rstd + P.re_b[8 * fq + 4 + r]; }
                int i1 = 0; float l1 = el[0];
#pragma unroll
                for (int r = 1; r < 8; ++r) if (el[r] > l1) { l1 = el[r]; i1 = r; }
                int i2 = -1; float l2 = -3.0e38f;
#pragma unroll
                for (int r = 0; r < 8; ++r) if (r != i1 && el[r] > l2) { l2 = el[r]; i2 = r; }
                const float ex = __builtin_amdgcn_exp2f((l2 - l1) * LOG2E);
                const float p1 = 1.f / (1.f + ex), p2 = ex * p1;
                owner = (fq == gsel);
                if (owner) {
                    e1 = 8 * gsel + i1; e2 = 8 * gsel + i2;
                    lr1 = __hip_atomic_fetch_add(lcount + e1, 1u, __ATOMIC_RELAXED, __HIP_MEMORY_SCOPE_WORKGROUP);
                    lr2 = __hip_atomic_fetch_add(lcount + e2, 1u, __ATOMIC_RELAXED, __HIP_MEMORY_SCOPE_WORKGROUP);
                    RSTD[tok] = rstd; GATE[2 * tok] = pgrp * p1; GATE[2 * tok + 1] = pgrp * p2;
                }
            }
            __syncthreads();
            if (grp < NGRP) {
                if (tid < 32) CNTS[grp * 32 + tid] = lcount[tid];
                if (owner) { LOCL[((size_t)grp * 32 + e1) * 128 + lr1] = 2u * tok; LOCL[((size_t)grp * 32 + e2) * 128 + lr2] = 2u * tok + 1u; }
            }
            __syncthreads();
        }
        REPBAR(6); }
        if (BOTH(6)) GRID_BAR();
    }

    if (IN(7) || IN(8)) {
        LAS int* pre = (LAS int*)(lds + RING_OFF);
        LAS int* segsum = pre + NGRP * 32;
        for (int i = tid; i < NGRP * 32; i += NWAVES * 64) pre[i] = (int)CNTS[i];
        __syncthreads();
        { const int e = tid & 31, seg = tid >> 5; int run = 0;
          for (int g = seg * 16; g < seg * 16 + 16; ++g) { const int c = pre[g * 32 + e]; pre[g * 32 + e] = run; run += c; }
          segsum[seg * 32 + e] = run; }
        __syncthreads();
        { const int e = tid & 31, seg = tid >> 5; int off = 0, tot = 0;
          for (int q = 0; q < 16; ++q) { const int v = segsum[q * 32 + e]; if (q < seg) off += v; tot += v; }
          for (int g = seg * 16; g < seg * 16 + 16; ++g) pre[g * 32 + e] += off;
          if (seg == 0) tab[T_CNT / 4 + e] = tot; }
        __syncthreads();
        if (tid == 0) { int tb = 0; for (int e = 0; e < 32; ++e) { tab[T_TBASE / 4 + e] = tb; tb += (tab[T_CNT / 4 + e] + 255) >> 8; } tab[T_TBASE / 4 + 32] = tb; tab[T_NT / 4] = tb; }
        __syncthreads();
        { const int NT = tab[T_NT / 4];
          for (int t = tid; t < NT; t += NWAVES * 64) { int e = 0; for (int q = 0; q < 32; ++q) if (tab[T_TBASE / 4 + q] <= t && t < tab[T_TBASE / 4 + q + 1]) e = q; tab[T_TILE_E / 4 + t] = e; } }
        __syncthreads();
        { pg8::SchedMoE<false> S0; S0.A = nullptr; S0.Bt = nullptr; S0.K = 0; S0.bstride = 0; S0.G = G; S0.c = vcu; S0.tab = tab;
          const int half = tid >> 8, r = tid & 255; unsigned vals[NU_MAX / 2]; bool ok[NU_MAX / 2];
#pragma unroll
          for (int k = 0; k < NU_MAX / 2; ++k) { const int ui = 2 * k + half; pg8::Unit u; ok[k] = S0.next(ui, u); vals[k] = 0u;
              if (ok[k]) { const int cnt = tab[T_CNT / 4 + u.e], e = u.e; int p = u.rt * 256 + r; if (p > cnt - 1) p = cnt - 1;
                  int lo_ = 0, hi_ = NGRP - 1;
                  while (lo_ < hi_) { const int mid = (lo_ + hi_ + 1) >> 1; if (pre[mid * 32 + e] <= p) lo_ = mid; else hi_ = mid - 1; }
                  vals[k] = LOCL[((size_t)lo_ * 32 + e) * 128 + (p - pre[lo_ * 32 + e])]; } }
          float rsl[NU_MAX / 2];
#pragma unroll
          for (int k = 0; k < NU_MAX / 2; ++k) rsl[k] = ok[k] ? RSTD[vals[k] >> 1] : 0.f;
#pragma unroll
          for (int k = 0; k < NU_MAX / 2; ++k) if (ok[k]) { tab[T_ROWTAB / 4 + (2 * k + half) * 256 + r] = (int)vals[k]; ((LAS float*)tab)[T_RSTAB / 4 + (2 * k + half) * 256 + r] = rsl[k]; }
        }
        __syncthreads();
    }
#define PH7_BODY() do { \
        pg8::SchedMoE<true> S; S.A = (const char*)H8; S.Bt = (const char*)WGU8; S.K = DM / 2; S.bstride = (size_t)DM * DM; S.G = G; S.c = vcu; S.tab = tab; \
        pg8::EpiGU E{ACT, RSTD, tab}; \
        pg8::gemm_phase<pg8::EpiGU, pg8::SchedMoE<true>, false, true>(lds + RING_OFF, DM / 2, S, E); } while (0)
    if (IN(7)) {
        if (PROBE_TWICE == 7) { PH7_BODY(); GRID_BAR(); }
        PH7_BODY();
        {
            const int NT4 = tab[T_NT / 4] * 4, remu = NT4 % G;
            const bool early = (remu == 0) || (vcu >= remu); const int nE = (remu == 0) ? G : (G - remu), rank = (remu == 0) ? vcu : (vcu - remu);
            if (early) { LAS float* scr = (LAS float*)(lds + RING_OFF + wave * 16384);
                for (int r = rank * NWAVES + wave; r < 32 * 32 * 8; r += nE * NWAVES) {
                    const int e = r >> 8, q = r & 255, nb = 4 * (q >> 5) + (q & 3), kb = 2 * ((q >> 3) & 3) + ((q >> 2) & 1);
                    tr_item8(P.wd + (size_t)e * DEXP * DM, DM, 64 * kb, 32 * nb, WD8 + (size_t)e * DM * DEXP, 32 * nb, DEXP, nullptr, WD_SC, scr, lane); } }
        }
        if (BOTH(7)) GRID_BAR();
    }
    if (IN(8)) { REP(8) {
        pg8::SchedMoE<false> S; S.A = (const char*)ACT; S.Bt = (const char*)WD8; S.K = DEXP / 2; S.bstride = (size_t)DM * DEXP; S.G = G; S.c = vcu; S.tab = tab;
        pg8::EpiDown E{Y, tab};
        pg8::gemm_phase<pg8::EpiDown, pg8::SchedMoE<false>, false, true>(lds + RING_OFF, DEXP / 2, S, E);
        REPBAR(8); }
        if (BOTH(8)) GRID_BAR();
    }
    if (IN(9)) { REP(9) {
        for (int m0 = gw; m0 < NTOK; m0 += 2 * NGW) {
            bf16x8 hv[2][2]; u32x4 ya[2], yb[2]; float g0[2], g1[2];
#pragma unroll
            for (int t = 0; t < 2; ++t) { int m = m0 + t * NGW; if (m >= NTOK) m = m0;
                g0[t] = GATE[2 * m] * (1.f / Y_SC); g1[t] = GATE[2 * m + 1] * (1.f / Y_SC);
                const bf16* hp = H + (size_t)m * DM + 16 * lane; const unsigned char* y0 = Y + (size_t)(2 * m) * DM + 16 * lane;
                hv[t][0] = *(const bf16x8*)(hp); hv[t][1] = *(const bf16x8*)(hp + 8); ya[t] = *(const u32x4*)(y0); yb[t] = *(const u32x4*)(y0 + DM); }
#pragma unroll
            for (int t = 0; t < 2; ++t) { const int m = m0 + t * NGW; if (m < NTOK) {
                float* op = P.out + (size_t)m * DM + 16 * lane;
#pragma unroll
                for (int q = 0; q < 4; ++q) { const unsigned wa = ya[t][q], wb = yb[t][q];
                    const f32x2_t a0 = __builtin_amdgcn_cvt_pk_f32_fp8((int)wa, false), a1 = __builtin_amdgcn_cvt_pk_f32_fp8((int)wa, true);
                    const f32x2_t b0 = __builtin_amdgcn_cvt_pk_f32_fp8((int)wb, false), b1 = __builtin_amdgcn_cvt_pk_f32_fp8((int)wb, true);
                    const bf16x8 hh = hv[t][q >> 1]; const int e0 = 4 * (q & 1);
                    f32x4 o; o[0] = bf2f(hh[e0]) + g0[t] * a0.x + g1[t] * b0.x; o[1] = bf2f(hh[e0 + 1]) + g0[t] * a0.y + g1[t] * b0.y;
                    o[2] = bf2f(hh[e0 + 2]) + g0[t] * a1.x + g1[t] * b1.x; o[3] = bf2f(hh[e0 + 3]) + g0[t] * a1.y + g1[t] * b1.y;
                    *(f32x4*)(op + 4 * q) = o; } } }
        }
    REPBAR(9); } }
#undef IN
#undef BOTH
}

extern "C" void kernel_launch(void* const* d_in, const int* in_sizes, int n_in, void* d_out, int out_size, void* d_ws, size_t ws_size, hipStream_t stream) {
    static int grid = 0;
    if (grid == 0) {
        if (n_in != 18 || in_sizes[0] != NTOK * DM || out_size != NTOK * DM || ws_size < WS_END) { fprintf(stderr, "kernel_launch: unexpected shapes / workspace (n_in %d, in0 %d, out %d, ws %zu, need %zu)\n", n_in, n_in > 0 ? in_sizes[0] : -1, out_size, ws_size, (size_t)WS_END); grid = -1; return; }
        int dev = 0, cus = 0, per_cu = 0;
        if (hipGetDevice(&dev) != hipSuccess || hipDeviceGetAttribute(&cus, hipDeviceAttributeMultiprocessorCount, dev) != hipSuccess) { grid = -1; return; }
        if (hipFuncSetAttribute((const void*)fwd_kernel, hipFuncAttributeMaxDynamicSharedMemorySize, LDS_BYTES) != hipSuccess) { fprintf(stderr, "kernel_launch: hipFuncSetAttribute failed\n"); grid = -1; return; }
        if (hipOccupancyMaxActiveBlocksPerMultiprocessor(&per_cu, (const void*)fwd_kernel, NWAVES * 64, LDS_BYTES) != hipSuccess || per_cu < 1) fprintf(stderr, "kernel_launch: occupancy query reports %d\n", per_cu);
        (void)hipGetLastError();
        grid = cus;
    }
    if (grid < 0) return;
    if (hipMemsetAsync((char*)d_ws + WS_CTL, 0, CTL_ZERO_BYTES, stream) != hipSuccess) return;
    Args a{};
    const float** pp = (const float**)&a.p;
    for (int i = 0; i < 18; ++i) pp[i] = (const float*)d_in[i];
    a.p.out = (float*)d_out; a.p.ws = (unsigned char*)d_ws;
    if (MK_N_LAUNCHES == 1) { a.ph_lo = 0; a.ph_hi = N_PHASES; hipLaunchKernelGGL(fwd_kernel, dim3(grid), dim3(NWAVES * 64), LDS_BYTES, stream, a); }
    else for (int li = 0; li < N_PHASES; ++li) { a.ph_lo = li; a.ph_hi = li + 1; hipLaunchKernelGGL(fwd_kernel, dim3(grid), dim3(NWAVES * 64), LDS_BYTES, stream, a); }
}
```

```cpp
#include <hip/hip_runtime.h>
#include <cstdio>
#include <cstdint>

#ifndef MK_N_LAUNCHES
#define MK_N_LAUNCHES 1
#endif

#define LAS __attribute__((address_space(3)))
#define GAS __attribute__((address_space(1)))
typedef unsigned short bf16;
typedef short bf16x8 __attribute__((ext_vector_type(8)));
typedef float f32x4 __attribute__((ext_vector_type(4)));
typedef float f32x16 __attribute__((ext_vector_type(16)));
typedef unsigned u32x4 __attribute__((ext_vector_type(4)));
typedef unsigned u32x2 __attribute__((ext_vector_type(2)));
typedef float f32x2_t __attribute__((ext_vector_type(2)));
typedef __bf16 bf16x2_t __attribute__((ext_vector_type(2)));
typedef GAS unsigned gu32;
typedef int v8i __attribute__((ext_vector_type(8)));
typedef int v4i __attribute__((ext_vector_type(4)));
typedef _Float16 f16x8 __attribute__((ext_vector_type(8)));
typedef _Float16 f16x2 __attribute__((ext_vector_type(2)));

constexpr int BATCH = 16, SEQ = 2048, DM = 1024, NTOK = BATCH * SEQ;
constexpr int IN_DIM = 3088;
constexpr int NEXP = 32, DEXP = 512;
constexpr float EPS = 1e-6f;
constexpr float LOG2E = 1.4426950408889634f;
constexpr float WGU_SC = 64.f, WD_SC = 32.f, ACT_SC = 8.f, Y_SC = 8.f;
constexpr int NA = 1792, NB = 1280;
constexpr int NGRP = NTOK / 128;

constexpr size_t MiB = 1u << 20;
constexpr size_t WS_CTL = 0, CTL_ZERO_BYTES = 64 * 1024;
constexpr size_t WS_WA = 2 * MiB;
constexpr size_t WS_WB = 6 * MiB;
constexpr size_t WS_WO = 9 * MiB;
constexpr size_t WS_WR = 11 * MiB;
constexpr size_t WS_W2T = WS_WR + 2 * 48 * 1024 * 2;
constexpr size_t WS_WGU = 12 * MiB;
constexpr size_t WS_WD = 76 * MiB;
constexpr size_t WS_H = 108 * MiB;
constexpr size_t WS_KV = WS_H;
constexpr size_t WS_XB = 44 * MiB;
constexpr size_t WS_MIX = 172 * MiB;
constexpr size_t WS_SQ = 236 * MiB;
constexpr size_t WS_SK = 268 * MiB;
constexpr size_t WS_GQ = 300 * MiB;
constexpr size_t WS_GRS = 316 * MiB;
constexpr size_t WS_TT = 348 * MiB;
constexpr size_t WS_GLR = 428 * MiB;
constexpr size_t WS_ST = 429 * MiB;
constexpr size_t WS_DTOT = 461 * MiB;
constexpr size_t WS_ACT = 236 * MiB;
constexpr size_t WS_H8 = 272 * MiB;
constexpr size_t WS_Y = 308 * MiB;
constexpr size_t WS_LOCL = 462 * MiB;
constexpr size_t WS_CNTS = 467 * MiB;
constexpr size_t WS_GATE = 470 * MiB;
constexpr size_t WS_RSTD = WS_GATE + 512 * 1024;
constexpr size_t WS_RSTD1 = WS_GATE + 768 * 1024;
constexpr size_t WS_END = 472 * MiB;
constexpr int CW_TMO = 0, CW_CODE = 1;
constexpr int CW_BAR = 4096;
constexpr int CW_CNT = 16384;

constexpr int RING_OFF = 0, RING_BYTES = 131072;
constexpr int LDSCTL_OFF = RING_BYTES, MISC_OFF = LDSCTL_OFF + 320;
constexpr int TAB_OFF = LDSCTL_OFF + 1024;
constexpr int LDS_BYTES = 147456;
constexpr int T_CNT = 0, T_TBASE = 128, T_NT = 264, T_TILE_E = 272, T_ROWTAB = 272 + 320 * 4, NU_MAX = 6;
constexpr int T_RSTAB = T_ROWTAB + NU_MAX * 1024;
static_assert(TAB_OFF + T_RSTAB + NU_MAX * 256 * 4 <= LDS_BYTES, "LDS tables");

#define RLX_AGENT __ATOMIC_RELAXED, __HIP_MEMORY_SCOPE_AGENT
#define LDS_WAIT() asm volatile("s_waitcnt lgkmcnt(0)" ::: "memory")
#define VM_WAIT() asm volatile("s_waitcnt vmcnt(0)" ::: "memory")

__device__ __forceinline__ unsigned cvtpk(float lo, float hi) { f32x2_t v = {lo, hi}; bf16x2_t b = __builtin_convertvector(v, bf16x2_t); return __builtin_bit_cast(unsigned, b); }
__device__ __forceinline__ u32x2 pack8_fp8(const float* a) { int lo = __builtin_amdgcn_cvt_pk_fp8_f32(a[0], a[1], 0, false); lo = __builtin_amdgcn_cvt_pk_fp8_f32(a[2], a[3], lo, true);
    int hi = __builtin_amdgcn_cvt_pk_fp8_f32(a[4], a[5], 0, false); hi = __builtin_amdgcn_cvt_pk_fp8_f32(a[6], a[7], hi, true); u32x2 r; r.x = (unsigned)lo; r.y = (unsigned)hi; return r; }
__device__ __forceinline__ float bf2f(short s) { return __uint_as_float(((unsigned)(unsigned short)s) << 16); }
__device__ __forceinline__ bf16x8 pack8(const float* a) { u32x4 p; p.x = cvtpk(a[0], a[1]); p.y = cvtpk(a[2], a[3]); p.z = cvtpk(a[4], a[5]); p.w = cvtpk(a[6], a[7]); return __builtin_bit_cast(bf16x8, p); }
__device__ __forceinline__ int PI32(int i) { return 16 * ((i >> 2) & 1) + (i & 3) + 4 * (i >> 3); }
#define MFMA32(a, b, c) __builtin_amdgcn_mfma_f32_32x32x16_bf16((a), (b), (c), 0, 0, 0)
#define MFMA16(a, b, c) __builtin_amdgcn_mfma_f32_16x16x32_bf16((a), (b), (c), 0, 0, 0)
__device__ __forceinline__ void swap32(float x, float& lo, float& hi) { auto rr = __builtin_amdgcn_permlane32_swap(__float_as_uint(x), __float_as_uint(x), false, false); lo = __uint_as_float(rr[0]); hi = __uint_as_float(rr[1]); }

namespace pg8 {
#define PG8_LAS __attribute__((address_space(3)))
constexpr int BM = 256, BK = 64, HALF = 128, HTB = HALF * BK * 2, STAGE_BYTES = 8 * HTB, NXCD = 8, WGM = 8;
__host__ __device__ __forceinline__ int lds_byte(int r, int c) { const int st = (r >> 4) * 2 + (c >> 5), rr = r & 15, cc = c & 31, ob = rr * 64 + cc * 2; return st * 1024 + (ob ^ (((ob >> 9) & 1) << 5)); }
__host__ __device__ __forceinline__ void stage_rc(int b, int& R, int& C) { const int st = b / 1024, sb = b % 1024, swz = sb ^ (((sb >> 9) & 1) << 5); R = (st >> 1) * 16 + swz / 64; C = (st & 1) * 32 + (swz % 64) / 2; }
__host__ __device__ __forceinline__ int perm32(int rho) { const int n = rho >> 4, i = rho & 15; return 8 * (i >> 2) + 4 * n + (i & 3); }

struct Unit { int pm, pn, e, rt, nv; };

struct SchedDense {
    const char* A; const char* Bt; int K; int nM, nN, nwg, G, c;
    __device__ void init(const void* A_, const void* Bt_, int M, int N, int K_, int G_, int c_) { A = (const char*)A_; Bt = (const char*)Bt_; K = K_; nM = M / BM; nN = N / BM; nwg = nM * nN; G = G_; c = c_; }
    __device__ __forceinline__ bool next(int i, Unit& u) const {
        const long L = (long)i * G + c; if (L >= nwg) return false;
        int wgid = (int)L; { const int q = nwg / NXCD, r = nwg % NXCD, xcd = wgid % NXCD, off = wgid / NXCD; wgid = (xcd < r ? xcd * (q + 1) : r * (q + 1) + (xcd - r) * q) + off; }
        const int nig = WGM * nN, gid = wgid / nig, fm = gid * WGM, gsz = (nM - fm) < WGM ? (nM - fm) : WGM;
        u.pm = fm + ((wgid % nig) % gsz); u.pn = (wgid % nig) / gsz; u.e = 0; u.rt = 0; u.nv = 256; return true;
    }
    __device__ __forceinline__ const char* a_ptr(const Unit& u) const { return A + (size_t)u.pm * BM * K * 2; }
    __device__ __forceinline__ const char* b_ptr(const Unit& u) const { return Bt + (size_t)u.pn * BM * K * 2; }
    __device__ __forceinline__ void a_voff(int, const Unit&, int tid, unsigned (&v)[2][2]) const {
#pragma unroll
        for (int i = 0; i < 2; ++i) { int R, C; stage_rc(tid * 16 + i * 8192, R, C);
#pragma unroll
            for (int h = 0; h < 2; ++h) v[h][i] = (unsigned)((h * HALF + R) * K + C) * 2u; }
    }
};
template <bool GATHER> struct SchedMoE {
    const char* A; const char* Bt; int K; size_t bstride; int G, c;
    const PG8_LAS int* tab;
    __device__ __forceinline__ bool next(int i, Unit& u) const {
        const int L = i * G + c; const int NT = tab[T_NT / 4];
        if (L >= NT * 4) return false;
        const int tile = L >> 2; u.pm = tile; u.pn = L & 3; const int e = tab[T_TILE_E / 4 + tile]; u.e = e;
        u.rt = tile - tab[T_TBASE / 4 + e]; const int rem = tab[T_CNT / 4 + e] - u.rt * 256; u.nv = rem < 256 ? rem : 256; return true;
    }
    __device__ __forceinline__ const char* a_ptr(const Unit& u) const { return GATHER ? A : A + (size_t)u.pm * BM * K * 2; }
    __device__ __forceinline__ const char* b_ptr(const Unit& u) const { return Bt + (size_t)u.e * bstride + (size_t)u.pn * BM * K * 2; }
    __device__ __forceinline__ void a_voff(int ui, const Unit&, int tid, unsigned (&v)[2][2]) const {
        asm volatile("" : "+v"(tid));
#pragma unroll
        for (int i = 0; i < 2; ++i) { int R, C; stage_rc(tid * 16 + i * 8192, R, C);
#pragma unroll
            for (int h = 0; h < 2; ++h) {
                if (GATHER) { const int tok = tab[T_ROWTAB / 4 + ui * 256 + h * HALF + R] >> 1; v[h][i] = (unsigned)(tok * K + C) * 2u; }
                else v[h][i] = (unsigned)((h * HALF + R) * K + C) * 2u; } }
    }
};

template <class Epi, class Sched, bool TAIL = false, bool FP8 = false>
__device__ __forceinline__ void gemm_phase(PG8_LAS unsigned char* lds, const int K, const Sched& S, const Epi& E) {
    const int tid = threadIdx.x, wid = __builtin_amdgcn_readfirstlane(tid >> 6), lane = tid & 63, wr = wid >> 2, wc = wid & 3, fr = lane & 15, fq = lane >> 4;
    const int nt = K / BK;
    constexpr bool EARLY = !FP8;
    unsigned voffB[1][2];
#pragma unroll
    for (int i = 0; i < 2; ++i) { int R, C; stage_rc(tid * 16 + i * 8192, R, C); const int Rb = (R & ~31) + perm32(R & 31);
        voffB[0][i] = (unsigned)(Rb * K + C) * 2u; }
    const size_t hstepB = (size_t)HALF * K * 2;
    const size_t kstep = (size_t)(BK * 2);
    const unsigned ldsw = (unsigned)wid * 1024u;
    const int aoff = lds_byte(wr * 64 + fr, fq * 8), boff = lds_byte(wc * 32 + fr, fq * 8);
#define PG8_SA(b, h) (((b) * 2 + (h)) * HTB)
#define PG8_SB(b, h) ((4 + (b) * 2 + (h)) * HTB)
#define PG8_STAGE(bufoff, gbase, voff) do { _Pragma("unroll") for (int _i = 0; _i < 2; ++_i) \
        __builtin_amdgcn_global_load_lds((const unsigned*)((const char*)(gbase) + (voff)[_i]), (PG8_LAS unsigned*)(lds + (bufoff) + ldsw + _i * 8192), 16, 0, 0); } while (0)
#define PG8_RD16(off) (*(const PG8_LAS v4i*)(lds + (off)))
#define PG8_LDA(dst, b, h) do { _Pragma("unroll") for (int m = 0; m < 4; ++m) { \
        if constexpr (FP8) At8[m] = __builtin_shufflevector(PG8_RD16(PG8_SA(b, h) + aoff + m * 2048), PG8_RD16(PG8_SA(b, h) + aoff + m * 2048 + 1024), 0, 1, 2, 3, 4, 5, 6, 7); \
        else { _Pragma("unroll") for (int k = 0; k < 2; ++k) dst[m][k] = *(const PG8_LAS bf16x8*)(lds + PG8_SA(b, h) + aoff + m * 2048 + k * 1024); } } } while (0)
#define PG8_LDB(dst, b, h) do { _Pragma("unroll") for (int n = 0; n < 2; ++n) { \
        if constexpr (FP8) dst##8[n] = __builtin_shufflevector(PG8_RD16(PG8_SB(b, h) + boff + n * 2048), PG8_RD16(PG8_SB(b, h) + boff + n * 2048 + 1024), 0, 1, 2, 3, 4, 5, 6, 7); \
        else { _Pragma("unroll") for (int k = 0; k < 2; ++k) dst[n][k] = *(const PG8_LAS bf16x8*)(lds + PG8_SB(b, h) + boff + n * 2048 + k * 1024); } } } while (0)
#define PG8_MMA(ai, bj, At, Bt) do { __builtin_amdgcn_s_setprio(1); _Pragma("unroll") for (int m = 0; m < 4; ++m) _Pragma("unroll") for (int n = 0; n < 2; ++n) { \
        if constexpr (FP8) asm volatile("v_mfma_scale_f32_16x16x128_f8f6f4 %0, %1, %2, %0, %3, %3 op_sel_hi:[0,0,0]" : "+v"(acc[ai][bj][m][n]) : "v"(Bt##8[n]), "v"(At8[m]), "v"(sc1)); \
        else { _Pragma("unroll") for (int k = 0; k < 2; ++k) acc[ai][bj][m][n] = __builtin_amdgcn_mfma_f32_16x16x32_bf16(Bt[n][k], At[m][k], acc[ai][bj][m][n], 0, 0, 0); } } \
        __builtin_amdgcn_s_setprio(0); } while (0)
#define PG8_WAIT_V(n) asm volatile("s_waitcnt vmcnt(" #n ")" ::: "memory")
#define PG8_WAIT_L(n) asm volatile("s_waitcnt lgkmcnt(" #n ")" ::: "memory")
#define PG8_BAR __builtin_amdgcn_s_barrier()
#define PG8_SCHED __builtin_amdgcn_sched_barrier(0)
    Unit cur, nxt; int ui = 0;
    if (!S.next(0, cur)) return;
    f32x4 acc[2][2][4][2];
#pragma unroll
    for (int a = 0; a < 2; ++a)
#pragma unroll
        for (int b = 0; b < 2; ++b)
#pragma unroll
            for (int m = 0; m < 4; ++m)
#pragma unroll
                for (int n = 0; n < 2; ++n) acc[a][b][m][n] = (f32x4){0.f, 0.f, 0.f, 0.f};
    bf16x8 At[4][2], B0[2][2], B1[2][2];
    v8i At8[4], B08[2], B18[2];
    int sc1 = 0x7f7f7f7f; asm volatile("" : "+v"(sc1));
    unsigned vc[2][2], vn[2][2];
    S.a_voff(0, cur, tid, vc);
    const char* cA = S.a_ptr(cur); const char* cB = S.b_ptr(cur);
    PG8_STAGE(PG8_SB(0, 0), cB, voffB[0]); PG8_STAGE(PG8_SB(0, 1), (cB) + hstepB, voffB[0]); PG8_STAGE(PG8_SA(0, 0), cA, vc[0]); PG8_STAGE(PG8_SA(0, 1), cA, vc[1]);
    if (wr == 1) PG8_BAR;
    PG8_WAIT_V(2); PG8_BAR;
    PG8_STAGE(PG8_SB(1, 0), cB + kstep, voffB[0]); PG8_STAGE(PG8_SA(1, 0), cA + kstep, vc[0]); PG8_STAGE(PG8_SB(1, 1), (cB + kstep) + hstepB, voffB[0]);
    PG8_WAIT_V(6); PG8_BAR;
    for (;;) {
        const bool has_next = S.next(ui + 1, nxt);
        const char* nA = has_next ? S.a_ptr(nxt) : cA; const char* nB = has_next ? S.b_ptr(nxt) : cB;
        if (has_next) S.a_voff(ui + 1, nxt, tid, vn);
        else {
#pragma unroll
            for (int h = 0; h < 2; ++h)
#pragma unroll
                for (int i = 0; i < 2; ++i) vn[h][i] = vc[h][i]; }
        const bool full_hi = !TAIL || cur.nv > HALF;
        for (int t = 0; t < nt; t += 2) {
            const bool last = (t == nt - 2);
            int fl_ = __builtin_amdgcn_readfirstlane(EARLY ? (t | (ui == 0)) : 1); asm volatile("" : "+s"(fl_));
            const bool fresh = (fl_ == 0);
            const char* a1 = cA + (size_t)(t + 1) * kstep;
            const char* a2 = last ? nA : cA + (size_t)(t + 2) * kstep; const char* b2 = last ? nB : cB + (size_t)(t + 2) * kstep;
            const char* a3 = a2 + kstep; const char* b3 = b2 + kstep;
            unsigned w0[2], w1[2];
            w0[0] = last ? vn[0][0] : vc[0][0]; w0[1] = last ? vn[0][1] : vc[0][1]; w1[0] = last ? vn[1][0] : vc[1][0]; w1[1] = last ? vn[1][1] : vc[1][1];
            PG8_LDB(B0, 0, 0); PG8_LDB(B1, 0, 1); PG8_SCHED; PG8_LDA(At, 0, 0); if (!fresh) { PG8_STAGE(PG8_SA(1, 1), a1, vc[1]); PG8_WAIT_V(8); }
            PG8_WAIT_L(0); PG8_BAR; PG8_MMA(0, 0, At, B0); PG8_MMA(0, 1, At, B1); PG8_BAR; PG8_SCHED;
            PG8_LDA(At, 0, 1); PG8_STAGE(PG8_SB(0, 0), b2, voffB[0]); PG8_STAGE(PG8_SB(0, 1), (b2) + hstepB, voffB[0]); PG8_STAGE(PG8_SA(0, 0), a2, w0);
            if (!fresh) PG8_WAIT_V(8); PG8_WAIT_L(0); PG8_BAR; if (full_hi) { PG8_MMA(1, 0, At, B0); PG8_MMA(1, 1, At, B1); } PG8_BAR; PG8_SCHED;
            PG8_LDB(B0, 1, 0); PG8_LDB(B1, 1, 1); PG8_SCHED; PG8_LDA(At, 1, 0); PG8_STAGE(PG8_SA(0, 1), a2, w1);
            if (!fresh) PG8_WAIT_V(8); PG8_WAIT_L(0); PG8_BAR; PG8_MMA(0, 0, At, B0); PG8_MMA(0, 1, At, B1); PG8_BAR; PG8_SCHED;
            PG8_LDA(At, 1, 1); PG8_STAGE(PG8_SB(1, 0), b3, voffB[0]); PG8_STAGE(PG8_SB(1, 1), (b3) + hstepB, voffB[0]); PG8_STAGE(PG8_SA(1, 0), a3, w0);
            PG8_WAIT_V(8); PG8_WAIT_L(0); PG8_BAR; if (full_hi) { PG8_MMA(1, 0, At, B0); PG8_MMA(1, 1, At, B1); } PG8_BAR; PG8_SCHED;
        }
        if (wr == 0) PG8_BAR;
        if constexpr (EARLY) {
            PG8_STAGE(PG8_SA(1, 1), nA + kstep, vn[1]);
            PG8_WAIT_V(0); }
        if constexpr (FP8) asm volatile("s_nop 15\n\ts_nop 15" ::: "memory");
        { int t2_ = threadIdx.x; asm volatile("" : "+v"(t2_)); E(acc, cur, ui, wr, wc, t2_ & 15, (t2_ >> 4) & 3); }
        if (!has_next) break;
#pragma unroll
        for (int a = 0; a < 2; ++a)
#pragma unroll
            for (int b = 0; b < 2; ++b)
#pragma unroll
                for (int m = 0; m < 4; ++m)
#pragma unroll
                    for (int n = 0; n < 2; ++n) acc[a][b][m][n] = (f32x4){0.f, 0.f, 0.f, 0.f};
        cur = nxt; cA = nA; cB = nB; ++ui;
#pragma unroll
        for (int h = 0; h < 2; ++h)
#pragma unroll
            for (int i = 0; i < 2; ++i) vc[h][i] = vn[h][i];
        if (wr == 1) PG8_BAR;
    }
    PG8_WAIT_V(0);
    PG8_BAR;
#undef PG8_SA
#undef PG8_SB
#undef PG8_STAGE
#undef PG8_LDA
#undef PG8_LDB
#undef PG8_MMA
#undef PG8_RD16
#undef PG8_WAIT_V
#undef PG8_WAIT_L
#undef PG8_BAR
#undef PG8_SCHED
}

struct EpiBf16 {
    bf16* O; int ldc;
    __device__ __forceinline__ void operator()(const f32x4 (&acc)[2][2][4][2], const Unit& u, int, int wr, int wc, int fr, int fq) const {
        const int row0 = u.pm * BM + wr * 64 + fr, col0 = u.pn * BM + wc * 32 + 8 * fq;
#pragma unroll
        for (int ai = 0; ai < 2; ++ai)
#pragma unroll
            for (int m = 0; m < 4; ++m) { bf16* rowp = O + (size_t)(row0 + ai * HALF + m * 16) * ldc + col0;
#pragma unroll
                for (int bj = 0; bj < 2; ++bj) { const f32x4 v0 = acc[ai][bj][m][0], v1 = acc[ai][bj][m][1];
                    u32x4 w; w.x = cvtpk(v0[0], v0[1]); w.y = cvtpk(v0[2], v0[3]); w.z = cvtpk(v1[0], v1[1]); w.w = cvtpk(v1[2], v1[3]);
                    *(u32x4*)(rowp + bj * HALF) = w; } }
    }
};
struct EpiTT {
    bf16* O; const float* RS;
    __device__ __forceinline__ void operator()(const f32x4 (&acc)[2][2][4][2], const Unit& u, int, int wr, int wc, int fr, int fq) const {
        const int row0 = u.pm * BM + wr * 64 + fr, tokb0 = u.pn * 8 + wc;
        f32x4 rs[2][2];
#pragma unroll
        for (int bj = 0; bj < 2; ++bj) { const float* rp = RS + (size_t)(tokb0 + 4 * bj) * 32 + 8 * fq; rs[bj][0] = *(const f32x4*)rp; rs[bj][1] = *(const f32x4*)(rp + 4); }
#pragma unroll
        for (int ai = 0; ai < 2; ++ai)
#pragma unroll
            for (int m = 0; m < 4; ++m) { const int col = row0 + ai * HALF + m * 16;
#pragma unroll
                for (int bj = 0; bj < 2; ++bj) { const f32x4 v0 = acc[ai][bj][m][0] * rs[bj][0], v1 = acc[ai][bj][m][1] * rs[bj][1];
                    u32x4 w; w.x = cvtpk(v0[0], v0[1]); w.y = cvtpk(v0[2], v0[3]); w.z = cvtpk(v1[0], v1[1]); w.w = cvtpk(v1[2], v1[3]);
                    *(u32x4*)(O + ((size_t)(tokb0 + 4 * bj) * 1280 + col) * 32 + 8 * fq) = w; } }
    }
};
struct EpiA {
    bf16 *SQ, *SK, *GQ, *GRS; const float *gq_norm, *gk_norm; const float* RS;
    __device__ __forceinline__ void operator()(const f32x4 (&acc)[2][2][4][2], const Unit& u, int, int wr, int wc, int fr, int fq) const {
        const int pn = u.pn; const int row0 = u.pm * BM + wr * 64 + fr;
        bf16* base; int ldc, colt; int mode;
        float scale = 1.f; const float* gain = nullptr;
        if (pn < 2)      { base = SQ; ldc = 512; colt = pn * 256; mode = 0; gain = gq_norm; scale = 0.125f * LOG2E; }
        else if (pn < 4) { base = SK; ldc = 512; colt = (pn - 2) * 256; mode = 0; gain = gk_norm; scale = 1.f; }
        else if (pn < 5) { base = GQ; ldc = 256; colt = 0; mode = 1; scale = 0.125f; }
        else             { base = GRS; ldc = 512; colt = (pn - 5) * 256; mode = 2; }
        const int col0 = colt + wc * 64 + 8 * fq;
        f32x4 gv[2][2];
#pragma unroll
        for (int bj = 0; bj < 2; ++bj)
#pragma unroll
            for (int n = 0; n < 2; ++n) { if (mode == 0) { gv[bj][n] = *(const f32x4*)(gain + 32 * bj + 8 * fq + 4 * n); gv[bj][n] = gv[bj][n] * scale; } else gv[bj][n] = (f32x4){scale, scale, scale, scale}; }
        float rs1v[2][4];
#pragma unroll
        for (int ai = 0; ai < 2; ++ai)
#pragma unroll
            for (int m = 0; m < 4; ++m) rs1v[ai][m] = RS[row0 + ai * HALF + m * 16];
#pragma unroll
        for (int ai = 0; ai < 2; ++ai)
#pragma unroll
            for (int m = 0; m < 4; ++m) {
                const float rs1 = rs1v[ai][m]; float rs = rs1;
                if (mode == 0) { float s = 0.f;
#pragma unroll
                    for (int bj = 0; bj < 2; ++bj)
#pragma unroll
                        for (int n = 0; n < 2; ++n) { const f32x4 x = acc[ai][bj][m][n]; s += (x[0] * x[0] + x[1] * x[1]) + (x[2] * x[2] + x[3] * x[3]); }
                    s += __shfl_xor(s, 16); s += __shfl_xor(s, 32);
                    rs = rs1 * __builtin_amdgcn_rsqf(rs1 * rs1 * s * (1.f / 64.f) + EPS); }
                bf16* rowp = base + (size_t)(row0 + ai * HALF + m * 16) * ldc + col0;
#pragma unroll
                for (int bj = 0; bj < 2; ++bj) { f32x4 v0 = acc[ai][bj][m][0], v1 = acc[ai][bj][m][1];
                    if (mode == 2) {
#pragma unroll
                        for (int e = 0; e < 4; ++e) { v0[e] *= rs1; v1[e] *= rs1; v0[e] = v0[e] * __builtin_amdgcn_rcpf(1.f + __builtin_amdgcn_exp2f(-v0[e] * LOG2E)); v1[e] = v1[e] * __builtin_amdgcn_rcpf(1.f + __builtin_amdgcn_exp2f(-v1[e] * LOG2E)); }
                    } else { v0 = v0 * rs * gv[bj][0]; v1 = v1 * rs * gv[bj][1]; }
                    u32x4 w; w.x = cvtpk(v0[0], v0[1]); w.y = cvtpk(v0[2], v0[3]); w.z = cvtpk(v1[0], v1[1]); w.w = cvtpk(v1[2], v1[3]);
                    *(u32x4*)(rowp + bj * 32) = w; } }
    }
};
struct EpiH {
    const bf16* XB; bf16* H; unsigned char* H8;
    __device__ __forceinline__ void operator()(const f32x4 (&acc)[2][2][4][2], const Unit& u, int, int wr, int wc, int fr, int fq) const {
        const int row0 = u.pm * BM + wr * 64 + fr, col0 = u.pn * BM + wc * 32 + 8 * fq;
#pragma unroll
        for (int ai = 0; ai < 2; ++ai) {
            u32x2 h8[4][2];
            bf16x8 xv[4][2];
#pragma unroll
            for (int m = 0; m < 4; ++m) { const size_t off = (size_t)(row0 + ai * HALF + m * 16) * DM + col0;
#pragma unroll
                for (int bj = 0; bj < 2; ++bj) xv[m][bj] = *(const bf16x8*)(XB + off + bj * HALF); }
#pragma unroll
            for (int m = 0; m < 4; ++m) { const size_t off = (size_t)(row0 + ai * HALF + m * 16) * DM + col0;
#pragma unroll
                for (int bj = 0; bj < 2; ++bj) { const bf16x8 xx = xv[m][bj];
                    const f32x4 v0 = acc[ai][bj][m][0] + (f32x4){bf2f(xx[0]), bf2f(xx[1]), bf2f(xx[2]), bf2f(xx[3])}, v1 = acc[ai][bj][m][1] + (f32x4){bf2f(xx[4]), bf2f(xx[5]), bf2f(xx[6]), bf2f(xx[7])};
                    u32x4 w; w.x = cvtpk(v0[0], v0[1]); w.y = cvtpk(v0[2], v0[3]); w.z = cvtpk(v1[0], v1[1]); w.w = cvtpk(v1[2], v1[3]);
                    *(u32x4*)(H + off + bj * HALF) = w;
                    const float f8[8] = {v0[0], v0[1], v0[2], v0[3], v1[0], v1[1], v1[2], v1[3]};
                    h8[m][bj] = pack8_fp8(f8); } }
#pragma unroll
            for (int mp = 0; mp < 2; ++mp)
#pragma unroll
                for (int bj = 0; bj < 2; ++bj) {
                    const auto r0 = __builtin_amdgcn_permlane16_swap(h8[2 * mp][bj].x, h8[2 * mp + 1][bj].x, false, false);
                    const auto r1 = __builtin_amdgcn_permlane16_swap(h8[2 * mp][bj].y, h8[2 * mp + 1][bj].y, false, false);
                    u32x4 w8; w8.x = r0[0]; w8.y = r1[0]; w8.z = r0[1]; w8.w = r1[1];
                    const size_t off8 = (size_t)(row0 + ai * HALF + (2 * mp + (fq & 1)) * 16) * DM + u.pn * BM + wc * 32 + 8 * (fq & ~1) + bj * HALF;
                    *(u32x4*)(H8 + off8) = w8; }
        }
    }
};
struct EpiGU {
    unsigned char* ACT; const float* RSTD; const PG8_LAS int* tab;
    __device__ __forceinline__ void operator()(const f32x4 (&acc)[2][2][4][2], const Unit& u, int ui, int wr, int wc, int fr, int fq) const {
        const int col0 = u.pn * 128 + wc * 32 + 8 * (fq & ~1); const int odd = fq & 1;
        float rsv[2][4];
#pragma unroll
        for (int ai = 0; ai < 2; ++ai)
#pragma unroll
            for (int m = 0; m < 4; ++m) { const int rl = ai * HALF + wr * 64 + m * 16 + fr; rsv[ai][m] = ((const PG8_LAS float*)tab)[T_RSTAB / 4 + ui * 256 + rl] * (1.f / WGU_SC); }
#pragma unroll
        for (int ai = 0; ai < 2; ++ai)
#pragma unroll
            for (int mp = 0; mp < 2; ++mp) {
                u32x2 pk[2];
#pragma unroll
                for (int q = 0; q < 2; ++q) { const int m = 2 * mp + q; const float rs = rsv[ai][m];
                    f32x4 g0 = acc[ai][0][m][0] * rs, g1 = acc[ai][0][m][1] * rs, u0 = acc[ai][1][m][0] * rs, u1 = acc[ai][1][m][1] * rs;
#pragma unroll
                    for (int e = 0; e < 4; ++e) { g0[e] = g0[e] * __builtin_amdgcn_rcpf(1.f + __builtin_amdgcn_exp2f(-g0[e] * LOG2E)) * u0[e]; g1[e] = g1[e] * __builtin_amdgcn_rcpf(1.f + __builtin_amdgcn_exp2f(-g1[e] * LOG2E)) * u1[e]; }
                    float f8[8] = {g0[0] * ACT_SC, g0[1] * ACT_SC, g0[2] * ACT_SC, g0[3] * ACT_SC, g1[0] * ACT_SC, g1[1] * ACT_SC, g1[2] * ACT_SC, g1[3] * ACT_SC};
#pragma unroll
                    for (int e = 0; e < 8; ++e) f8[e] = __builtin_fminf(__builtin_fmaxf(f8[e], -448.f), 448.f);
                    pk[q] = pack8_fp8(f8); }
                const auto r0 = __builtin_amdgcn_permlane16_swap(pk[0].x, pk[1].x, false, false);
                const auto r1 = __builtin_amdgcn_permlane16_swap(pk[0].y, pk[1].y, false, false);
                u32x4 w; w.x = r0[0]; w.y = r1[0]; w.z = r0[1]; w.w = r1[1];
                const int rl = ai * HALF + wr * 64 + (2 * mp + odd) * 16 + fr;
                if (rl < u.nv) *(u32x4*)(ACT + (size_t)(u.pm * 256 + rl) * DEXP + col0) = w; }
    }
};
struct EpiDown {
    unsigned char* Y; const PG8_LAS int* tab;
    __device__ __forceinline__ void operator()(const f32x4 (&acc)[2][2][4][2], const Unit& u, int ui, int wr, int wc, int fr, int fq) const {
        const int col0 = u.pn * BM + wc * 32 + 8 * (fq & ~1); const float sc = Y_SC / (WD_SC * ACT_SC); const int odd = fq & 1;
#pragma unroll
        for (int ai = 0; ai < 2; ++ai)
#pragma unroll
            for (int mp = 0; mp < 2; ++mp) { const int rl = ai * HALF + wr * 64 + (2 * mp + odd) * 16 + fr;
                const bool ok = rl < u.nv; const unsigned ts = (unsigned)tab[T_ROWTAB / 4 + ui * 256 + (ok ? rl : 0)];
                unsigned char* rowp = Y + (size_t)ts * DM + col0;
#pragma unroll
                for (int bj = 0; bj < 2; ++bj) {
                    u32x2 pk[2];
#pragma unroll
                    for (int q = 0; q < 2; ++q) { const f32x4 v0 = acc[ai][bj][2 * mp + q][0] * sc, v1 = acc[ai][bj][2 * mp + q][1] * sc;
                        const float f8[8] = {v0[0], v0[1], v0[2], v0[3], v1[0], v1[1], v1[2], v1[3]}; pk[q] = pack8_fp8(f8); }
                    const auto r0 = __builtin_amdgcn_permlane16_swap(pk[0].x, pk[1].x, false, false);
                    const auto r1 = __builtin_amdgcn_permlane16_swap(pk[0].y, pk[1].y, false, false);
                    u32x4 w; w.x = r0[0]; w.y = r1[0]; w.z = r0[1]; w.w = r1[1];
                    if (ok) *(u32x4*)(rowp + bj * HALF) = w; } }
    }
};
}

#define XB_TMO      128
#define XB_XCNT(j)  (256  + 64 * (j))
#define XB_XSUB(j)  (1280 + 64 * (j))
#define XB_XGEN(j)  (2304 + 64 * (j))
#define XB_TOP      3328
#define XB_TOPGEN   3392
#define XCD_BAR_WORDS 3456
#define XB_SPIN_CAP (1u << 18)
__device__ __forceinline__ unsigned xb_ld(unsigned* p)              { return __hip_atomic_load(p, __ATOMIC_RELAXED, __HIP_MEMORY_SCOPE_AGENT); }
__device__ __forceinline__ unsigned xb_add(unsigned* p, unsigned v) { return __hip_atomic_fetch_add(p, v, __ATOMIC_RELAXED, __HIP_MEMORY_SCOPE_AGENT); }
__device__ __forceinline__ unsigned xb_xcc_id() { return (unsigned)__builtin_amdgcn_s_getreg((3 << 11) | 20) & 0xFu; }
#define XB_SPIN(cond, bar) do { unsigned _sp = 0; while (cond) { __builtin_amdgcn_s_sleep(1); \
    if ((++_sp & 255u) == 0u) { if (xb_ld(&(bar)[XB_TMO])) break; if (_sp > XB_SPIN_CAP) { atomicAdd(&(bar)[XB_TMO], 1u); break; } } } } while (0)
struct XcdBarrier { unsigned* bar; unsigned x; volatile LAS unsigned* st; };
__device__ __forceinline__ XcdBarrier xcd_barrier_post(unsigned* bar, volatile LAS unsigned* st) {
    XcdBarrier b; b.bar = bar; b.x = xb_xcc_id(); b.st = st;
    if (threadIdx.x == 0) (void)xb_add(&bar[XB_XCNT(b.x)], 1u);
    return b;
}
__device__ __forceinline__ void xcd_barrier_complete(unsigned* bar, unsigned x, unsigned& nloc, unsigned& nx) {
    const unsigned G = gridDim.x * gridDim.y * gridDim.z;
    unsigned sum, cnt, mine, sp = 0u;
    for (;;) {
        sum = 0u; cnt = 0u; mine = 0u;
#pragma unroll
        for (unsigned j = 0; j < 16; ++j) { const unsigned c = xb_ld(&bar[XB_XCNT(j)]); sum += c; cnt += (c > 0u) ? 1u : 0u; mine = (j == x) ? c : mine; }
        if (sum == G) break;
        __builtin_amdgcn_s_sleep(1);
        if ((++sp & 255u) == 0u) { if (xb_ld(&bar[XB_TMO])) break; if (sp > XB_SPIN_CAP) { atomicAdd(&bar[XB_TMO], 1u); break; } }
    }
    nloc = mine > 0u ? mine : 1u; nx = cnt > 0u ? cnt : 1u;
}
__device__ __forceinline__ void xcd_barrier(const XcdBarrier& b) {
    asm volatile("s_waitcnt vmcnt(0)" ::: "memory");
    __syncthreads();
    if (threadIdx.x == 0) {
        unsigned* bar = b.bar;
        __builtin_amdgcn_s_waitcnt(0);
        unsigned nloc = b.st[0], nx = b.st[1];
        if (nloc == 0u) { xcd_barrier_complete(bar, b.x, nloc, nx); b.st[0] = nloc; b.st[1] = nx; }
        const unsigned old = xb_add(&bar[XB_XSUB(b.x)], 1u);
        const unsigned gen = old / nloc;
        if (old + 1u == (gen + 1u) * nloc) {
            __builtin_amdgcn_fence(__ATOMIC_RELEASE, "agent");
            asm volatile("s_waitcnt vmcnt(0)" ::: "memory");
            const unsigned og = xb_add(&bar[XB_TOP], 1u);
            const unsigned tg = og / nx;
            if (og + 1u == (tg + 1u) * nx) xb_add(&bar[XB_TOPGEN], 1u);
            else XB_SPIN(xb_ld(&bar[XB_TOPGEN]) == tg, bar);
            __builtin_amdgcn_fence(__ATOMIC_ACQUIRE, "agent");
            xb_add(&bar[XB_XGEN(b.x)], 1u);
            asm volatile("s_waitcnt vmcnt(0)" ::: "memory");
        } else {
            XB_SPIN(xb_ld(&bar[XB_XGEN(b.x)]) == gen, bar);
            __builtin_amdgcn_fence(__ATOMIC_ACQUIRE, "agent");
            asm volatile("s_waitcnt vmcnt(0)" ::: "memory");
        }
    }
    __syncthreads();
}

__device__ __forceinline__ void xcd_barrier_arrive(const XcdBarrier& b, volatile LAS unsigned* sv) {
    asm volatile("s_waitcnt vmcnt(0)" ::: "memory");
    __syncthreads();
    if (threadIdx.x == 0) {
        unsigned* bar = b.bar;
        __builtin_amdgcn_s_waitcnt(0);
        unsigned nloc = b.st[0], nx = b.st[1];
        if (nloc == 0u) { xcd_barrier_complete(bar, b.x, nloc, nx); b.st[0] = nloc; b.st[1] = nx; }
        const unsigned old = xb_add(&bar[XB_XSUB(b.x)], 1u);
        const unsigned gen = old / nloc;
        unsigned role = 0u, tg = 0u;
        if (old + 1u == (gen + 1u) * nloc) {
            __builtin_amdgcn_fence(__ATOMIC_RELEASE, "agent");
            asm volatile("s_waitcnt vmcnt(0)" ::: "memory");
            const unsigned og = xb_add(&bar[XB_TOP], 1u);
            tg = og / nx;
            if (og + 1u == (tg + 1u) * nx) { xb_add(&bar[XB_TOPGEN], 1u); role = 2u; } else role = 1u;
        }
        sv[0] = role; sv[1] = gen; sv[2] = tg;
    }
}
__device__ __forceinline__ void xcd_barrier_wait(const XcdBarrier& b, volatile LAS unsigned* sv) {
    asm volatile("s_waitcnt vmcnt(0)" ::: "memory");
    __syncthreads();
    if (threadIdx.x == 0) {
        unsigned* bar = b.bar; const unsigned role = sv[0], gen = sv[1], tg = sv[2];
        if (role != 0u) {
            if (role == 1u) XB_SPIN(xb_ld(&bar[XB_TOPGEN]) == tg, bar);
            __builtin_amdgcn_fence(__ATOMIC_ACQUIRE, "agent");
            xb_add(&bar[XB_XGEN(b.x)], 1u);
            asm volatile("s_waitcnt vmcnt(0)" ::: "memory");
        } else {
            XB_SPIN(xb_ld(&bar[XB_XGEN(b.x)]) == gen, bar);
            __builtin_amdgcn_fence(__ATOMIC_ACQUIRE, "agent");
            asm volatile("s_waitcnt vmcnt(0)" ::: "memory");
        }
    }
    __syncthreads();
}

__device__ __forceinline__ float wave_sum(float v) {
#pragma unroll
    for (int o = 1; o < 64; o <<= 1) v += __shfl_xor(v, o);
    return v;
}
__device__ __forceinline__ void tr_item(const float* src, int srcN, int k0, int n0, bf16* dst, int drow0, int dK, const float* kscale, LAS float* scr, int lane) {
    float w[32];
    const float* sp = src + (size_t)(k0 + (lane >> 5)) * srcN + n0 + (lane & 31);
#pragma unroll
    for (int i = 0; i < 32; ++i) w[i] = __builtin_nontemporal_load(sp + (size_t)(2 * i) * srcN);
    if (kscale) { const float ksv = kscale[k0 + lane];
#pragma unroll
        for (int i = 0; i < 32; ++i) { const float a = __int_as_float(__builtin_amdgcn_readlane(__float_as_int(ksv), 2 * i)), b = __int_as_float(__builtin_amdgcn_readlane(__float_as_int(ksv), 2 * i + 1)); w[i] *= (lane >> 5) ? b : a; } }
#pragma unroll
    for (int i = 0; i < 32; ++i) scr[(2 * i + (lane >> 5)) * 33 + (lane & 31)] = w[i];
    LDS_WAIT(); asm volatile("" ::: "memory");
    const int c = lane & 7;
#pragma unroll
    for (int j = 0; j < 4; ++j) { const int n = (lane >> 3) + 8 * j; const LAS float* s = scr + (8 * c) * 33 + n;
        u32x4 o; o.x = cvtpk(s[0 * 33], s[1 * 33]); o.y = cvtpk(s[2 * 33], s[3 * 33]); o.z = cvtpk(s[4 * 33], s[5 * 33]); o.w = cvtpk(s[6 * 33], s[7 * 33]);
        *(GAS u32x4*)(dst + (size_t)(drow0 + n) * dK + k0 + 8 * c) = o; }
    LDS_WAIT(); asm volatile("" ::: "memory");
}

__device__ __forceinline__ void tr_item8(const float* src, int srcN, int k0, int n0, unsigned char* dst, int drow0, int dK, const float* kscale, float scale, LAS float* scr, int lane) {
    float w[32];
    const float* sp = src + (size_t)(k0 + (lane >> 5)) * srcN + n0 + (lane & 31);
#pragma unroll
    for (int i = 0; i < 32; ++i) w[i] = __builtin_nontemporal_load(sp + (size_t)(2 * i) * srcN);
    float ksv = scale; if (kscale) ksv *= kscale[k0 + lane];
#pragma unroll
    for (int i = 0; i < 32; ++i) { const float a = __int_as_float(__builtin_amdgcn_readlane(__float_as_int(ksv), 2 * i)), b = __int_as_float(__builtin_amdgcn_readlane(__float_as_int(ksv), 2 * i + 1)); w[i] *= (lane >> 5) ? b : a; }
#pragma unroll
    for (int i = 0; i < 32; ++i) scr[(2 * i + (lane >> 5)) * 33 + (lane & 31)] = w[i];
    LDS_WAIT(); asm volatile("" ::: "memory");
#pragma unroll
    for (int j = 0; j < 2; ++j) { const int idx = lane + 64 * j, n = idx >> 2, c = idx & 3; const LAS float* sc_ = scr + (16 * c) * 33 + n;
        float f[16];
#pragma unroll
        for (int i = 0; i < 16; ++i) f[i] = sc_[i * 33];
        const u32x2 lo = pack8_fp8(f), hi = pack8_fp8(f + 8);
        u32x4 o; o.x = lo.x; o.y = lo.y; o.z = hi.x; o.w = hi.y;
        *(GAS u32x4*)(dst + (size_t)(drow0 + n) * dK + k0 + 16 * c) = o; }
    LDS_WAIT(); asm volatile("" ::: "memory");
}

struct Ptrs {
    const float *x, *attn_g, *w_in, *sbq_g, *sbk_g, *sbo_g, *w2, *gate_b, *glan_g, *w_out, *ffn_g, *rg_w, *rg_b, *re_w, *re_b, *wg, *wu, *wd;
    float* out; unsigned char* ws;
};

constexpr int SB_SPAN = 14, SB_VOFF = SB_SPAN * 4096;
__device__ __forceinline__ int sb_keyK(int r) { return ((r >> 1) & 3) | (((r >> 4) & 1) << 2); }
__device__ __forceinline__ int sb_keyV(int r) { return ((r >> 2) & 1) | (((r >> 4) & 1) << 1); }
__device__ __forceinline__ void sb_round(LAS unsigned char* lds, const bf16* SQ, const bf16* SK, const bf16* TT, const float* gout, bf16* MIX, int b, int h, int qg, int tid, int wave, int lane) {
    const int il = lane & 31, hi = lane >> 5, pil = PI32(il);
    const int qt = 8 * qg + wave;
    const size_t row0 = (size_t)b * SEQ + (size_t)qt * 32;
    bf16x8 qf[4];
    { const bf16* qp = SQ + (row0 + il) * 512 + h * 64 + 32 * hi;
#pragma unroll
      for (int s = 0; s < 4; ++s) qf[s] = *(const bf16x8*)(qp + 8 * s); }
    const int lo = (8 * qg - 6) > 0 ? (8 * qg - 6) : 0, nblk = 8 * qg + 8 - lo;
    {
        u32x4 st[SB_SPAN];
        const bool isK = tid < 256; const int q = tid - 256;
        const bf16* src = isK ? SK + ((size_t)b * SEQ + (size_t)lo * 32 + (tid >> 3)) * 512 + h * 64 + 8 * (tid & 7)
                              : TT + ((size_t)(b * (SEQ / 32) + lo) * NB + h * 64 + (q >> 2)) * 32 + 8 * (q & 3);
        const size_t bstep = isK ? (size_t)32 * 512 : (size_t)NB * 32;
#pragma unroll
        for (int i = 0; i < SB_SPAN; ++i) if (i < nblk) st[i] = *(const u32x4*)(src + (size_t)i * bstep);
        const int r = isK ? (tid >> 3) : (q >> 2);
        const unsigned dst = isK ? (unsigned)(r * 128 + (((tid & 7) ^ sb_keyK(r)) << 4)) : (unsigned)(SB_VOFF + r * 64 + (((q & 3) ^ sb_keyV(r & 31)) << 4));
#pragma unroll
        for (int i = 0; i < SB_SPAN; ++i) if (i < nblk) *(LAS u32x4*)(lds + dst + i * 4096) = st[i];
    }
    __syncthreads();
    f32x16 o0, o1;
#pragma unroll
    for (int r = 0; r < 16; ++r) { o0[r] = 0.f; o1[r] = 0.f; }
    float R = 1.f;
#define SB_MATH(KC, VC, kb_) do { \
        f32x16 z; \
        _Pragma("unroll") for (int r = 0; r < 16; ++r) z[r] = 0.f; \
        _Pragma("unroll") for (int s = 0; s < 4; ++s) z = MFMA32(KC[s], qf[s], z); \
        float beta[16], omb[16]; \
        const bool diag = ((kb_) == qt); \
        _Pragma("unroll") for (int r = 0; r < 16; ++r) { \
            const float zz = z[r]; const float t = __builtin_amdgcn_exp2f(-__builtin_fabsf(zz)); const float rr = __builtin_amdgcn_rcpf(1.f + t); const float sm = t * rr; \
            const bool pos = zz >= 0.f; float be = pos ? rr : sm; float om = pos ? sm : rr; \
            if (diag) { const bool valid = (16 * hi + r) < il; be = valid ? be : 0.f; om = valid ? om : 1.f; } \
            beta[r] = be; omb[r] = om; } \
        float e[16]; e[15] = 1.f; \
        _Pragma("unroll") for (int r = 14; r >= 0; --r) e[r] = e[r + 1] * omb[r + 1]; \
        const float P16 = e[0] * omb[0]; \
        float Plo, Phi; swap32(P16, Plo, Phi); \
        const float base = R * (hi ? 1.f : Phi); \
        float a[16]; \
        _Pragma("unroll") for (int r = 0; r < 16; ++r) a[r] = beta[r] * e[r] * base; \
        R = R * (Plo * Phi); \
        const bf16x8 p0 = pack8(a), p1 = pack8(a + 8); \
        o0 = MFMA32(VC[0][0], p0, o0); o0 = MFMA32(VC[0][1], p1, o0); \
        o1 = MFMA32(VC[1][0], p0, o1); o1 = MFMA32(VC[1][1], p1, o1); } while (0)
    bool fin = false;
    {
        const unsigned kbase = (unsigned)(pil * 128), vbase = (unsigned)(SB_VOFF + pil * 64);
        unsigned kx[4], vx[2];
#pragma unroll
        for (int s = 0; s < 4; ++s) kx[s] = (unsigned)(((4 * hi + s) ^ sb_keyK(pil)) << 4);
#pragma unroll
        for (int s = 0; s < 2; ++s) vx[s] = (unsigned)(((2 * hi + s) ^ sb_keyV(pil)) << 4);
        for (int kb = qt; ; --kb) {
            const unsigned so = (unsigned)(kb - lo) * 4096u;
            bf16x8 kf[4], vf[2][2];
#pragma unroll
            for (int s = 0; s < 4; ++s) kf[s] = *(const LAS bf16x8*)(lds + so + kbase + kx[s]);
#pragma unroll
            for (int dt = 0; dt < 2; ++dt)
#pragma unroll
                for (int s = 0; s < 2; ++s) vf[dt][s] = *(const LAS bf16x8*)(lds + so + vbase + dt * 2048 + vx[s]);
            SB_MATH(kf, vf, kb);
            if (kb == 0 || __all(R == 0.f)) { fin = true; break; }
            if (kb == lo) break;
        }
    }
    if (!fin) {
        for (int kb = lo - 1; ; --kb) {
            bf16x8 kf[4], vf[2][2];
            const bf16* kp = SK + ((size_t)b * SEQ + (size_t)kb * 32 + pil) * 512 + h * 64 + 32 * hi;
#pragma unroll
            for (int s = 0; s < 4; ++s) kf[s] = *(const bf16x8*)(kp + 8 * s);
            const bf16* vp = TT + ((size_t)(b * (SEQ / 32) + kb) * NB + h * 64 + pil) * 32 + 16 * hi;
#pragma unroll
            for (int dt = 0; dt < 2; ++dt)
#pragma unroll
                for (int s = 0; s < 2; ++s) vf[dt][s] = *(const bf16x8*)(vp + dt * 32 * 32 + 8 * s);
            SB_MATH(kf, vf, kb);
            if (kb == 0 || __all(R == 0.f)) break;
        }
    }
#undef SB_MATH
    float ss = 0.f;
#pragma unroll
    for (int r = 0; r < 16; ++r) ss += o0[r] * o0[r] + o1[r] * o1[r];
    float slo, shi; swap32(ss, slo, shi);
    const float rstd = __builtin_amdgcn_rsqf((slo + shi) * (1.f / 64.f) + EPS);
    bf16* op = MIX + (row0 + il) * DM + h * 64 + 16 * hi;
#pragma unroll
    for (int dt = 0; dt < 2; ++dt) {
        float v[16];
#pragma unroll
        for (int r4 = 0; r4 < 4; ++r4) { const f32x4 g = *(const f32x4*)(gout + 32 * dt + 16 * hi + 4 * r4);
#pragma unroll
            for (int e2 = 0; e2 < 4; ++e2) v[4 * r4 + e2] = (dt ? o1[4 * r4 + e2] : o0[4 * r4 + e2]) * rstd * g[e2]; }
        *(bf16x8*)(op + 32 * dt) = pack8(v); *(bf16x8*)(op + 32 * dt + 8) = pack8(v + 8);
    }
    __syncthreads();
}

__device__ __forceinline__ void gla_a(const bf16* GLR, const bf16* W2T, const float* gate_b, const bf16* TT, bf16* KV, float* DTOT, int bh, int j, int lane) {
    const int il = lane & 31, hi = lane >> 5, pil = PI32(il);
    const int b = bh >> 2, h = bh & 3;
    const size_t t0 = (size_t)b * SEQ + (size_t)j * 64;
    bf16x8 gf[2], wf[2], gkf[2][2][2], bvf[4][4]; float bias[2];
#pragma unroll
    for (int ch = 0; ch < 2; ++ch) gf[ch] = *(const bf16x8*)(GLR + (t0 + 32 * ch + pil) * 16 + 8 * hi);
#pragma unroll
    for (int kh = 0; kh < 2; ++kh) { const int kcol = 64 * h + 32 * kh + pil; wf[kh] = *(const bf16x8*)(W2T + kcol * 16 + 8 * hi); bias[kh] = gate_b[kcol];
        const bf16* gkp = TT + ((t0 >> 5) * NB + 512 + kcol) * 32 + 16 * hi;
#pragma unroll
        for (int ch = 0; ch < 2; ++ch) { gkf[kh][ch][0] = *(const bf16x8*)(gkp + ch * NB * 32); gkf[kh][ch][1] = *(const bf16x8*)(gkp + ch * NB * 32 + 8); } }
#pragma unroll
    for (int vq = 0; vq < 4; ++vq) { const bf16* vp = TT + ((t0 >> 5) * NB + 768 + 128 * h + 32 * vq + il) * 32 + 16 * hi;
#pragma unroll
        for (int s = 0; s < 4; ++s) bvf[vq][s] = *(const bf16x8*)(vp + (s >> 1) * NB * 32 + 8 * (s & 1)); }
    bf16x8 akf[2][4];
#pragma unroll
    for (int kh = 0; kh < 2; ++kh) {
        const int kcol = 64 * h + 32 * kh + pil;
        float cs[2][16];
#pragma unroll
        for (int ch = 0; ch < 2; ++ch) {
            f32x16 g;
#pragma unroll
            for (int r = 0; r < 16; ++r) g[r] = 0.f;
            g = MFMA32(gf[ch], wf[kh], g);
            if (kh == 0 && ch == 0) asm volatile("" : "+v"(g) :: "memory");
            float run = 0.f;
#pragma unroll
            for (int r = 0; r < 16; ++r) { const float x = g[r] + bias[kh];
                const float ls2 = __builtin_fminf(x, 0.f) * LOG2E - __builtin_amdgcn_logf(1.f + __builtin_amdgcn_exp2f(-__builtin_fabsf(x) * LOG2E));
                run += ls2 * (1.f / 16.f); cs[ch][r] = run; }
        }
        float t0lo, t0hi, t1lo, t1hi; swap32(cs[0][15], t0lo, t0hi); swap32(cs[1][15], t1lo, t1hi);
        const float off0 = hi ? t0lo : 0.f, off1 = (t0lo + t0hi) + (hi ? t1lo : 0.f), total = (t0lo + t0hi) + (t1lo + t1hi);
        if (hi == 0) DTOT[((size_t)bh * 32 + j) * 64 + 32 * kh + pil] = __builtin_amdgcn_exp2f(total);
#pragma unroll
        for (int ch = 0; ch < 2; ++ch) {
            const bf16x8 k0 = gkf[kh][ch][0], k1 = gkf[kh][ch][1];
            float kd[16]; const float off = ch ? off1 : off0;
#pragma unroll
            for (int r = 0; r < 16; ++r) { const float dec = __builtin_amdgcn_exp2f(total - (cs[ch][r] + off)); kd[r] = bf2f(r < 8 ? k0[r] : k1[r - 8]) * dec; }
            akf[kh][2 * ch] = pack8(kd); akf[kh][2 * ch + 1] = pack8(kd + 8);
        }
    }
#pragma unroll
    for (int vq = 0; vq < 4; ++vq) {
#pragma unroll
        for (int kh = 0; kh < 2; ++kh) {
            f32x16 kv;
#pragma unroll
            for (int r = 0; r < 16; ++r) kv[r] = 0.f;
#pragma unroll
            for (int s = 0; s < 4; ++s) kv = MFMA32(akf[kh][s], bvf[vq][s], kv);
            bf16* dst = KV + (((size_t)bh * 32 + j) * 128 + 32 * vq + il) * 64 + 32 * kh + 16 * hi;
            float kvf[16];
#pragma unroll
            for (int r = 0; r < 16; ++r) kvf[r] = kv[r];
            *(bf16x8*)dst = pack8(kvf); *(bf16x8*)(dst + 8) = pack8(kvf + 8);
        }
    }
}
__device__ __forceinline__ void gla_b(const bf16* KV, const float* DTOT, bf16* ST, int task, int lane) {
    const int bh = task >> 5, part = task & 31; const int e0 = part * 256 + lane * 4; const int k = e0 & 63;
    f32x4 S = (f32x4){0.f, 0.f, 0.f, 0.f};
#pragma unroll
    for (int half = 0; half < 2; ++half) {
        u32x2 kvp[16]; f32x4 d[16];
#pragma unroll
        for (int q = 0; q < 16; ++q) { const int j = 16 * half + q;
            kvp[q] = *(const u32x2*)(KV + ((size_t)bh * 32 + j) * 8192 + e0); d[q] = *(const f32x4*)(DTOT + ((size_t)bh * 32 + j) * 64 + k); }
#pragma unroll
        for (int q = 0; q < 16; ++q) { const int j = 16 * half + q;
            const f32x4 kv = (f32x4){__uint_as_float(kvp[q].x << 16), __uint_as_float(kvp[q].x & 0xffff0000u), __uint_as_float(kvp[q].y << 16), __uint_as_float(kvp[q].y & 0xffff0000u)};
            S = d[q] * S + kv;
            u32x2 w; w.x = cvtpk(S[0], S[1]); w.y = cvtpk(S[2], S[3]);
            *(u32x2*)(ST + ((size_t)bh * 32 + j) * 8192 + e0) = w; }
        asm volatile("" ::: "memory");
    }
}
__device__ __forceinline__ void gla_c(LAS unsigned char* wl, const bf16* ST, const bf16* GQ, const bf16* GRS, const float* gn, bf16* MIX, int bh, int j, int lane) {
    const int il = lane & 31, hi = lane >> 5, pil = PI32(il);
    const int b = bh >> 2, h = bh & 3;
    const size_t t0 = (size_t)b * SEQ + (size_t)j * 64;
    const bf16* sp = ST + ((size_t)bh * 32 + j) * 8192 + lane * 8;
    u32x4 st[16];
#pragma unroll
    for (int i = 0; i < 16; ++i) st[i] = *(const u32x4*)(sp + i * 512);
    bf16x8 bq[2][4], gr[2][4][2];
#pragma unroll
    for (int ch = 0; ch < 2; ++ch) { const size_t row = t0 + 32 * ch + il;
#pragma unroll
        for (int s = 0; s < 4; ++s) bq[ch][s] = *(const bf16x8*)(GQ + row * 256 + 64 * h + 16 * s + 8 * hi); }
    { const size_t row = t0 + il;
#pragma unroll
      for (int vt = 0; vt < 4; ++vt) { gr[0][vt][0] = *(const bf16x8*)(GRS + row * 512 + 128 * h + 32 * vt + 16 * hi); gr[0][vt][1] = *(const bf16x8*)(GRS + row * 512 + 128 * h + 32 * vt + 16 * hi + 8); } }
    { const int vr = lane >> 3, c = lane & 7;
#pragma unroll
      for (int i = 0; i < 16; ++i) { const int v = 8 * i + vr; *(LAS u32x4*)(wl + v * 128 + ((c ^ sb_keyK(v & 31)) << 4)) = st[i]; } }
    LDS_WAIT(); asm volatile("" ::: "memory");
    unsigned ax[4];
#pragma unroll
    for (int s = 0; s < 4; ++s) ax[s] = (unsigned)(pil * 128 + (((2 * s + hi) ^ sb_keyK(pil)) << 4));
#pragma unroll
    for (int ch = 0; ch < 2; ++ch) {
        const size_t row = t0 + 32 * ch + il;
        f32x16 O[4]; float ss = 0.f;
#pragma unroll
        for (int vt = 0; vt < 4; ++vt) {
#pragma unroll
            for (int r = 0; r < 16; ++r) O[vt][r] = 0.f;
#pragma unroll
            for (int s = 0; s < 4; ++s) { const bf16x8 af = *(const LAS bf16x8*)(wl + vt * 4096 + ax[s]); O[vt] = MFMA32(af, bq[ch][s], O[vt]); }
            if (ch == 0 && vt == 0) {
                const size_t row1 = t0 + 32 + il;
#pragma unroll
                for (int v2 = 0; v2 < 4; ++v2) { gr[1][v2][0] = *(const bf16x8*)(GRS + row1 * 512 + 128 * h + 32 * v2 + 16 * hi); gr[1][v2][1] = *(const bf16x8*)(GRS + row1 * 512 + 128 * h + 32 * v2 + 16 * hi + 8); }
                asm volatile("" : "+v"(O[0]) :: "memory"); }
#pragma unroll
            for (int r = 0; r < 16; ++r) ss += O[vt][r] * O[vt][r];
        }
        float slo, shi; swap32(ss, slo, shi);
        const float rstd = __builtin_amdgcn_rsqf((slo + shi) * (1.f / 128.f) + EPS);
#pragma unroll
        for (int vt = 0; vt < 4; ++vt) {
            const int vc0 = 32 * vt + 16 * hi;
            float v[16];
#pragma unroll
            for (int r4 = 0; r4 < 4; ++r4) { const f32x4 g = *(const f32x4*)(gn + vc0 + 4 * r4);
#pragma unroll
                for (int e2 = 0; e2 < 4; ++e2) { const int r = 4 * r4 + e2; v[r] = O[vt][r] * rstd * g[e2] * bf2f(r < 8 ? gr[ch][vt][0][r] : gr[ch][vt][1][r - 8]); } }
            bf16* op = MIX + row * DM + 512 + 128 * h + vc0;
            *(bf16x8*)(op) = pack8(v); *(bf16x8*)(op + 8) = pack8(v + 8);
        }
    }
    LDS_WAIT(); asm volatile("" ::: "memory");
}

constexpr int NWAVES = 8;
constexpr int N_PHASES = 10;
struct Args { Ptrs p; int ph_lo, ph_hi; };

__global__ void __launch_bounds__(NWAVES * 64, 2) fwd_kernel(Args args) {
    extern __shared__ __attribute__((aligned(16))) unsigned char lds_raw[];
    LAS unsigned char* lds = (LAS unsigned char*)lds_raw;
    const Ptrs& P = args.p;
    const int tid = threadIdx.x, lane = tid & 63, wave = __builtin_amdgcn_readfirstlane(tid >> 6);
    const int G = gridDim.x; const int bx = blockIdx.x; const int vcu = (G % 8 == 0) ? (bx % 8) * (G / 8) + bx / 8 : bx;
    const int gw = vcu * NWAVES + wave, NGW = G * NWAVES;
    unsigned char* ws = P.ws;
    gu32* ctl = (gu32*)(ws + WS_CTL);
    volatile LAS unsigned* MISC = (volatile LAS unsigned*)(lds + MISC_OFF);
    LAS int* tab = (LAS int*)(lds + TAB_OFF);
    for (int u = tid; u < (LDS_BYTES - LDSCTL_OFF) / 4; u += NWAVES * 64) ((LAS unsigned*)(lds + LDSCTL_OFF))[u] = 0u;
    __syncthreads();
    XcdBarrier bar; bar.bar = (unsigned*)(ctl + CW_BAR); bar.x = 0; bar.st = nullptr;
    if (MK_N_LAUNCHES == 1) bar = xcd_barrier_post((unsigned*)(ctl + CW_BAR), MISC + 8);
#define GRID_BAR() do { if (MK_N_LAUNCHES == 1) xcd_barrier(bar); } while (0)
#define BAR_ARRIVE() do { if (MK_N_LAUNCHES == 1) xcd_barrier_arrive(bar, MISC + 12); } while (0)
#define BAR_WAIT() do { if (MK_N_LAUNCHES == 1) xcd_barrier_wait(bar, MISC + 12); } while (0)
    const int lo = args.ph_lo, hi_ph = args.ph_hi;
#ifndef PHASE_MASK
#define PHASE_MASK 0x3ff
#endif
#define IN(k) (((PHASE_MASK >> (k)) & 1) && lo <= (k) && (k) < hi_ph)
#define BOTH(k) (IN(k) && IN((k) + 1))
#ifndef PROBE_TWICE
#define PROBE_TWICE -1
#endif
#define REP(k) for (int rep_ = 0; rep_ < ((PROBE_TWICE == (k)) ? 2 : 1); ++rep_)
#define REPBAR(k) do { if (PROBE_TWICE == (k) && rep_ == 0) GRID_BAR(); } while (0)

    bf16* WA = (bf16*)(ws + WS_WA); bf16* WB = (bf16*)(ws + WS_WB); bf16* WO = (bf16*)(ws + WS_WO);
    bf16* WRH = (bf16*)(ws + WS_WR); bf16* WRL = WRH + 48 * 1024; bf16* W2T = (bf16*)(ws + WS_W2T);
    bf16* WGU = (bf16*)(ws + WS_WGU); bf16* WD = (bf16*)(ws + WS_WD);
    bf16* H = (bf16*)(ws + WS_H); bf16* KV = (bf16*)(ws + WS_KV);
    bf16* XB = (bf16*)(ws + WS_XB); bf16* MIX = (bf16*)(ws + WS_MIX); float* RSTD1 = (float*)(ws + WS_RSTD1);
    bf16* SQ = (bf16*)(ws + WS_SQ); bf16* SK = (bf16*)(ws + WS_SK); bf16* GQ = (bf16*)(ws + WS_GQ); bf16* GRS = (bf16*)(ws + WS_GRS);
    bf16* TT = (bf16*)(ws + WS_TT); bf16* GLR = (bf16*)(ws + WS_GLR); bf16* ST = (bf16*)(ws + WS_ST); float* DTOT = (float*)(ws + WS_DTOT);
    unsigned char* ACT = ws + WS_ACT; unsigned char* Y = ws + WS_Y;
    unsigned char* WGU8 = ws + WS_WGU; unsigned char* WD8 = ws + WS_WD; unsigned char* H8 = ws + WS_H8;
    unsigned* LOCL = (unsigned*)(ws + WS_LOCL); unsigned* CNTS = (unsigned*)(ws + WS_CNTS); float* GATE = (float*)(ws + WS_GATE); float* RSTD = (float*)(ws + WS_RSTD);

#define WGU_PIECE(q_) do { LAS float* scr_ = (LAS float*)(lds + RING_OFF + wave * 16384); \
        for (int r = (q_) * 4096 + gw; r < ((q_) + 1) * 4096; r += NGW) { \
            const int e = r >> 9, q = r & 511, ib = 4 * (q >> 6) + (q & 3), kb = 2 * ((q >> 3) & 7) + ((q >> 2) & 1), P0 = 32 * ib; const int pn = P0 >> 8, bj = (P0 >> 7) & 1, r0 = P0 & 127; \
            const float* src = (bj ? P.wu : P.wg) + (size_t)e * DM * DEXP; \
            tr_item8(src, DEXP, 64 * kb, 128 * pn + r0, WGU8 + (size_t)e * DM * DM, P0, DM, P.ffn_g, WGU_SC, scr_, lane); } } while (0)
    if (IN(0)) { REP(0) {
        LAS float* scr = (LAS float*)(lds + RING_OFF + wave * 16384);
        constexpr int I_A = (NA / 32) * 16, I_B = (NB / 32) * 16, I_O = 32 * 16, I_GU = 32 * 32 * 16, I_D = 32 * 32 * 8;
        constexpr int NITEMS = I_A + I_B + I_O;
        for (int it = gw; it < NITEMS; it += NGW) {
            int r = it;
            if (r < I_A) { const int ib = r >> 4, kb = r & 15, P0 = 32 * ib; const int pn = P0 >> 8, bj = (P0 >> 7) & 1, wcc = (P0 >> 5) & 3; const int LA = 256 * pn + 64 * wcc + 32 * bj;
                const int sc = LA < 1024 ? LA : (LA < 1280 ? 1536 + (LA - 1024) : 2560 + (LA - 1280));
                tr_item(P.w_in, IN_DIM, 64 * kb, sc, WA, P0, DM, P.attn_g, scr, lane); continue; } r -= I_A;
            if (r < I_B) { const int ib = r >> 4, kb = r & 15, P0 = 32 * ib; const int sc = P0 < 512 ? 1024 + P0 : (P0 < 768 ? 1792 + (P0 - 512) : 2048 + (P0 - 768));
                tr_item(P.w_in, IN_DIM, 64 * kb, sc, WB, P0, DM, P.attn_g, scr, lane); continue; } r -= I_B;
            if (r < I_O) { const int ib = r >> 4, kb = r & 15; tr_item(P.w_out, DM, 64 * kb, 32 * ib, WO, 32 * ib, DM, nullptr, scr, lane); continue; } r -= I_O;
        }
        (void)I_D; (void)I_GU;
        for (int idx = gw * 64 + lane; idx < 48 * 1024; idx += NGW * 64) {
            const int rho = idx >> 10, k = idx & 1023, m = rho >> 4, i = rho & 15;
            float v = (m < 2) ? P.re_w[k * 32 + 8 * (i >> 2) + 4 * m + (i & 3)] : P.rg_w[k * 4 + (i & 3)];
            v *= P.ffn_g[k];
            WRH[idx] = __builtin_bit_cast(unsigned short, (_Float16)v);
        }
        for (int idx = gw * 64 + lane; idx < 256 * 16; idx += NGW * 64) { const int kc = idx >> 4, r = idx & 15; W2T[idx] = (bf16)(cvtpk(P.w2[r * 256 + kc], 0.f) & 0xffffu); }
        __syncthreads();
        constexpr int WLP = 1032;
        LAS bf16* wl = (LAS bf16*)(lds + RING_OFF);
        for (int idx = tid; idx < 16 * 1024; idx += NWAVES * 64) { const int c = idx & 15, k = idx >> 4; wl[c * WLP + k] = (bf16)(cvtpk(P.attn_g[k] * P.w_in[(size_t)k * IN_DIM + 3072 + c], 0.f) & 0xffffu); }
        __syncthreads();
        {
            for (int task = gw; task < NTOK / 16; task += NGW) {
                const size_t row0 = (size_t)task * 16;
                f32x4 cur[4], nxt[4]; float rsv = 0.f;
#pragma unroll
                for (int j = 0; j < 4; ++j) { cur[j] = __builtin_nontemporal_load((const GAS f32x4*)(P.x + row0 * DM) + lane + 64 * j); nxt[j] = cur[j]; }
#pragma unroll 2
                for (int r = 0; r < 16; ++r) {
                    if (r < 15) {
#pragma unroll
                        for (int j = 0; j < 4; ++j) nxt[j] = __builtin_nontemporal_load((const GAS f32x4*)(P.x + (row0 + r + 1) * DM) + lane + 64 * j); }
                    float s2 = 0.f;
#pragma unroll
                    for (int j = 0; j < 4; ++j) s2 += (cur[j].x * cur[j].x + cur[j].y * cur[j].y) + (cur[j].z * cur[j].z + cur[j].w * cur[j].w);
                    const float rstd = __builtin_amdgcn_rsqf(wave_sum(s2) * (1.f / DM) + EPS);
                    if ((lane & 15) == r) rsv = rstd;
                    GAS unsigned long long* o8 = (GAS unsigned long long*)(XB + (row0 + r) * DM) + lane;
#pragma unroll
                    for (int j = 0; j < 4; ++j) { const f32x4 v = cur[j];
                        o8[64 * j] = (unsigned long long)cvtpk(v.x, v.y) | ((unsigned long long)cvtpk(v.z, v.w) << 32); }
#pragma unroll
                    for (int j = 0; j < 4; ++j) cur[j] = nxt[j];
                }
                if (lane < 16) RSTD1[row0 + lane] = rsv;
                VM_WAIT();
                const int fr = lane & 15, fq = lane >> 4;
                f32x4 acc = (f32x4){0.f, 0.f, 0.f, 0.f};
                const bf16* up = XB + (row0 + fr) * DM + 8 * fq;
#pragma unroll 8
                for (int ks = 0; ks < 32; ++ks) { const bf16x8 ub = *(const bf16x8*)(up + 32 * ks); const bf16x8 wb = *(const LAS bf16x8*)(wl + fr * WLP + 32 * ks + 8 * fq); acc = MFMA16(wb, ub, acc); }
                u32x2 o; o.x = cvtpk(acc[0] * rsv, acc[1] * rsv); o.y = cvtpk(acc[2] * rsv, acc[3] * rsv);
                *(u32x2*)(GLR + (row0 + fr) * 16 + 4 * fq) = o;
            }
        }
        __syncthreads();
        REPBAR(0); }
        if (BOTH(0)) BAR_ARRIVE();
        WGU_PIECE(0);
        if (BOTH(0)) BAR_WAIT();
    }

#define PH1_BODY() do { \
        { pg8::SchedDense S; S.init(XB, WA, NTOK, NA, DM, G, bx); \
          pg8::EpiA E{SQ, SK, GQ, GRS, P.sbq_g, P.sbk_g, RSTD1}; \
          pg8::gemm_phase<pg8::EpiA, pg8::SchedDense>(lds + RING_OFF, DM, S, E); } \
        { pg8::SchedDense S; S.init(WB, XB, NB, NTOK, DM, G, (bx + G / 2) % G); \
          pg8::EpiTT E{TT, RSTD1}; \
          pg8::gemm_phase<pg8::EpiTT, pg8::SchedDense>(lds + RING_OFF, DM, S, E); } } while (0)
    if (IN(1)) {
        if (PROBE_TWICE == 1) { PH1_BODY(); GRID_BAR(); }
        PH1_BODY();
        if (BOTH(1)) BAR_ARRIVE();
        WGU_PIECE(1);
        if (BOTH(1)) BAR_WAIT();
    }

#define SB_ROUND(rho_) do { for (int u__ = (rho_) * G + vcu; u__ < 1024; u__ += 4 * G) { const int bh_ = u__ & 127; \
        sb_round(lds + RING_OFF, SQ, SK, TT, P.sbo_g + (bh_ & 7) * 64, MIX, bh_ >> 3, bh_ & 7, u__ >> 7, tid, wave, lane); } } while (0)
#define REPX(code) for (int rx_ = 0; rx_ < ((PROBE_TWICE == (code)) ? 5 : 1); ++rx_)
    if (IN(2)) {
        for (int t = gw; t < 2048; t += NGW) gla_a(GLR, W2T, P.gate_b, TT, KV, DTOT, t >> 5, t & 31, lane);
        if (BOTH(2)) BAR_ARRIVE();
        SB_ROUND(0);
        if (BOTH(2)) BAR_WAIT();
    }
    if (IN(3)) {
        for (int t = gw; t < 2048; t += NGW) gla_b(KV, DTOT, ST, t, lane);
        if (BOTH(3)) BAR_ARRIVE();
        SB_ROUND(1);
        if (BOTH(3)) BAR_WAIT();
    }
    if (IN(4)) {
        for (int t = gw; t < 2048; t += NGW) gla_c(lds + RING_OFF + wave * 16384, ST, GQ, GRS, P.glan_g, MIX, t >> 5, t & 31, lane);
        __syncthreads();
        SB_ROUND(2); SB_ROUND(3);
        if (BOTH(4)) BAR_ARRIVE();
        WGU_PIECE(2);
        if (BOTH(4)) BAR_WAIT();
    }

#define PH5_BODY() do { \
        pg8::SchedDense S; S.init(MIX, WO, NTOK, DM, DM, G, bx); \
        pg8::EpiH E{XB, H, H8}; \
        pg8::gemm_phase<pg8::EpiH, pg8::SchedDense>(lds + RING_OFF, DM, S, E); } while (0)
    if (IN(5)) {
        if (PROBE_TWICE == 5) { PH5_BODY(); GRID_BAR(); }
        PH5_BODY();
        if (BOTH(5)) BAR_ARRIVE();
        WGU_PIECE(3);
        if (BOTH(5)) BAR_WAIT();
    }

    if (IN(6)) { REP(6) {
        constexpr int WP = 1032;
        LAS unsigned short* wl16 = (LAS unsigned short*)(lds + RING_OFF);
        LAS unsigned* lcount = (LAS unsigned*)(lds + RING_OFF + 48 * WP * 2);
        for (int idx = tid; idx < 48 * 128; idx += NWAVES * 64) { const int row = idx >> 7, c = idx & 127; *(LAS u32x4*)(wl16 + row * WP + 8 * c) = *(const u32x4*)(WRH + row * 1024 + 8 * c); }
        const int fr = lane & 15, fq = lane >> 4;
        for (int it = 0; it * G < NGRP; ++it) {
            const int grp = it * G + vcu;
            const int tile = grp * 8 + wave; const int ntile = NGRP * 8;
            if (tid < 32) lcount[tid] = 0u;
            __syncthreads();
            bool owner = false; int e1 = 0, e2 = 0; unsigned lr1 = 0, lr2 = 0; int tok = 0;
            if (tile < ntile) {
                tok = tile * 16 + fr;
                const bf16* hp = H + (size_t)tok * DM + 8 * fq;
                f32x4 acc[3]; acc[0] = acc[1] = acc[2] = (f32x4){0.f, 0.f, 0.f, 0.f};
                float ssq = 0.f;
#pragma unroll 1
                for (int half = 0; half < 2; ++half) {
                    bf16x8 hb[16];
#pragma unroll
                    for (int q = 0; q < 16; ++q) hb[q] = *(const bf16x8*)(hp + 32 * (16 * half + q));
#pragma unroll
                    for (int q = 0; q < 16; ++q) { const int ks = 16 * half + q;
                        float f[8];
#pragma unroll
                        for (int e = 0; e < 8; ++e) { f[e] = bf2f(hb[q][e]); ssq += f[e] * f[e]; }
                        f16x8 hh;
#pragma unroll
                        for (int e = 0; e < 8; ++e) hh[e] = (_Float16)f[e];
#pragma unroll
                        for (int m = 0; m < 3; ++m) { const f16x8 wv = *(const LAS f16x8*)(wl16 + (16 * m + fr) * WP + 32 * ks + 8 * fq);
                            acc[m] = __builtin_amdgcn_mfma_f32_16x16x32_f16(wv, hh, acc[m], 0, 0, 0); }
                    }
                }
                ssq += __shfl_xor(ssq, 16); ssq += __shfl_xor(ssq, 32);
                const float rstd = __builtin_amdgcn_rsqf(ssq * (1.f / DM) + EPS);
                float gl[4];
#pragma unroll
                for (int r = 0; r < 4; ++r) gl[r] = acc[2][r] * rstd + P.rg_b[r];
                int gsel = 0; float gmax = gl[0];
#pragma unroll
                for (int r = 1; r < 4; ++r) if (gl[r] > gmax) { gmax = gl[r]; gsel = r; }
                float gden = 0.f;
#pragma unroll
                for (int r = 0; r < 4; ++r) gden += __builtin_amdgcn_exp2f((gl[r] - gmax) * LOG2E);
                const float pgrp = 1.f / gden;
                float el[8];
#pragma unroll
                for (int r = 0; r < 4; ++r) { el[r] = acc[0][r] * rstd + P.re_b[8 * fq + r]; el[4 + r] = acc[1][r] * rstd + P.re_b[8 * fq + 4 + r]; }
                int i1 = 0; float l1 = el[0];
#pragma unroll
                for (int r = 1; r < 8; ++r) if (el[r] > l1) { l1 = el[r]; i1 = r; }
                int i2 = -1; float l2 = -3.0e38f;
#pragma unroll
                for (int r = 0; r < 8; ++r) if (r != i1 && el[r] > l2) { l2 = el[r]; i2 = r; }
                const float ex = __builtin_amdgcn_exp2f((l2 - l1) * LOG2E);
                const float p1 = 1.f / (1.f + ex), p2 = ex * p1;
                owner = (fq == gsel);
                if (owner) {
                    e1 = 8 * gsel + i1; e2 = 8 * gsel + i2;
                    lr1 = __hip_atomic_fetch_add(lcount + e1, 1u, __ATOMIC_RELAXED, __HIP_MEMORY_SCOPE_WORKGROUP);
                    lr2 = __hip_atomic_fetch_add(lcount + e2, 1u, __ATOMIC_RELAXED, __HIP_MEMORY_SCOPE_WORKGROUP);
                    RSTD[tok] = rstd; GATE[2 * tok] = pgrp * p1; GATE[2 * tok + 1] = pgrp * p2;
                }
            }
            __syncthreads();
            if (grp < NGRP) {
                if (tid < 32) CNTS[grp * 32 + tid] = lcount[tid];
                if (owner) { LOCL[((size_t)grp * 32 + e1) * 128 + lr1] = 2u * tok; LOCL[((size_t)grp * 32 + e2) * 128 + lr2] = 2u * tok + 1u; }
            }
            __syncthreads();
        }
        REPBAR(6); }
        if (BOTH(6)) GRID_BAR();
    }

    if (IN(7) || IN(8)) {
        LAS int* pre = (LAS int*)(lds + RING_OFF);
        LAS int* segsum = pre + NGRP * 32;
        for (int i = tid; i < NGRP * 32; i += NWAVES * 64) pre[i] = (int)CNTS[i];
        __syncthreads();
        { const int e = tid & 31, seg = tid >> 5; int run = 0;
          for (int g = seg * 16; g < seg * 16 + 16; ++g) { const int c = pre[g * 32 + e]; pre[g * 32 + e] = run; run += c; }
          segsum[seg * 32 + e] = run; }
        __syncthreads();
        { const int e = tid & 31, seg = tid >> 5; int off = 0, tot = 0;
          for (int q = 0; q < 16; ++q) { const int v = segsum[q * 32 + e]; if (q < seg) off += v; tot += v; }
          for (int g = seg * 16; g < seg * 16 + 16; ++g) pre[g * 32 + e] += off;
          if (seg == 0) tab[T_CNT / 4 + e] = tot; }
        __syncthreads();
        if (tid == 0) { int tb = 0; for (int e = 0; e < 32; ++e) { tab[T_TBASE / 4 + e] = tb; tb += (tab[T_CNT / 4 + e] + 255) >> 8; } tab[T_TBASE / 4 + 32] = tb; tab[T_NT / 4] = tb; }
        __syncthreads();
        { const int NT = tab[T_NT / 4];
          for (int t = tid; t < NT; t += NWAVES * 64) { int e = 0; for (int q = 0; q < 32; ++q) if (tab[T_TBASE / 4 + q] <= t && t < tab[T_TBASE / 4 + q + 1]) e = q; tab[T_TILE_E / 4 + t] = e; } }
        __syncthreads();
        { pg8::SchedMoE<false> S0; S0.A = nullptr; S0.Bt = nullptr; S0.K = 0; S0.bstride = 0; S0.G = G; S0.c = vcu; S0.tab = tab;
          const int half = tid >> 8, r = tid & 255; unsigned vals[NU_MAX / 2]; bool ok[NU_MAX / 2];
#pragma unroll
          for (int k = 0; k < NU_MAX / 2; ++k) { const int ui = 2 * k + half; pg8::Unit u; ok[k] = S0.next(ui, u); vals[k] = 0u;
              if (ok[k]) { const int cnt = tab[T_CNT / 4 + u.e], e = u.e; int p = u.rt * 256 + r; if (p > cnt - 1) p = cnt - 1;
                  int lo_ = 0, hi_ = NGRP - 1;
                  while (lo_ < hi_) { const int mid = (lo_ + hi_ + 1) >> 1; if (pre[mid * 32 + e] <= p) lo_ = mid; else hi_ = mid - 1; }
                  vals[k] = LOCL[((size_t)lo_ * 32 + e) * 128 + (p - pre[lo_ * 32 + e])]; } }
          float rsl[NU_MAX / 2];
#pragma unroll
          for (int k = 0; k < NU_MAX / 2; ++k) rsl[k] = ok[k] ? RSTD[vals[k] >> 1] : 0.f;
#pragma unroll
          for (int k = 0; k < NU_MAX / 2; ++k) if (ok[k]) { tab[T_ROWTAB / 4 + (2 * k + half) * 256 + r] = (int)vals[k]; ((LAS float*)tab)[T_RSTAB / 4 + (2 * k + half) * 256 + r] = rsl[k]; }
        }
        __syncthreads();
    }
#define PH7_BODY() do { \
        pg8::SchedMoE<true> S; S.A = (const char*)H8; S.Bt = (const char*)WGU8; S.K = DM / 2; S.bstride = (size_t)DM * DM; S.G = G; S.c = vcu; S.tab = tab; \
        pg8::EpiGU E{ACT, RSTD, tab}; \
        pg8::gemm_phase<pg8::EpiGU, pg8::SchedMoE<true>, false, true>(lds + RING_OFF, DM / 2, S, E); } while (0)
    if (IN(7)) {
        if (PROBE_TWICE == 7) { PH7_BODY(); GRID_BAR(); }
        PH7_BODY();
        {
            const int NT4 = tab[T_NT / 4] * 4, remu = NT4 % G;
            const bool early = (remu == 0) || (vcu >= remu); const int nE = (remu == 0) ? G : (G - remu), rank = (remu == 0) ? vcu : (vcu - remu);
            if (early) { LAS float* scr = (LAS float*)(lds + RING_OFF + wave * 16384);
                for (int r = rank * NWAVES + wave; r < 32 * 32 * 8; r += nE * NWAVES) {
                    const int e = r >> 8, q = r & 255, nb = 4 * (q >> 5) + (q & 3), kb = 2 * ((q >> 3) & 3) + ((q >> 2) & 1);
                    tr_item8(P.wd + (size_t)e * DEXP * DM, DM, 64 * kb, 32 * nb, WD8 + (size_t)e * DM * DEXP, 32 * nb, DEXP, nullptr, WD_SC, scr, lane); } }
        }
        if (BOTH(7)) GRID_BAR();
    }
    if (IN(8)) { REP(8) {
        pg8::SchedMoE<false> S; S.A = (const char*)ACT; S.Bt = (const char*)WD8; S.K = DEXP / 2; S.bstride = (size_t)DM * DEXP; S.G = G; S.c = vcu; S.tab = tab;
        pg8::EpiDown E{Y, tab};
        pg8::gemm_phase<pg8::EpiDown, pg8::SchedMoE<false>, false, true>(lds + RING_OFF, DEXP / 2, S, E);
        REPBAR(8); }
        if (BOTH(8)) GRID_BAR();
    }
    if (IN(9)) { REP(9) {
        for (int m0 = gw; m0 < NTOK; m0 += 2 * NGW) {
            u32x2 hv[2][4]; unsigned ya[2][4], yb[2][4]; float g0[2], g1[2];
#pragma unroll
            for (int t = 0; t < 2; ++t) { int m = m0 + t * NGW; if (m >= NTOK) m = m0;
                g0[t] = GATE[2 * m] * (1.f / Y_SC); g1[t] = GATE[2 * m + 1] * (1.f / Y_SC);
                const bf16* hp = H + (size_t)m * DM + 4 * lane; const unsigned char* y0 = Y + (size_t)(2 * m) * DM + 4 * lane;
#pragma unroll
                for (int q = 0; q < 4; ++q) { hv[t][q] = *(const u32x2*)(hp + 256 * q); ya[t][q] = *(const unsigned*)(y0 + 256 * q); yb[t][q] = *(const unsigned*)(y0 + DM + 256 * q); } }
#pragma unroll
            for (int t = 0; t < 2; ++t) { const int m = m0 + t * NGW; if (m < NTOK) {
                float* op = P.out + (size_t)m * DM + 4 * lane;
#pragma unroll
                for (int q = 0; q < 4; ++q) { const unsigned wa = ya[t][q], wb = yb[t][q];
                    const f32x2_t a0 = __builtin_amdgcn_cvt_pk_f32_fp8((int)wa, false), a1 = __builtin_amdgcn_cvt_pk_f32_fp8((int)wa, true);
                    const f32x2_t b0 = __builtin_amdgcn_cvt_pk_f32_fp8((int)wb, false), b1 = __builtin_amdgcn_cvt_pk_f32_fp8((int)wb, true);
                    const unsigned h01 = hv[t][q].x, h23 = hv[t][q].y;
                    f32x4 o; o[0] = __uint_as_float(h01 << 16) + g0[t] * a0.x + g1[t] * b0.x; o[1] = __uint_as_float(h01 & 0xffff0000u) + g0[t] * a0.y + g1[t] * b0.y;
                    o[2] = __uint_as_float(h23 << 16) + g0[t] * a1.x + g1[t] * b1.x; o[3] = __uint_as_float(h23 & 0xffff0000u) + g0[t] * a1.y + g1[t] * b1.y;
                    *(f32x4*)(op + 256 * q) = o; } } }
        }
    REPBAR(9); } }
#undef IN
#undef BOTH
}

extern "C" void kernel_launch(void* const* d_in, const int* in_sizes, int n_in, void* d_out, int out_size, void* d_ws, size_t ws_size, hipStream_t stream) {
    static int grid = 0;
    if (grid == 0) {
        if (n_in != 18 || in_sizes[0] != NTOK * DM || out_size != NTOK * DM || ws_size < WS_END) { fprintf(stderr, "kernel_launch: unexpected shapes / workspace (n_in %d, in0 %d, out %d, ws %zu, need %zu)\n", n_in, n_in > 0 ? in_sizes[0] : -1, out_size, ws_size, (size_t)WS_END); grid = -1; return; }
        int dev = 0, cus = 0, per_cu = 0;
        if (hipGetDevice(&dev) != hipSuccess || hipDeviceGetAttribute(&cus, hipDeviceAttributeMultiprocessorCount, dev) != hipSuccess) { grid = -1; return; }
        if (hipFuncSetAttribute((const void*)fwd_kernel, hipFuncAttributeMaxDynamicSharedMemorySize, LDS_BYTES) != hipSuccess) { fprintf(stderr, "kernel_launch: hipFuncSetAttribute failed\n"); grid = -1; return; }
        if (hipOccupancyMaxActiveBlocksPerMultiprocessor(&per_cu, (const void*)fwd_kernel, NWAVES * 64, LDS_BYTES) != hipSuccess || per_cu < 1) fprintf(stderr, "kernel_launch: occupancy query reports %d\n", per_cu);
        (void)hipGetLastError();
        grid = cus;
    }
    if (grid < 0) return;
    if (hipMemsetAsync((char*)d_ws + WS_CTL, 0, CTL_ZERO_BYTES, stream) != hipSuccess) return;
    Args a{};
    const float** pp = (const float**)&a.p;
    for (int i = 0; i < 18; ++i) pp[i] = (const float*)d_in[i];
    a.p.out = (float*)d_out; a.p.ws = (unsigned char*)d_ws;
    if (MK_N_LAUNCHES == 1) { a.ph_lo = 0; a.ph_hi = N_PHASES; hipLaunchKernelGGL(fwd_kernel, dim3(grid), dim3(NWAVES * 64), LDS_BYTES, stream, a); }
    else for (int li = 0; li < N_PHASES; ++li) { a.ph_lo = li; a.ph_hi = li + 1; hipLaunchKernelGGL(fwd_kernel, dim3(grid), dim3(NWAVES * 64), LDS_BYTES, stream, a); }
}
```

```cpp
#include <hip/hip_runtime.h>
#include <cstdio>
#include <cstdint>

#ifndef MK_N_LAUNCHES
#define MK_N_LAUNCHES 1
#endif

#define LAS __attribute__((address_space(3)))
#define GAS __attribute__((address_space(1)))
typedef unsigned short bf16;
typedef short bf16x8 __attribute__((ext_vector_type(8)));
typedef float f32x4 __attribute__((ext_vector_type(4)));
typedef float f32x16 __attribute__((ext_vector_type(16)));
typedef unsigned u32x4 __attribute__((ext_vector_type(4)));
typedef unsigned u32x2 __attribute__((ext_vector_type(2)));
typedef float f32x2_t __attribute__((ext_vector_type(2)));
typedef __bf16 bf16x2_t __attribute__((ext_vector_type(2)));
typedef GAS unsigned gu32;
typedef int v8i __attribute__((ext_vector_type(8)));
typedef int v4i __attribute__((ext_vector_type(4)));
typedef _Float16 f16x8 __attribute__((ext_vector_type(8)));
typedef _Float16 f16x2 __attribute__((ext_vector_type(2)));

constexpr int BATCH = 16, SEQ = 2048, DM = 1024, NTOK = BATCH * SEQ;
constexpr int IN_DIM = 3088;
constexpr int NEXP = 32, DEXP = 512;
constexpr float EPS = 1e-6f;
constexpr float LOG2E = 1.4426950408889634f;
constexpr float WGU_SC = 64.f, WD_SC = 32.f, ACT_SC = 8.f, Y_SC = 8.f;
constexpr int NA = 1792, NB = 1280;
constexpr int NGRP = NTOK / 128;

constexpr size_t MiB = 1u << 20;
constexpr size_t WS_CTL = 0, CTL_ZERO_BYTES = 64 * 1024;
constexpr size_t WS_WA = 2 * MiB;
constexpr size_t WS_WB = 6 * MiB;
constexpr size_t WS_WO = 9 * MiB;
constexpr size_t WS_WR = 11 * MiB;
constexpr size_t WS_W2T = WS_WR + 2 * 48 * 1024 * 2;
constexpr size_t WS_WGU = 12 * MiB;
constexpr size_t WS_WD = 76 * MiB;
constexpr size_t WS_H = 108 * MiB;
constexpr size_t WS_KV = WS_H;
constexpr size_t WS_XB = 44 * MiB;
constexpr size_t WS_MIX = 172 * MiB;
constexpr size_t WS_SQ = 236 * MiB;
constexpr size_t WS_SK = 268 * MiB;
constexpr size_t WS_GQ = 300 * MiB;
constexpr size_t WS_GRS = 316 * MiB;
constexpr size_t WS_TT = 348 * MiB;
constexpr size_t WS_GLR = 428 * MiB;
constexpr size_t WS_ST = 429 * MiB;
constexpr size_t WS_DTOT = 461 * MiB;
constexpr size_t WS_ACT = 236 * MiB;
constexpr size_t WS_H8 = 272 * MiB;
constexpr size_t WS_Y = 308 * MiB;
constexpr size_t WS_LOCL = 462 * MiB;
constexpr size_t WS_CNTS = 467 * MiB;
constexpr size_t WS_GATE = 470 * MiB;
constexpr size_t WS_RSTD = WS_GATE + 512 * 1024;
constexpr size_t WS_RSTD1 = WS_GATE + 768 * 1024;
constexpr size_t WS_END = 472 * MiB;
constexpr int CW_TMO = 0, CW_CODE = 1;
constexpr int CW_BAR = 4096;
constexpr int CW_CNT = 16384;

constexpr int RING_OFF = 0, RING_BYTES = 131072;
constexpr int LDSCTL_OFF = RING_BYTES, MISC_OFF = LDSCTL_OFF + 320;
constexpr int TAB_OFF = LDSCTL_OFF + 1024;
constexpr int LDS_BYTES = 147456;
constexpr int T_CNT = 0, T_TBASE = 128, T_NT = 264, T_TILE_E = 272, T_ROWTAB = 272 + 320 * 4, NU_MAX = 6;
constexpr int T_RSTAB = T_ROWTAB + NU_MAX * 1024;
static_assert(TAB_OFF + T_RSTAB + NU_MAX * 256 * 4 <= LDS_BYTES, "LDS tables");

#define RLX_AGENT __ATOMIC_RELAXED, __HIP_MEMORY_SCOPE_AGENT
#define LDS_WAIT() asm volatile("s_waitcnt lgkmcnt(0)" ::: "memory")
#define VM_WAIT() asm volatile("s_waitcnt vmcnt(0)" ::: "memory")

__device__ __forceinline__ unsigned cvtpk(float lo, float hi) { f32x2_t v = {lo, hi}; bf16x2_t b = __builtin_convertvector(v, bf16x2_t); return __builtin_bit_cast(unsigned, b); }
__device__ __forceinline__ u32x2 pack8_fp8(const float* a) { int lo = __builtin_amdgcn_cvt_pk_fp8_f32(a[0], a[1], 0, false); lo = __builtin_amdgcn_cvt_pk_fp8_f32(a[2], a[3], lo, true);
    int hi = __builtin_amdgcn_cvt_pk_fp8_f32(a[4], a[5], 0, false); hi = __builtin_amdgcn_cvt_pk_fp8_f32(a[6], a[7], hi, true); u32x2 r; r.x = (unsigned)lo; r.y = (unsigned)hi; return r; }
__device__ __forceinline__ float bf2f(short s) { return __uint_as_float(((unsigned)(unsigned short)s) << 16); }
__device__ __forceinline__ bf16x8 pack8(const float* a) { u32x4 p; p.x = cvtpk(a[0], a[1]); p.y = cvtpk(a[2], a[3]); p.z = cvtpk(a[4], a[5]); p.w = cvtpk(a[6], a[7]); return __builtin_bit_cast(bf16x8, p); }
__device__ __forceinline__ int PI32(int i) { return 16 * ((i >> 2) & 1) + (i & 3) + 4 * (i >> 3); }
#define MFMA32(a, b, c) __builtin_amdgcn_mfma_f32_32x32x16_bf16((a), (b), (c), 0, 0, 0)
#define MFMA16(a, b, c) __builtin_amdgcn_mfma_f32_16x16x32_bf16((a), (b), (c), 0, 0, 0)
__device__ __forceinline__ void swap32(float x, float& lo, float& hi) { auto rr = __builtin_amdgcn_permlane32_swap(__float_as_uint(x), __float_as_uint(x), false, false); lo = __uint_as_float(rr[0]); hi = __uint_as_float(rr[1]); }

namespace pg8 {
#define PG8_LAS __attribute__((address_space(3)))
constexpr int BM = 256, BK = 64, HALF = 128, HTB = HALF * BK * 2, STAGE_BYTES = 8 * HTB, NXCD = 8, WGM = 8;
__host__ __device__ __forceinline__ int lds_byte(int r, int c) { const int st = (r >> 4) * 2 + (c >> 5), rr = r & 15, cc = c & 31, ob = rr * 64 + cc * 2; return st * 1024 + (ob ^ (((ob >> 9) & 1) << 5)); }
__host__ __device__ __forceinline__ void stage_rc(int b, int& R, int& C) { const int st = b / 1024, sb = b % 1024, swz = sb ^ (((sb >> 9) & 1) << 5); R = (st >> 1) * 16 + swz / 64; C = (st & 1) * 32 + (swz % 64) / 2; }
__host__ __device__ __forceinline__ int perm32(int rho) { const int n = rho >> 4, i = rho & 15; return 8 * (i >> 2) + 4 * n + (i & 3); }

struct Unit { int pm, pn, e, rt, nv; };

struct SchedDense {
    const char* A; const char* Bt; int K; int nM, nN, nwg, G, c;
    __device__ void init(const void* A_, const void* Bt_, int M, int N, int K_, int G_, int c_) { A = (const char*)A_; Bt = (const char*)Bt_; K = K_; nM = M / BM; nN = N / BM; nwg = nM * nN; G = G_; c = c_; }
    __device__ __forceinline__ bool next(int i, Unit& u) const {
        const long L = (long)i * G + c; if (L >= nwg) return false;
        int wgid = (int)L; { const int q = nwg / NXCD, r = nwg % NXCD, xcd = wgid % NXCD, off = wgid / NXCD; wgid = (xcd < r ? xcd * (q + 1) : r * (q + 1) + (xcd - r) * q) + off; }
        const int nig = WGM * nN, gid = wgid / nig, fm = gid * WGM, gsz = (nM - fm) < WGM ? (nM - fm) : WGM;
        u.pm = fm + ((wgid % nig) % gsz); u.pn = (wgid % nig) / gsz; u.e = 0; u.rt = 0; u.nv = 256; return true;
    }
    __device__ __forceinline__ const char* a_ptr(const Unit& u) const { return A + (size_t)u.pm * BM * K * 2; }
    __device__ __forceinline__ const char* b_ptr(const Unit& u) const { return Bt + (size_t)u.pn * BM * K * 2; }
    __device__ __forceinline__ void a_voff(int, const Unit&, int tid, unsigned (&v)[2][2]) const {
#pragma unroll
        for (int i = 0; i < 2; ++i) { int R, C; stage_rc(tid * 16 + i * 8192, R, C);
#pragma unroll
            for (int h = 0; h < 2; ++h) v[h][i] = (unsigned)((h * HALF + R) * K + C) * 2u; }
    }
};
template <bool GATHER> struct SchedMoE {
    const char* A; const char* Bt; int K; size_t bstride; int G, c;
    const PG8_LAS int* tab;
    __device__ __forceinline__ bool next(int i, Unit& u) const {
        const int L = i * G + c; const int NT = tab[T_NT / 4];
        if (L >= NT * 4) return false;
        const int tile = L >> 2; u.pm = tile; u.pn = L & 3; const int e = tab[T_TILE_E / 4 + tile]; u.e = e;
        u.rt = tile - tab[T_TBASE / 4 + e]; const int rem = tab[T_CNT / 4 + e] - u.rt * 256; u.nv = rem < 256 ? rem : 256; return true;
    }
    __device__ __forceinline__ const char* a_ptr(const Unit& u) const { return GATHER ? A : A + (size_t)u.pm * BM * K * 2; }
    __device__ __forceinline__ const char* b_ptr(const Unit& u) const { return Bt + (size_t)u.e * bstride + (size_t)u.pn * BM * K * 2; }
    __device__ __forceinline__ void a_voff(int ui, const Unit&, int tid, unsigned (&v)[2][2]) const {
        asm volatile("" : "+v"(tid));
#pragma unroll
        for (int i = 0; i < 2; ++i) { int R, C; stage_rc(tid * 16 + i * 8192, R, C);
#pragma unroll
            for (int h = 0; h < 2; ++h) {
                if (GATHER) { const int tok = tab[T_ROWTAB / 4 + ui * 256 + h * HALF + R] >> 1; v[h][i] = (unsigned)(tok * K + C) * 2u; }
                else v[h][i] = (unsigned)((h * HALF + R) * K + C) * 2u; } }
    }
};

template <class Epi, class Sched, bool TAIL = false, bool FP8 = false>
__device__ __forceinline__ void gemm_phase(PG8_LAS unsigned char* lds, const int K, const Sched& S, const Epi& E) {
    const int tid = threadIdx.x, wid = __builtin_amdgcn_readfirstlane(tid >> 6), lane = tid & 63, wr = wid >> 2, wc = wid & 3, fr = lane & 15, fq = lane >> 4;
    const int nt = K / BK;
    constexpr bool EARLY = !FP8;
    unsigned voffB[1][2];
#pragma unroll
    for (int i = 0; i < 2; ++i) { int R, C; stage_rc(tid * 16 + i * 8192, R, C); const int Rb = (R & ~31) + perm32(R & 31);
        voffB[0][i] = (unsigned)(Rb * K + C) * 2u; }
    const size_t hstepB = (size_t)HALF * K * 2;
    const size_t kstep = (size_t)(BK * 2);
    const unsigned ldsw = (unsigned)wid * 1024u;
    const int aoff = lds_byte(wr * 64 + fr, fq * 8), boff = lds_byte(wc * 32 + fr, fq * 8);
#define PG8_SA(b, h) (((b) * 2 + (h)) * HTB)
#define PG8_SB(b, h) ((4 + (b) * 2 + (h)) * HTB)
#define PG8_STAGE(bufoff, gbase, voff) do { _Pragma("unroll") for (int _i = 0; _i < 2; ++_i) \
        __builtin_amdgcn_global_load_lds((const unsigned*)((const char*)(gbase) + (voff)[_i]), (PG8_LAS unsigned*)(lds + (bufoff) + ldsw + _i * 8192), 16, 0, 0); } while (0)
#define PG8_RD16(off) (*(const PG8_LAS v4i*)(lds + (off)))
#define PG8_LDA(dst, b, h) do { _Pragma("unroll") for (int m = 0; m < 4; ++m) { \
        if constexpr (FP8) At8[m] = __builtin_shufflevector(PG8_RD16(PG8_SA(b, h) + aoff + m * 2048), PG8_RD16(PG8_SA(b, h) + aoff + m * 2048 + 1024), 0, 1, 2, 3, 4, 5, 6, 7); \
        else { _Pragma("unroll") for (int k = 0; k < 2; ++k) dst[m][k] = *(const PG8_LAS bf16x8*)(lds + PG8_SA(b, h) + aoff + m * 2048 + k * 1024); } } } while (0)
#define PG8_LDB(dst, b, h) do { _Pragma("unroll") for (int n = 0; n < 2; ++n) { \
        if constexpr (FP8) dst##8[n] = __builtin_shufflevector(PG8_RD16(PG8_SB(b, h) + boff + n * 2048), PG8_RD16(PG8_SB(b, h) + boff + n * 2048 + 1024), 0, 1, 2, 3, 4, 5, 6, 7); \
        else { _Pragma("unroll") for (int k = 0; k < 2; ++k) dst[n][k] = *(const PG8_LAS bf16x8*)(lds + PG8_SB(b, h) + boff + n * 2048 + k * 1024); } } } while (0)
#define PG8_MMA(ai, bj, At, Bt) do { __builtin_amdgcn_s_setprio(1); _Pragma("unroll") for (int m = 0; m < 4; ++m) _Pragma("unroll") for (int n = 0; n < 2; ++n) { \
        if constexpr (FP8) asm volatile("v_mfma_scale_f32_16x16x128_f8f6f4 %0, %1, %2, %0, %3, %3 op_sel_hi:[0,0,0]" : "+v"(acc[ai][bj][m][n]) : "v"(Bt##8[n]), "v"(At8[m]), "v"(sc1)); \
        else { _Pragma("unroll") for (int k = 0; k < 2; ++k) acc[ai][bj][m][n] = __builtin_amdgcn_mfma_f32_16x16x32_bf16(Bt[n][k], At[m][k], acc[ai][bj][m][n], 0, 0, 0); } } \
        __builtin_amdgcn_s_setprio(0); } while (0)
#define PG8_WAIT_V(n) asm volatile("s_waitcnt vmcnt(" #n ")" ::: "memory")
#define PG8_WAIT_L(n) asm volatile("s_waitcnt lgkmcnt(" #n ")" ::: "memory")
#define PG8_BAR __builtin_amdgcn_s_barrier()
#define PG8_SCHED __builtin_amdgcn_sched_barrier(0)
    Unit cur, nxt; int ui = 0;
    if (!S.next(0, cur)) return;
    f32x4 acc[2][2][4][2];
#pragma unroll
    for (int a = 0; a < 2; ++a)
#pragma unroll
        for (int b = 0; b < 2; ++b)
#pragma unroll
            for (int m = 0; m < 4; ++m)
#pragma unroll
                for (int n = 0; n < 2; ++n) acc[a][b][m][n] = (f32x4){0.f, 0.f, 0.f, 0.f};
    bf16x8 At[4][2], B0[2][2], B1[2][2];
    v8i At8[4], B08[2], B18[2];
    int sc1 = 0x7f7f7f7f; asm volatile("" : "+v"(sc1));
    unsigned vc[2][2], vn[2][2];
    S.a_voff(0, cur, tid, vc);
    const char* cA = S.a_ptr(cur); const char* cB = S.b_ptr(cur);
    PG8_STAGE(PG8_SB(0, 0), cB, voffB[0]); PG8_STAGE(PG8_SB(0, 1), (cB) + hstepB, voffB[0]); PG8_STAGE(PG8_SA(0, 0), cA, vc[0]); PG8_STAGE(PG8_SA(0, 1), cA, vc[1]);
    if (wr == 1) PG8_BAR;
    PG8_WAIT_V(2); PG8_BAR;
    PG8_STAGE(PG8_SB(1, 0), cB + kstep, voffB[0]); PG8_STAGE(PG8_SA(1, 0), cA + kstep, vc[0]); PG8_STAGE(PG8_SB(1, 1), (cB + kstep) + hstepB, voffB[0]);
    PG8_WAIT_V(6); PG8_BAR;
    for (;;) {
        const bool has_next = S.next(ui + 1, nxt);
        const char* nA = has_next ? S.a_ptr(nxt) : cA; const char* nB = has_next ? S.b_ptr(nxt) : cB;
        if (has_next) S.a_voff(ui + 1, nxt, tid, vn);
        else {
#pragma unroll
            for (int h = 0; h < 2; ++h)
#pragma unroll
                for (int i = 0; i < 2; ++i) vn[h][i] = vc[h][i]; }
        const bool full_hi = !TAIL || cur.nv > HALF;
        for (int t = 0; t < nt; t += 2) {
            const bool last = (t == nt - 2);
            int fl_ = __builtin_amdgcn_readfirstlane(EARLY ? (t | (ui == 0)) : 1); asm volatile("" : "+s"(fl_));
            const bool fresh = (fl_ == 0);
            const char* a1 = cA + (size_t)(t + 1) * kstep;
            const char* a2 = last ? nA : cA + (size_t)(t + 2) * kstep; const char* b2 = last ? nB : cB + (size_t)(t + 2) * kstep;
            const char* a3 = a2 + kstep; const char* b3 = b2 + kstep;
            unsigned w0[2], w1[2];
            w0[0] = last ? vn[0][0] : vc[0][0]; w0[1] = last ? vn[0][1] : vc[0][1]; w1[0] = last ? vn[1][0] : vc[1][0]; w1[1] = last ? vn[1][1] : vc[1][1];
            PG8_LDB(B0, 0, 0); PG8_LDB(B1, 0, 1); PG8_SCHED; PG8_LDA(At, 0, 0); if (!fresh) { PG8_STAGE(PG8_SA(1, 1), a1, vc[1]); PG8_WAIT_V(8); }
            PG8_WAIT_L(0); PG8_BAR; PG8_MMA(0, 0, At, B0); PG8_MMA(0, 1, At, B1); PG8_BAR; PG8_SCHED;
            PG8_LDA(At, 0, 1); PG8_STAGE(PG8_SB(0, 0), b2, voffB[0]); PG8_STAGE(PG8_SB(0, 1), (b2) + hstepB, voffB[0]); PG8_STAGE(PG8_SA(0, 0), a2, w0);
            if (!fresh) PG8_WAIT_V(8); PG8_WAIT_L(0); PG8_BAR; if (full_hi) { PG8_MMA(1, 0, At, B0); PG8_MMA(1, 1, At, B1); } PG8_BAR; PG8_SCHED;
            PG8_LDB(B0, 1, 0); PG8_LDB(B1, 1, 1); PG8_SCHED; PG8_LDA(At, 1, 0); PG8_STAGE(PG8_SA(0, 1), a2, w1);
            if (!fresh) PG8_WAIT_V(8); PG8_WAIT_L(0); PG8_BAR; PG8_MMA(0, 0, At, B0); PG8_MMA(0, 1, At, B1); PG8_BAR; PG8_SCHED;
            PG8_LDA(At, 1, 1); PG8_STAGE(PG8_SB(1, 0), b3, voffB[0]); PG8_STAGE(PG8_SB(1, 1), (b3) + hstepB, voffB[0]); PG8_STAGE(PG8_SA(1, 0), a3, w0);
            PG8_WAIT_V(8); PG8_WAIT_L(0); PG8_BAR; if (full_hi) { PG8_MMA(1, 0, At, B0); PG8_MMA(1, 1, At, B1); } PG8_BAR; PG8_SCHED;
        }
        if (wr == 0) PG8_BAR;
        if constexpr (EARLY) {
            PG8_STAGE(PG8_SA(1, 1), nA + kstep, vn[1]);
            PG8_WAIT_V(0); }
        if constexpr (FP8) asm volatile("s_nop 15\n\ts_nop 15" ::: "memory");
        { int t2_ = threadIdx.x; asm volatile("" : "+v"(t2_)); E(acc, cur, ui, wr, wc, t2_ & 15, (t2_ >> 4) & 3); }
        if (!has_next) break;
#pragma unroll
        for (int a = 0; a < 2; ++a)
#pragma unroll
            for (int b = 0; b < 2; ++b)
#pragma unroll
                for (int m = 0; m < 4; ++m)
#pragma unroll
                    for (int n = 0; n < 2; ++n) acc[a][b][m][n] = (f32x4){0.f, 0.f, 0.f, 0.f};
        cur = nxt; cA = nA; cB = nB; ++ui;
#pragma unroll
        for (int h = 0; h < 2; ++h)
#pragma unroll
            for (int i = 0; i < 2; ++i) vc[h][i] = vn[h][i];
        if (wr == 1) PG8_BAR;
    }
    PG8_WAIT_V(0);
    PG8_BAR;
#undef PG8_SA
#undef PG8_SB
#undef PG8_STAGE
#undef PG8_LDA
#undef PG8_LDB
#undef PG8_MMA
#undef PG8_RD16
#undef PG8_WAIT_V
#undef PG8_WAIT_L
#undef PG8_BAR
#undef PG8_SCHED
}

struct EpiBf16 {
    bf16* O; int ldc;
    __device__ __forceinline__ void operator()(const f32x4 (&acc)[2][2][4][2], const Unit& u, int, int wr, int wc, int fr, int fq) const {
        const int row0 = u.pm * BM + wr * 64 + fr, col0 = u.pn * BM + wc * 32 + 8 * fq;
#pragma unroll
        for (int ai = 0; ai < 2; ++ai)
#pragma unroll
            for (int m = 0; m < 4; ++m) { bf16* rowp = O + (size_t)(row0 + ai * HALF + m * 16) * ldc + col0;
#pragma unroll
                for (int bj = 0; bj < 2; ++bj) { const f32x4 v0 = acc[ai][bj][m][0], v1 = acc[ai][bj][m][1];
                    u32x4 w; w.x = cvtpk(v0[0], v0[1]); w.y = cvtpk(v0[2], v0[3]); w.z = cvtpk(v1[0], v1[1]); w.w = cvtpk(v1[2], v1[3]);
                    *(u32x4*)(rowp + bj * HALF) = w; } }
    }
};
struct EpiTT {
    bf16* O; const float* RS;
    __device__ __forceinline__ void operator()(const f32x4 (&acc)[2][2][4][2], const Unit& u, int, int wr, int wc, int fr, int fq) const {
        const int row0 = u.pm * BM + wr * 64 + fr, tokb0 = u.pn * 8 + wc;
        f32x4 rs[2][2];
#pragma unroll
        for (int bj = 0; bj < 2; ++bj) { const float* rp = RS + (size_t)(tokb0 + 4 * bj) * 32 + 8 * fq; rs[bj][0] = *(const f32x4*)rp; rs[bj][1] = *(const f32x4*)(rp + 4); }
#pragma unroll
        for (int ai = 0; ai < 2; ++ai)
#pragma unroll
            for (int m = 0; m < 4; ++m) { const int col = row0 + ai * HALF + m * 16;
#pragma unroll
                for (int bj = 0; bj < 2; ++bj) { const f32x4 v0 = acc[ai][bj][m][0] * rs[bj][0], v1 = acc[ai][bj][m][1] * rs[bj][1];
                    u32x4 w; w.x = cvtpk(v0[0], v0[1]); w.y = cvtpk(v0[2], v0[3]); w.z = cvtpk(v1[0], v1[1]); w.w = cvtpk(v1[2], v1[3]);
                    *(u32x4*)(O + ((size_t)(tokb0 + 4 * bj) * 1280 + col) * 32 + 8 * fq) = w; } }
    }
};
struct EpiA {
    bf16 *SQ, *SK, *GQ, *GRS; const float *gq_norm, *gk_norm; const float* RS;
    __device__ __forceinline__ void operator()(const f32x4 (&acc)[2][2][4][2], const Unit& u, int, int wr, int wc, int fr, int fq) const {
        const int pn = u.pn; const int row0 = u.pm * BM + wr * 64 + fr;
        bf16* base; int ldc, colt; int mode;
        float scale = 1.f; const float* gain = nullptr;
        if (pn < 2)      { base = SQ; ldc = 512; colt = pn * 256; mode = 0; gain = gq_norm; scale = 0.125f * LOG2E; }
        else if (pn < 4) { base = SK; ldc = 512; colt = (pn - 2) * 256; mode = 0; gain = gk_norm; scale = 1.f; }
        else if (pn < 5) { base = GQ; ldc = 256; colt = 0; mode = 1; scale = 0.125f; }
        else             { base = GRS; ldc = 512; colt = (pn - 5) * 256; mode = 2; }
        const int col0 = colt + wc * 64 + 8 * fq;
        f32x4 gv[2][2];
#pragma unroll
        for (int bj = 0; bj < 2; ++bj)
#pragma unroll
            for (int n = 0; n < 2; ++n) { if (mode == 0) { gv[bj][n] = *(const f32x4*)(gain + 32 * bj + 8 * fq + 4 * n); gv[bj][n] = gv[bj][n] * scale; } else gv[bj][n] = (f32x4){scale, scale, scale, scale}; }
        float rs1v[2][4];
#pragma unroll
        for (int ai = 0; ai < 2; ++ai)
#pragma unroll
            for (int m = 0; m < 4; ++m) rs1v[ai][m] = RS[row0 + ai * HALF + m * 16];
#pragma unroll
        for (int ai = 0; ai < 2; ++ai)
#pragma unroll
            for (int m = 0; m < 4; ++m) {
                const float rs1 = rs1v[ai][m]; float rs = rs1;
                if (mode == 0) { float s = 0.f;
#pragma unroll
                    for (int bj = 0; bj < 2; ++bj)
#pragma unroll
                        for (int n = 0; n < 2; ++n) { const f32x4 x = acc[ai][bj][m][n]; s += (x[0] * x[0] + x[1] * x[1]) + (x[2] * x[2] + x[3] * x[3]); }
                    s += __shfl_xor(s, 16); s += __shfl_xor(s, 32);
                    rs = rs1 * __builtin_amdgcn_rsqf(rs1 * rs1 * s * (1.f / 64.f) + EPS); }
                bf16* rowp = base + (size_t)(row0 + ai * HALF + m * 16) * ldc + col0;
#pragma unroll
                for (int bj = 0; bj < 2; ++bj) { f32x4 v0 = acc[ai][bj][m][0], v1 = acc[ai][bj][m][1];
                    if (mode == 2) {
#pragma unroll
                        for (int e = 0; e < 4; ++e) { v0[e] *= rs1; v1[e] *= rs1; v0[e] = v0[e] * __builtin_amdgcn_rcpf(1.f + __builtin_amdgcn_exp2f(-v0[e] * LOG2E)); v1[e] = v1[e] * __builtin_amdgcn_rcpf(1.f + __builtin_amdgcn_exp2f(-v1[e] * LOG2E)); }
                    } else { v0 = v0 * rs * gv[bj][0]; v1 = v1 * rs * gv[bj][1]; }
                    u32x4 w; w.x = cvtpk(v0[0], v0[1]); w.y = cvtpk(v0[2], v0[3]); w.z = cvtpk(v1[0], v1[1]); w.w = cvtpk(v1[2], v1[3]);
                    *(u32x4*)(rowp + bj * 32) = w; } }
    }
};
struct EpiH {
    const bf16* XB; bf16* H; unsigned char* H8;
    __device__ __forceinline__ void operator()(const f32x4 (&acc)[2][2][4][2], const Unit& u, int, int wr, int wc, int fr, int fq) const {
        const int row0 = u.pm * BM + wr * 64 + fr, col0 = u.pn * BM + wc * 32 + 8 * fq;
#pragma unroll
        for (int ai = 0; ai < 2; ++ai) {
            u32x2 h8[4][2];
            bf16x8 xv[4][2];
#pragma unroll
            for (int m = 0; m < 4; ++m) { const size_t off = (size_t)(row0 + ai * HALF + m * 16) * DM + col0;
#pragma unroll
                for (int bj = 0; bj < 2; ++bj) xv[m][bj] = *(const bf16x8*)(XB + off + bj * HALF); }
#pragma unroll
            for (int m = 0; m < 4; ++m) { const size_t off = (size_t)(row0 + ai * HALF + m * 16) * DM + col0;
#pragma unroll
                for (int bj = 0; bj < 2; ++bj) { const bf16x8 xx = xv[m][bj];
                    const f32x4 v0 = acc[ai][bj][m][0] + (f32x4){bf2f(xx[0]), bf2f(xx[1]), bf2f(xx[2]), bf2f(xx[3])}, v1 = acc[ai][bj][m][1] + (f32x4){bf2f(xx[4]), bf2f(xx[5]), bf2f(xx[6]), bf2f(xx[7])};
                    u32x4 w; w.x = cvtpk(v0[0], v0[1]); w.y = cvtpk(v0[2], v0[3]); w.z = cvtpk(v1[0], v1[1]); w.w = cvtpk(v1[2], v1[3]);
                    *(u32x4*)(H + off + bj * HALF) = w;
                    const float f8[8] = {v0[0], v0[1], v0[2], v0[3], v1[0], v1[1], v1[2], v1[3]};
                    h8[m][bj] = pack8_fp8(f8); } }
#pragma unroll
            for (int mp = 0; mp < 2; ++mp)
#pragma unroll
                for (int bj = 0; bj < 2; ++bj) {
                    const auto r0 = __builtin_amdgcn_permlane16_swap(h8[2 * mp][bj].x, h8[2 * mp + 1][bj].x, false, false);
                    const auto r1 = __builtin_amdgcn_permlane16_swap(h8[2 * mp][bj].y, h8[2 * mp + 1][bj].y, false, false);
                    u32x4 w8; w8.x = r0[0]; w8.y = r1[0]; w8.z = r0[1]; w8.w = r1[1];
                    const size_t off8 = (size_t)(row0 + ai * HALF + (2 * mp + (fq & 1)) * 16) * DM + u.pn * BM + wc * 32 + 8 * (fq & ~1) + bj * HALF;
                    *(u32x4*)(H8 + off8) = w8; }
        }
    }
};
struct EpiGU {
    unsigned char* ACT; const float* RSTD; const PG8_LAS int* tab;
    __device__ __forceinline__ void operator()(const f32x4 (&acc)[2][2][4][2], const Unit& u, int ui, int wr, int wc, int fr, int fq) const {
        const int col0 = u.pn * 128 + wc * 32 + 8 * (fq & ~1); const int odd = fq & 1;
        float rsv[2][4];
#pragma unroll
        for (int ai = 0; ai < 2; ++ai)
#pragma unroll
            for (int m = 0; m < 4; ++m) { const int rl = ai * HALF + wr * 64 + m * 16 + fr; rsv[ai][m] = ((const PG8_LAS float*)tab)[T_RSTAB / 4 + ui * 256 + rl] * (1.f / WGU_SC); }
#pragma unroll
        for (int ai = 0; ai < 2; ++ai)
#pragma unroll
            for (int mp = 0; mp < 2; ++mp) {
                u32x2 pk[2];
#pragma unroll
                for (int q = 0; q < 2; ++q) { const int m = 2 * mp + q; const float rs = rsv[ai][m];
                    f32x4 g0 = acc[ai][0][m][0] * rs, g1 = acc[ai][0][m][1] * rs, u0 = acc[ai][1][m][0] * rs, u1 = acc[ai][1][m][1] * rs;
#pragma unroll
                    for (int e = 0; e < 4; ++e) { g0[e] = g0[e] * __builtin_amdgcn_rcpf(1.f + __builtin_amdgcn_exp2f(-g0[e] * LOG2E)) * u0[e]; g1[e] = g1[e] * __builtin_amdgcn_rcpf(1.f + __builtin_amdgcn_exp2f(-g1[e] * LOG2E)) * u1[e]; }
                    float f8[8] = {g0[0] * ACT_SC, g0[1] * ACT_SC, g0[2] * ACT_SC, g0[3] * ACT_SC, g1[0] * ACT_SC, g1[1] * ACT_SC, g1[2] * ACT_SC, g1[3] * ACT_SC};
#pragma unroll
                    for (int e = 0; e < 8; ++e) f8[e] = __builtin_fminf(__builtin_fmaxf(f8[e], -448.f), 448.f);
                    pk[q] = pack8_fp8(f8); }
                const auto r0 = __builtin_amdgcn_permlane16_swap(pk[0].x, pk[1].x, false, false);
                const auto r1 = __builtin_amdgcn_permlane16_swap(pk[0].y, pk[1].y, false, false);
                u32x4 w; w.x = r0[0]; w.y = r1[0]; w.z = r0[1]; w.w = r1[1];
                const int rl = ai * HALF + wr * 64 + (2 * mp + odd) * 16 + fr;
                if (rl < u.nv) *(u32x4*)(ACT + (size_t)(u.pm * 256 + rl) * DEXP + col0) = w; }
    }
};
struct EpiDown {
    unsigned char* Y; const PG8_LAS int* tab;
    __device__ __forceinline__ void operator()(const f32x4 (&acc)[2][2][4][2], const Unit& u, int ui, int wr, int wc, int fr, int fq) const {
        const int col0 = u.pn * BM + wc * 32 + 8 * (fq & ~1); const float sc = Y_SC / (WD_SC * ACT_SC); const int odd = fq & 1;
#pragma unroll
        for (int ai = 0; ai < 2; ++ai)
#pragma unroll
            for (int mp = 0; mp < 2; ++mp) { const int rl = ai * HALF + wr * 64 + (2 * mp + odd) * 16 + fr;
                const bool ok = rl < u.nv; const unsigned ts = (unsigned)tab[T_ROWTAB / 4 + ui * 256 + (ok ? rl : 0)];
                unsigned char* rowp = Y + (size_t)ts * DM + col0;
#pragma unroll
                for (int bj = 0; bj < 2; ++bj) {
                    u32x2 pk[2];
#pragma unroll
                    for (int q = 0; q < 2; ++q) { const f32x4 v0 = acc[ai][bj][2 * mp + q][0] * sc, v1 = acc[ai][bj][2 * mp + q][1] * sc;
                        const float f8[8] = {v0[0], v0[1], v0[2], v0[3], v1[0], v1[1], v1[2], v1[3]}; pk[q] = pack8_fp8(f8); }
                    const auto r0 = __builtin_amdgcn_permlane16_swap(pk[0].x, pk[1].x, false, false);
                    const auto r1 = __builtin_amdgcn_permlane16_swap(pk[0].y, pk[1].y, false, false);
                    u32x4 w; w.x = r0[0]; w.y = r1[0]; w.z = r0[1]; w.w = r1[1];
                    if (ok) *(u32x4*)(rowp + bj * HALF) = w; } }
    }
};
}

#define XB_TMO      128
#define XB_XCNT(j)  (256  + 64 * (j))
#define XB_XSUB(j)  (1280 + 64 * (j))
#define XB_XGEN(j)  (2304 + 64 * (j))
#define XB_TOP      3328
#define XB_TOPGEN   3392
#define XCD_BAR_WORDS 3456
#define XB_SPIN_CAP (1u << 18)
__device__ __forceinline__ unsigned xb_ld(unsigned* p)              { return __hip_atomic_load(p, __ATOMIC_RELAXED, __HIP_MEMORY_SCOPE_AGENT); }
__device__ __forceinline__ unsigned xb_add(unsigned* p, unsigned v) { return __hip_atomic_fetch_add(p, v, __ATOMIC_RELAXED, __HIP_MEMORY_SCOPE_AGENT); }
__device__ __forceinline__ unsigned xb_xcc_id() { return (unsigned)__builtin_amdgcn_s_getreg((3 << 11) | 20) & 0xFu; }
#define XB_SPIN(cond, bar) do { unsigned _sp = 0; while (cond) { __builtin_amdgcn_s_sleep(1); \
    if ((++_sp & 255u) == 0u) { if (xb_ld(&(bar)[XB_TMO])) break; if (_sp > XB_SPIN_CAP) { atomicAdd(&(bar)[XB_TMO], 1u); break; } } } } while (0)
struct XcdBarrier { unsigned* bar; unsigned x; volatile LAS unsigned* st; };
__device__ __forceinline__ XcdBarrier xcd_barrier_post(unsigned* bar, volatile LAS unsigned* st) {
    XcdBarrier b; b.bar = bar; b.x = xb_xcc_id(); b.st = st;
    if (threadIdx.x == 0) (void)xb_add(&bar[XB_XCNT(b.x)], 1u);
    return b;
}
__device__ __forceinline__ void xcd_barrier_complete(unsigned* bar, unsigned x, unsigned& nloc, unsigned& nx) {
    const unsigned G = gridDim.x * gridDim.y * gridDim.z;
    unsigned sum, cnt, mine, sp = 0u;
    for (;;) {
        sum = 0u; cnt = 0u; mine = 0u;
#pragma unroll
        for (unsigned j = 0; j < 16; ++j) { const unsigned c = xb_ld(&bar[XB_XCNT(j)]); sum += c; cnt += (c > 0u) ? 1u : 0u; mine = (j == x) ? c : mine; }
        if (sum == G) break;
        __builtin_amdgcn_s_sleep(1);
        if ((++sp & 255u) == 0u) { if (xb_ld(&bar[XB_TMO])) break; if (sp > XB_SPIN_CAP) { atomicAdd(&bar[XB_TMO], 1u); break; } }
    }
    nloc = mine > 0u ? mine : 1u; nx = cnt > 0u ? cnt : 1u;
}
__device__ __forceinline__ void xcd_barrier(const XcdBarrier& b) {
    asm volatile("s_waitcnt vmcnt(0)" ::: "memory");
    __syncthreads();
    if (threadIdx.x == 0) {
        unsigned* bar = b.bar;
        __builtin_amdgcn_s_waitcnt(0);
        unsigned nloc = b.st[0], nx = b.st[1];
        if (nloc == 0u) { xcd_barrier_complete(bar, b.x, nloc, nx); b.st[0] = nloc; b.st[1] = nx; }
        const unsigned old = xb_add(&bar[XB_XSUB(b.x)], 1u);
        const unsigned gen = old / nloc;
        if (old + 1u == (gen + 1u) * nloc) {
            __builtin_amdgcn_fence(__ATOMIC_RELEASE, "agent");
            asm volatile("s_waitcnt vmcnt(0)" ::: "memory");
            const unsigned og = xb_add(&bar[XB_TOP], 1u);
            const unsigned tg = og / nx;
            if (og + 1u == (tg + 1u) * nx) xb_add(&bar[XB_TOPGEN], 1u);
            else XB_SPIN(xb_ld(&bar[XB_TOPGEN]) == tg, bar);
            __builtin_amdgcn_fence(__ATOMIC_ACQUIRE, "agent");
            xb_add(&bar[XB_XGEN(b.x)], 1u);
            asm volatile("s_waitcnt vmcnt(0)" ::: "memory");
        } else {
            XB_SPIN(xb_ld(&bar[XB_XGEN(b.x)]) == gen, bar);
            __builtin_amdgcn_fence(__ATOMIC_ACQUIRE, "agent");
            asm volatile("s_waitcnt vmcnt(0)" ::: "memory");
        }
    }
    __syncthreads();
}

__device__ __forceinline__ void xcd_barrier_arrive(const XcdBarrier& b, volatile LAS unsigned* sv) {
    asm volatile("s_waitcnt vmcnt(0)" ::: "memory");
    __syncthreads();
    if (threadIdx.x == 0) {
        unsigned* bar = b.bar;
        __builtin_amdgcn_s_waitcnt(0);
        unsigned nloc = b.st[0], nx = b.st[1];
        if (nloc == 0u) { xcd_barrier_complete(bar, b.x, nloc, nx); b.st[0] = nloc; b.st[1] = nx; }
        const unsigned old = xb_add(&bar[XB_XSUB(b.x)], 1u);
        const unsigned gen = old / nloc;
        unsigned role = 0u, tg = 0u;
        if (old + 1u == (gen + 1u) * nloc) {
            __builtin_amdgcn_fence(__ATOMIC_RELEASE, "agent");
            asm volatile("s_waitcnt vmcnt(0)" ::: "memory");
            const unsigned og = xb_add(&bar[XB_TOP], 1u);
            tg = og / nx;
            if (og + 1u == (tg + 1u) * nx) { xb_add(&bar[XB_TOPGEN], 1u); role = 2u; } else role = 1u;
        }
        sv[0] = role; sv[1] = gen; sv[2] = tg;
    }
}
__device__ __forceinline__ void xcd_barrier_wait(const XcdBarrier& b, volatile LAS unsigned* sv) {
    asm volatile("s_waitcnt vmcnt(0)" ::: "memory");
    __syncthreads();
    if (threadIdx.x == 0) {
        unsigned* bar = b.bar; const unsigned role = sv[0], gen = sv[1], tg = sv[2];
        if (role != 0u) {
            if (role == 1u) XB_SPIN(xb_ld(&bar[XB_TOPGEN]) == tg, bar);
            __builtin_amdgcn_fence(__ATOMIC_ACQUIRE, "agent");
            xb_add(&bar[XB_XGEN(b.x)], 1u);
            asm volatile("s_waitcnt vmcnt(0)" ::: "memory");
        } else {
            XB_SPIN(xb_ld(&bar[XB_XGEN(b.x)]) == gen, bar);
            __builtin_amdgcn_fence(__ATOMIC_ACQUIRE, "agent");
            asm volatile("s_waitcnt vmcnt(0)" ::: "memory");
        }
    }
    __syncthreads();
}

__device__ __forceinline__ float wave_sum(float v) {
#pragma unroll
    for (int o = 1; o < 64; o <<= 1) v += __shfl_xor(v, o);
    return v;
}
__device__ __forceinline__ void tr_item(const float* src, int srcN, int k0, int n0, bf16* dst, int drow0, int dK, const float* kscale, LAS float* scr, int lane) {
    float w[32];
    const float* sp = src + (size_t)(k0 + (lane >> 5)) * srcN + n0 + (lane & 31);
#pragma unroll
    for (int i = 0; i < 32; ++i) w[i] = __builtin_nontemporal_load(sp + (size_t)(2 * i) * srcN);
    if (kscale) { const float ksv = kscale[k0 + lane];
#pragma unroll
        for (int i = 0; i < 32; ++i) { const float a = __int_as_float(__builtin_amdgcn_readlane(__float_as_int(ksv), 2 * i)), b = __int_as_float(__builtin_amdgcn_readlane(__float_as_int(ksv), 2 * i + 1)); w[i] *= (lane >> 5) ? b : a; } }
#pragma unroll
    for (int i = 0; i < 32; ++i) scr[(2 * i + (lane >> 5)) * 33 + (lane & 31)] = w[i];
    LDS_WAIT(); asm volatile("" ::: "memory");
    const int c = lane & 7;
#pragma unroll
    for (int j = 0; j < 4; ++j) { const int n = (lane >> 3) + 8 * j; const LAS float* s = scr + (8 * c) * 33 + n;
        u32x4 o; o.x = cvtpk(s[0 * 33], s[1 * 33]); o.y = cvtpk(s[2 * 33], s[3 * 33]); o.z = cvtpk(s[4 * 33], s[5 * 33]); o.w = cvtpk(s[6 * 33], s[7 * 33]);
        *(GAS u32x4*)(dst + (size_t)(drow0 + n) * dK + k0 + 8 * c) = o; }
    LDS_WAIT(); asm volatile("" ::: "memory");
}

__device__ __forceinline__ void tr_item8(const float* src, int srcN, int k0, int n0, unsigned char* dst, int drow0, int dK, const float* kscale, float scale, LAS float* scr, int lane) {
    float w[32];
    const float* sp = src + (size_t)(k0 + (lane >> 5)) * srcN + n0 + (lane & 31);
#pragma unroll
    for (int i = 0; i < 32; ++i) w[i] = __builtin_nontemporal_load(sp + (size_t)(2 * i) * srcN);
    float ksv = scale; if (kscale) ksv *= kscale[k0 + lane];
#pragma unroll
    for (int i = 0; i < 32; ++i) { const float a = __int_as_float(__builtin_amdgcn_readlane(__float_as_int(ksv), 2 * i)), b = __int_as_float(__builtin_amdgcn_readlane(__float_as_int(ksv), 2 * i + 1)); w[i] *= (lane >> 5) ? b : a; }
#pragma unroll
    for (int i = 0; i < 32; ++i) scr[(2 * i + (lane >> 5)) * 33 + (lane & 31)] = w[i];
    LDS_WAIT(); asm volatile("" ::: "memory");
#pragma unroll
    for (int j = 0; j < 2; ++j) { const int idx = lane + 64 * j, n = idx >> 2, c = idx & 3; const LAS float* sc_ = scr + (16 * c) * 33 + n;
        float f[16];
#pragma unroll
        for (int i = 0; i < 16; ++i) f[i] = sc_[i * 33];
        const u32x2 lo = pack8_fp8(f), hi = pack8_fp8(f + 8);
        u32x4 o; o.x = lo.x; o.y = lo.y; o.z = hi.x; o.w = hi.y;
        *(GAS u32x4*)(dst + (size_t)(drow0 + n) * dK + k0 + 16 * c) = o; }
    LDS_WAIT(); asm volatile("" ::: "memory");
}

struct Ptrs {
    const float *x, *attn_g, *w_in, *sbq_g, *sbk_g, *sbo_g, *w2, *gate_b, *glan_g, *w_out, *ffn_g, *rg_w, *rg_b, *re_w, *re_b, *wg, *wu, *wd;
    float* out; unsigned char* ws;
};

constexpr int SB_SPAN = 14, SB_VOFF = SB_SPAN * 4096;
__device__ __forceinline__ int sb_keyK(int r) { return ((r >> 1) & 3) | (((r >> 4) & 1) << 2); }
__device__ __forceinline__ int sb_keyV(int r) { return ((r >> 2) & 1) | (((r >> 4) & 1) << 1); }
__device__ __forceinline__ void sb_round(LAS unsigned char* lds, const bf16* SQ, const bf16* SK, const bf16* TT, const float* gout, bf16* MIX, int b, int h, int qg, int tid, int wave, int lane) {
    const int il = lane & 31, hi = lane >> 5, pil = PI32(il);
    const int qt = 8 * qg + wave;
    const size_t row0 = (size_t)b * SEQ + (size_t)qt * 32;
    bf16x8 qf[4];
    { const bf16* qp = SQ + (row0 + il) * 512 + h * 64 + 32 * hi;
#pragma unroll
      for (int s = 0; s < 4; ++s) qf[s] = *(const bf16x8*)(qp + 8 * s); }
    const int lo = (8 * qg - 6) > 0 ? (8 * qg - 6) : 0, nblk = 8 * qg + 8 - lo;
    {
        u32x4 st[SB_SPAN];
        const bool isK = tid < 256; const int q = tid - 256;
        const bf16* src = isK ? SK + ((size_t)b * SEQ + (size_t)lo * 32 + (tid >> 3)) * 512 + h * 64 + 8 * (tid & 7)
                              : TT + ((size_t)(b * (SEQ / 32) + lo) * NB + h * 64 + (q >> 2)) * 32 + 8 * (q & 3);
        const size_t bstep = isK ? (size_t)32 * 512 : (size_t)NB * 32;
#pragma unroll
        for (int i = 0; i < SB_SPAN; ++i) if (i < nblk) st[i] = *(const u32x4*)(src + (size_t)i * bstep);
        const int r = isK ? (tid >> 3) : (q >> 2);
        const unsigned dst = isK ? (unsigned)(r * 128 + (((tid & 7) ^ sb_keyK(r)) << 4)) : (unsigned)(SB_VOFF + r * 64 + (((q & 3) ^ sb_keyV(r & 31)) << 4));
#pragma unroll
        for (int i = 0; i < SB_SPAN; ++i) if (i < nblk) *(LAS u32x4*)(lds + dst + i * 4096) = st[i];
    }
    __syncthreads();
    f32x16 o0, o1;
#pragma unroll
    for (int r = 0; r < 16; ++r) { o0[r] = 0.f; o1[r] = 0.f; }
    float R = 1.f;
#define SB_MATH(KC, VC, kb_) do { \
        f32x16 z; \
        _Pragma("unroll") for (int r = 0; r < 16; ++r) z[r] = 0.f; \
        _Pragma("unroll") for (int s = 0; s < 4; ++s) z = MFMA32(KC[s], qf[s], z); \
        float beta[16], omb[16]; \
        const bool diag = ((kb_) == qt); \
        _Pragma("unroll") for (int r = 0; r < 16; ++r) { \
            const float zz = z[r]; const float t = __builtin_amdgcn_exp2f(-__builtin_fabsf(zz)); const float rr = __builtin_amdgcn_rcpf(1.f + t); const float sm = t * rr; \
            const bool pos = zz >= 0.f; float be = pos ? rr : sm; float om = pos ? sm : rr; \
            if (diag) { const bool valid = (16 * hi + r) < il; be = valid ? be : 0.f; om = valid ? om : 1.f; } \
            beta[r] = be; omb[r] = om; } \
        float e[16]; e[15] = 1.f; \
        _Pragma("unroll") for (int r = 14; r >= 0; --r) e[r] = e[r + 1] * omb[r + 1]; \
        const float P16 = e[0] * omb[0]; \
        float Plo, Phi; swap32(P16, Plo, Phi); \
        const float base = R * (hi ? 1.f : Phi); \
        float a[16]; \
        _Pragma("unroll") for (int r = 0; r < 16; ++r) a[r] = beta[r] * e[r] * base; \
        R = R * (Plo * Phi); \
        const bf16x8 p0 = pack8(a), p1 = pack8(a + 8); \
        o0 = MFMA32(VC[0][0], p0, o0); o0 = MFMA32(VC[0][1], p1, o0); \
        o1 = MFMA32(VC[1][0], p0, o1); o1 = MFMA32(VC[1][1], p1, o1); } while (0)
    bool fin = false;
    {
        const unsigned kbase = (unsigned)(pil * 128), vbase = (unsigned)(SB_VOFF + pil * 64);
        unsigned kx[4], vx[2];
#pragma unroll
        for (int s = 0; s < 4; ++s) kx[s] = (unsigned)(((4 * hi + s) ^ sb_keyK(pil)) << 4);
#pragma unroll
        for (int s = 0; s < 2; ++s) vx[s] = (unsigned)(((2 * hi + s) ^ sb_keyV(pil)) << 4);
        for (int kb = qt; ; --kb) {
            const unsigned so = (unsigned)(kb - lo) * 4096u;
            bf16x8 kf[4], vf[2][2];
#pragma unroll
            for (int s = 0; s < 4; ++s) kf[s] = *(const LAS bf16x8*)(lds + so + kbase + kx[s]);
#pragma unroll
            for (int dt = 0; dt < 2; ++dt)
#pragma unroll
                for (int s = 0; s < 2; ++s) vf[dt][s] = *(const LAS bf16x8*)(lds + so + vbase + dt * 2048 + vx[s]);
            SB_MATH(kf, vf, kb);
            if (kb == 0 || __all(R == 0.f)) { fin = true; break; }
            if (kb == lo) break;
        }
    }
    if (!fin) {
        for (int kb = lo - 1; ; --kb) {
            bf16x8 kf[4], vf[2][2];
            const bf16* kp = SK + ((size_t)b * SEQ + (size_t)kb * 32 + pil) * 512 + h * 64 + 32 * hi;
#pragma unroll
            for (int s = 0; s < 4; ++s) kf[s] = *(const bf16x8*)(kp + 8 * s);
            const bf16* vp = TT + ((size_t)(b * (SEQ / 32) + kb) * NB + h * 64 + pil) * 32 + 16 * hi;
#pragma unroll
            for (int dt = 0; dt < 2; ++dt)
#pragma unroll
                for (int s = 0; s < 2; ++s) vf[dt][s] = *(const bf16x8*)(vp + dt * 32 * 32 + 8 * s);
            SB_MATH(kf, vf, kb);
            if (kb == 0 || __all(R == 0.f)) break;
        }
    }
#undef SB_MATH
    float ss = 0.f;
#pragma unroll
    for (int r = 0; r < 16; ++r) ss += o0[r] * o0[r] + o1[r] * o1[r];
    float slo, shi; swap32(ss, slo, shi);
    const float rstd = __builtin_amdgcn_rsqf((slo + shi) * (1.f / 64.f) + EPS);
    bf16* op = MIX + (row0 + il) * DM + h * 64 + 16 * hi;
#pragma unroll
    for (int dt = 0; dt < 2; ++dt) {
        float v[16];
#pragma unroll
        for (int r4 = 0; r4 < 4; ++r4) { const f32x4 g = *(const f32x4*)(gout + 32 * dt + 16 * hi + 4 * r4);
#pragma unroll
            for (int e2 = 0; e2 < 4; ++e2) v[4 * r4 + e2] = (dt ? o1[4 * r4 + e2] : o0[4 * r4 + e2]) * rstd * g[e2]; }
        *(bf16x8*)(op + 32 * dt) = pack8(v); *(bf16x8*)(op + 32 * dt + 8) = pack8(v + 8);
    }
    __syncthreads();
}

__device__ __forceinline__ void gla_a(const bf16* GLR, const bf16* W2T, const float* gate_b, const bf16* TT, bf16* KV, float* DTOT, int bh, int j, int lane) {
    const int il = lane & 31, hi = lane >> 5, pil = PI32(il);
    const int b = bh >> 2, h = bh & 3;
    const size_t t0 = (size_t)b * SEQ + (size_t)j * 64;
    bf16x8 gf[2], wf[2], gkf[2][2][2], bvf[4][4]; float bias[2];
#pragma unroll
    for (int ch = 0; ch < 2; ++ch) gf[ch] = *(const bf16x8*)(GLR + (t0 + 32 * ch + pil) * 16 + 8 * hi);
#pragma unroll
    for (int kh = 0; kh < 2; ++kh) { const int kcol = 64 * h + 32 * kh + pil; wf[kh] = *(const bf16x8*)(W2T + kcol * 16 + 8 * hi); bias[kh] = gate_b[kcol];
        const bf16* gkp = TT + ((t0 >> 5) * NB + 512 + kcol) * 32 + 16 * hi;
#pragma unroll
        for (int ch = 0; ch < 2; ++ch) { gkf[kh][ch][0] = *(const bf16x8*)(gkp + ch * NB * 32); gkf[kh][ch][1] = *(const bf16x8*)(gkp + ch * NB * 32 + 8); } }
#pragma unroll
    for (int vq = 0; vq < 4; ++vq) { const bf16* vp = TT + ((t0 >> 5) * NB + 768 + 128 * h + 32 * vq + il) * 32 + 16 * hi;
#pragma unroll
        for (int s = 0; s < 4; ++s) bvf[vq][s] = *(const bf16x8*)(vp + (s >> 1) * NB * 32 + 8 * (s & 1)); }
    bf16x8 akf[2][4];
#pragma unroll
    for (int kh = 0; kh < 2; ++kh) {
        const int kcol = 64 * h + 32 * kh + pil;
        float cs[2][16];
#pragma unroll
        for (int ch = 0; ch < 2; ++ch) {
            f32x16 g;
#pragma unroll
            for (int r = 0; r < 16; ++r) g[r] = 0.f;
            g = MFMA32(gf[ch], wf[kh], g);
            if (kh == 0 && ch == 0) asm volatile("" : "+v"(g) :: "memory");
            float run = 0.f;
#pragma unroll
            for (int r = 0; r < 16; ++r) { const float x = g[r] + bias[kh];
                const float ls2 = __builtin_fminf(x, 0.f) * LOG2E - __builtin_amdgcn_logf(1.f + __builtin_amdgcn_exp2f(-__builtin_fabsf(x) * LOG2E));
                run += ls2 * (1.f / 16.f); cs[ch][r] = run; }
        }
        float t0lo, t0hi, t1lo, t1hi; swap32(cs[0][15], t0lo, t0hi); swap32(cs[1][15], t1lo, t1hi);
        const float off0 = hi ? t0lo : 0.f, off1 = (t0lo + t0hi) + (hi ? t1lo : 0.f), total = (t0lo + t0hi) + (t1lo + t1hi);
        if (hi == 0) DTOT[((size_t)bh * 32 + j) * 64 + 32 * kh + pil] = __builtin_amdgcn_exp2f(total);
#pragma unroll
        for (int ch = 0; ch < 2; ++ch) {
            const bf16x8 k0 = gkf[kh][ch][0], k1 = gkf[kh][ch][1];
            float kd[16]; const float off = ch ? off1 : off0;
#pragma unroll
            for (int r = 0; r < 16; ++r) { const float dec = __builtin_amdgcn_exp2f(total - (cs[ch][r] + off)); kd[r] = bf2f(r < 8 ? k0[r] : k1[r - 8]) * dec; }
            akf[kh][2 * ch] = pack8(kd); akf[kh][2 * ch + 1] = pack8(kd + 8);
        }
    }
#pragma unroll
    for (int vq = 0; vq < 4; ++vq) {
#pragma unroll
        for (int kh = 0; kh < 2; ++kh) {
            f32x16 kv;
#pragma unroll
            for (int r = 0; r < 16; ++r) kv[r] = 0.f;
#pragma unroll
            for (int s = 0; s < 4; ++s) kv = MFMA32(akf[kh][s], bvf[vq][s], kv);
            bf16* dst = KV + (((size_t)bh * 32 + j) * 128 + 32 * vq + il) * 64 + 32 * kh + 16 * hi;
            float kvf[16];
#pragma unroll
            for (int r = 0; r < 16; ++r) kvf[r] = kv[r];
            *(bf16x8*)dst = pack8(kvf); *(bf16x8*)(dst + 8) = pack8(kvf + 8);
        }
    }
}
__device__ __forceinline__ void gla_b(const bf16* KV, const float* DTOT, bf16* ST, int task, int lane) {
    const int bh = task >> 5, part = task & 31; const int e0 = part * 256 + lane * 4; const int k = e0 & 63;
    f32x4 S = (f32x4){0.f, 0.f, 0.f, 0.f};
#pragma unroll
    for (int half = 0; half < 2; ++half) {
        u32x2 kvp[16]; f32x4 d[16];
#pragma unroll
        for (int q = 0; q < 16; ++q) { const int j = 16 * half + q;
            kvp[q] = *(const u32x2*)(KV + ((size_t)bh * 32 + j) * 8192 + e0); d[q] = *(const f32x4*)(DTOT + ((size_t)bh * 32 + j) * 64 + k); }
#pragma unroll
        for (int q = 0; q < 16; ++q) { const int j = 16 * half + q;
            const f32x4 kv = (f32x4){__uint_as_float(kvp[q].x << 16), __uint_as_float(kvp[q].x & 0xffff0000u), __uint_as_float(kvp[q].y << 16), __uint_as_float(kvp[q].y & 0xffff0000u)};
            S = d[q] * S + kv;
            u32x2 w; w.x = cvtpk(S[0], S[1]); w.y = cvtpk(S[2], S[3]);
            *(u32x2*)(ST + ((size_t)bh * 32 + j) * 8192 + e0) = w; }
        asm volatile("" ::: "memory");
    }
}
__device__ __forceinline__ void gla_c(LAS unsigned char* wl, const bf16* ST, const bf16* GQ, const bf16* GRS, const float* gn, bf16* MIX, int bh, int j, int lane) {
    const int il = lane & 31, hi = lane >> 5, pil = PI32(il);
    const int b = bh >> 2, h = bh & 3;
    const size_t t0 = (size_t)b * SEQ + (size_t)j * 64;
    const bf16* sp = ST + ((size_t)bh * 32 + j) * 8192 + lane * 8;
    u32x4 st[16];
#pragma unroll
    for (int i = 0; i < 16; ++i) st[i] = *(const u32x4*)(sp + i * 512);
    bf16x8 bq[2][4], gr[2][4][2];
#pragma unroll
    for (int ch = 0; ch < 2; ++ch) { const size_t row = t0 + 32 * ch + il;
#pragma unroll
        for (int s = 0; s < 4; ++s) bq[ch][s] = *(const bf16x8*)(GQ + row * 256 + 64 * h + 16 * s + 8 * hi); }
    { const size_t row = t0 + il;
#pragma unroll
      for (int vt = 0; vt < 4; ++vt) { gr[0][vt][0] = *(const bf16x8*)(GRS + row * 512 + 128 * h + 32 * vt + 16 * hi); gr[0][vt][1] = *(const bf16x8*)(GRS + row * 512 + 128 * h + 32 * vt + 16 * hi + 8); } }
    { const int vr = lane >> 3, c = lane & 7;
#pragma unroll
      for (int i = 0; i < 16; ++i) { const int v = 8 * i + vr; *(LAS u32x4*)(wl + v * 128 + ((c ^ sb_keyK(v & 31)) << 4)) = st[i]; } }
    LDS_WAIT(); asm volatile("" ::: "memory");
    unsigned ax[4];
#pragma unroll
    for (int s = 0; s < 4; ++s) ax[s] = (unsigned)(pil * 128 + (((2 * s + hi) ^ sb_keyK(pil)) << 4));
#pragma unroll
    for (int ch = 0; ch < 2; ++ch) {
        const size_t row = t0 + 32 * ch + il;
        f32x16 O[4]; float ss = 0.f;
#pragma unroll
        for (int vt = 0; vt < 4; ++vt) {
#pragma unroll
            for (int r = 0; r < 16; ++r) O[vt][r] = 0.f;
#pragma unroll
            for (int s = 0; s < 4; ++s) { const bf16x8 af = *(const LAS bf16x8*)(wl + vt * 4096 + ax[s]); O[vt] = MFMA32(af, bq[ch][s], O[vt]); }
            if (ch == 0 && vt == 0) {
                const size_t row1 = t0 + 32 + il;
#pragma unroll
                for (int v2 = 0; v2 < 4; ++v2) { gr[1][v2][0] = *(const bf16x8*)(GRS + row1 * 512 + 128 * h + 32 * v2 + 16 * hi); gr[1][v2][1] = *(const bf16x8*)(GRS + row1 * 512 + 128 * h + 32 * v2 + 16 * hi + 8); }
                asm volatile("" : "+v"(O[0]) :: "memory"); }
#pragma unroll
            for (int r = 0; r < 16; ++r) ss += O[vt][r] * O[vt][r];
        }
        float slo, shi; swap32(ss, slo, shi);
        const float rstd = __builtin_amdgcn_rsqf((slo + shi) * (1.f / 128.f) + EPS);
#pragma unroll
        for (int vt = 0; vt < 4; ++vt) {
            const int vc0 = 32 * vt + 16 * hi;
            float v[16];
#pragma unroll
            for (int r4 = 0; r4 < 4; ++r4) { const f32x4 g = *(const f32x4*)(gn + vc0 + 4 * r4);
#pragma unroll
                for (int e2 = 0; e2 < 4; ++e2) { const int r = 4 * r4 + e2; v[r] = O[vt][r] * rstd * g[e2] * bf2f(r < 8 ? gr[ch][vt][0][r] : gr[ch][vt][1][r - 8]); } }
            bf16* op = MIX + row * DM + 512 + 128 * h + vc0;
            *(bf16x8*)(op) = pack8(v); *(bf16x8*)(op + 8) = pack8(v + 8);
        }
    }
    LDS_WAIT(); asm volatile("" ::: "memory");
}

constexpr int NWAVES = 8;
constexpr int N_PHASES = 10;
struct Args { Ptrs p; int ph_lo, ph_hi; };

__global__ void __launch_bounds__(NWAVES * 64, 2) fwd_kernel(Args args) {
    extern __shared__ __attribute__((aligned(16))) unsigned char lds_raw[];
    LAS unsigned char* lds = (LAS unsigned char*)lds_raw;
    const Ptrs& P = args.p;
    const int tid = threadIdx.x, lane = tid & 63, wave = __builtin_amdgcn_readfirstlane(tid >> 6);
    const int G = gridDim.x; const int bx = blockIdx.x; const int vcu = (G % 8 == 0) ? (bx % 8) * (G / 8) + bx / 8 : bx;
    const int gw = vcu * NWAVES + wave, NGW = G * NWAVES;
    unsigned char* ws = P.ws;
    gu32* ctl = (gu32*)(ws + WS_CTL);
    volatile LAS unsigned* MISC = (volatile LAS unsigned*)(lds + MISC_OFF);
    LAS int* tab = (LAS int*)(lds + TAB_OFF);
    for (int u = tid; u < (LDS_BYTES - LDSCTL_OFF) / 4; u += NWAVES * 64) ((LAS unsigned*)(lds + LDSCTL_OFF))[u] = 0u;
    __syncthreads();
    XcdBarrier bar; bar.bar = (unsigned*)(ctl + CW_BAR); bar.x = 0; bar.st = nullptr;
    if (MK_N_LAUNCHES == 1) bar = xcd_barrier_post((unsigned*)(ctl + CW_BAR), MISC + 8);
#define GRID_BAR() do { if (MK_N_LAUNCHES == 1) xcd_barrier(bar); } while (0)
#define BAR_ARRIVE() do { if (MK_N_LAUNCHES == 1) xcd_barrier_arrive(bar, MISC + 12); } while (0)
#define BAR_WAIT() do { if (MK_N_LAUNCHES == 1) xcd_barrier_wait(bar, MISC + 12); } while (0)
    const int lo = args.ph_lo, hi_ph = args.ph_hi;
#ifndef PHASE_MASK
#define PHASE_MASK 0x3ff
#endif
#define IN(k) (((PHASE_MASK >> (k)) & 1) && lo <= (k) && (k) < hi_ph)
#define BOTH(k) (IN(k) && IN((k) + 1))
#ifndef PROBE_TWICE
#define PROBE_TWICE -1
#endif
#define REP(k) for (int rep_ = 0; rep_ < ((PROBE_TWICE == (k)) ? 2 : 1); ++rep_)
#define REPBAR(k) do { if (PROBE_TWICE == (k) && rep_ == 0) GRID_BAR(); } while (0)

    bf16* WA = (bf16*)(ws + WS_WA); bf16* WB = (bf16*)(ws + WS_WB); bf16* WO = (bf16*)(ws + WS_WO);
    bf16* WRH = (bf16*)(ws + WS_WR); bf16* WRL = WRH + 48 * 1024; bf16* W2T = (bf16*)(ws + WS_W2T);
    bf16* WGU = (bf16*)(ws + WS_WGU); bf16* WD = (bf16*)(ws + WS_WD);
    bf16* H = (bf16*)(ws + WS_H); bf16* KV = (bf16*)(ws + WS_KV);
    bf16* XB = (bf16*)(ws + WS_XB); bf16* MIX = (bf16*)(ws + WS_MIX); float* RSTD1 = (float*)(ws + WS_RSTD1);
    bf16* SQ = (bf16*)(ws + WS_SQ); bf16* SK = (bf16*)(ws + WS_SK); bf16* GQ = (bf16*)(ws + WS_GQ); bf16* GRS = (bf16*)(ws + WS_GRS);
    bf16* TT = (bf16*)(ws + WS_TT); bf16* GLR = (bf16*)(ws + WS_GLR); bf16* ST = (bf16*)(ws + WS_ST); float* DTOT = (float*)(ws + WS_DTOT);
    unsigned char* ACT = ws + WS_ACT; unsigned char* Y = ws + WS_Y;
    unsigned char* WGU8 = ws + WS_WGU; unsigned char* WD8 = ws + WS_WD; unsigned char* H8 = ws + WS_H8;
    unsigned* LOCL = (unsigned*)(ws + WS_LOCL); unsigned* CNTS = (unsigned*)(ws + WS_CNTS); float* GATE = (float*)(ws + WS_GATE); float* RSTD = (float*)(ws + WS_RSTD);

#define WGU_PIECE(q_) do { LAS float* scr_ = (LAS float*)(lds + RING_OFF + wave * 16384); \
        for (int r = (q_) * 4096 + gw; r < ((q_) + 1) * 4096; r += NGW) { \
            const int e = r >> 9, q = r & 511, ib = 4 * (q >> 6) + (q & 3), kb = 2 * ((q >> 3) & 7) + ((q >> 2) & 1), P0 = 32 * ib; const int pn = P0 >> 8, bj = (P0 >> 7) & 1, r0 = P0 & 127; \
            const float* src = (bj ? P.wu : P.wg) + (size_t)e * DM * DEXP; \
            tr_item8(src, DEXP, 64 * kb, 128 * pn + r0, WGU8 + (size_t)e * DM * DM, P0, DM, P.ffn_g, WGU_SC, scr_, lane); } } while (0)
    if (IN(0)) { REP(0) {
        LAS float* scr = (LAS float*)(lds + RING_OFF + wave * 16384);
        constexpr int I_A = (NA / 32) * 16, I_B = (NB / 32) * 16, I_O = 32 * 16, I_GU = 32 * 32 * 16, I_D = 32 * 32 * 8;
        constexpr int NITEMS = I_A + I_B + I_O;
        for (int it = gw; it < NITEMS; it += NGW) {
            int r = it;
            if (r < I_A) { const int ib = r >> 4, kb = r & 15, P0 = 32 * ib; const int pn = P0 >> 8, bj = (P0 >> 7) & 1, wcc = (P0 >> 5) & 3; const int LA = 256 * pn + 64 * wcc + 32 * bj;
                const int sc = LA < 1024 ? LA : (LA < 1280 ? 1536 + (LA - 1024) : 2560 + (LA - 1280));
                tr_item(P.w_in, IN_DIM, 64 * kb, sc, WA, P0, DM, P.attn_g, scr, lane); continue; } r -= I_A;
            if (r < I_B) { const int ib = r >> 4, kb = r & 15, P0 = 32 * ib; const int sc = P0 < 512 ? 1024 + P0 : (P0 < 768 ? 1792 + (P0 - 512) : 2048 + (P0 - 768));
                tr_item(P.w_in, IN_DIM, 64 * kb, sc, WB, P0, DM, P.attn_g, scr, lane); continue; } r -= I_B;
            if (r < I_O) { const int ib = r >> 4, kb = r & 15; tr_item(P.w_out, DM, 64 * kb, 32 * ib, WO, 32 * ib, DM, nullptr, scr, lane); continue; } r -= I_O;
        }
        (void)I_D; (void)I_GU;
        for (int idx = gw * 64 + lane; idx < 48 * 1024; idx += NGW * 64) {
            const int rho = idx >> 10, k = idx & 1023, m = rho >> 4, i = rho & 15;
            float v = (m < 2) ? P.re_w[k * 32 + 8 * (i >> 2) + 4 * m + (i & 3)] : P.rg_w[k * 4 + (i & 3)];
            v *= P.ffn_g[k];
            WRH[idx] = __builtin_bit_cast(unsigned short, (_Float16)v);
        }
        for (int idx = gw * 64 + lane; idx < 256 * 16; idx += NGW * 64) { const int kc = idx >> 4, r = idx & 15; W2T[idx] = (bf16)(cvtpk(P.w2[r * 256 + kc], 0.f) & 0xffffu); }
        __syncthreads();
        constexpr int WLP = 1032;
        LAS bf16* wl = (LAS bf16*)(lds + RING_OFF);
        for (int idx = tid; idx < 16 * 1024; idx += NWAVES * 64) { const int c = idx & 15, k = idx >> 4; wl[c * WLP + k] = (bf16)(cvtpk(P.attn_g[k] * P.w_in[(size_t)k * IN_DIM + 3072 + c], 0.f) & 0xffffu); }
        __syncthreads();
        {
            for (int task = gw; task < NTOK / 16; task += NGW) {
                const size_t row0 = (size_t)task * 16;
                f32x4 cur[4], nxt[4]; float rsv = 0.f;
#pragma unroll
                for (int j = 0; j < 4; ++j) { cur[j] = __builtin_nontemporal_load((const GAS f32x4*)(P.x + row0 * DM) + lane + 64 * j); nxt[j] = cur[j]; }
#pragma unroll 2
                for (int r = 0; r < 16; ++r) {
                    if (r < 15) {
#pragma unroll
                        for (int j = 0; j < 4; ++j) nxt[j] = __builtin_nontemporal_load((const GAS f32x4*)(P.x + (row0 + r + 1) * DM) + lane + 64 * j); }
                    float s2 = 0.f;
#pragma unroll
                    for (int j = 0; j < 4; ++j) s2 += (cur[j].x * cur[j].x + cur[j].y * cur[j].y) + (cur[j].z * cur[j].z + cur[j].w * cur[j].w);
                    const float rstd = __builtin_amdgcn_rsqf(wave_sum(s2) * (1.f / DM) + EPS);
                    if ((lane & 15) == r) rsv = rstd;
                    GAS unsigned long long* o8 = (GAS unsigned long long*)(XB + (row0 + r) * DM) + lane;
#pragma unroll
                    for (int j = 0; j < 4; ++j) { const f32x4 v = cur[j];
                        o8[64 * j] = (unsigned long long)cvtpk(v.x, v.y) | ((unsigned long long)cvtpk(v.z, v.w) << 32); }
#pragma unroll
                    for (int j = 0; j < 4; ++j) cur[j] = nxt[j];
                }
                if (lane < 16) RSTD1[row0 + lane] = rsv;
                VM_WAIT();
                const int fr = lane & 15, fq = lane >> 4;
                f32x4 acc = (f32x4){0.f, 0.f, 0.f, 0.f};
                const bf16* up = XB + (row0 + fr) * DM + 8 * fq;
#pragma unroll 8
                for (int ks = 0; ks < 32; ++ks) { const bf16x8 ub = *(const bf16x8*)(up + 32 * ks); const bf16x8 wb = *(const LAS bf16x8*)(wl + fr * WLP + 32 * ks + 8 * fq); acc = MFMA16(wb, ub, acc); }
                u32x2 o; o.x = cvtpk(acc[0] * rsv, acc[1] * rsv); o.y = cvtpk(acc[2] * rsv, acc[3] * rsv);
                *(u32x2*)(GLR + (row0 + fr) * 16 + 4 * fq) = o;
            }
        }
        __syncthreads();
        REPBAR(0); }
        if (BOTH(0)) BAR_ARRIVE();
        WGU_PIECE(0);
        if (BOTH(0)) BAR_WAIT();
    }

#define PH1_BODY() do { \
        { pg8::SchedDense S; S.init(XB, WA, NTOK, NA, DM, G, bx); \
          pg8::EpiA E{SQ, SK, GQ, GRS, P.sbq_g, P.sbk_g, RSTD1}; \
          pg8::gemm_phase<pg8::EpiA, pg8::SchedDense>(lds + RING_OFF, DM, S, E); } \
        { pg8::SchedDense S; S.init(WB, XB, NB, NTOK, DM, G, (bx + G / 2) % G); \
          pg8::EpiTT E{TT, RSTD1}; \
          pg8::gemm_phase<pg8::EpiTT, pg8::SchedDense>(lds + RING_OFF, DM, S, E); } } while (0)
    if (IN(1)) {
        if (PROBE_TWICE == 1) { PH1_BODY(); GRID_BAR(); }
        PH1_BODY();
        if (BOTH(1)) BAR_ARRIVE();
        WGU_PIECE(1);
        if (BOTH(1)) BAR_WAIT();
    }

#define SB_ROUND(rho_) do { for (int u__ = (rho_) * G + vcu; u__ < 1024; u__ += 4 * G) { const int bh_ = u__ & 127; \
        sb_round(lds + RING_OFF, SQ, SK, TT, P.sbo_g + (bh_ & 7) * 64, MIX, bh_ >> 3, bh_ & 7, u__ >> 7, tid, wave, lane); } } while (0)
#define REPX(code) for (int rx_ = 0; rx_ < ((PROBE_TWICE == (code)) ? 5 : 1); ++rx_)
    if (IN(2)) {
        for (int t = gw; t < 2048; t += NGW) gla_a(GLR, W2T, P.gate_b, TT, KV, DTOT, t >> 5, t & 31, lane);
        if (BOTH(2)) BAR_ARRIVE();
        SB_ROUND(0);
        if (BOTH(2)) BAR_WAIT();
    }
    if (IN(3)) {
        for (int t = gw; t < 2048; t += NGW) gla_b(KV, DTOT, ST, t, lane);
        if (BOTH(3)) BAR_ARRIVE();
        SB_ROUND(1);
        if (BOTH(3)) BAR_WAIT();
    }
    if (IN(4)) {
        for (int t = gw; t < 2048; t += NGW) gla_c(lds + RING_OFF + wave * 16384, ST, GQ, GRS, P.glan_g, MIX, t >> 5, t & 31, lane);
        __syncthreads();
        SB_ROUND(2); SB_ROUND(3);
        if (BOTH(4)) BAR_ARRIVE();
        WGU_PIECE(2);
        if (BOTH(4)) BAR_WAIT();
    }

#define PH5_BODY() do { \
        pg8::SchedDense S; S.init(MIX, WO, NTOK, DM, DM, G, bx); \
        pg8::EpiH E{XB, H, H8}; \
        pg8::gemm_phase<pg8::EpiH, pg8::SchedDense>(lds + RING_OFF, DM, S, E); } while (0)
    if (IN(5)) {
        if (PROBE_TWICE == 5) { PH5_BODY(); GRID_BAR(); }
        PH5_BODY();
        if (BOTH(5)) BAR_ARRIVE();
        WGU_PIECE(3);
        if (BOTH(5)) BAR_WAIT();
    }

    if (IN(6)) { REP(6) {
        constexpr int WP = 1032;
        LAS unsigned short* wl16 = (LAS unsigned short*)(lds + RING_OFF);
        LAS unsigned* lcount = (LAS unsigned*)(lds + RING_OFF + 48 * WP * 2);
        for (int idx = tid; idx < 48 * 128; idx += NWAVES * 64) { const int row = idx >> 7, c = idx & 127; *(LAS u32x4*)(wl16 + row * WP + 8 * c) = *(const u32x4*)(WRH + row * 1024 + 8 * c); }
        const int fr = lane & 15, fq = lane >> 4;
        for (int it = 0; it * G < NGRP; ++it) {
            const int grp = it * G + vcu;
            const int tile = grp * 8 + wave; const int ntile = NGRP * 8;
            if (tid < 32) lcount[tid] = 0u;
            __syncthreads();
            bool owner = false; int e1 = 0, e2 = 0; unsigned lr1 = 0, lr2 = 0; int tok = 0;
            if (tile < ntile) {
                tok = tile * 16 + fr;
                const bf16* hp = H + (size_t)tok * DM + 8 * fq;
                f32x4 acc[3]; acc[0] = acc[1] = acc[2] = (f32x4){0.f, 0.f, 0.f, 0.f};
                float ssq = 0.f;
#pragma unroll 1
                for (int half = 0; half < 2; ++half) {
                    bf16x8 hb[16];
#pragma unroll
                    for (int q = 0; q < 16; ++q) hb[q] = *(const bf16x8*)(hp + 32 * (16 * half + q));
#pragma unroll
                    for (int q = 0; q < 16; ++q) { const int ks = 16 * half + q;
                        float f[8];
#pragma unroll
                        for (int e = 0; e < 8; ++e) { f[e] = bf2f(hb[q][e]); ssq += f[e] * f[e]; }
                        f16x8 hh;
#pragma unroll
                        for (int e = 0; e < 8; ++e) hh[e] = (_Float16)f[e];
#pragma unroll
                        for (int m = 0; m < 3; ++m) { const f16x8 wv = *(const LAS f16x8*)(wl16 + (16 * m + fr) * WP + 32 * ks + 8 * fq);
                            acc[m] = __builtin_amdgcn_mfma_f32_16x16x32_f16(wv, hh, acc[m], 0, 0, 0); }
                    }
                }
                ssq += __shfl_xor(ssq, 16); ssq += __shfl_xor(ssq, 32);
                const float rstd = __builtin_amdgcn_rsqf(ssq * (1.f / DM) + EPS);
                float gl[4];
#pragma unroll
                for (int r = 0; r < 4; ++r) gl[r] = acc[2][r] * rstd + P.rg_b[r];
                int gsel = 0; float gmax = gl[0];
#pragma unroll
                for (int r = 1; r < 4; ++r) if (gl[r] > gmax) { gmax = gl[r]; gsel = r; }
                float gden = 0.f;
#pragma unroll
                for (int r = 0; r < 4; ++r) gden += __builtin_amdgcn_exp2f((gl[r] - gmax) * LOG2E);
                const float pgrp = 1.f / gden;
                float el[8];
#pragma unroll
                for (int r = 0; r < 4; ++r) { el[r] = acc[0][r] * rstd + P.re_b[8 * fq + r]; el[4 + r] = acc[1][r] * rstd + P.re_b[8 * fq + 4 + r]; }
                int i1 = 0; float l1 = el[0];
#pragma unroll
                for (int r = 1; r < 8; ++r) if (el[r] > l1) { l1 = el[r]; i1 = r; }
                int i2 = -1; float l2 = -3.0e38f;
#pragma unroll
                for (int r = 0; r < 8; ++r) if (r != i1 && el[r] > l2) { l2 = el[r]; i2 = r; }
                const float ex = __builtin_amdgcn_exp2f((l2 - l1) * LOG2E);
                const float p1 = 1.f / (1.f + ex), p2 = ex * p1;
                owner = (fq == gsel);
                if (owner) {
                    e1 = 8 * gsel + i1; e2 = 8 * gsel + i2;
                    lr1 = __hip_atomic_fetch_add(lcount + e1, 1u, __ATOMIC_RELAXED, __HIP_MEMORY_SCOPE_WORKGROUP);
                    lr2 = __hip_atomic_fetch_add(lcount + e2, 1u, __ATOMIC_RELAXED, __HIP_MEMORY_SCOPE_WORKGROUP);
                    RSTD[tok] = rstd; GATE[2 * tok] = pgrp * p1; GATE[2 * tok + 1] = pgrp * p2;
                }
            }
            __syncthreads();
            if (grp < NGRP) {
                if (tid < 32) CNTS[grp * 32 + tid] = lcount[tid];
                if (owner) { LOCL[((size_t)grp * 32 + e1) * 128 + lr1] = 2u * tok; LOCL[((size_t)grp * 32 + e2) * 128 + lr2] = 2u * tok + 1u; }
            }
            __syncthreads();
        }
        REPBAR(6); }
        if (BOTH(6)) GRID_BAR();
    }

    if (IN(7) || IN(8)) {
        LAS int* pre = (LAS int*)(lds + RING_OFF);
        LAS int* segsum = pre + NGRP * 32;
        for (int i = tid; i < NGRP * 32; i += NWAVES * 64) pre[i] = (int)CNTS[i];
        __syncthreads();
        { const int e = tid & 31, seg = tid >> 5; int run = 0;
          for (int g = seg * 16; g < seg * 16 + 16; ++g) { const int c = pre[g * 32 + e]; pre[g * 32 + e] = run; run += c; }
          segsum[seg * 32 + e] = run; }
        __syncthreads();
        { const int e = tid & 31, seg = tid >> 5; int off = 0, tot = 0;
          for (int q = 0; q < 16; ++q) { const int v = segsum[q * 32 + e]; if (q < seg) off += v; tot += v; }
          for (int g = seg * 16; g < seg * 16 + 16; ++g) pre[g * 32 + e] += off;
          if (seg == 0) tab[T_CNT / 4 + e] = tot; }
        __syncthreads();
        if (tid == 0) { int tb = 0; for (int e = 0; e < 32; ++e) { tab[T_TBASE / 4 + e] = tb; tb += (tab[T_CNT / 4 + e] + 255) >> 8; } tab[T_TBASE / 4 + 32] = tb; tab[T_NT / 4] = tb; }
        __syncthreads();
        { const int NT = tab[T_NT / 4];
          for (int t = tid; t < NT; t += NWAVES * 64) { int e = 0; for (int q = 0; q < 32; ++q) if (tab[T_TBASE / 4 + q] <= t && t < tab[T_TBASE / 4 + q + 1]) e = q; tab[T_TILE_E / 4 + t] = e; } }
        __syncthreads();
        { pg8::SchedMoE<false> S0; S0.A = nullptr; S0.Bt = nullptr; S0.K = 0; S0.bstride = 0; S0.G = G; S0.c = vcu; S0.tab = tab;
          const int half = tid >> 8, r = tid & 255; unsigned vals[NU_MAX / 2]; bool ok[NU_MAX / 2];
#pragma unroll
          for (int k = 0; k < NU_MAX / 2; ++k) { const int ui = 2 * k + half; pg8::Unit u; ok[k] = S0.next(ui, u); vals[k] = 0u;
              if (ok[k]) { const int cnt = tab[T_CNT / 4 + u.e], e = u.e; int p = u.rt * 256 + r; if (p > cnt - 1) p = cnt - 1;
                  int lo_ = 0, hi_ = NGRP - 1;
                  while (lo_ < hi_) { const int mid = (lo_ + hi_ + 1) >> 1; if (pre[mid * 32 + e] <= p) lo_ = mid; else hi_ = mid - 1; }
                  vals[k] = LOCL[((size_t)lo_ * 32 + e) * 128 + (p - pre[lo_ * 32 + e])]; } }
          float rsl[NU_MAX / 2];
#pragma unroll
          for (int k = 0; k < NU_MAX / 2; ++k) rsl[k] = ok[k] ? RSTD[vals[k] >> 1] : 0.f;
#pragma unroll
          for (int k = 0; k < NU_MAX / 2; ++k) if (ok[k]) { tab[T_ROWTAB / 4 + (2 * k + half) * 256 + r] = (int)vals[k]; ((LAS float*)tab)[T_RSTAB / 4 + (2 * k + half) * 256 + r] = rsl[k]; }
        }
        __syncthreads();
    }
#define PH7_BODY() do { \
        pg8::SchedMoE<true> S; S.A = (const char*)H8; S.Bt = (const char*)WGU8; S.K = DM / 2; S.bstride = (size_t)DM * DM; S.G = G; S.c = vcu; S.tab = tab; \
        pg8::EpiGU E{ACT, RSTD, tab}; \
        pg8::gemm_phase<pg8::EpiGU, pg8::SchedMoE<true>, false, true>(lds + RING_OFF, DM / 2, S, E); } while (0)
    if (IN(7)) {
        if (PROBE_TWICE == 7) { PH7_BODY(); GRID_BAR(); }
        PH7_BODY();
        {
            const int NT4 = tab[T_NT / 4] * 4, remu = NT4 % G;
            const bool early = (remu == 0) || (vcu >= remu); const int nE = (remu == 0) ? G : (G - remu), rank = (remu == 0) ? vcu : (vcu - remu);
            if (early) { LAS float* scr = (LAS float*)(lds + RING_OFF + wave * 16384);
                for (int r = rank * NWAVES + wave; r < 32 * 32 * 8; r += nE * NWAVES) {
                    const int e = r >> 8, q = r & 255, nb = 4 * (q >> 5) + (q & 3), kb = 2 * ((q >> 3) & 3) + ((q >> 2) & 1);
                    tr_item8(P.wd + (size_t)e * DEXP * DM, DM, 64 * kb, 32 * nb, WD8 + (size_t)e * DM * DEXP, 32 * nb, DEXP, nullptr, WD_SC, scr, lane); } }
        }
        if (BOTH(7)) GRID_BAR();
    }
    if (IN(8)) { REP(8) {
        pg8::SchedMoE<false> S; S.A = (const char*)ACT; S.Bt = (const char*)WD8; S.K = DEXP / 2; S.bstride = (size_t)DM * DEXP; S.G = G; S.c = vcu; S.tab = tab;
        pg8::EpiDown E{Y, tab};
        pg8::gemm_phase<pg8::EpiDown, pg8::SchedMoE<false>, false, true>(lds + RING_OFF, DEXP / 2, S, E);
        REPBAR(8); }
        if (BOTH(8)) BAR_ARRIVE();
    }
    constexpr int HPRE = 16;
    u32x2 hpre[HPRE][4]; float gpre[HPRE][2];
    if (IN(9)) {
#pragma unroll
        for (int k = 0; k < HPRE; ++k) { int m = gw + k * NGW; if (m >= NTOK) m = gw;
            const bf16* hp = H + (size_t)m * DM + 4 * lane;
#pragma unroll
            for (int q = 0; q < 4; ++q) hpre[k][q] = *(const u32x2*)(hp + 256 * q);
            gpre[k][0] = GATE[2 * m] * (1.f / Y_SC); gpre[k][1] = GATE[2 * m + 1] * (1.f / Y_SC); }
    }
    if (BOTH(8)) BAR_WAIT();
#define CMB_ROW(m_, hv_, ya_, yb_, g0_, g1_) do { float* op = P.out + (size_t)(m_) * DM + 4 * lane; \
        _Pragma("unroll") for (int q = 0; q < 4; ++q) { const unsigned wa = (ya_)[q], wb = (yb_)[q]; \
            const f32x2_t a0 = __builtin_amdgcn_cvt_pk_f32_fp8((int)wa, false), a1 = __builtin_amdgcn_cvt_pk_f32_fp8((int)wa, true); \
            const f32x2_t b0 = __builtin_amdgcn_cvt_pk_f32_fp8((int)wb, false), b1 = __builtin_amdgcn_cvt_pk_f32_fp8((int)wb, true); \
            const unsigned h01 = (hv_)[q].x, h23 = (hv_)[q].y; \
            f32x4 o; o[0] = __uint_as_float(h01 << 16) + (g0_) * a0.x + (g1_) * b0.x; o[1] = __uint_as_float(h01 & 0xffff0000u) + (g0_) * a0.y + (g1_) * b0.y; \
            o[2] = __uint_as_float(h23 << 16) + (g0_) * a1.x + (g1_) * b1.x; o[3] = __uint_as_float(h23 & 0xffff0000u) + (g0_) * a1.y + (g1_) * b1.y; \
            *(f32x4*)(op + 256 * q) = o; } } while (0)
    if (IN(9)) { REP(9) {
#pragma unroll
        for (int k0 = 0; k0 < HPRE; k0 += 4) {
            unsigned ya[4][4], yb[4][4];
#pragma unroll
            for (int t = 0; t < 4; ++t) { int m = gw + (k0 + t) * NGW; if (m >= NTOK) m = gw;
                const unsigned char* y0 = Y + (size_t)(2 * m) * DM + 4 * lane;
#pragma unroll
                for (int q = 0; q < 4; ++q) { ya[t][q] = *(const unsigned*)(y0 + 256 * q); yb[t][q] = *(const unsigned*)(y0 + DM + 256 * q); } }
#pragma unroll
            for (int t = 0; t < 4; ++t) { const int m = gw + (k0 + t) * NGW; if (m < NTOK) CMB_ROW(m, hpre[k0 + t], ya[t], yb[t], gpre[k0 + t][0], gpre[k0 + t][1]); }
        }
        for (int m0 = gw + HPRE * NGW; m0 < NTOK; m0 += 2 * NGW) {
            u32x2 hv[2][4]; unsigned ya[2][4], yb[2][4]; float g0[2], g1[2];
#pragma unroll
            for (int t = 0; t < 2; ++t) { int m = m0 + t * NGW; if (m >= NTOK) m = m0;
                g0[t] = GATE[2 * m] * (1.f / Y_SC); g1[t] = GATE[2 * m + 1] * (1.f / Y_SC);
                const bf16* hp = H + (size_t)m * DM + 4 * lane; const unsigned char* y0 = Y + (size_t)(2 * m) * DM + 4 * lane;
#pragma unroll
                for (int q = 0; q < 4; ++q) { hv[t][q] = *(const u32x2*)(hp + 256 * q); ya[t][q] = *(const unsigned*)(y0 + 256 * q); yb[t][q] = *(const unsigned*)(y0 + DM + 256 * q); } }
#pragma unroll
            for (int t = 0; t < 2; ++t) { const int m = m0 + t * NGW; if (m < NTOK) CMB_ROW(m, hv[t], ya[t], yb[t], g0[t], g1[t]); }
        }
    REPBAR(9); } }
#undef CMB_ROW
#undef IN
#undef BOTH
}

extern "C" void kernel_launch(void* const* d_in, const int* in_sizes, int n_in, void* d_out, int out_size, void* d_ws, size_t ws_size, hipStream_t stream) {
    static int grid = 0;
    if (grid == 0) {
        if (n_in != 18 || in_sizes[0] != NTOK * DM || out_size != NTOK * DM || ws_size < WS_END) { fprintf(stderr, "kernel_launch: unexpected shapes / workspace (n_in %d, in0 %d, out %d, ws %zu, need %zu)\n", n_in, n_in > 0 ? in_sizes[0] : -1, out_size, ws_size, (size_t)WS_END); grid = -1; return; }
        int dev = 0, cus = 0, per_cu = 0;
        if (hipGetDevice(&dev) != hipSuccess || hipDeviceGetAttribute(&cus, hipDeviceAttributeMultiprocessorCount, dev) != hipSuccess) { grid = -1; return; }
        if (hipFuncSetAttribute((const void*)fwd_kernel, hipFuncAttributeMaxDynamicSharedMemorySize, LDS_BYTES) != hipSuccess) { fprintf(stderr, "kernel_launch: hipFuncSetAttribute failed\n"); grid = -1; return; }
        if (hipOccupancyMaxActiveBlocksPerMultiprocessor(&per_cu, (const void*)fwd_kernel, NWAVES * 64, LDS_BYTES) != hipSuccess || per_cu < 1) fprintf(stderr, "kernel_launch: occupancy query reports %d\n", per_cu);
        (void)hipGetLastError();
        grid = cus;
    }
    if (grid < 0) return;
    if (hipMemsetAsync((char*)d_ws + WS_CTL, 0, CTL_ZERO_BYTES, stream) != hipSuccess) return;
    Args a{};
    const float** pp = (const float**)&a.p;
    for (int i = 0; i < 18; ++i) pp[i] = (const float*)d_in[i];
    a.p.out = (float*)d_out; a.p.ws = (unsigned char*)d_ws;
    if (MK_N_LAUNCHES == 1) { a.ph_lo = 0; a.ph_hi = N_PHASES; hipLaunchKernelGGL(fwd_kernel, dim3(grid), dim3(NWAVES * 64), LDS_BYTES, stream, a); }
    else for (int li = 0; li < N_PHASES; ++li) { a.ph_lo = li; a.ph_hi = li + 1; hipLaunchKernelGGL(fwd_kernel, dim3(grid), dim3(NWAVES * 64), LDS_BYTES, stream, a); }
}
```

```cpp
#include <hip/hip_runtime.h>
#include <cstdio>
#include <cstdint>

#ifndef MK_N_LAUNCHES
#define MK_N_LAUNCHES 1
#endif

#define LAS __attribute__((address_space(3)))
#define GAS __attribute__((address_space(1)))
typedef unsigned short bf16;
typedef short bf16x8 __attribute__((ext_vector_type(8)));
typedef float f32x4 __attribute__((ext_vector_type(4)));
typedef float f32x16 __attribute__((ext_vector_type(16)));
typedef unsigned u32x4 __attribute__((ext_vector_type(4)));
typedef unsigned u32x2 __attribute__((ext_vector_type(2)));
typedef float f32x2_t __attribute__((ext_vector_type(2)));
typedef __bf16 bf16x2_t __attribute__((ext_vector_type(2)));
typedef GAS unsigned gu32;
typedef int v8i __attribute__((ext_vector_type(8)));
typedef int v4i __attribute__((ext_vector_type(4)));
typedef _Float16 f16x8 __attribute__((ext_vector_type(8)));
typedef _Float16 f16x2 __attribute__((ext_vector_type(2)));

constexpr int BATCH = 16, SEQ = 2048, DM = 1024, NTOK = BATCH * SEQ;
constexpr int IN_DIM = 3088;
constexpr int NEXP = 32, DEXP = 512;
constexpr float EPS = 1e-6f;
constexpr float LOG2E = 1.4426950408889634f;
constexpr float WGU_SC = 64.f, WD_SC = 32.f, ACT_SC = 8.f, Y_SC = 8.f;
constexpr int NA = 1792, NB = 1280;
constexpr int NGRP = NTOK / 128;

constexpr size_t MiB = 1u << 20;
constexpr size_t WS_CTL = 0, CTL_ZERO_BYTES = 64 * 1024;
constexpr size_t WS_WA = 2 * MiB;
constexpr size_t WS_WB = 6 * MiB;
constexpr size_t WS_WO = 9 * MiB;
constexpr size_t WS_WR = 11 * MiB;
constexpr size_t WS_W2T = WS_WR + 2 * 48 * 1024 * 2;
constexpr size_t WS_WGU = 12 * MiB;
constexpr size_t WS_WD = 76 * MiB;
constexpr size_t WS_H = 108 * MiB;
constexpr size_t WS_KV = WS_H;
constexpr size_t WS_XB = 44 * MiB;
constexpr size_t WS_MIX = 172 * MiB;
constexpr size_t WS_SQ = 236 * MiB;
constexpr size_t WS_SK = 268 * MiB;
constexpr size_t WS_GQ = 300 * MiB;
constexpr size_t WS_GRS = 316 * MiB;
constexpr size_t WS_TT = 348 * MiB;
constexpr size_t WS_GLR = 428 * MiB;
constexpr size_t WS_ST = 429 * MiB;
constexpr size_t WS_DTOT = 461 * MiB;
constexpr size_t WS_ACT = 236 * MiB;
constexpr size_t WS_H8 = 272 * MiB;
constexpr size_t WS_Y = 308 * MiB;
constexpr size_t WS_LOCL = 462 * MiB;
constexpr size_t WS_CNTS = 467 * MiB;
constexpr size_t WS_GATE = 470 * MiB;
constexpr size_t WS_RSTD = WS_GATE + 512 * 1024;
constexpr size_t WS_RSTD1 = WS_GATE + 768 * 1024;
constexpr size_t WS_END = 472 * MiB;
constexpr int CW_TMO = 0, CW_CODE = 1;
constexpr int CW_BAR = 4096;
constexpr int CW_SBQ = 12288;
constexpr int CW_CNT = 16384;

constexpr int RING_OFF = 0, RING_BYTES = 131072;
constexpr int LDSCTL_OFF = RING_BYTES, MISC_OFF = LDSCTL_OFF + 320;
constexpr int TAB_OFF = LDSCTL_OFF + 1024;
constexpr int LDS_BYTES = 147456;
constexpr int T_CNT = 0, T_TBASE = 128, T_NT = 264, T_TILE_E = 272, T_ROWTAB = 272 + 320 * 4, NU_MAX = 6;
constexpr int T_RSTAB = T_ROWTAB + NU_MAX * 1024;
static_assert(TAB_OFF + T_RSTAB + NU_MAX * 256 * 4 <= LDS_BYTES, "LDS tables");

#define RLX_AGENT __ATOMIC_RELAXED, __HIP_MEMORY_SCOPE_AGENT
#define LDS_WAIT() asm volatile("s_waitcnt lgkmcnt(0)" ::: "memory")
#define VM_WAIT() asm volatile("s_waitcnt vmcnt(0)" ::: "memory")

__device__ __forceinline__ unsigned cvtpk(float lo, float hi) { f32x2_t v = {lo, hi}; bf16x2_t b = __builtin_convertvector(v, bf16x2_t); return __builtin_bit_cast(unsigned, b); }
__device__ __forceinline__ u32x2 pack8_fp8(const float* a) { int lo = __builtin_amdgcn_cvt_pk_fp8_f32(a[0], a[1], 0, false); lo = __builtin_amdgcn_cvt_pk_fp8_f32(a[2], a[3], lo, true);
    int hi = __builtin_amdgcn_cvt_pk_fp8_f32(a[4], a[5], 0, false); hi = __builtin_amdgcn_cvt_pk_fp8_f32(a[6], a[7], hi, true); u32x2 r; r.x = (unsigned)lo; r.y = (unsigned)hi; return r; }
__device__ __forceinline__ float bf2f(short s) { return __uint_as_float(((unsigned)(unsigned short)s) << 16); }
__device__ __forceinline__ bf16x8 pack8(const float* a) { u32x4 p; p.x = cvtpk(a[0], a[1]); p.y = cvtpk(a[2], a[3]); p.z = cvtpk(a[4], a[5]); p.w = cvtpk(a[6], a[7]); return __builtin_bit_cast(bf16x8, p); }
__device__ __forceinline__ int PI32(int i) { return 16 * ((i >> 2) & 1) + (i & 3) + 4 * (i >> 3); }
#define MFMA32(a, b, c) __builtin_amdgcn_mfma_f32_32x32x16_bf16((a), (b), (c), 0, 0, 0)
#define MFMA16(a, b, c) __builtin_amdgcn_mfma_f32_16x16x32_bf16((a), (b), (c), 0, 0, 0)
__device__ __forceinline__ void swap32(float x, float& lo, float& hi) { auto rr = __builtin_amdgcn_permlane32_swap(__float_as_uint(x), __float_as_uint(x), false, false); lo = __uint_as_float(rr[0]); hi = __uint_as_float(rr[1]); }

namespace pg8 {
#define PG8_LAS __attribute__((address_space(3)))
constexpr int BM = 256, BK = 64, HALF = 128, HTB = HALF * BK * 2, STAGE_BYTES = 8 * HTB, NXCD = 8, WGM = 8;
__host__ __device__ __forceinline__ int lds_byte(int r, int c) { const int st = (r >> 4) * 2 + (c >> 5), rr = r & 15, cc = c & 31, ob = rr * 64 + cc * 2; return st * 1024 + (ob ^ (((ob >> 9) & 1) << 5)); }
__host__ __device__ __forceinline__ void stage_rc(int b, int& R, int& C) { const int st = b / 1024, sb = b % 1024, swz = sb ^ (((sb >> 9) & 1) << 5); R = (st >> 1) * 16 + swz / 64; C = (st & 1) * 32 + (swz % 64) / 2; }
__host__ __device__ __forceinline__ int perm32(int rho) { const int n = rho >> 4, i = rho & 15; return 8 * (i >> 2) + 4 * n + (i & 3); }

struct Unit { int pm, pn, e, rt, nv; };

struct SchedDense {
    const char* A; const char* Bt; int K; int nM, nN, nwg, G, c;
    __device__ void init(const void* A_, const void* Bt_, int M, int N, int K_, int G_, int c_) { A = (const char*)A_; Bt = (const char*)Bt_; K = K_; nM = M / BM; nN = N / BM; nwg = nM * nN; G = G_; c = c_; }
    __device__ __forceinline__ bool next(int i, Unit& u) const {
        const long L = (long)i * G + c; if (L >= nwg) return false;
        int wgid = (int)L; { const int q = nwg / NXCD, r = nwg % NXCD, xcd = wgid % NXCD, off = wgid / NXCD; wgid = (xcd < r ? xcd * (q + 1) : r * (q + 1) + (xcd - r) * q) + off; }
        const int nig = WGM * nN, gid = wgid / nig, fm = gid * WGM, gsz = (nM - fm) < WGM ? (nM - fm) : WGM;
        u.pm = fm + ((wgid % nig) % gsz); u.pn = (wgid % nig) / gsz; u.e = 0; u.rt = 0; u.nv = 256; return true;
    }
    __device__ __forceinline__ const char* a_ptr(const Unit& u) const { return A + (size_t)u.pm * BM * K * 2; }
    __device__ __forceinline__ const char* b_ptr(const Unit& u) const { return Bt + (size_t)u.pn * BM * K * 2; }
    __device__ __forceinline__ void a_voff(int, const Unit&, int tid, unsigned (&v)[2][2]) const {
#pragma unroll
        for (int i = 0; i < 2; ++i) { int R, C; stage_rc(tid * 16 + i * 8192, R, C);
#pragma unroll
            for (int h = 0; h < 2; ++h) v[h][i] = (unsigned)((h * HALF + R) * K + C) * 2u; }
    }
};
template <bool GATHER> struct SchedMoE {
    const char* A; const char* Bt; int K; size_t bstride; int G, c;
    const PG8_LAS int* tab;
    __device__ __forceinline__ bool next(int i, Unit& u) const {
        const int L = i * G + c; const int NT = tab[T_NT / 4];
        if (L >= NT * 4) return false;
        const int tile = L >> 2; u.pm = tile; u.pn = L & 3; const int e = tab[T_TILE_E / 4 + tile]; u.e = e;
        u.rt = tile - tab[T_TBASE / 4 + e]; const int rem = tab[T_CNT / 4 + e] - u.rt * 256; u.nv = rem < 256 ? rem : 256; return true;
    }
    __device__ __forceinline__ const char* a_ptr(const Unit& u) const { return GATHER ? A : A + (size_t)u.pm * BM * K * 2; }
    __device__ __forceinline__ const char* b_ptr(const Unit& u) const { return Bt + (size_t)u.e * bstride + (size_t)u.pn * BM * K * 2; }
    __device__ __forceinline__ void a_voff(int ui, const Unit&, int tid, unsigned (&v)[2][2]) const {
        asm volatile("" : "+v"(tid));
#pragma unroll
        for (int i = 0; i < 2; ++i) { int R, C; stage_rc(tid * 16 + i * 8192, R, C);
#pragma unroll
            for (int h = 0; h < 2; ++h) {
                if (GATHER) { const int tok = tab[T_ROWTAB / 4 + ui * 256 + h * HALF + R] >> 1; v[h][i] = (unsigned)(tok * K + C) * 2u; }
                else v[h][i] = (unsigned)((h * HALF + R) * K + C) * 2u; } }
    }
};

template <class Epi, class Sched, bool TAIL = false, bool FP8 = false>
__device__ __forceinline__ void gemm_phase(PG8_LAS unsigned char* lds, const int K, const Sched& S, const Epi& E) {
    const int tid = threadIdx.x, wid = __builtin_amdgcn_readfirstlane(tid >> 6), lane = tid & 63, wr = wid >> 2, wc = wid & 3, fr = lane & 15, fq = lane >> 4;
    const int nt = K / BK;
    constexpr bool EARLY = !FP8;
    unsigned voffB[1][2];
#pragma unroll
    for (int i = 0; i < 2; ++i) { int R, C; stage_rc(tid * 16 + i * 8192, R, C); const int Rb = (R & ~31) + perm32(R & 31);
        voffB[0][i] = (unsigned)(Rb * K + C) * 2u; }
    const size_t hstepB = (size_t)HALF * K * 2;
    const size_t kstep = (size_t)(BK * 2);
    const unsigned ldsw = (unsigned)wid * 1024u;
    const int aoff = lds_byte(wr * 64 + fr, fq * 8), boff = lds_byte(wc * 32 + fr, fq * 8);
#define PG8_SA(b, h) (((b) * 2 + (h)) * HTB)
#define PG8_SB(b, h) ((4 + (b) * 2 + (h)) * HTB)
#define PG8_STAGE(bufoff, gbase, voff) do { _Pragma("unroll") for (int _i = 0; _i < 2; ++_i) \
        __builtin_amdgcn_global_load_lds((const unsigned*)((const char*)(gbase) + (voff)[_i]), (PG8_LAS unsigned*)(lds + (bufoff) + ldsw + _i * 8192), 16, 0, 0); } while (0)
#define PG8_RD16(off) (*(const PG8_LAS v4i*)(lds + (off)))
#define PG8_LDA(dst, b, h) do { _Pragma("unroll") for (int m = 0; m < 4; ++m) { \
        if constexpr (FP8) At8[m] = __builtin_shufflevector(PG8_RD16(PG8_SA(b, h) + aoff + m * 2048), PG8_RD16(PG8_SA(b, h) + aoff + m * 2048 + 1024), 0, 1, 2, 3, 4, 5, 6, 7); \
        else { _Pragma("unroll") for (int k = 0; k < 2; ++k) dst[m][k] = *(const PG8_LAS bf16x8*)(lds + PG8_SA(b, h) + aoff + m * 2048 + k * 1024); } } } while (0)
#define PG8_LDB(dst, b, h) do { _Pragma("unroll") for (int n = 0; n < 2; ++n) { \
        if constexpr (FP8) dst##8[n] = __builtin_shufflevector(PG8_RD16(PG8_SB(b, h) + boff + n * 2048), PG8_RD16(PG8_SB(b, h) + boff + n * 2048 + 1024), 0, 1, 2, 3, 4, 5, 6, 7); \
        else { _Pragma("unroll") for (int k = 0; k < 2; ++k) dst[n][k] = *(const PG8_LAS bf16x8*)(lds + PG8_SB(b, h) + boff + n * 2048 + k * 1024); } } } while (0)
#define PG8_MMA(ai, bj, At, Bt) do { __builtin_amdgcn_s_setprio(1); _Pragma("unroll") for (int m = 0; m < 4; ++m) _Pragma("unroll") for (int n = 0; n < 2; ++n) { \
        if constexpr (FP8) asm volatile("v_mfma_scale_f32_16x16x128_f8f6f4 %0, %1, %2, %0, %3, %3 op_sel_hi:[0,0,0]" : "+v"(acc[ai][bj][m][n]) : "v"(Bt##8[n]), "v"(At8[m]), "v"(sc1)); \
        else { _Pragma("unroll") for (int k = 0; k < 2; ++k) acc[ai][bj][m][n] = __builtin_amdgcn_mfma_f32_16x16x32_bf16(Bt[n][k], At[m][k], acc[ai][bj][m][n], 0, 0, 0); } } \
        __builtin_amdgcn_s_setprio(0); } while (0)
#define PG8_WAIT_V(n) asm volatile("s_waitcnt vmcnt(" #n ")" ::: "memory")
#define PG8_WAIT_L(n) asm volatile("s_waitcnt lgkmcnt(" #n ")" ::: "memory")
#define PG8_BAR __builtin_amdgcn_s_barrier()
#define PG8_SCHED __builtin_amdgcn_sched_barrier(0)
    Unit cur, nxt; int ui = 0;
    if (!S.next(0, cur)) return;
    f32x4 acc[2][2][4][2];
#pragma unroll
    for (int a = 0; a < 2; ++a)
#pragma unroll
        for (int b = 0; b < 2; ++b)
#pragma unroll
            for (int m = 0; m < 4; ++m)
#pragma unroll
                for (int n = 0; n < 2; ++n) acc[a][b][m][n] = (f32x4){0.f, 0.f, 0.f, 0.f};
    bf16x8 At[4][2], B0[2][2], B1[2][2];
    v8i At8[4], B08[2], B18[2];
    int sc1 = 0x7f7f7f7f; asm volatile("" : "+v"(sc1));
    unsigned vc[2][2], vn[2][2];
    S.a_voff(0, cur, tid, vc);
    const char* cA = S.a_ptr(cur); const char* cB = S.b_ptr(cur);
    PG8_STAGE(PG8_SB(0, 0), cB, voffB[0]); PG8_STAGE(PG8_SB(0, 1), (cB) + hstepB, voffB[0]); PG8_STAGE(PG8_SA(0, 0), cA, vc[0]); PG8_STAGE(PG8_SA(0, 1), cA, vc[1]);
    if (wr == 1) PG8_BAR;
    PG8_WAIT_V(2); PG8_BAR;
    PG8_STAGE(PG8_SB(1, 0), cB + kstep, voffB[0]); PG8_STAGE(PG8_SA(1, 0), cA + kstep, vc[0]); PG8_STAGE(PG8_SB(1, 1), (cB + kstep) + hstepB, voffB[0]);
    PG8_WAIT_V(6); PG8_BAR;
    for (;;) {
        const bool has_next = S.next(ui + 1, nxt);
        const char* nA = has_next ? S.a_ptr(nxt) : cA; const char* nB = has_next ? S.b_ptr(nxt) : cB;
        if (has_next) S.a_voff(ui + 1, nxt, tid, vn);
        else {
#pragma unroll
            for (int h = 0; h < 2; ++h)
#pragma unroll
                for (int i = 0; i < 2; ++i) vn[h][i] = vc[h][i]; }
        const bool full_hi = !TAIL || cur.nv > HALF;
        for (int t = 0; t < nt; t += 2) {
            const bool last = (t == nt - 2);
            int fl_ = __builtin_amdgcn_readfirstlane(EARLY ? (t | (ui == 0)) : 1); asm volatile("" : "+s"(fl_));
            const bool fresh = (fl_ == 0);
            const char* a1 = cA + (size_t)(t + 1) * kstep;
            const char* a2 = last ? nA : cA + (size_t)(t + 2) * kstep; const char* b2 = last ? nB : cB + (size_t)(t + 2) * kstep;
            const char* a3 = a2 + kstep; const char* b3 = b2 + kstep;
            unsigned w0[2], w1[2];
            w0[0] = last ? vn[0][0] : vc[0][0]; w0[1] = last ? vn[0][1] : vc[0][1]; w1[0] = last ? vn[1][0] : vc[1][0]; w1[1] = last ? vn[1][1] : vc[1][1];
            PG8_LDB(B0, 0, 0); PG8_LDB(B1, 0, 1); PG8_SCHED; PG8_LDA(At, 0, 0); if (!fresh) { PG8_STAGE(PG8_SA(1, 1), a1, vc[1]); PG8_WAIT_V(8); }
            PG8_WAIT_L(0); PG8_BAR; PG8_MMA(0, 0, At, B0); PG8_MMA(0, 1, At, B1); PG8_BAR; PG8_SCHED;
            PG8_LDA(At, 0, 1); PG8_STAGE(PG8_SB(0, 0), b2, voffB[0]); PG8_STAGE(PG8_SB(0, 1), (b2) + hstepB, voffB[0]); PG8_STAGE(PG8_SA(0, 0), a2, w0);
            if (!fresh) PG8_WAIT_V(8); PG8_WAIT_L(0); PG8_BAR; if (full_hi) { PG8_MMA(1, 0, At, B0); PG8_MMA(1, 1, At, B1); } PG8_BAR; PG8_SCHED;
            PG8_LDB(B0, 1, 0); PG8_LDB(B1, 1, 1); PG8_SCHED; PG8_LDA(At, 1, 0); PG8_STAGE(PG8_SA(0, 1), a2, w1);
            if (!fresh) PG8_WAIT_V(8); PG8_WAIT_L(0); PG8_BAR; PG8_MMA(0, 0, At, B0); PG8_MMA(0, 1, At, B1); PG8_BAR; PG8_SCHED;
            PG8_LDA(At, 1, 1); PG8_STAGE(PG8_SB(1, 0), b3, voffB[0]); PG8_STAGE(PG8_SB(1, 1), (b3) + hstepB, voffB[0]); PG8_STAGE(PG8_SA(1, 0), a3, w0);
            PG8_WAIT_V(8); PG8_WAIT_L(0); PG8_BAR; if (full_hi) { PG8_MMA(1, 0, At, B0); PG8_MMA(1, 1, At, B1); } PG8_BAR; PG8_SCHED;
        }
        if (wr == 0) PG8_BAR;
        if constexpr (EARLY) {
            PG8_STAGE(PG8_SA(1, 1), nA + kstep, vn[1]);
            PG8_WAIT_V(0); }
        if constexpr (FP8) asm volatile("s_nop 15\n\ts_nop 15" ::: "memory");
        { int t2_ = threadIdx.x; asm volatile("" : "+v"(t2_)); E(acc, cur, ui, wr, wc, t2_ & 15, (t2_ >> 4) & 3); }
        if (!has_next) break;
#pragma unroll
        for (int a = 0; a < 2; ++a)
#pragma unroll
            for (int b = 0; b < 2; ++b)
#pragma unroll
                for (int m = 0; m < 4; ++m)
#pragma unroll
                    for (int n = 0; n < 2; ++n) acc[a][b][m][n] = (f32x4){0.f, 0.f, 0.f, 0.f};
        cur = nxt; cA = nA; cB = nB; ++ui;
#pragma unroll
        for (int h = 0; h < 2; ++h)
#pragma unroll
            for (int i = 0; i < 2; ++i) vc[h][i] = vn[h][i];
        if (wr == 1) PG8_BAR;
    }
    PG8_WAIT_V(0);
    PG8_BAR;
#undef PG8_SA
#undef PG8_SB
#undef PG8_STAGE
#undef PG8_LDA
#undef PG8_LDB
#undef PG8_MMA
#undef PG8_RD16
#undef PG8_WAIT_V
#undef PG8_WAIT_L
#undef PG8_BAR
#undef PG8_SCHED
}

struct EpiBf16 {
    bf16* O; int ldc;
    __device__ __forceinline__ void operator()(const f32x4 (&acc)[2][2][4][2], const Unit& u, int, int wr, int wc, int fr, int fq) const {
        const int row0 = u.pm * BM + wr * 64 + fr, col0 = u.pn * BM + wc * 32 + 8 * fq;
#pragma unroll
        for (int ai = 0; ai < 2; ++ai)
#pragma unroll
            for (int m = 0; m < 4; ++m) { bf16* rowp = O + (size_t)(row0 + ai * HALF + m * 16) * ldc + col0;
#pragma unroll
                for (int bj = 0; bj < 2; ++bj) { const f32x4 v0 = acc[ai][bj][m][0], v1 = acc[ai][bj][m][1];
                    u32x4 w; w.x = cvtpk(v0[0], v0[1]); w.y = cvtpk(v0[2], v0[3]); w.z = cvtpk(v1[0], v1[1]); w.w = cvtpk(v1[2], v1[3]);
                    *(u32x4*)(rowp + bj * HALF) = w; } }
    }
};
struct EpiTT {
    bf16* O; const float* RS;
    __device__ __forceinline__ void operator()(const f32x4 (&acc)[2][2][4][2], const Unit& u, int, int wr, int wc, int fr, int fq) const {
        const int row0 = u.pm * BM + wr * 64 + fr, tokb0 = u.pn * 8 + wc;
        f32x4 rs[2][2];
#pragma unroll
        for (int bj = 0; bj < 2; ++bj) { const float* rp = RS + (size_t)(tokb0 + 4 * bj) * 32 + 8 * fq; rs[bj][0] = *(const f32x4*)rp; rs[bj][1] = *(const f32x4*)(rp + 4); }
#pragma unroll
        for (int ai = 0; ai < 2; ++ai)
#pragma unroll
            for (int m = 0; m < 4; ++m) { const int col = row0 + ai * HALF + m * 16;
#pragma unroll
                for (int bj = 0; bj < 2; ++bj) { const f32x4 v0 = acc[ai][bj][m][0] * rs[bj][0], v1 = acc[ai][bj][m][1] * rs[bj][1];
                    u32x4 w; w.x = cvtpk(v0[0], v0[1]); w.y = cvtpk(v0[2], v0[3]); w.z = cvtpk(v1[0], v1[1]); w.w = cvtpk(v1[2], v1[3]);
                    *(u32x4*)(O + ((size_t)(tokb0 + 4 * bj) * 1280 + col) * 32 + 8 * fq) = w; } }
    }
};
struct EpiA {
    bf16 *SQ, *SK, *GQ, *GRS; const float *gq_norm, *gk_norm; const float* RS;
    __device__ __forceinline__ void operator()(const f32x4 (&acc)[2][2][4][2], const Unit& u, int, int wr, int wc, int fr, int fq) const {
        const int pn = u.pn; const int row0 = u.pm * BM + wr * 64 + fr;
        bf16* base; int ldc, colt; int mode;
        float scale = 1.f; const float* gain = nullptr;
        if (pn < 2)      { base = SQ; ldc = 512; colt = pn * 256; mode = 0; gain = gq_norm; scale = 0.125f * LOG2E; }
        else if (pn < 4) { base = SK; ldc = 512; colt = (pn - 2) * 256; mode = 0; gain = gk_norm; scale = 1.f; }
        else if (pn < 5) { base = GQ; ldc = 256; colt = 0; mode = 1; scale = 0.125f; }
        else             { base = GRS; ldc = 512; colt = (pn - 5) * 256; mode = 2; }
        const int col0 = colt + wc * 64 + 8 * fq;
        f32x4 gv[2][2];
#pragma unroll
        for (int bj = 0; bj < 2; ++bj)
#pragma unroll
            for (int n = 0; n < 2; ++n) { if (mode == 0) { gv[bj][n] = *(const f32x4*)(gain + 32 * bj + 8 * fq + 4 * n); gv[bj][n] = gv[bj][n] * scale; } else gv[bj][n] = (f32x4){scale, scale, scale, scale}; }
        float rs1v[2][4];
#pragma unroll
        for (int ai = 0; ai < 2; ++ai)
#pragma unroll
            for (int m = 0; m < 4; ++m) rs1v[ai][m] = RS[row0 + ai * HALF + m * 16];
#pragma unroll
        for (int ai = 0; ai < 2; ++ai)
#pragma unroll
            for (int m = 0; m < 4; ++m) {
                const float rs1 = rs1v[ai][m]; float rs = rs1;
                if (mode == 0) { float s = 0.f;
#pragma unroll
                    for (int bj = 0; bj < 2; ++bj)
#pragma unroll
                        for (int n = 0; n < 2; ++n) { const f32x4 x = acc[ai][bj][m][n]; s += (x[0] * x[0] + x[1] * x[1]) + (x[2] * x[2] + x[3] * x[3]); }
                    s += __shfl_xor(s, 16); s += __shfl_xor(s, 32);
                    rs = rs1 * __builtin_amdgcn_rsqf(rs1 * rs1 * s * (1.f / 64.f) + EPS); }
                bf16* rowp = base + (size_t)(row0 + ai * HALF + m * 16) * ldc + col0;
#pragma unroll
                for (int bj = 0; bj < 2; ++bj) { f32x4 v0 = acc[ai][bj][m][0], v1 = acc[ai][bj][m][1];
                    if (mode == 2) {
#pragma unroll
                        for (int e = 0; e < 4; ++e) { v0[e] *= rs1; v1[e] *= rs1; v0[e] = v0[e] * __builtin_amdgcn_rcpf(1.f + __builtin_amdgcn_exp2f(-v0[e] * LOG2E)); v1[e] = v1[e] * __builtin_amdgcn_rcpf(1.f + __builtin_amdgcn_exp2f(-v1[e] * LOG2E)); }
                    } else { v0 = v0 * rs * gv[bj][0]; v1 = v1 * rs * gv[bj][1]; }
                    u32x4 w; w.x = cvtpk(v0[0], v0[1]); w.y = cvtpk(v0[2], v0[3]); w.z = cvtpk(v1[0], v1[1]); w.w = cvtpk(v1[2], v1[3]);
                    *(u32x4*)(rowp + bj * 32) = w; } }
    }
};
struct EpiH {
    const bf16* XB; bf16* H; unsigned char* H8;
    __device__ __forceinline__ void operator()(const f32x4 (&acc)[2][2][4][2], const Unit& u, int, int wr, int wc, int fr, int fq) const {
        const int row0 = u.pm * BM + wr * 64 + fr, col0 = u.pn * BM + wc * 32 + 8 * fq;
#pragma unroll
        for (int ai = 0; ai < 2; ++ai) {
            u32x2 h8[4][2];
            bf16x8 xv[4][2];
#pragma unroll
            for (int m = 0; m < 4; ++m) { const size_t off = (size_t)(row0 + ai * HALF + m * 16) * DM + col0;
#pragma unroll
                for (int bj = 0; bj < 2; ++bj) xv[m][bj] = *(const bf16x8*)(XB + off + bj * HALF); }
#pragma unroll
            for (int m = 0; m < 4; ++m) { const size_t off = (size_t)(row0 + ai * HALF + m * 16) * DM + col0;
#pragma unroll
                for (int bj = 0; bj < 2; ++bj) { const bf16x8 xx = xv[m][bj];
                    const f32x4 v0 = acc[ai][bj][m][0] + (f32x4){bf2f(xx[0]), bf2f(xx[1]), bf2f(xx[2]), bf2f(xx[3])}, v1 = acc[ai][bj][m][1] + (f32x4){bf2f(xx[4]), bf2f(xx[5]), bf2f(xx[6]), bf2f(xx[7])};
                    u32x4 w; w.x = cvtpk(v0[0], v0[1]); w.y = cvtpk(v0[2], v0[3]); w.z = cvtpk(v1[0], v1[1]); w.w = cvtpk(v1[2], v1[3]);
                    *(u32x4*)(H + off + bj * HALF) = w;
                    const float f8[8] = {v0[0], v0[1], v0[2], v0[3], v1[0], v1[1], v1[2], v1[3]};
                    h8[m][bj] = pack8_fp8(f8); } }
#pragma unroll
            for (int mp = 0; mp < 2; ++mp)
#pragma unroll
                for (int bj = 0; bj < 2; ++bj) {
                    const auto r0 = __builtin_amdgcn_permlane16_swap(h8[2 * mp][bj].x, h8[2 * mp + 1][bj].x, false, false);
                    const auto r1 = __builtin_amdgcn_permlane16_swap(h8[2 * mp][bj].y, h8[2 * mp + 1][bj].y, false, false);
                    u32x4 w8; w8.x = r0[0]; w8.y = r1[0]; w8.z = r0[1]; w8.w = r1[1];
                    const size_t off8 = (size_t)(row0 + ai * HALF + (2 * mp + (fq & 1)) * 16) * DM + u.pn * BM + wc * 32 + 8 * (fq & ~1) + bj * HALF;
                    *(u32x4*)(H8 + off8) = w8; }
        }
    }
};
struct EpiGU {
    unsigned char* ACT; const float* RSTD; const PG8_LAS int* tab;
    __device__ __forceinline__ void operator()(const f32x4 (&acc)[2][2][4][2], const Unit& u, int ui, int wr, int wc, int fr, int fq) const {
        const int col0 = u.pn * 128 + wc * 32 + 8 * (fq & ~1); const int odd = fq & 1;
        float rsv[2][4];
#pragma unroll
        for (int ai = 0; ai < 2; ++ai)
#pragma unroll
            for (int m = 0; m < 4; ++m) { const int rl = ai * HALF + wr * 64 + m * 16 + fr; rsv[ai][m] = ((const PG8_LAS float*)tab)[T_RSTAB / 4 + ui * 256 + rl] * (1.f / WGU_SC); }
#pragma unroll
        for (int ai = 0; ai < 2; ++ai)
#pragma unroll
            for (int mp = 0; mp < 2; ++mp) {
                u32x2 pk[2];
#pragma unroll
                for (int q = 0; q < 2; ++q) { const int m = 2 * mp + q; const float rs = rsv[ai][m];
                    f32x4 g0 = acc[ai][0][m][0] * rs, g1 = acc[ai][0][m][1] * rs, u0 = acc[ai][1][m][0] * rs, u1 = acc[ai][1][m][1] * rs;
#pragma unroll
                    for (int e = 0; e < 4; ++e) { g0[e] = g0[e] * __builtin_amdgcn_rcpf(1.f + __builtin_amdgcn_exp2f(-g0[e] * LOG2E)) * u0[e]; g1[e] = g1[e] * __builtin_amdgcn_rcpf(1.f + __builtin_amdgcn_exp2f(-g1[e] * LOG2E)) * u1[e]; }
                    float f8[8] = {g0[0] * ACT_SC, g0[1] * ACT_SC, g0[2] * ACT_SC, g0[3] * ACT_SC, g1[0] * ACT_SC, g1[1] * ACT_SC, g1[2] * ACT_SC, g1[3] * ACT_SC};
#pragma unroll
                    for (int e = 0; e < 8; ++e) f8[e] = __builtin_fminf(__builtin_fmaxf(f8[e], -448.f), 448.f);
                    pk[q] = pack8_fp8(f8); }
                const auto r0 = __builtin_amdgcn_permlane16_swap(pk[0].x, pk[1].x, false, false);
                const auto r1 = __builtin_amdgcn_permlane16_swap(pk[0].y, pk[1].y, false, false);
                u32x4 w; w.x = r0[0]; w.y = r1[0]; w.z = r0[1]; w.w = r1[1];
                const int rl = ai * HALF + wr * 64 + (2 * mp + odd) * 16 + fr;
                if (rl < u.nv) *(u32x4*)(ACT + (size_t)(u.pm * 256 + rl) * DEXP + col0) = w; }
    }
};
struct EpiDown {
    unsigned char* Y; const PG8_LAS int* tab;
    __device__ __forceinline__ void operator()(const f32x4 (&acc)[2][2][4][2], const Unit& u, int ui, int wr, int wc, int fr, int fq) const {
        const int col0 = u.pn * BM + wc * 32 + 8 * (fq & ~1); const float sc = Y_SC / (WD_SC * ACT_SC); const int odd = fq & 1;
#pragma unroll
        for (int ai = 0; ai < 2; ++ai)
#pragma unroll
            for (int mp = 0; mp < 2; ++mp) { const int rl = ai * HALF + wr * 64 + (2 * mp + odd) * 16 + fr;
                const bool ok = rl < u.nv; const unsigned ts = (unsigned)tab[T_ROWTAB / 4 + ui * 256 + (ok ? rl : 0)];
                unsigned char* rowp = Y + (size_t)ts * DM + col0;
#pragma unroll
                for (int bj = 0; bj < 2; ++bj) {
                    u32x2 pk[2];
#pragma unroll
                    for (int q = 0; q < 2; ++q) { const f32x4 v0 = acc[ai][bj][2 * mp + q][0] * sc, v1 = acc[ai][bj][2 * mp + q][1] * sc;
                        const float f8[8] = {v0[0], v0[1], v0[2], v0[3], v1[0], v1[1], v1[2], v1[3]}; pk[q] = pack8_fp8(f8); }
                    const auto r0 = __builtin_amdgcn_permlane16_swap(pk[0].x, pk[1].x, false, false);
                    const auto r1 = __builtin_amdgcn_permlane16_swap(pk[0].y, pk[1].y, false, false);
                    u32x4 w; w.x = r0[0]; w.y = r1[0]; w.z = r0[1]; w.w = r1[1];
                    if (ok) *(u32x4*)(rowp + bj * HALF) = w; } }
    }
};
}

#define XB_TMO      128
#define XB_XCNT(j)  (256  + 64 * (j))
#define XB_XSUB(j)  (1280 + 64 * (j))
#define XB_XGEN(j)  (2304 + 64 * (j))
#define XB_TOP      3328
#define XB_TOPGEN   3392
#define XCD_BAR_WORDS 3456
#define XB_SPIN_CAP (1u << 18)
__device__ __forceinline__ unsigned xb_ld(unsigned* p)              { return __hip_atomic_load(p, __ATOMIC_RELAXED, __HIP_MEMORY_SCOPE_AGENT); }
__device__ __forceinline__ unsigned xb_add(unsigned* p, unsigned v) { return __hip_atomic_fetch_add(p, v, __ATOMIC_RELAXED, __HIP_MEMORY_SCOPE_AGENT); }
__device__ __forceinline__ unsigned xb_xcc_id() { return (unsigned)__builtin_amdgcn_s_getreg((3 << 11) | 20) & 0xFu; }
#define XB_SPIN(cond, bar) do { unsigned _sp = 0; while (cond) { __builtin_amdgcn_s_sleep(1); \
    if ((++_sp & 255u) == 0u) { if (xb_ld(&(bar)[XB_TMO])) break; if (_sp > XB_SPIN_CAP) { atomicAdd(&(bar)[XB_TMO], 1u); break; } } } } while (0)
struct XcdBarrier { unsigned* bar; unsigned x; volatile LAS unsigned* st; };
__device__ __forceinline__ XcdBarrier xcd_barrier_post(unsigned* bar, volatile LAS unsigned* st) {
    XcdBarrier b; b.bar = bar; b.x = xb_xcc_id(); b.st = st;
    if (threadIdx.x == 0) (void)xb_add(&bar[XB_XCNT(b.x)], 1u);
    return b;
}
__device__ __forceinline__ void xcd_barrier_complete(unsigned* bar, unsigned x, unsigned& nloc, unsigned& nx) {
    const unsigned G = gridDim.x * gridDim.y * gridDim.z;
    unsigned sum, cnt, mine, sp = 0u;
    for (;;) {
        sum = 0u; cnt = 0u; mine = 0u;
#pragma unroll
        for (unsigned j = 0; j < 16; ++j) { const unsigned c = xb_ld(&bar[XB_XCNT(j)]); sum += c; cnt += (c > 0u) ? 1u : 0u; mine = (j == x) ? c : mine; }
        if (sum == G) break;
        __builtin_amdgcn_s_sleep(1);
        if ((++sp & 255u) == 0u) { if (xb_ld(&bar[XB_TMO])) break; if (sp > XB_SPIN_CAP) { atomicAdd(&bar[XB_TMO], 1u); break; } }
    }
    nloc = mine > 0u ? mine : 1u; nx = cnt > 0u ? cnt : 1u;
}
__device__ __forceinline__ void xcd_barrier(const XcdBarrier& b) {
    asm volatile("s_waitcnt vmcnt(0)" ::: "memory");
    __syncthreads();
    if (threadIdx.x == 0) {
        unsigned* bar = b.bar;
        __builtin_amdgcn_s_waitcnt(0);
        unsigned nloc = b.st[0], nx = b.st[1];
        if (nloc == 0u) { xcd_barrier_complete(bar, b.x, nloc, nx); b.st[0] = nloc; b.st[1] = nx; }
        const unsigned old = xb_add(&bar[XB_XSUB(b.x)], 1u);
        const unsigned gen = old / nloc;
        if (old + 1u == (gen + 1u) * nloc) {
            __builtin_amdgcn_fence(__ATOMIC_RELEASE, "agent");
            asm volatile("s_waitcnt vmcnt(0)" ::: "memory");
            const unsigned og = xb_add(&bar[XB_TOP], 1u);
            const unsigned tg = og / nx;
            if (og + 1u == (tg + 1u) * nx) xb_add(&bar[XB_TOPGEN], 1u);
            else XB_SPIN(xb_ld(&bar[XB_TOPGEN]) == tg, bar);
            __builtin_amdgcn_fence(__ATOMIC_ACQUIRE, "agent");
            xb_add(&bar[XB_XGEN(b.x)], 1u);
            asm volatile("s_waitcnt vmcnt(0)" ::: "memory");
        } else {
            XB_SPIN(xb_ld(&bar[XB_XGEN(b.x)]) == gen, bar);
            __builtin_amdgcn_fence(__ATOMIC_ACQUIRE, "agent");
            asm volatile("s_waitcnt vmcnt(0)" ::: "memory");
        }
    }
    __syncthreads();
}

__device__ __forceinline__ void xcd_barrier_arrive(const XcdBarrier& b, volatile LAS unsigned* sv) {
    asm volatile("s_waitcnt vmcnt(0)" ::: "memory");
    __syncthreads();
    if (threadIdx.x == 0) {
        unsigned* bar = b.bar;
        __builtin_amdgcn_s_waitcnt(0);
        unsigned nloc = b.st[0], nx = b.st[1];
        if (nloc == 0u) { xcd_barrier_complete(bar, b.x, nloc, nx); b.st[0] = nloc; b.st[1] = nx; }
        const unsigned old = xb_add(&bar[XB_XSUB(b.x)], 1u);
        const unsigned gen = old / nloc;
        unsigned role = 0u, tg = 0u;
        if (old + 1u == (gen + 1u) * nloc) {
            __builtin_amdgcn_fence(__ATOMIC_RELEASE, "agent");
            asm volatile("s_waitcnt vmcnt(0)" ::: "memory");
            const unsigned og = xb_add(&bar[XB_TOP], 1u);
            tg = og / nx;
            if (og + 1u == (tg + 1u) * nx) { xb_add(&bar[XB_TOPGEN], 1u); role = 2u; } else role = 1u;
        }
        sv[0] = role; sv[1] = gen; sv[2] = tg;
    }
}
__device__ __forceinline__ void xcd_barrier_wait(const XcdBarrier& b, volatile LAS unsigned* sv) {
    asm volatile("s_waitcnt vmcnt(0)" ::: "memory");
    __syncthreads();
    if (threadIdx.x == 0) {
        unsigned* bar = b.bar; const unsigned role = sv[0], gen = sv[1], tg = sv[2];
        if (role != 0u) {
            if (role == 1u) XB_SPIN(xb_ld(&bar[XB_TOPGEN]) == tg, bar);
            __builtin_amdgcn_fence(__ATOMIC_ACQUIRE, "agent");
            xb_add(&bar[XB_XGEN(b.x)], 1u);
            asm volatile("s_waitcnt vmcnt(0)" ::: "memory");
        } else {
            XB_SPIN(xb_ld(&bar[XB_XGEN(b.x)]) == gen, bar);
            __builtin_amdgcn_fence(__ATOMIC_ACQUIRE, "agent");
            asm volatile("s_waitcnt vmcnt(0)" ::: "memory");
        }
    }
    __syncthreads();
}

__device__ __forceinline__ float wave_sum(float v) {
#pragma unroll
    for (int o = 1; o < 64; o <<= 1) v += __shfl_xor(v, o);
    return v;
}
__device__ __forceinline__ void tr_item(const float* src, int srcN, int k0, int n0, bf16* dst, int drow0, int dK, const float* kscale, LAS float* scr, int lane) {
    float w[32];
    const float* sp = src + (size_t)(k0 + (lane >> 5)) * srcN + n0 + (lane & 31);
#pragma unroll
    for (int i = 0; i < 32; ++i) w[i] = __builtin_nontemporal_load(sp + (size_t)(2 * i) * srcN);
    if (kscale) { const float ksv = kscale[k0 + lane];
#pragma unroll
        for (int i = 0; i < 32; ++i) { const float a = __int_as_float(__builtin_amdgcn_readlane(__float_as_int(ksv), 2 * i)), b = __int_as_float(__builtin_amdgcn_readlane(__float_as_int(ksv), 2 * i + 1)); w[i] *= (lane >> 5) ? b : a; } }
#pragma unroll
    for (int i = 0; i < 32; ++i) scr[(2 * i + (lane >> 5)) * 33 + (lane & 31)] = w[i];
    LDS_WAIT(); asm volatile("" ::: "memory");
    const int c = lane & 7;
#pragma unroll
    for (int j = 0; j < 4; ++j) { const int n = (lane >> 3) + 8 * j; const LAS float* s = scr + (8 * c) * 33 + n;
        u32x4 o; o.x = cvtpk(s[0 * 33], s[1 * 33]); o.y = cvtpk(s[2 * 33], s[3 * 33]); o.z = cvtpk(s[4 * 33], s[5 * 33]); o.w = cvtpk(s[6 * 33], s[7 * 33]);
        *(GAS u32x4*)(dst + (size_t)(drow0 + n) * dK + k0 + 8 * c) = o; }
    LDS_WAIT(); asm volatile("" ::: "memory");
}

__device__ __forceinline__ void tr_item8(const float* src, int srcN, int k0, int n0, unsigned char* dst, int drow0, int dK, const float* kscale, float scale, LAS float* scr, int lane) {
    float w[32];
    const float* sp = src + (size_t)(k0 + (lane >> 5)) * srcN + n0 + (lane & 31);
#pragma unroll
    for (int i = 0; i < 32; ++i) w[i] = __builtin_nontemporal_load(sp + (size_t)(2 * i) * srcN);
    float ksv = scale; if (kscale) ksv *= kscale[k0 + lane];
#pragma unroll
    for (int i = 0; i < 32; ++i) { const float a = __int_as_float(__builtin_amdgcn_readlane(__float_as_int(ksv), 2 * i)), b = __int_as_float(__builtin_amdgcn_readlane(__float_as_int(ksv), 2 * i + 1)); w[i] *= (lane >> 5) ? b : a; }
#pragma unroll
    for (int i = 0; i < 32; ++i) scr[(2 * i + (lane >> 5)) * 33 + (lane & 31)] = w[i];
    LDS_WAIT(); asm volatile("" ::: "memory");
#pragma unroll
    for (int j = 0; j < 2; ++j) { const int idx = lane + 64 * j, n = idx >> 2, c = idx & 3; const LAS float* sc_ = scr + (16 * c) * 33 + n;
        float f[16];
#pragma unroll
        for (int i = 0; i < 16; ++i) f[i] = sc_[i * 33];
        const u32x2 lo = pack8_fp8(f), hi = pack8_fp8(f + 8);
        u32x4 o; o.x = lo.x; o.y = lo.y; o.z = hi.x; o.w = hi.y;
        *(GAS u32x4*)(dst + (size_t)(drow0 + n) * dK + k0 + 16 * c) = o; }
    LDS_WAIT(); asm volatile("" ::: "memory");
}

struct Ptrs {
    const float *x, *attn_g, *w_in, *sbq_g, *sbk_g, *sbo_g, *w2, *gate_b, *glan_g, *w_out, *ffn_g, *rg_w, *rg_b, *re_w, *re_b, *wg, *wu, *wd;
    float* out; unsigned char* ws;
};

constexpr int SB_SPAN = 14, SB_VOFF = SB_SPAN * 4096;
__device__ __forceinline__ int sb_keyK(int r) { return ((r >> 1) & 3) | (((r >> 4) & 1) << 2); }
__device__ __forceinline__ int sb_keyV(int r) { return ((r >> 2) & 1) | (((r >> 4) & 1) << 1); }
__device__ __forceinline__ void sb_round(LAS unsigned char* lds, const bf16* SQ, const bf16* SK, const bf16* TT, const float* gout, bf16* MIX, int b, int h, int qg, int tid, int wave, int lane) {
    const int il = lane & 31, hi = lane >> 5, pil = PI32(il);
    const int qt = 8 * qg + wave;
    const size_t row0 = (size_t)b * SEQ + (size_t)qt * 32;
    bf16x8 qf[4];
    { const bf16* qp = SQ + (row0 + il) * 512 + h * 64 + 32 * hi;
#pragma unroll
      for (int s = 0; s < 4; ++s) qf[s] = *(const bf16x8*)(qp + 8 * s); }
    const int lo = (8 * qg - 6) > 0 ? (8 * qg - 6) : 0, nblk = 8 * qg + 8 - lo;
    {
        u32x4 st[SB_SPAN];
        const bool isK = tid < 256; const int q = tid - 256;
        const bf16* src = isK ? SK + ((size_t)b * SEQ + (size_t)lo * 32 + (tid >> 3)) * 512 + h * 64 + 8 * (tid & 7)
                              : TT + ((size_t)(b * (SEQ / 32) + lo) * NB + h * 64 + (q >> 2)) * 32 + 8 * (q & 3);
        const size_t bstep = isK ? (size_t)32 * 512 : (size_t)NB * 32;
#pragma unroll
        for (int i = 0; i < SB_SPAN; ++i) if (i < nblk) st[i] = *(const u32x4*)(src + (size_t)i * bstep);
        const int r = isK ? (tid >> 3) : (q >> 2);
        const unsigned dst = isK ? (unsigned)(r * 128 + (((tid & 7) ^ sb_keyK(r)) << 4)) : (unsigned)(SB_VOFF + r * 64 + (((q & 3) ^ sb_keyV(r & 31)) << 4));
#pragma unroll
        for (int i = 0; i < SB_SPAN; ++i) if (i < nblk) *(LAS u32x4*)(lds + dst + i * 4096) = st[i];
    }
    __syncthreads();
    f32x16 o0, o1;
#pragma unroll
    for (int r = 0; r < 16; ++r) { o0[r] = 0.f; o1[r] = 0.f; }
    float R = 1.f;
#define SB_MATH(KC, VC, kb_) do { \
        f32x16 z; \
        _Pragma("unroll") for (int r = 0; r < 16; ++r) z[r] = 0.f; \
        _Pragma("unroll") for (int s = 0; s < 4; ++s) z = MFMA32(KC[s], qf[s], z); \
        float beta[16], omb[16]; \
        const bool diag = ((kb_) == qt); \
        _Pragma("unroll") for (int r = 0; r < 16; ++r) { \
            const float zz = z[r]; const float t = __builtin_amdgcn_exp2f(-__builtin_fabsf(zz)); const float rr = __builtin_amdgcn_rcpf(1.f + t); const float sm = t * rr; \
            const bool pos = zz >= 0.f; float be = pos ? rr : sm; float om = pos ? sm : rr; \
            if (diag) { const bool valid = (16 * hi + r) < il; be = valid ? be : 0.f; om = valid ? om : 1.f; } \
            beta[r] = be; omb[r] = om; } \
        float e[16]; e[15] = 1.f; \
        _Pragma("unroll") for (int r = 14; r >= 0; --r) e[r] = e[r + 1] * omb[r + 1]; \
        const float P16 = e[0] * omb[0]; \
        float Plo, Phi; swap32(P16, Plo, Phi); \
        const float base = R * (hi ? 1.f : Phi); \
        float a[16]; \
        _Pragma("unroll") for (int r = 0; r < 16; ++r) a[r] = beta[r] * e[r] * base; \
        R = R * (Plo * Phi); \
        const bf16x8 p0 = pack8(a), p1 = pack8(a + 8); \
        o0 = MFMA32(VC[0][0], p0, o0); o0 = MFMA32(VC[0][1], p1, o0); \
        o1 = MFMA32(VC[1][0], p0, o1); o1 = MFMA32(VC[1][1], p1, o1); } while (0)
    bool fin = false;
    {
        const unsigned kbase = (unsigned)(pil * 128), vbase = (unsigned)(SB_VOFF + pil * 64);
        unsigned kx[4], vx[2];
#pragma unroll
        for (int s = 0; s < 4; ++s) kx[s] = (unsigned)(((4 * hi + s) ^ sb_keyK(pil)) << 4);
#pragma unroll
        for (int s = 0; s < 2; ++s) vx[s] = (unsigned)(((2 * hi + s) ^ sb_keyV(pil)) << 4);
        for (int kb = qt; ; --kb) {
            const unsigned so = (unsigned)(kb - lo) * 4096u;
            bf16x8 kf[4], vf[2][2];
#pragma unroll
            for (int s = 0; s < 4; ++s) kf[s] = *(const LAS bf16x8*)(lds + so + kbase + kx[s]);
#pragma unroll
            for (int dt = 0; dt < 2; ++dt)
#pragma unroll
                for (int s = 0; s < 2; ++s) vf[dt][s] = *(const LAS bf16x8*)(lds + so + vbase + dt * 2048 + vx[s]);
            SB_MATH(kf, vf, kb);
            if (kb == 0 || __all(R == 0.f)) { fin = true; break; }
            if (kb == lo) break;
        }
    }
    if (!fin) {
        for (int kb = lo - 1; ; --kb) {
            bf16x8 kf[4], vf[2][2];
            const bf16* kp = SK + ((size_t)b * SEQ + (size_t)kb * 32 + pil) * 512 + h * 64 + 32 * hi;
#pragma unroll
            for (int s = 0; s < 4; ++s) kf[s] = *(const bf16x8*)(kp + 8 * s);
            const bf16* vp = TT + ((size_t)(b * (SEQ / 32) + kb) * NB + h * 64 + pil) * 32 + 16 * hi;
#pragma unroll
            for (int dt = 0; dt < 2; ++dt)
#pragma unroll
                for (int s = 0; s < 2; ++s) vf[dt][s] = *(const bf16x8*)(vp + dt * 32 * 32 + 8 * s);
            SB_MATH(kf, vf, kb);
            if (kb == 0 || __all(R == 0.f)) break;
        }
    }
#undef SB_MATH
    float ss = 0.f;
#pragma unroll
    for (int r = 0; r < 16; ++r) ss += o0[r] * o0[r] + o1[r] * o1[r];
    float slo, shi; swap32(ss, slo, shi);
    const float rstd = __builtin_amdgcn_rsqf((slo + shi) * (1.f / 64.f) + EPS);
    bf16* op = MIX + (row0 + il) * DM + h * 64 + 16 * hi;
#pragma unroll
    for (int dt = 0; dt < 2; ++dt) {
        float v[16];
#pragma unroll
        for (int r4 = 0; r4 < 4; ++r4) { const f32x4 g = *(const f32x4*)(gout + 32 * dt + 16 * hi + 4 * r4);
#pragma unroll
            for (int e2 = 0; e2 < 4; ++e2) v[4 * r4 + e2] = (dt ? o1[4 * r4 + e2] : o0[4 * r4 + e2]) * rstd * g[e2]; }
        *(bf16x8*)(op + 32 * dt) = pack8(v); *(bf16x8*)(op + 32 * dt + 8) = pack8(v + 8);
    }
    __syncthreads();
}

__device__ __forceinline__ void gla_a(const bf16* GLR, const bf16* W2T, const float* gate_b, const bf16* TT, bf16* KV, float* DTOT, int bh, int j, int lane) {
    const int il = lane & 31, hi = lane >> 5, pil = PI32(il);
    const int b = bh >> 2, h = bh & 3;
    const size_t t0 = (size_t)b * SEQ + (size_t)j * 64;
    bf16x8 gf[2], wf[2], gkf[2][2][2], bvf[4][4]; float bias[2];
#pragma unroll
    for (int ch = 0; ch < 2; ++ch) gf[ch] = *(const bf16x8*)(GLR + (t0 + 32 * ch + pil) * 16 + 8 * hi);
#pragma unroll
    for (int kh = 0; kh < 2; ++kh) { const int kcol = 64 * h + 32 * kh + pil; wf[kh] = *(const bf16x8*)(W2T + kcol * 16 + 8 * hi); bias[kh] = gate_b[kcol];
        const bf16* gkp = TT + ((t0 >> 5) * NB + 512 + kcol) * 32 + 16 * hi;
#pragma unroll
        for (int ch = 0; ch < 2; ++ch) { gkf[kh][ch][0] = *(const bf16x8*)(gkp + ch * NB * 32); gkf[kh][ch][1] = *(const bf16x8*)(gkp + ch * NB * 32 + 8); } }
#pragma unroll
    for (int vq = 0; vq < 4; ++vq) { const bf16* vp = TT + ((t0 >> 5) * NB + 768 + 128 * h + 32 * vq + il) * 32 + 16 * hi;
#pragma unroll
        for (int s = 0; s < 4; ++s) bvf[vq][s] = *(const bf16x8*)(vp + (s >> 1) * NB * 32 + 8 * (s & 1)); }
    bf16x8 akf[2][4];
#pragma unroll
    for (int kh = 0; kh < 2; ++kh) {
        const int kcol = 64 * h + 32 * kh + pil;
        float cs[2][16];
#pragma unroll
        for (int ch = 0; ch < 2; ++ch) {
            f32x16 g;
#pragma unroll
            for (int r = 0; r < 16; ++r) g[r] = 0.f;
            g = MFMA32(gf[ch], wf[kh], g);
            if (kh == 0 && ch == 0) asm volatile("" : "+v"(g) :: "memory");
            float run = 0.f;
#pragma unroll
            for (int r = 0; r < 16; ++r) { const float x = g[r] + bias[kh];
                const float ls2 = __builtin_fminf(x, 0.f) * LOG2E - __builtin_amdgcn_logf(1.f + __builtin_amdgcn_exp2f(-__builtin_fabsf(x) * LOG2E));
                run += ls2 * (1.f / 16.f); cs[ch][r] = run; }
        }
        float t0lo, t0hi, t1lo, t1hi; swap32(cs[0][15], t0lo, t0hi); swap32(cs[1][15], t1lo, t1hi);
        const float off0 = hi ? t0lo : 0.f, off1 = (t0lo + t0hi) + (hi ? t1lo : 0.f), total = (t0lo + t0hi) + (t1lo + t1hi);
        if (hi == 0) DTOT[((size_t)bh * 32 + j) * 64 + 32 * kh + pil] = __builtin_amdgcn_exp2f(total);
#pragma unroll
        for (int ch = 0; ch < 2; ++ch) {
            const bf16x8 k0 = gkf[kh][ch][0], k1 = gkf[kh][ch][1];
            float kd[16]; const float off = ch ? off1 : off0;
#pragma unroll
            for (int r = 0; r < 16; ++r) { const float dec = __builtin_amdgcn_exp2f(total - (cs[ch][r] + off)); kd[r] = bf2f(r < 8 ? k0[r] : k1[r - 8]) * dec; }
            akf[kh][2 * ch] = pack8(kd); akf[kh][2 * ch + 1] = pack8(kd + 8);
        }
    }
#pragma unroll
    for (int vq = 0; vq < 4; ++vq) {
#pragma unroll
        for (int kh = 0; kh < 2; ++kh) {
            f32x16 kv;
#pragma unroll
            for (int r = 0; r < 16; ++r) kv[r] = 0.f;
#pragma unroll
            for (int s = 0; s < 4; ++s) kv = MFMA32(akf[kh][s], bvf[vq][s], kv);
            bf16* dst = KV + (((size_t)bh * 32 + j) * 128 + 32 * vq + il) * 64 + 32 * kh + 16 * hi;
            float kvf[16];
#pragma unroll
            for (int r = 0; r < 16; ++r) kvf[r] = kv[r];
            *(bf16x8*)dst = pack8(kvf); *(bf16x8*)(dst + 8) = pack8(kvf + 8);
        }
    }
}
__device__ __forceinline__ void gla_b(const bf16* KV, const float* DTOT, bf16* ST, int task, int lane) {
    const int bh = task >> 5, part = task & 31; const int e0 = part * 256 + lane * 4; const int k = e0 & 63;
    f32x4 S = (f32x4){0.f, 0.f, 0.f, 0.f};
#pragma unroll
    for (int half = 0; half < 2; ++half) {
        u32x2 kvp[16]; f32x4 d[16];
#pragma unroll
        for (int q = 0; q < 16; ++q) { const int j = 16 * half + q;
            kvp[q] = *(const u32x2*)(KV + ((size_t)bh * 32 + j) * 8192 + e0); d[q] = *(const f32x4*)(DTOT + ((size_t)bh * 32 + j) * 64 + k); }
#pragma unroll
        for (int q = 0; q < 16; ++q) { const int j = 16 * half + q;
            const f32x4 kv = (f32x4){__uint_as_float(kvp[q].x << 16), __uint_as_float(kvp[q].x & 0xffff0000u), __uint_as_float(kvp[q].y << 16), __uint_as_float(kvp[q].y & 0xffff0000u)};
            S = d[q] * S + kv;
            u32x2 w; w.x = cvtpk(S[0], S[1]); w.y = cvtpk(S[2], S[3]);
            *(u32x2*)(ST + ((size_t)bh * 32 + j) * 8192 + e0) = w; }
        asm volatile("" ::: "memory");
    }
}
__device__ __forceinline__ void gla_c(LAS unsigned char* wl, const bf16* ST, const bf16* GQ, const bf16* GRS, const float* gn, bf16* MIX, int bh, int j, int lane) {
    const int il = lane & 31, hi = lane >> 5, pil = PI32(il);
    const int b = bh >> 2, h = bh & 3;
    const size_t t0 = (size_t)b * SEQ + (size_t)j * 64;
    const bf16* sp = ST + ((size_t)bh * 32 + j) * 8192 + lane * 8;
    u32x4 st[16];
#pragma unroll
    for (int i = 0; i < 16; ++i) st[i] = *(const u32x4*)(sp + i * 512);
    bf16x8 bq[2][4], gr[2][4][2];
#pragma unroll
    for (int ch = 0; ch < 2; ++ch) { const size_t row = t0 + 32 * ch + il;
#pragma unroll
        for (int s = 0; s < 4; ++s) bq[ch][s] = *(const bf16x8*)(GQ + row * 256 + 64 * h + 16 * s + 8 * hi); }
    { const size_t row = t0 + il;
#pragma unroll
      for (int vt = 0; vt < 4; ++vt) { gr[0][vt][0] = *(const bf16x8*)(GRS + row * 512 + 128 * h + 32 * vt + 16 * hi); gr[0][vt][1] = *(const bf16x8*)(GRS + row * 512 + 128 * h + 32 * vt + 16 * hi + 8); } }
    { const int vr = lane >> 3, c = lane & 7;
#pragma unroll
      for (int i = 0; i < 16; ++i) { const int v = 8 * i + vr; *(LAS u32x4*)(wl + v * 128 + ((c ^ sb_keyK(v & 31)) << 4)) = st[i]; } }
    LDS_WAIT(); asm volatile("" ::: "memory");
    unsigned ax[4];
#pragma unroll
    for (int s = 0; s < 4; ++s) ax[s] = (unsigned)(pil * 128 + (((2 * s + hi) ^ sb_keyK(pil)) << 4));
#pragma unroll
    for (int ch = 0; ch < 2; ++ch) {
        const size_t row = t0 + 32 * ch + il;
        f32x16 O[4]; float ss = 0.f;
#pragma unroll
        for (int vt = 0; vt < 4; ++vt) {
#pragma unroll
            for (int r = 0; r < 16; ++r) O[vt][r] = 0.f;
#pragma unroll
            for (int s = 0; s < 4; ++s) { const bf16x8 af = *(const LAS bf16x8*)(wl + vt * 4096 + ax[s]); O[vt] = MFMA32(af, bq[ch][s], O[vt]); }
            if (ch == 0 && vt == 0) {
                const size_t row1 = t0 + 32 + il;
#pragma unroll
                for (int v2 = 0; v2 < 4; ++v2) { gr[1][v2][0] = *(const bf16x8*)(GRS + row1 * 512 + 128 * h + 32 * v2 + 16 * hi); gr[1][v2][1] = *(const bf16x8*)(GRS + row1 * 512 + 128 * h + 32 * v2 + 16 * hi + 8); }
                asm volatile("" : "+v"(O[0]) :: "memory"); }
#pragma unroll
            for (int r = 0; r < 16; ++r) ss += O[vt][r] * O[vt][r];
        }
        float slo, shi; swap32(ss, slo, shi);
        const float rstd = __builtin_amdgcn_rsqf((slo + shi) * (1.f / 128.f) + EPS);
#pragma unroll
        for (int vt = 0; vt < 4; ++vt) {
            const int vc0 = 32 * vt + 16 * hi;
            float v[16];
#pragma unroll
            for (int r4 = 0; r4 < 4; ++r4) { const f32x4 g = *(const f32x4*)(gn + vc0 + 4 * r4);
#pragma unroll
                for (int e2 = 0; e2 < 4; ++e2) { const int r = 4 * r4 + e2; v[r] = O[vt][r] * rstd * g[e2] * bf2f(r < 8 ? gr[ch][vt][0][r] : gr[ch][vt][1][r - 8]); } }
            bf16* op = MIX + row * DM + 512 + 128 * h + vc0;
            *(bf16x8*)(op) = pack8(v); *(bf16x8*)(op + 8) = pack8(v + 8);
        }
    }
    LDS_WAIT(); asm volatile("" ::: "memory");
}

#define GS_LD16(dst, ptr, off) asm volatile("global_load_dwordx4 %0, %1, off offset:%2" : "+v"(dst) : "v"(ptr), "n"(off) : "memory")
#define GS_LD8(dst, ptr, off)  asm volatile("global_load_dwordx2 %0, %1, off offset:%2" : "+v"(dst) : "v"(ptr), "n"(off) : "memory")
#define GS_BAR() do { asm volatile("s_waitcnt lgkmcnt(0)" ::: "memory"); __builtin_amdgcn_s_barrier(); asm volatile("" ::: "memory"); } while (0)
__device__ __forceinline__ void gla_seq(LAS unsigned char* lds, const bf16* KV, const float* DTOT, const bf16* GQ, const bf16* GRS, const float* gn, bf16* MIX, int bh, int tid, int wave, int lane) {
    const int b = bh >> 2, h = bh & 3;
    if (wave >= 4) {
        const int pt = tid - 256, k = (pt & 15) * 4, vr = pt >> 4;
        const bf16* kvp = KV + (size_t)bh * 32 * 8192 + pt * 4; const float* dp = DTOT + (size_t)bh * 32 * 64 + k;
        const unsigned wo = (unsigned)(vr * 128 + (k & 4) * 2); const int ck = k >> 3, kf = (vr >> 1) & 3;
        f32x4 S[8]; u32x2 kvr[4][8]; f32x4 dr[4];
#pragma unroll
        for (int g = 0; g < 8; ++g) S[g] = (f32x4){0.f, 0.f, 0.f, 0.f};
#define GS_PLOAD(sl_, j_) do { const int jj_ = (j_) < 32 ? (j_) : 31; const float* d_ = dp + jj_ * 64; const bf16* k_ = kvp + (size_t)jj_ * 8192; GS_LD16(dr[sl_], d_, 0); \
            _Pragma("unroll") for (int g = 0; g < 8; g += 2) { const bf16* kg_ = k_ + g * 1024; GS_LD8(kvr[sl_][g], kg_, 0); GS_LD8(kvr[sl_][g + 1], kg_, 2048); } } while (0)
#define GS_PWAIT(sl_, n_) asm volatile("s_waitcnt vmcnt(" #n_ ")" : "+v"(dr[sl_]), "+v"(kvr[sl_][0]), "+v"(kvr[sl_][1]), "+v"(kvr[sl_][2]), "+v"(kvr[sl_][3]), "+v"(kvr[sl_][4]), "+v"(kvr[sl_][5]), "+v"(kvr[sl_][6]), "+v"(kvr[sl_][7]) :: "memory")
#pragma unroll
        for (int q = 0; q < 4; ++q) { dr[q] = (f32x4){0.f, 0.f, 0.f, 0.f};
#pragma unroll
            for (int g = 0; g < 8; ++g) kvr[q][g] = (u32x2){0u, 0u}; }
        GS_PLOAD(0, 0); GS_PLOAD(1, 1); GS_PLOAD(2, 2); GS_PLOAD(3, 3);
        GS_PWAIT(0, 0); GS_PWAIT(1, 0); GS_PWAIT(2, 0); GS_PWAIT(3, 0);
        for (int p0 = 0; p0 < 36; p0 += 4) {
#pragma unroll
            for (int u = 0; u < 4; ++u) { const int j = p0 + u;
                if (j > 32) break;
                if (j < 32) {
                    GS_PWAIT(u, 27);
                    LAS unsigned char* img = lds + (j & 1) * 16384;
#pragma unroll
                    for (int g = 0; g < 8; ++g) { const u32x2 kk = kvr[u][g];
                        const f32x4 kv = (f32x4){__uint_as_float(kk.x << 16), __uint_as_float(kk.x & 0xffff0000u), __uint_as_float(kk.y << 16), __uint_as_float(kk.y & 0xffff0000u)};
                        S[g] = dr[u] * S[g] + kv;
                        u32x2 w; w.x = cvtpk(S[g][0], S[g][1]); w.y = cvtpk(S[g][2], S[g][3]);
                        *(LAS u32x2*)(img + g * 2048 + wo + ((ck ^ (kf | ((g & 1) << 2))) << 4)) = w; }
                    GS_PLOAD(u, j + 4);
                }
                GS_BAR();
            }
        }
        asm volatile("s_waitcnt vmcnt(0)" ::: "memory");
#undef GS_PLOAD
#undef GS_PWAIT
    } else {
        const int fr = lane & 15, fq = lane >> 4, kf = (fr >> 1) & 3, lr = lane >> 4, lc = lane & 15;
        const size_t rowb = (size_t)b * SEQ + 16 * wave;
        const bf16* qp = GQ + (rowb + fr) * 256 + 64 * h + 8 * fq; const bf16* gp = GRS + (rowb + lr) * 512 + 128 * h + 8 * lc; bf16* op = MIX + (rowb + lr) * DM + 512 + 128 * h + 8 * lc;
        LAS float* ot = (LAS float*)(lds + 32768 + wave * 8448);
        f32x4 gnv[8]; u32x4 qr[4][2]; u32x4 gl[4][4];
#pragma unroll
        for (int vt = 0; vt < 8; ++vt) gnv[vt] = *(const f32x4*)(gn + 16 * vt + 4 * fq);
#define GS_CLOAD(sl_, c_) do { const int cc_ = (c_) < 32 ? (c_) : 31; const bf16* q_ = qp + (size_t)cc_ * 64 * 256; const bf16* g_ = gp + (size_t)cc_ * 64 * 512; \
            GS_LD16(qr[sl_][0], q_, 0); GS_LD16(qr[sl_][1], q_, 64); \
            _Pragma("unroll") for (int i = 0; i < 4; ++i) { const bf16* gi_ = g_ + i * 4 * 512; GS_LD16(gl[sl_][i], gi_, 0); } } while (0)
#define GS_CWAIT(sl_, n_) asm volatile("s_waitcnt vmcnt(" #n_ ")" : "+v"(qr[sl_][0]), "+v"(qr[sl_][1]), "+v"(gl[sl_][0]), "+v"(gl[sl_][1]), "+v"(gl[sl_][2]), "+v"(gl[sl_][3]) :: "memory")
#pragma unroll
        for (int q = 0; q < 4; ++q) { qr[q][0] = (u32x4){0u, 0u, 0u, 0u}; qr[q][1] = (u32x4){0u, 0u, 0u, 0u};
#pragma unroll
            for (int i = 0; i < 4; ++i) gl[q][i] = (u32x4){0u, 0u, 0u, 0u}; }
        asm volatile("s_waitcnt vmcnt(0)" ::: "memory");
        GS_CLOAD(0, 0); GS_CLOAD(1, 1); GS_CLOAD(2, 2); GS_CLOAD(3, 3);
        GS_CWAIT(0, 0); GS_CWAIT(1, 0); GS_CWAIT(2, 0); GS_CWAIT(3, 0);
        for (int p0 = 0; p0 < 36; p0 += 4) {
#pragma unroll
            for (int u = 0; u < 4; ++u) { const int p = p0 + u;
                if (p > 32) break;
                if (p >= 1) { const int c = p - 1;
                    const int sl = (u + 3) & 3;
                    GS_CWAIT(sl, 30);
                    const LAS unsigned char* img = lds + (c & 1) * 16384;
                    const bf16x8 q0 = __builtin_bit_cast(bf16x8, qr[sl][0]), q1 = __builtin_bit_cast(bf16x8, qr[sl][1]);
                    f32x4 acc[8]; float ss = 0.f;
#pragma unroll
                    for (int vt = 0; vt < 8; ++vt) { const unsigned ro = (unsigned)((16 * vt + fr) * 128); const int key = kf | ((vt & 1) << 2);
                        const bf16x8 a0 = *(const LAS bf16x8*)(img + ro + ((fq ^ key) << 4)), a1 = *(const LAS bf16x8*)(img + ro + (((4 + fq) ^ key) << 4));
                        acc[vt] = (f32x4){0.f, 0.f, 0.f, 0.f};
                        acc[vt] = MFMA16(a0, q0, acc[vt]); acc[vt] = MFMA16(a1, q1, acc[vt]); }
#pragma unroll
                    for (int vt = 0; vt < 8; ++vt) ss += (acc[vt][0] * acc[vt][0] + acc[vt][1] * acc[vt][1]) + (acc[vt][2] * acc[vt][2] + acc[vt][3] * acc[vt][3]);
                    ss += __shfl_xor(ss, 16); ss += __shfl_xor(ss, 32);
                    const float rstd = __builtin_amdgcn_rsqf(ss * (1.f / 128.f) + EPS);
#pragma unroll
                    for (int vt = 0; vt < 8; ++vt) *(LAS f32x4*)(ot + fr * 132 + 16 * vt + 4 * fq) = acc[vt] * rstd * gnv[vt];
                    asm volatile("s_waitcnt lgkmcnt(0)" ::: "memory");
#pragma unroll
                    for (int i = 0; i < 4; ++i) { const LAS float* rp = ot + (lr + 4 * i) * 132 + 8 * lc; const f32x4 x0 = *(const LAS f32x4*)rp, x1 = *(const LAS f32x4*)(rp + 4); const u32x4 gg = gl[sl][i];
                        u32x4 w; w.x = cvtpk(x0[0] * __uint_as_float(gg.x << 16), x0[1] * __uint_as_float(gg.x & 0xffff0000u)); w.y = cvtpk(x0[2] * __uint_as_float(gg.y << 16), x0[3] * __uint_as_float(gg.y & 0xffff0000u));
                        w.z = cvtpk(x1[0] * __uint_as_float(gg.z << 16), x1[1] * __uint_as_float(gg.z & 0xffff0000u)); w.w = cvtpk(x1[2] * __uint_as_float(gg.w << 16), x1[3] * __uint_as_float(gg.w & 0xffff0000u));
                        *(u32x4*)(op + (size_t)c * 64 * DM + (size_t)i * 4 * DM) = w; }
                    asm volatile("s_waitcnt lgkmcnt(0)" ::: "memory");
                    GS_CLOAD(sl, c + 4);
                }
                GS_BAR();
            }
        }
        asm volatile("s_waitcnt vmcnt(0)" ::: "memory");
#undef GS_CLOAD
#undef GS_CWAIT
    }
}
#undef GS_BAR
#undef GS_LD16
#undef GS_LD8

constexpr int NWAVES = 8;
constexpr int N_PHASES = 10;
struct Args { Ptrs p; int ph_lo, ph_hi; };

__global__ void __launch_bounds__(NWAVES * 64, 2) fwd_kernel(Args args) {
    extern __shared__ __attribute__((aligned(16))) unsigned char lds_raw[];
    LAS unsigned char* lds = (LAS unsigned char*)lds_raw;
    const Ptrs& P = args.p;
    const int tid = threadIdx.x, lane = tid & 63, wave = __builtin_amdgcn_readfirstlane(tid >> 6);
    const int G = gridDim.x; const int bx = blockIdx.x; const int vcu = (G % 8 == 0) ? (bx % 8) * (G / 8) + bx / 8 : bx;
    const int gw = vcu * NWAVES + wave, NGW = G * NWAVES;
    unsigned char* ws = P.ws;
    gu32* ctl = (gu32*)(ws + WS_CTL);
    volatile LAS unsigned* MISC = (volatile LAS unsigned*)(lds + MISC_OFF);
    LAS int* tab = (LAS int*)(lds + TAB_OFF);
    for (int u = tid; u < (LDS_BYTES - LDSCTL_OFF) / 4; u += NWAVES * 64) ((LAS unsigned*)(lds + LDSCTL_OFF))[u] = 0u;
    __syncthreads();
    XcdBarrier bar; bar.bar = (unsigned*)(ctl + CW_BAR); bar.x = 0; bar.st = nullptr;
    if (MK_N_LAUNCHES == 1) bar = xcd_barrier_post((unsigned*)(ctl + CW_BAR), MISC + 8);
#define GRID_BAR() do { if (MK_N_LAUNCHES == 1) xcd_barrier(bar); } while (0)
#define BAR_ARRIVE() do { if (MK_N_LAUNCHES == 1) xcd_barrier_arrive(bar, MISC + 12); } while (0)
#define BAR_WAIT() do { if (MK_N_LAUNCHES == 1) xcd_barrier_wait(bar, MISC + 12); } while (0)
    const int lo = args.ph_lo, hi_ph = args.ph_hi;
#ifndef PHASE_MASK
#define PHASE_MASK 0x3ff
#endif
#define IN(k) (((PHASE_MASK >> (k)) & 1) && lo <= (k) && (k) < hi_ph)
#define BOTH(k) (IN(k) && IN((k) + 1))
#ifndef PROBE_TWICE
#define PROBE_TWICE -1
#endif
#define REP(k) for (int rep_ = 0; rep_ < ((PROBE_TWICE == (k)) ? 2 : 1); ++rep_)
#define REPBAR(k) do { if (PROBE_TWICE == (k) && rep_ == 0) GRID_BAR(); } while (0)

    bf16* WA = (bf16*)(ws + WS_WA); bf16* WB = (bf16*)(ws + WS_WB); bf16* WO = (bf16*)(ws + WS_WO);
    bf16* WRH = (bf16*)(ws + WS_WR); bf16* WRL = WRH + 48 * 1024; bf16* W2T = (bf16*)(ws + WS_W2T);
    bf16* WGU = (bf16*)(ws + WS_WGU); bf16* WD = (bf16*)(ws + WS_WD);
    bf16* H = (bf16*)(ws + WS_H); bf16* KV = (bf16*)(ws + WS_KV);
    bf16* XB = (bf16*)(ws + WS_XB); bf16* MIX = (bf16*)(ws + WS_MIX); float* RSTD1 = (float*)(ws + WS_RSTD1);
    bf16* SQ = (bf16*)(ws + WS_SQ); bf16* SK = (bf16*)(ws + WS_SK); bf16* GQ = (bf16*)(ws + WS_GQ); bf16* GRS = (bf16*)(ws + WS_GRS);
    bf16* TT = (bf16*)(ws + WS_TT); bf16* GLR = (bf16*)(ws + WS_GLR); bf16* ST = (bf16*)(ws + WS_ST); float* DTOT = (float*)(ws + WS_DTOT);
    unsigned char* ACT = ws + WS_ACT; unsigned char* Y = ws + WS_Y;
    unsigned char* WGU8 = ws + WS_WGU; unsigned char* WD8 = ws + WS_WD; unsigned char* H8 = ws + WS_H8;
    unsigned* LOCL = (unsigned*)(ws + WS_LOCL); unsigned* CNTS = (unsigned*)(ws + WS_CNTS); float* GATE = (float*)(ws + WS_GATE); float* RSTD = (float*)(ws + WS_RSTD);

#define WGU_PIECE(q_) do { LAS float* scr_ = (LAS float*)(lds + RING_OFF + wave * 16384); \
        for (int r = (q_) * 4096 + gw; r < ((q_) + 1) * 4096; r += NGW) { \
            const int e = r >> 9, q = r & 511, ib = 4 * (q >> 6) + (q & 3), kb = 2 * ((q >> 3) & 7) + ((q >> 2) & 1), P0 = 32 * ib; const int pn = P0 >> 8, bj = (P0 >> 7) & 1, r0 = P0 & 127; \
            const float* src = (bj ? P.wu : P.wg) + (size_t)e * DM * DEXP; \
            tr_item8(src, DEXP, 64 * kb, 128 * pn + r0, WGU8 + (size_t)e * DM * DM, P0, DM, P.ffn_g, WGU_SC, scr_, lane); } } while (0)
    if (IN(0)) { REP(0) {
        LAS float* scr = (LAS float*)(lds + RING_OFF + wave * 16384);
        constexpr int I_A = (NA / 32) * 16, I_B = (NB / 32) * 16, I_O = 32 * 16, I_GU = 32 * 32 * 16, I_D = 32 * 32 * 8;
        constexpr int NITEMS = I_A + I_B + I_O;
        for (int it = gw; it < NITEMS; it += NGW) {
            int r = it;
            if (r < I_A) { const int ib = r >> 4, kb = r & 15, P0 = 32 * ib; const int pn = P0 >> 8, bj = (P0 >> 7) & 1, wcc = (P0 >> 5) & 3; const int LA = 256 * pn + 64 * wcc + 32 * bj;
                const int sc = LA < 1024 ? LA : (LA < 1280 ? 1536 + (LA - 1024) : 2560 + (LA - 1280));
                tr_item(P.w_in, IN_DIM, 64 * kb, sc, WA, P0, DM, P.attn_g, scr, lane); continue; } r -= I_A;
            if (r < I_B) { const int ib = r >> 4, kb = r & 15, P0 = 32 * ib; const int sc = P0 < 512 ? 1024 + P0 : (P0 < 768 ? 1792 + (P0 - 512) : 2048 + (P0 - 768));
                tr_item(P.w_in, IN_DIM, 64 * kb, sc, WB, P0, DM, P.attn_g, scr, lane); continue; } r -= I_B;
            if (r < I_O) { const int ib = r >> 4, kb = r & 15; tr_item(P.w_out, DM, 64 * kb, 32 * ib, WO, 32 * ib, DM, nullptr, scr, lane); continue; } r -= I_O;
        }
        (void)I_D; (void)I_GU;
        for (int idx = gw * 64 + lane; idx < 48 * 1024; idx += NGW * 64) {
            const int rho = idx >> 10, k = idx & 1023, m = rho >> 4, i = rho & 15;
            float v = (m < 2) ? P.re_w[k * 32 + 8 * (i >> 2) + 4 * m + (i & 3)] : P.rg_w[k * 4 + (i & 3)];
            v *= P.ffn_g[k];
            WRH[idx] = __builtin_bit_cast(unsigned short, (_Float16)v);
        }
        for (int idx = gw * 64 + lane; idx < 256 * 16; idx += NGW * 64) { const int kc = idx >> 4, r = idx & 15; W2T[idx] = (bf16)(cvtpk(P.w2[r * 256 + kc], 0.f) & 0xffffu); }
        __syncthreads();
        constexpr int WLP = 1032;
        LAS bf16* wl = (LAS bf16*)(lds + RING_OFF);
        for (int idx = tid; idx < 16 * 1024; idx += NWAVES * 64) { const int c = idx & 15, k = idx >> 4; wl[c * WLP + k] = (bf16)(cvtpk(P.attn_g[k] * P.w_in[(size_t)k * IN_DIM + 3072 + c], 0.f) & 0xffffu); }
        __syncthreads();
        {
            for (int task = gw; task < NTOK / 16; task += NGW) {
                const size_t row0 = (size_t)task * 16;
                f32x4 cur[4], nxt[4]; float rsv = 0.f;
#pragma unroll
                for (int j = 0; j < 4; ++j) { cur[j] = __builtin_nontemporal_load((const GAS f32x4*)(P.x + row0 * DM) + lane + 64 * j); nxt[j] = cur[j]; }
#pragma unroll 2
                for (int r = 0; r < 16; ++r) {
                    if (r < 15) {
#pragma unroll
                        for (int j = 0; j < 4; ++j) nxt[j] = __builtin_nontemporal_load((const GAS f32x4*)(P.x + (row0 + r + 1) * DM) + lane + 64 * j); }
                    float s2 = 0.f;
#pragma unroll
                    for (int j = 0; j < 4; ++j) s2 += (cur[j].x * cur[j].x + cur[j].y * cur[j].y) + (cur[j].z * cur[j].z + cur[j].w * cur[j].w);
                    const float rstd = __builtin_amdgcn_rsqf(wave_sum(s2) * (1.f / DM) + EPS);
                    if ((lane & 15) == r) rsv = rstd;
                    GAS unsigned long long* o8 = (GAS unsigned long long*)(XB + (row0 + r) * DM) + lane;
#pragma unroll
                    for (int j = 0; j < 4; ++j) { const f32x4 v = cur[j];
                        o8[64 * j] = (unsigned long long)cvtpk(v.x, v.y) | ((unsigned long long)cvtpk(v.z, v.w) << 32); }
#pragma unroll
                    for (int j = 0; j < 4; ++j) cur[j] = nxt[j];
                }
                if (lane < 16) RSTD1[row0 + lane] = rsv;
                VM_WAIT();
                const int fr = lane & 15, fq = lane >> 4;
                f32x4 acc = (f32x4){0.f, 0.f, 0.f, 0.f};
                const bf16* up = XB + (row0 + fr) * DM + 8 * fq;
#pragma unroll 8
                for (int ks = 0; ks < 32; ++ks) { const bf16x8 ub = *(const bf16x8*)(up + 32 * ks); const bf16x8 wb = *(const LAS bf16x8*)(wl + fr * WLP + 32 * ks + 8 * fq); acc = MFMA16(wb, ub, acc); }
                u32x2 o; o.x = cvtpk(acc[0] * rsv, acc[1] * rsv); o.y = cvtpk(acc[2] * rsv, acc[3] * rsv);
                *(u32x2*)(GLR + (row0 + fr) * 16 + 4 * fq) = o;
            }
        }
        __syncthreads();
        REPBAR(0); }
        if (BOTH(0)) BAR_ARRIVE();
        WGU_PIECE(0);
        if (BOTH(0)) BAR_WAIT();
    }

#define PH1_BODY() do { \
        { pg8::SchedDense S; S.init(XB, WA, NTOK, NA, DM, G, bx); \
          pg8::EpiA E{SQ, SK, GQ, GRS, P.sbq_g, P.sbk_g, RSTD1}; \
          pg8::gemm_phase<pg8::EpiA, pg8::SchedDense>(lds + RING_OFF, DM, S, E); } \
        { pg8::SchedDense S; S.init(WB, XB, NB, NTOK, DM, G, (bx + G / 2) % G); \
          pg8::EpiTT E{TT, RSTD1}; \
          pg8::gemm_phase<pg8::EpiTT, pg8::SchedDense>(lds + RING_OFF, DM, S, E); } } while (0)
    if (IN(1)) {
        if (PROBE_TWICE == 1) { PH1_BODY(); GRID_BAR(); }
        PH1_BODY();
        if (BOTH(1)) BAR_ARRIVE();
        WGU_PIECE(1);
        if (BOTH(1)) BAR_WAIT();
    }

#define SB_ROUND(rho_) do { for (int u__ = (rho_) * G + vcu; u__ < 1024; u__ += 4 * G) { const int bh_ = u__ & 127; \
        sb_round(lds + RING_OFF, SQ, SK, TT, P.sbo_g + (bh_ & 7) * 64, MIX, bh_ >> 3, bh_ & 7, u__ >> 7, tid, wave, lane); } } while (0)
#define REPX(code) for (int rx_ = 0; rx_ < ((PROBE_TWICE == (code)) ? 5 : 1); ++rx_)
    if (IN(2)) {
        for (int t = gw; t < 2048; t += NGW) gla_a(GLR, W2T, P.gate_b, TT, KV, DTOT, t >> 5, t & 31, lane);
        if (BOTH(2)) BAR_ARRIVE();
        if (vcu < 1024) { const int bh_ = vcu & 127; sb_round(lds + RING_OFF, SQ, SK, TT, P.sbo_g + (bh_ & 7) * 64, MIX, bh_ >> 3, bh_ & 7, vcu >> 7, tid, wave, lane); }
        if (BOTH(2)) BAR_WAIT();
    }
    if (IN(3)) {
        if (G >= 256) { if ((vcu & 3) == 0 && (vcu >> 2) < 64) gla_seq(lds + RING_OFF, KV, DTOT, GQ, GRS, P.glan_g, MIX, vcu >> 2, tid, wave, lane); }
        else for (int bh = vcu; bh < 64; bh += G) gla_seq(lds + RING_OFF, KV, DTOT, GQ, GRS, P.glan_g, MIX, bh, tid, wave, lane);
        for (;;) {
            __syncthreads();
            if (tid == 0) MISC[20] = (unsigned)G + __hip_atomic_fetch_add((unsigned*)(ctl + CW_SBQ), 1u, __ATOMIC_RELAXED, __HIP_MEMORY_SCOPE_AGENT);
            __syncthreads();
            const int u__ = (int)MISC[20];
            if (u__ >= 1024) break;
            const int bh_ = u__ & 127;
            sb_round(lds + RING_OFF, SQ, SK, TT, P.sbo_g + (bh_ & 7) * 64, MIX, bh_ >> 3, bh_ & 7, u__ >> 7, tid, wave, lane);
        }
    }
    if (IN(4)) {
        if (BOTH(4)) BAR_ARRIVE();
        WGU_PIECE(2);
        if (BOTH(4)) BAR_WAIT();
    }

#define PH5_BODY() do { \
        pg8::SchedDense S; S.init(MIX, WO, NTOK, DM, DM, G, bx); \
        pg8::EpiH E{XB, H, H8}; \
        pg8::gemm_phase<pg8::EpiH, pg8::SchedDense>(lds + RING_OFF, DM, S, E); } while (0)
    if (IN(5)) {
        if (PROBE_TWICE == 5) { PH5_BODY(); GRID_BAR(); }
        PH5_BODY();
        if (BOTH(5)) BAR_ARRIVE();
        WGU_PIECE(3);
        if (BOTH(5)) BAR_WAIT();
    }

    if (IN(6)) { REP(6) {
        constexpr int WP = 1032;
        LAS unsigned short* wl16 = (LAS unsigned short*)(lds + RING_OFF);
        LAS unsigned* lcount = (LAS unsigned*)(lds + RING_OFF + 48 * WP * 2);
        for (int idx = tid; idx < 48 * 128; idx += NWAVES * 64) { const int row = idx >> 7, c = idx & 127; *(LAS u32x4*)(wl16 + row * WP + 8 * c) = *(const u32x4*)(WRH + row * 1024 + 8 * c); }
        const int fr = lane & 15, fq = lane >> 4;
        for (int it = 0; it * G < NGRP; ++it) {
            const int grp = it * G + vcu;
            const int tile = grp * 8 + wave; const int ntile = NGRP * 8;
            if (tid < 32) lcount[tid] = 0u;
            __syncthreads();
            bool owner = false; int e1 = 0, e2 = 0; unsigned lr1 = 0, lr2 = 0; int tok = 0;
            if (tile < ntile) {
                tok = tile * 16 + fr;
                const bf16* hp = H + (size_t)tok * DM + 8 * fq;
                f32x4 acc[3]; acc[0] = acc[1] = acc[2] = (f32x4){0.f, 0.f, 0.f, 0.f};
                float ssq = 0.f;
#pragma unroll 1
                for (int half = 0; half < 2; ++half) {
                    bf16x8 hb[16];
#pragma unroll
                    for (int q = 0; q < 16; ++q) hb[q] = *(const bf16x8*)(hp + 32 * (16 * half + q));
#pragma unroll
                    for (int q = 0; q < 16; ++q) { const int ks = 16 * half + q;
                        float f[8];
#pragma unroll
                        for (int e = 0; e < 8; ++e) { f[e] = bf2f(hb[q][e]); ssq += f[e] * f[e]; }
                        f16x8 hh;
#pragma unroll
                        for (int e = 0; e < 8; ++e) hh[e] = (_Float16)f[e];
#pragma unroll
                        for (int m = 0; m < 3; ++m) { const f16x8 wv = *(const LAS f16x8*)(wl16 + (16 * m + fr) * WP + 32 * ks + 8 * fq);
                            acc[m] = __builtin_amdgcn_mfma_f32_16x16x32_f16(wv, hh, acc[m], 0, 0, 0); }
                    }
                }
                ssq += __shfl_xor(ssq, 16); ssq += __shfl_xor(ssq, 32);
                const float rstd = __builtin_amdgcn_rsqf(ssq * (1.f / DM) + EPS);
                float gl[4];
#pragma unroll
                for (int r = 0; r < 4; ++r) gl[r] = acc[2][r] * rstd + P.rg_b[r];
                int gsel = 0; float gmax = gl[0];
#pragma unroll
                for (int r = 1; r < 4; ++r) if (gl[r] > gmax) { gmax = gl[r]; gsel = r; }
                float gden = 0.f;
#pragma unroll
                for (int r = 0; r < 4; ++r) gden += __builtin_amdgcn_exp2f((gl[r] - gmax) * LOG2E);
                const float pgrp = 1.f / gden;
                float el[8];
#pragma unroll
                for (int r = 0; r < 4; ++r) { el[r] = acc[0][r] * rstd + P.re_b[8 * fq + r]; el[4 + r] = acc[1][r] * rstd + P.re_b[8 * fq + 4 + r]; }
                int i1 = 0; float l1 = el[0];
#pragma unroll
                for (int r = 1; r < 8; ++r) if (el[r] > l1) { l1 = el[r]; i1 = r; }
                int i2 = -1; float l2 = -3.0e38f;
#pragma unroll
                for (int r = 0; r < 8; ++r) if (r != i1 && el[r] > l2) { l2 = el[r]; i2 = r; }
                const float ex = __builtin_amdgcn_exp2f((l2 - l1) * LOG2E);
                const float p1 = 1.f / (1.f + ex), p2 = ex * p1;
                owner = (fq == gsel);
                if (owner) {
                    e1 = 8 * gsel + i1; e2 = 8 * gsel + i2;
                    lr1 = __hip_atomic_fetch_add(lcount + e1, 1u, __ATOMIC_RELAXED, __HIP_MEMORY_SCOPE_WORKGROUP);
                    lr2 = __hip_atomic_fetch_add(lcount + e2, 1u, __ATOMIC_RELAXED, __HIP_MEMORY_SCOPE_WORKGROUP);
                    RSTD[tok] = rstd; GATE[2 * tok] = pgrp * p1; GATE[2 * tok + 1] = pgrp * p2;
                }
            }
            __syncthreads();
            if (grp < NGRP) {
                if (tid < 32) CNTS[grp * 32 + tid] = lcount[tid];
                if (owner) { LOCL[((size_t)grp * 32 + e1) * 128 + lr1] = 2u * tok; LOCL[((size_t)grp * 32 + e2) * 128 + lr2] = 2u * tok + 1u; }
            }
            __syncthreads();
        }
        REPBAR(6); }
        if (BOTH(6)) GRID_BAR();
    }

    if (IN(7) || IN(8)) {
        LAS int* pre = (LAS int*)(lds + RING_OFF);
        LAS int* segsum = pre + NGRP * 32;
        for (int i = tid; i < NGRP * 32; i += NWAVES * 64) pre[i] = (int)CNTS[i];
        __syncthreads();
        { const int e = tid & 31, seg = tid >> 5; int run = 0;
          for (int g = seg * 16; g < seg * 16 + 16; ++g) { const int c = pre[g * 32 + e]; pre[g * 32 + e] = run; run += c; }
          segsum[seg * 32 + e] = run; }
        __syncthreads();
        { const int e = tid & 31, seg = tid >> 5; int off = 0, tot = 0;
          for (int q = 0; q < 16; ++q) { const int v = segsum[q * 32 + e]; if (q < seg) off += v; tot += v; }
          for (int g = seg * 16; g < seg * 16 + 16; ++g) pre[g * 32 + e] += off;
          if (seg == 0) tab[T_CNT / 4 + e] = tot; }
        __syncthreads();
        if (tid == 0) { int tb = 0; for (int e = 0; e < 32; ++e) { tab[T_TBASE / 4 + e] = tb; tb += (tab[T_CNT / 4 + e] + 255) >> 8; } tab[T_TBASE / 4 + 32] = tb; tab[T_NT / 4] = tb; }
        __syncthreads();
        { const int NT = tab[T_NT / 4];
          for (int t = tid; t < NT; t += NWAVES * 64) { int e = 0; for (int q = 0; q < 32; ++q) if (tab[T_TBASE / 4 + q] <= t && t < tab[T_TBASE / 4 + q + 1]) e = q; tab[T_TILE_E / 4 + t] = e; } }
        __syncthreads();
        { pg8::SchedMoE<false> S0; S0.A = nullptr; S0.Bt = nullptr; S0.K = 0; S0.bstride = 0; S0.G = G; S0.c = vcu; S0.tab = tab;
          const int half = tid >> 8, r = tid & 255; unsigned vals[NU_MAX / 2]; bool ok[NU_MAX / 2];
#pragma unroll
          for (int k = 0; k < NU_MAX / 2; ++k) { const int ui = 2 * k + half; pg8::Unit u; ok[k] = S0.next(ui, u); vals[k] = 0u;
              if (ok[k]) { const int cnt = tab[T_CNT / 4 + u.e], e = u.e; int p = u.rt * 256 + r; if (p > cnt - 1) p = cnt - 1;
                  int lo_ = 0, hi_ = NGRP - 1;
                  while (lo_ < hi_) { const int mid = (lo_ + hi_ + 1) >> 1; if (pre[mid * 32 + e] <= p) lo_ = mid; else hi_ = mid - 1; }
                  vals[k] = LOCL[((size_t)lo_ * 32 + e) * 128 + (p - pre[lo_ * 32 + e])]; } }
          float rsl[NU_MAX / 2];
#pragma unroll
          for (int k = 0; k < NU_MAX / 2; ++k) rsl[k] = ok[k] ? RSTD[vals[k] >> 1] : 0.f;
#pragma unroll
          for (int k = 0; k < NU_MAX / 2; ++k) if (ok[k]) { tab[T_ROWTAB / 4 + (2 * k + half) * 256 + r] = (int)vals[k]; ((LAS float*)tab)[T_RSTAB / 4 + (2 * k + half) * 256 + r] = rsl[k]; }
        }
        __syncthreads();
    }
#define PH7_BODY() do { \
        pg8::SchedMoE<true> S; S.A = (const char*)H8; S.Bt = (const char*)WGU8; S.K = DM / 2; S.bstride = (size_t)DM * DM; S.G = G; S.c = vcu; S.tab = tab; \
        pg8::EpiGU E{ACT, RSTD, tab}; \
        pg8::gemm_phase<pg8::EpiGU, pg8::SchedMoE<true>, false, true>(lds + RING_OFF, DM / 2, S, E); } while (0)
    if (IN(7)) {
        if (PROBE_TWICE == 7) { PH7_BODY(); GRID_BAR(); }
        PH7_BODY();
        {
            const int NT4 = tab[T_NT / 4] * 4, remu = NT4 % G;
            const bool early = (remu == 0) || (vcu >= remu); const int nE = (remu == 0) ? G : (G - remu), rank = (remu == 0) ? vcu : (vcu - remu);
            if (early) { LAS float* scr = (LAS float*)(lds + RING_OFF + wave * 16384);
                for (int r = rank * NWAVES + wave; r < 32 * 32 * 8; r += nE * NWAVES) {
                    const int e = r >> 8, q = r & 255, nb = 4 * (q >> 5) + (q & 3), kb = 2 * ((q >> 3) & 3) + ((q >> 2) & 1);
                    tr_item8(P.wd + (size_t)e * DEXP * DM, DM, 64 * kb, 32 * nb, WD8 + (size_t)e * DM * DEXP, 32 * nb, DEXP, nullptr, WD_SC, scr, lane); } }
        }
        if (BOTH(7)) GRID_BAR();
    }
    if (IN(8)) { REP(8) {
        pg8::SchedMoE<false> S; S.A = (const char*)ACT; S.Bt = (const char*)WD8; S.K = DEXP / 2; S.bstride = (size_t)DM * DEXP; S.G = G; S.c = vcu; S.tab = tab;
        pg8::EpiDown E{Y, tab};
        pg8::gemm_phase<pg8::EpiDown, pg8::SchedMoE<false>, false, true>(lds + RING_OFF, DEXP / 2, S, E);
        REPBAR(8); }
        if (BOTH(8)) GRID_BAR();
    }
    if (IN(9)) { REP(9) {
        for (int m0 = gw; m0 < NTOK; m0 += 2 * NGW) {
            u32x2 hv[2][4]; unsigned ya[2][4], yb[2][4]; float g0[2], g1[2];
#pragma unroll
            for (int t = 0; t < 2; ++t) { int m = m0 + t * NGW; if (m >= NTOK) m = m0;
                g0[t] = GATE[2 * m] * (1.f / Y_SC); g1[t] = GATE[2 * m + 1] * (1.f / Y_SC);
                const bf16* hp = H + (size_t)m * DM + 4 * lane; const unsigned char* y0 = Y + (size_t)(2 * m) * DM + 4 * lane;
#pragma unroll
                for (int q = 0; q < 4; ++q) { hv[t][q] = *(const u32x2*)(hp + 256 * q); ya[t][q] = *(const unsigned*)(y0 + 256 * q); yb[t][q] = *(const unsigned*)(y0 + DM + 256 * q); } }
#pragma unroll
            for (int t = 0; t < 2; ++t) { const int m = m0 + t * NGW; if (m < NTOK) {
                float* op = P.out + (size_t)m * DM + 4 * lane;
#pragma unroll
                for (int q = 0; q < 4; ++q) { const unsigned wa = ya[t][q], wb = yb[t][q];
                    const f32x2_t a0 = __builtin_amdgcn_cvt_pk_f32_fp8((int)wa, false), a1 = __builtin_amdgcn_cvt_pk_f32_fp8((int)wa, true);
                    const f32x2_t b0 = __builtin_amdgcn_cvt_pk_f32_fp8((int)wb, false), b1 = __builtin_amdgcn_cvt_pk_f32_fp8((int)wb, true);
                    const unsigned h01 = hv[t][q].x, h23 = hv[t][q].y;
                    f32x4 o; o[0] = __uint_as_float(h01 << 16) + g0[t] * a0.x + g1[t] * b0.x; o[1] = __uint_as_float(h01 & 0xffff0000u) + g0[t] * a0.y + g1[t] * b0.y;
                    o[2] = __uint_as_float(h23 << 16) + g0[t] * a1.x + g1[t] * b1.x; o[3] = __uint_as_float(h23 & 0xffff0000u) + g0[t] * a1.y + g1[t] * b1.y;
                    *(f32x4*)(op + 256 * q) = o; } } }
        }
    REPBAR(9); } }
#undef IN
#undef BOTH
}

extern "C" void kernel_launch(void* const* d_in, const int* in_sizes, int n_in, void* d_out, int out_size, void* d_ws, size_t ws_size, hipStream_t stream) {
    static int grid = 0;
    if (grid == 0) {
        if (n_in != 18 || in_sizes[0] != NTOK * DM || out_size != NTOK * DM || ws_size < WS_END) { fprintf(stderr, "kernel_launch: unexpected shapes / workspace (n_in %d, in0 %d, out %d, ws %zu, need %zu)\n", n_in, n_in > 0 ? in_sizes[0] : -1, out_size, ws_size, (size_t)WS_END); grid = -1; return; }
        int dev = 0, cus = 0, per_cu = 0;
        if (hipGetDevice(&dev) != hipSuccess || hipDeviceGetAttribute(&cus, hipDeviceAttributeMultiprocessorCount, dev) != hipSuccess) { grid = -1; return; }
        if (hipFuncSetAttribute((const void*)fwd_kernel, hipFuncAttributeMaxDynamicSharedMemorySize, LDS_BYTES) != hipSuccess) { fprintf(stderr, "kernel_launch: hipFuncSetAttribute failed\n"); grid = -1; return; }
        if (hipOccupancyMaxActiveBlocksPerMultiprocessor(&per_cu, (const void*)fwd_kernel, NWAVES * 64, LDS_BYTES) != hipSuccess || per_cu < 1) fprintf(stderr, "kernel_launch: occupancy query reports %d\n", per_cu);
        (void)hipGetLastError();
        grid = cus;
    }
    if (grid < 0) return;
    if (hipMemsetAsync((char*)d_ws + WS_CTL, 0, CTL_ZERO_BYTES, stream) != hipSuccess) return;
    Args a{};
    const float** pp = (const float**)&a.p;
    for (int i = 0; i < 18; ++i) pp[i] = (const float*)d_in[i];
    a.p.out = (float*)d_out; a.p.ws = (unsigned char*)d_ws;
    if (MK_N_LAUNCHES == 1) { a.ph_lo = 0; a.ph_hi = N_PHASES; hipLaunchKernelGGL(fwd_kernel, dim3(grid), dim3(NWAVES * 64), LDS_BYTES, stream, a); }
    else for (int li = 0; li < N_PHASES; ++li) { a.ph_lo = li; a.ph_hi = li + 1; hipLaunchKernelGGL(fwd_kernel, dim3(grid), dim3(NWAVES * 64), LDS_BYTES, stream, a); }
}
```

```cpp
#include <hip/hip_runtime.h>
#include <cstdio>
#include <cstdint>

#ifndef MK_N_LAUNCHES
#define MK_N_LAUNCHES 1
#endif

#define LAS __attribute__((address_space(3)))
#define GAS __attribute__((address_space(1)))
typedef unsigned short bf16;
typedef short bf16x8 __attribute__((ext_vector_type(8)));
typedef float f32x4 __attribute__((ext_vector_type(4)));
typedef float f32x16 __attribute__((ext_vector_type(16)));
typedef unsigned u32x4 __attribute__((ext_vector_type(4)));
typedef unsigned u32x2 __attribute__((ext_vector_type(2)));
typedef float f32x2_t __attribute__((ext_vector_type(2)));
typedef __bf16 bf16x2_t __attribute__((ext_vector_type(2)));
typedef GAS unsigned gu32;
typedef int v8i __attribute__((ext_vector_type(8)));
typedef int v4i __attribute__((ext_vector_type(4)));
typedef _Float16 f16x8 __attribute__((ext_vector_type(8)));
typedef _Float16 f16x2 __attribute__((ext_vector_type(2)));

constexpr int BATCH = 16, SEQ = 2048, DM = 1024, NTOK = BATCH * SEQ;
constexpr int IN_DIM = 3088;
constexpr int NEXP = 32, DEXP = 512;
constexpr float EPS = 1e-6f;
constexpr float LOG2E = 1.4426950408889634f;
constexpr float WGU_SC = 64.f, WD_SC = 32.f, ACT_SC = 8.f, Y_SC = 8.f;
constexpr int NA = 1792, NB = 1280;
constexpr int NGRP = NTOK / 128;

constexpr size_t MiB = 1u << 20;
constexpr size_t WS_CTL = 0, CTL_ZERO_BYTES = 64 * 1024;
constexpr size_t WS_WA = 2 * MiB;
constexpr size_t WS_WB = 6 * MiB;
constexpr size_t WS_WO = 9 * MiB;
constexpr size_t WS_WR = 11 * MiB;
constexpr size_t WS_W2T = WS_WR + 2 * 48 * 1024 * 2;
constexpr size_t WS_WGU = 12 * MiB;
constexpr size_t WS_WD = 76 * MiB;
constexpr size_t WS_H = 108 * MiB;
constexpr size_t WS_KV = WS_H;
constexpr size_t WS_XB = 44 * MiB;
constexpr size_t WS_MIX = 172 * MiB;
constexpr size_t WS_SQ = 236 * MiB;
constexpr size_t WS_SK = 268 * MiB;
constexpr size_t WS_GQ = 300 * MiB;
constexpr size_t WS_GRS = 316 * MiB;
constexpr size_t WS_TT = 348 * MiB;
constexpr size_t WS_GLR = 428 * MiB;
constexpr size_t WS_ST = 429 * MiB;
constexpr size_t WS_DTOT = 461 * MiB;
constexpr size_t WS_ACT = 236 * MiB;
constexpr size_t WS_H8 = 272 * MiB;
constexpr size_t WS_Y = 308 * MiB;
constexpr size_t WS_LOCL = 462 * MiB;
constexpr size_t WS_CNTS = 467 * MiB;
constexpr size_t WS_GATE = 470 * MiB;
constexpr size_t WS_RSTD = WS_GATE + 512 * 1024;
constexpr size_t WS_RSTD1 = WS_GATE + 768 * 1024;
constexpr size_t WS_END = 472 * MiB;
constexpr int CW_TMO = 0, CW_CODE = 1;
constexpr int CW_BAR = 4096;
constexpr int CW_SBQ = 12288;
constexpr int CW_CNT = 16384;

constexpr int RING_OFF = 0, RING_BYTES = 131072;
constexpr int LDSCTL_OFF = RING_BYTES, MISC_OFF = LDSCTL_OFF + 320;
constexpr int TAB_OFF = LDSCTL_OFF + 1024;
constexpr int LDS_BYTES = 147456;
constexpr int T_CNT = 0, T_TBASE = 128, T_NT = 264, T_TILE_E = 272, T_ROWTAB = 272 + 320 * 4, NU_MAX = 6;
constexpr int T_RSTAB = T_ROWTAB + NU_MAX * 1024;
static_assert(TAB_OFF + T_RSTAB + NU_MAX * 256 * 4 <= LDS_BYTES, "LDS tables");

#define RLX_AGENT __ATOMIC_RELAXED, __HIP_MEMORY_SCOPE_AGENT
#define LDS_WAIT() asm volatile("s_waitcnt lgkmcnt(0)" ::: "memory")
#define VM_WAIT() asm volatile("s_waitcnt vmcnt(0)" ::: "memory")

__device__ __forceinline__ unsigned cvtpk(float lo, float hi) { f32x2_t v = {lo, hi}; bf16x2_t b = __builtin_convertvector(v, bf16x2_t); return __builtin_bit_cast(unsigned, b); }
__device__ __forceinline__ u32x2 pack8_fp8(const float* a) { int lo = __builtin_amdgcn_cvt_pk_fp8_f32(a[0], a[1], 0, false); lo = __builtin_amdgcn_cvt_pk_fp8_f32(a[2], a[3], lo, true);
    int hi = __builtin_amdgcn_cvt_pk_fp8_f32(a[4], a[5], 0, false); hi = __builtin_amdgcn_cvt_pk_fp8_f32(a[6], a[7], hi, true); u32x2 r; r.x = (unsigned)lo; r.y = (unsigned)hi; return r; }
__device__ __forceinline__ float bf2f(short s) { return __uint_as_float(((unsigned)(unsigned short)s) << 16); }
__device__ __forceinline__ bf16x8 pack8(const float* a) { u32x4 p; p.x = cvtpk(a[0], a[1]); p.y = cvtpk(a[2], a[3]); p.z = cvtpk(a[4], a[5]); p.w = cvtpk(a[6], a[7]); return __builtin_bit_cast(bf16x8, p); }
__device__ __forceinline__ int PI32(int i) { return 16 * ((i >> 2) & 1) + (i & 3) + 4 * (i >> 3); }
#define MFMA32(a, b, c) __builtin_amdgcn_mfma_f32_32x32x16_bf16((a), (b), (c), 0, 0, 0)
#define MFMA16(a, b, c) __builtin_amdgcn_mfma_f32_16x16x32_bf16((a), (b), (c), 0, 0, 0)
__device__ __forceinline__ void swap32(float x, float& lo, float& hi) { auto rr = __builtin_amdgcn_permlane32_swap(__float_as_uint(x), __float_as_uint(x), false, false); lo = __uint_as_float(rr[0]); hi = __uint_as_float(rr[1]); }

namespace pg8 {
#define PG8_LAS __attribute__((address_space(3)))
constexpr int BM = 256, BK = 64, HALF = 128, HTB = HALF * BK * 2, STAGE_BYTES = 8 * HTB, NXCD = 8, WGM = 8;
__host__ __device__ __forceinline__ int lds_byte(int r, int c) { const int st = (r >> 4) * 2 + (c >> 5), rr = r & 15, cc = c & 31, ob = rr * 64 + cc * 2; return st * 1024 + (ob ^ (((ob >> 9) & 1) << 5)); }
__host__ __device__ __forceinline__ void stage_rc(int b, int& R, int& C) { const int st = b / 1024, sb = b % 1024, swz = sb ^ (((sb >> 9) & 1) << 5); R = (st >> 1) * 16 + swz / 64; C = (st & 1) * 32 + (swz % 64) / 2; }
__host__ __device__ __forceinline__ int perm32(int rho) { const int n = rho >> 4, i = rho & 15; return 8 * (i >> 2) + 4 * n + (i & 3); }

struct Unit { int pm, pn, e, rt, nv; };

struct SchedDense {
    const char* A; const char* Bt; int K; int nM, nN, nwg, G, c;
    __device__ void init(const void* A_, const void* Bt_, int M, int N, int K_, int G_, int c_) { A = (const char*)A_; Bt = (const char*)Bt_; K = K_; nM = M / BM; nN = N / BM; nwg = nM * nN; G = G_; c = c_; }
    __device__ __forceinline__ bool next(int i, Unit& u) const {
        const long L = (long)i * G + c; if (L >= nwg) return false;
        int wgid = (int)L; { const int q = nwg / NXCD, r = nwg % NXCD, xcd = wgid % NXCD, off = wgid / NXCD; wgid = (xcd < r ? xcd * (q + 1) : r * (q + 1) + (xcd - r) * q) + off; }
        const int nig = WGM * nN, gid = wgid / nig, fm = gid * WGM, gsz = (nM - fm) < WGM ? (nM - fm) : WGM;
        u.pm = fm + ((wgid % nig) % gsz); u.pn = (wgid % nig) / gsz; u.e = 0; u.rt = 0; u.nv = 256; return true;
    }
    __device__ __forceinline__ const char* a_ptr(const Unit& u) const { return A + (size_t)u.pm * BM * K * 2; }
    __device__ __forceinline__ const char* b_ptr(const Unit& u) const { return Bt + (size_t)u.pn * BM * K * 2; }
    __device__ __forceinline__ void a_voff(int, const Unit&, int tid, unsigned (&v)[2][2]) const {
#pragma unroll
        for (int i = 0; i < 2; ++i) { int R, C; stage_rc(tid * 16 + i * 8192, R, C);
#pragma unroll
            for (int h = 0; h < 2; ++h) v[h][i] = (unsigned)((h * HALF + R) * K + C) * 2u; }
    }
};
struct SchedP1 {
    SchedDense a, b; int nA, G, c;
    __device__ __forceinline__ static void map(const SchedDense& d, int wgid0, Unit& u) {
        int wgid = wgid0; { const int q = d.nwg / NXCD, r = d.nwg % NXCD, xcd = wgid % NXCD, off = wgid / NXCD; wgid = (xcd < r ? xcd * (q + 1) : r * (q + 1) + (xcd - r) * q) + off; }
        const int nig = WGM * d.nN, gid = wgid / nig, fm = gid * WGM, gsz = (d.nM - fm) < WGM ? (d.nM - fm) : WGM;
        u.pm = fm + ((wgid % nig) % gsz); u.pn = (wgid % nig) / gsz; u.rt = 0; u.nv = 256; }
    __device__ __forceinline__ bool next(int i, Unit& u) const {
        const int L = i * G + c; if (L >= nA + b.nwg) return false;
        if (L < nA) { map(a, L, u); u.e = 0; } else { map(b, L - nA, u); u.e = 1; } return true; }
    __device__ __forceinline__ const char* a_ptr(const Unit& u) const { return (u.e ? b.A : a.A) + (size_t)u.pm * BM * a.K * 2; }
    __device__ __forceinline__ const char* b_ptr(const Unit& u) const { return (u.e ? b.Bt : a.Bt) + (size_t)u.pn * BM * a.K * 2; }
    __device__ __forceinline__ void a_voff(int i, const Unit& u, int tid, unsigned (&v)[2][2]) const { a.a_voff(i, u, tid, v); }
};
template <bool GATHER> struct SchedMoE {
    const char* A; const char* Bt; int K; size_t bstride; int G, c;
    const PG8_LAS int* tab;
    __device__ __forceinline__ bool next(int i, Unit& u) const {
        const int L = i * G + c; const int NT = tab[T_NT / 4];
        if (L >= NT * 4) return false;
        const int tile = L >> 2; u.pm = tile; u.pn = L & 3; const int e = tab[T_TILE_E / 4 + tile]; u.e = e;
        u.rt = tile - tab[T_TBASE / 4 + e]; const int rem = tab[T_CNT / 4 + e] - u.rt * 256; u.nv = rem < 256 ? rem : 256; return true;
    }
    __device__ __forceinline__ const char* a_ptr(const Unit& u) const { return GATHER ? A : A + (size_t)u.pm * BM * K * 2; }
    __device__ __forceinline__ const char* b_ptr(const Unit& u) const { return Bt + (size_t)u.e * bstride + (size_t)u.pn * BM * K * 2; }
    __device__ __forceinline__ void a_voff(int ui, const Unit&, int tid, unsigned (&v)[2][2]) const {
        asm volatile("" : "+v"(tid));
#pragma unroll
        for (int i = 0; i < 2; ++i) { int R, C; stage_rc(tid * 16 + i * 8192, R, C);
#pragma unroll
            for (int h = 0; h < 2; ++h) {
                if (GATHER) { const int tok = tab[T_ROWTAB / 4 + ui * 256 + h * HALF + R] >> 1; v[h][i] = (unsigned)(tok * K + C) * 2u; }
                else v[h][i] = (unsigned)((h * HALF + R) * K + C) * 2u; } }
    }
};

template <class Epi, class Sched, bool TAIL = false, bool FP8 = false>
__device__ __forceinline__ void gemm_phase(PG8_LAS unsigned char* lds, const int K, const Sched& S, const Epi& E) {
    const int tid = threadIdx.x, wid = __builtin_amdgcn_readfirstlane(tid >> 6), lane = tid & 63, wr = wid >> 2, wc = wid & 3, fr = lane & 15, fq = lane >> 4;
    const int nt = K / BK;
    constexpr bool EARLY = !FP8;
    unsigned voffB[1][2];
#pragma unroll
    for (int i = 0; i < 2; ++i) { int R, C; stage_rc(tid * 16 + i * 8192, R, C); const int Rb = (R & ~31) + perm32(R & 31);
        voffB[0][i] = (unsigned)(Rb * K + C) * 2u; }
    const size_t hstepB = (size_t)HALF * K * 2;
    const size_t kstep = (size_t)(BK * 2);
    const unsigned ldsw = (unsigned)wid * 1024u;
    const int aoff = lds_byte(wr * 64 + fr, fq * 8), boff = lds_byte(wc * 32 + fr, fq * 8);
#define PG8_SA(b, h) (((b) * 2 + (h)) * HTB)
#define PG8_SB(b, h) ((4 + (b) * 2 + (h)) * HTB)
#define PG8_STAGE(bufoff, gbase, voff) do { _Pragma("unroll") for (int _i = 0; _i < 2; ++_i) \
        __builtin_amdgcn_global_load_lds((const unsigned*)((const char*)(gbase) + (voff)[_i]), (PG8_LAS unsigned*)(lds + (bufoff) + ldsw + _i * 8192), 16, 0, 0); } while (0)
#define PG8_RD16(off) (*(const PG8_LAS v4i*)(lds + (off)))
#define PG8_LDA(dst, b, h) do { _Pragma("unroll") for (int m = 0; m < 4; ++m) { \
        if constexpr (FP8) At8[m] = __builtin_shufflevector(PG8_RD16(PG8_SA(b, h) + aoff + m * 2048), PG8_RD16(PG8_SA(b, h) + aoff + m * 2048 + 1024), 0, 1, 2, 3, 4, 5, 6, 7); \
        else { _Pragma("unroll") for (int k = 0; k < 2; ++k) dst[m][k] = *(const PG8_LAS bf16x8*)(lds + PG8_SA(b, h) + aoff + m * 2048 + k * 1024); } } } while (0)
#define PG8_LDB(dst, b, h) do { _Pragma("unroll") for (int n = 0; n < 2; ++n) { \
        if constexpr (FP8) dst##8[n] = __builtin_shufflevector(PG8_RD16(PG8_SB(b, h) + boff + n * 2048), PG8_RD16(PG8_SB(b, h) + boff + n * 2048 + 1024), 0, 1, 2, 3, 4, 5, 6, 7); \
        else { _Pragma("unroll") for (int k = 0; k < 2; ++k) dst[n][k] = *(const PG8_LAS bf16x8*)(lds + PG8_SB(b, h) + boff + n * 2048 + k * 1024); } } } while (0)
#define PG8_MMA(ai, bj, At, Bt) do { __builtin_amdgcn_s_setprio(1); _Pragma("unroll") for (int m = 0; m < 4; ++m) _Pragma("unroll") for (int n = 0; n < 2; ++n) { \
        if constexpr (FP8) asm volatile("v_mfma_scale_f32_16x16x128_f8f6f4 %0, %1, %2, %0, %3, %3 op_sel_hi:[0,0,0]" : "+v"(acc[ai][bj][m][n]) : "v"(Bt##8[n]), "v"(At8[m]), "v"(sc1)); \
        else { _Pragma("unroll") for (int k = 0; k < 2; ++k) acc[ai][bj][m][n] = __builtin_amdgcn_mfma_f32_16x16x32_bf16(Bt[n][k], At[m][k], acc[ai][bj][m][n], 0, 0, 0); } } \
        __builtin_amdgcn_s_setprio(0); } while (0)
#define PG8_WAIT_V(n) asm volatile("s_waitcnt vmcnt(" #n ")" ::: "memory")
#define PG8_WAIT_L(n) asm volatile("s_waitcnt lgkmcnt(" #n ")" ::: "memory")
#define PG8_BAR __builtin_amdgcn_s_barrier()
#define PG8_SCHED __builtin_amdgcn_sched_barrier(0)
    Unit cur, nxt; int ui = 0;
    if (!S.next(0, cur)) return;
    f32x4 acc[2][2][4][2];
#pragma unroll
    for (int a = 0; a < 2; ++a)
#pragma unroll
        for (int b = 0; b < 2; ++b)
#pragma unroll
            for (int m = 0; m < 4; ++m)
#pragma unroll
                for (int n = 0; n < 2; ++n) acc[a][b][m][n] = (f32x4){0.f, 0.f, 0.f, 0.f};
    bf16x8 At[4][2], B0[2][2], B1[2][2];
    v8i At8[4], B08[2], B18[2];
    int sc1 = 0x7f7f7f7f; asm volatile("" : "+v"(sc1));
    unsigned vc[2][2], vn[2][2];
    S.a_voff(0, cur, tid, vc);
    const char* cA = S.a_ptr(cur); const char* cB = S.b_ptr(cur);
    PG8_STAGE(PG8_SB(0, 0), cB, voffB[0]); PG8_STAGE(PG8_SB(0, 1), (cB) + hstepB, voffB[0]); PG8_STAGE(PG8_SA(0, 0), cA, vc[0]); PG8_STAGE(PG8_SA(0, 1), cA, vc[1]);
    if (wr == 1) PG8_BAR;
    PG8_WAIT_V(2); PG8_BAR;
    PG8_STAGE(PG8_SB(1, 0), cB + kstep, voffB[0]); PG8_STAGE(PG8_SA(1, 0), cA + kstep, vc[0]); PG8_STAGE(PG8_SB(1, 1), (cB + kstep) + hstepB, voffB[0]);
    PG8_WAIT_V(6); PG8_BAR;
    for (;;) {
        const bool has_next = S.next(ui + 1, nxt);
        const char* nA = has_next ? S.a_ptr(nxt) : cA; const char* nB = has_next ? S.b_ptr(nxt) : cB;
        if (has_next) S.a_voff(ui + 1, nxt, tid, vn);
        else {
#pragma unroll
            for (int h = 0; h < 2; ++h)
#pragma unroll
                for (int i = 0; i < 2; ++i) vn[h][i] = vc[h][i]; }
        const bool full_hi = !TAIL || cur.nv > HALF;
        for (int t = 0; t < nt; t += 2) {
            const bool last = (t == nt - 2);
            int fl_ = __builtin_amdgcn_readfirstlane(EARLY ? (t | (ui == 0)) : 1); asm volatile("" : "+s"(fl_));
            const bool fresh = (fl_ == 0);
            const char* a1 = cA + (size_t)(t + 1) * kstep;
            const char* a2 = last ? nA : cA + (size_t)(t + 2) * kstep; const char* b2 = last ? nB : cB + (size_t)(t + 2) * kstep;
            const char* a3 = a2 + kstep; const char* b3 = b2 + kstep;
            unsigned w0[2], w1[2];
            w0[0] = last ? vn[0][0] : vc[0][0]; w0[1] = last ? vn[0][1] : vc[0][1]; w1[0] = last ? vn[1][0] : vc[1][0]; w1[1] = last ? vn[1][1] : vc[1][1];
            PG8_LDB(B0, 0, 0); PG8_LDB(B1, 0, 1); PG8_SCHED; PG8_LDA(At, 0, 0); if (!fresh) { PG8_STAGE(PG8_SA(1, 1), a1, vc[1]); PG8_WAIT_V(8); }
            PG8_WAIT_L(0); PG8_BAR; PG8_MMA(0, 0, At, B0); PG8_MMA(0, 1, At, B1); PG8_BAR; PG8_SCHED;
            PG8_LDA(At, 0, 1); PG8_STAGE(PG8_SB(0, 0), b2, voffB[0]); PG8_STAGE(PG8_SB(0, 1), (b2) + hstepB, voffB[0]); PG8_STAGE(PG8_SA(0, 0), a2, w0);
            if (!fresh) PG8_WAIT_V(8); PG8_WAIT_L(0); PG8_BAR; if (full_hi) { PG8_MMA(1, 0, At, B0); PG8_MMA(1, 1, At, B1); } PG8_BAR; PG8_SCHED;
            PG8_LDB(B0, 1, 0); PG8_LDB(B1, 1, 1); PG8_SCHED; PG8_LDA(At, 1, 0); PG8_STAGE(PG8_SA(0, 1), a2, w1);
            if (!fresh) PG8_WAIT_V(8); PG8_WAIT_L(0); PG8_BAR; PG8_MMA(0, 0, At, B0); PG8_MMA(0, 1, At, B1); PG8_BAR; PG8_SCHED;
            PG8_LDA(At, 1, 1); PG8_STAGE(PG8_SB(1, 0), b3, voffB[0]); PG8_STAGE(PG8_SB(1, 1), (b3) + hstepB, voffB[0]); PG8_STAGE(PG8_SA(1, 0), a3, w0);
            PG8_WAIT_V(8); PG8_WAIT_L(0); PG8_BAR; if (full_hi) { PG8_MMA(1, 0, At, B0); PG8_MMA(1, 1, At, B1); } PG8_BAR; PG8_SCHED;
        }
        if (wr == 0) PG8_BAR;
        if constexpr (EARLY) {
            PG8_STAGE(PG8_SA(1, 1), nA + kstep, vn[1]);
            PG8_WAIT_V(0); }
        if constexpr (FP8) asm volatile("s_nop 15\n\ts_nop 15" ::: "memory");
        { int t2_ = threadIdx.x; asm volatile("" : "+v"(t2_)); E(acc, cur, ui, wr, wc, t2_ & 15, (t2_ >> 4) & 3); }
        if (!has_next) break;
#pragma unroll
        for (int a = 0; a < 2; ++a)
#pragma unroll
            for (int b = 0; b < 2; ++b)
#pragma unroll
                for (int m = 0; m < 4; ++m)
#pragma unroll
                    for (int n = 0; n < 2; ++n) acc[a][b][m][n] = (f32x4){0.f, 0.f, 0.f, 0.f};
        cur = nxt; cA = nA; cB = nB; ++ui;
#pragma unroll
        for (int h = 0; h < 2; ++h)
#pragma unroll
            for (int i = 0; i < 2; ++i) vc[h][i] = vn[h][i];
        if (wr == 1) PG8_BAR;
    }
    PG8_WAIT_V(0);
    PG8_BAR;
#undef PG8_SA
#undef PG8_SB
#undef PG8_STAGE
#undef PG8_LDA
#undef PG8_LDB
#undef PG8_MMA
#undef PG8_RD16
#undef PG8_WAIT_V
#undef PG8_WAIT_L
#undef PG8_BAR
#undef PG8_SCHED
}

struct EpiBf16 {
    bf16* O; int ldc;
    __device__ __forceinline__ void operator()(const f32x4 (&acc)[2][2][4][2], const Unit& u, int, int wr, int wc, int fr, int fq) const {
        const int row0 = u.pm * BM + wr * 64 + fr, col0 = u.pn * BM + wc * 32 + 8 * fq;
#pragma unroll
        for (int ai = 0; ai < 2; ++ai)
#pragma unroll
            for (int m = 0; m < 4; ++m) { bf16* rowp = O + (size_t)(row0 + ai * HALF + m * 16) * ldc + col0;
#pragma unroll
                for (int bj = 0; bj < 2; ++bj) { const f32x4 v0 = acc[ai][bj][m][0], v1 = acc[ai][bj][m][1];
                    u32x4 w; w.x = cvtpk(v0[0], v0[1]); w.y = cvtpk(v0[2], v0[3]); w.z = cvtpk(v1[0], v1[1]); w.w = cvtpk(v1[2], v1[3]);
                    *(u32x4*)(rowp + bj * HALF) = w; } }
    }
};
struct EpiTT {
    bf16* O; const float* RS;
    __device__ __forceinline__ void operator()(const f32x4 (&acc)[2][2][4][2], const Unit& u, int, int wr, int wc, int fr, int fq) const {
        const int row0 = u.pm * BM + wr * 64 + fr, tokb0 = u.pn * 8 + wc;
        f32x4 rs[2][2];
#pragma unroll
        for (int bj = 0; bj < 2; ++bj) { const float* rp = RS + (size_t)(tokb0 + 4 * bj) * 32 + 8 * fq; rs[bj][0] = *(const f32x4*)rp; rs[bj][1] = *(const f32x4*)(rp + 4); }
#pragma unroll
        for (int ai = 0; ai < 2; ++ai)
#pragma unroll
            for (int m = 0; m < 4; ++m) { const int col = row0 + ai * HALF + m * 16;
#pragma unroll
                for (int bj = 0; bj < 2; ++bj) { const f32x4 v0 = acc[ai][bj][m][0] * rs[bj][0], v1 = acc[ai][bj][m][1] * rs[bj][1];
                    u32x4 w; w.x = cvtpk(v0[0], v0[1]); w.y = cvtpk(v0[2], v0[3]); w.z = cvtpk(v1[0], v1[1]); w.w = cvtpk(v1[2], v1[3]);
                    *(u32x4*)(O + ((size_t)(tokb0 + 4 * bj) * 1280 + col) * 32 + 8 * fq) = w; } }
    }
};
struct EpiA {
    bf16 *SQ, *SK, *GQ, *GRS; const float *gq_norm, *gk_norm; const float* RS;
    __device__ __forceinline__ void operator()(const f32x4 (&acc)[2][2][4][2], const Unit& u, int, int wr, int wc, int fr, int fq) const {
        const int pn = u.pn; const int row0 = u.pm * BM + wr * 64 + fr;
        bf16* base; int ldc, colt; int mode;
        float scale = 1.f; const float* gain = nullptr;
        if (pn < 2)      { base = SQ; ldc = 512; colt = pn * 256; mode = 0; gain = gq_norm; scale = 0.125f * LOG2E; }
        else if (pn < 4) { base = SK; ldc = 512; colt = (pn - 2) * 256; mode = 0; gain = gk_norm; scale = 1.f; }
        else if (pn < 5) { base = GQ; ldc = 256; colt = 0; mode = 1; scale = 0.125f; }
        else             { base = GRS; ldc = 512; colt = (pn - 5) * 256; mode = 2; }
        const int col0 = colt + wc * 64 + 8 * fq;
        f32x4 gv[2][2];
#pragma unroll
        for (int bj = 0; bj < 2; ++bj)
#pragma unroll
            for (int n = 0; n < 2; ++n) { if (mode == 0) { gv[bj][n] = *(const f32x4*)(gain + 32 * bj + 8 * fq + 4 * n); gv[bj][n] = gv[bj][n] * scale; } else gv[bj][n] = (f32x4){scale, scale, scale, scale}; }
        float rs1v[2][4];
#pragma unroll
        for (int ai = 0; ai < 2; ++ai)
#pragma unroll
            for (int m = 0; m < 4; ++m) rs1v[ai][m] = RS[row0 + ai * HALF + m * 16];
#pragma unroll
        for (int ai = 0; ai < 2; ++ai)
#pragma unroll
            for (int m = 0; m < 4; ++m) {
                const float rs1 = rs1v[ai][m]; float rs = rs1;
                if (mode == 0) { float s = 0.f;
#pragma unroll
                    for (int bj = 0; bj < 2; ++bj)
#pragma unroll
                        for (int n = 0; n < 2; ++n) { const f32x4 x = acc[ai][bj][m][n]; s += (x[0] * x[0] + x[1] * x[1]) + (x[2] * x[2] + x[3] * x[3]); }
                    s += __shfl_xor(s, 16); s += __shfl_xor(s, 32);
                    rs = rs1 * __builtin_amdgcn_rsqf(rs1 * rs1 * s * (1.f / 64.f) + EPS); }
                bf16* rowp = base + (size_t)(row0 + ai * HALF + m * 16) * ldc + col0;
#pragma unroll
                for (int bj = 0; bj < 2; ++bj) { f32x4 v0 = acc[ai][bj][m][0], v1 = acc[ai][bj][m][1];
                    if (mode == 2) {
                        v0 = v0 * rs1; v1 = v1 * rs1;
                        f32x4 d0 = v0 * (-LOG2E), d1 = v1 * (-LOG2E);
#pragma unroll
                        for (int e = 0; e < 4; ++e) { d0[e] = __builtin_amdgcn_exp2f(d0[e]); d1[e] = __builtin_amdgcn_exp2f(d1[e]); }
                        d0 = d0 + 1.f; d1 = d1 + 1.f;
#pragma unroll
                        for (int e = 0; e < 4; ++e) { d0[e] = __builtin_amdgcn_rcpf(d0[e]); d1[e] = __builtin_amdgcn_rcpf(d1[e]); }
                        v0 = v0 * d0; v1 = v1 * d1;
                    } else { v0 = v0 * rs * gv[bj][0]; v1 = v1 * rs * gv[bj][1]; }
                    u32x4 w; w.x = cvtpk(v0[0], v0[1]); w.y = cvtpk(v0[2], v0[3]); w.z = cvtpk(v1[0], v1[1]); w.w = cvtpk(v1[2], v1[3]);
                    *(u32x4*)(rowp + bj * 32) = w; } }
    }
};
struct EpiP1 {
    EpiA ea; EpiTT et;
    __device__ __forceinline__ void operator()(const f32x4 (&acc)[2][2][4][2], const Unit& u, int ui, int wr, int wc, int fr, int fq) const {
        if (u.e == 0) ea(acc, u, ui, wr, wc, fr, fq); else et(acc, u, ui, wr, wc, fr, fq); }
};
struct EpiH {
    const bf16* XB; bf16* H; unsigned char* H8;
    __device__ __forceinline__ void operator()(const f32x4 (&acc)[2][2][4][2], const Unit& u, int, int wr, int wc, int fr, int fq) const {
        const int row0 = u.pm * BM + wr * 64 + fr, col0 = u.pn * BM + wc * 32 + 8 * fq;
#pragma unroll
        for (int ai = 0; ai < 2; ++ai) {
            u32x2 h8[4][2];
            bf16x8 xv[4][2];
#pragma unroll
            for (int m = 0; m < 4; ++m) { const size_t off = (size_t)(row0 + ai * HALF + m * 16) * DM + col0;
#pragma unroll
                for (int bj = 0; bj < 2; ++bj) xv[m][bj] = *(const bf16x8*)(XB + off + bj * HALF); }
#pragma unroll
            for (int m = 0; m < 4; ++m) { const size_t off = (size_t)(row0 + ai * HALF + m * 16) * DM + col0;
#pragma unroll
                for (int bj = 0; bj < 2; ++bj) { const bf16x8 xx = xv[m][bj];
                    const f32x4 v0 = acc[ai][bj][m][0] + (f32x4){bf2f(xx[0]), bf2f(xx[1]), bf2f(xx[2]), bf2f(xx[3])}, v1 = acc[ai][bj][m][1] + (f32x4){bf2f(xx[4]), bf2f(xx[5]), bf2f(xx[6]), bf2f(xx[7])};
                    u32x4 w; w.x = cvtpk(v0[0], v0[1]); w.y = cvtpk(v0[2], v0[3]); w.z = cvtpk(v1[0], v1[1]); w.w = cvtpk(v1[2], v1[3]);
                    *(u32x4*)(H + off + bj * HALF) = w;
                    const float f8[8] = {v0[0], v0[1], v0[2], v0[3], v1[0], v1[1], v1[2], v1[3]};
                    h8[m][bj] = pack8_fp8(f8); } }
#pragma unroll
            for (int mp = 0; mp < 2; ++mp)
#pragma unroll
                for (int bj = 0; bj < 2; ++bj) {
                    const auto r0 = __builtin_amdgcn_permlane16_swap(h8[2 * mp][bj].x, h8[2 * mp + 1][bj].x, false, false);
                    const auto r1 = __builtin_amdgcn_permlane16_swap(h8[2 * mp][bj].y, h8[2 * mp + 1][bj].y, false, false);
                    u32x4 w8; w8.x = r0[0]; w8.y = r1[0]; w8.z = r0[1]; w8.w = r1[1];
                    const size_t off8 = (size_t)(row0 + ai * HALF + (2 * mp + (fq & 1)) * 16) * DM + u.pn * BM + wc * 32 + 8 * (fq & ~1) + bj * HALF;
                    *(u32x4*)(H8 + off8) = w8; }
        }
    }
};
struct EpiGU {
    unsigned char* ACT; const float* RSTD; const PG8_LAS int* tab;
    __device__ __forceinline__ void operator()(const f32x4 (&acc)[2][2][4][2], const Unit& u, int ui, int wr, int wc, int fr, int fq) const {
        const int col0 = u.pn * 128 + wc * 32 + 8 * (fq & ~1); const int odd = fq & 1;
        float rsv[2][4];
#pragma unroll
        for (int ai = 0; ai < 2; ++ai)
#pragma unroll
            for (int m = 0; m < 4; ++m) { const int rl = ai * HALF + wr * 64 + m * 16 + fr; rsv[ai][m] = ((const PG8_LAS float*)tab)[T_RSTAB / 4 + ui * 256 + rl] * (1.f / WGU_SC); }
#pragma unroll
        for (int ai = 0; ai < 2; ++ai)
#pragma unroll
            for (int mp = 0; mp < 2; ++mp) {
                u32x2 pk[2];
#pragma unroll
                for (int q = 0; q < 2; ++q) { const int m = 2 * mp + q; const float rs = rsv[ai][m], rsa = rs * ACT_SC;
                    const f32x4 g0 = acc[ai][0][m][0] * rs, g1 = acc[ai][0][m][1] * rs, u0 = acc[ai][1][m][0] * rsa, u1 = acc[ai][1][m][1] * rsa;
                    const f32x4 n0 = g0 * (-LOG2E), n1 = g1 * (-LOG2E);
                    f32x4 d0, d1;
#pragma unroll
                    for (int e = 0; e < 4; ++e) { d0[e] = __builtin_amdgcn_exp2f(n0[e]); d1[e] = __builtin_amdgcn_exp2f(n1[e]); }
                    d0 = d0 + 1.f; d1 = d1 + 1.f;
#pragma unroll
                    for (int e = 0; e < 4; ++e) { d0[e] = __builtin_amdgcn_rcpf(d0[e]); d1[e] = __builtin_amdgcn_rcpf(d1[e]); }
                    const f32x4 o0 = (g0 * u0) * d0, o1 = (g1 * u1) * d1;
                    float f8[8] = {o0[0], o0[1], o0[2], o0[3], o1[0], o1[1], o1[2], o1[3]};
#pragma unroll
                    for (int e = 0; e < 8; ++e) f8[e] = __builtin_fminf(__builtin_fmaxf(f8[e], -448.f), 448.f);
                    pk[q] = pack8_fp8(f8); }
                const auto r0 = __builtin_amdgcn_permlane16_swap(pk[0].x, pk[1].x, false, false);
                const auto r1 = __builtin_amdgcn_permlane16_swap(pk[0].y, pk[1].y, false, false);
                u32x4 w; w.x = r0[0]; w.y = r1[0]; w.z = r0[1]; w.w = r1[1];
                const int rl = ai * HALF + wr * 64 + (2 * mp + odd) * 16 + fr;
                if (rl < u.nv) *(u32x4*)(ACT + (size_t)(u.pm * 256 + rl) * DEXP + col0) = w; }
    }
};
struct EpiDown {
    unsigned char* Y; const PG8_LAS int* tab;
    __device__ __forceinline__ void operator()(const f32x4 (&acc)[2][2][4][2], const Unit& u, int ui, int wr, int wc, int fr, int fq) const {
        const int col0 = u.pn * BM + wc * 64 + 16 * fq; const float sc = Y_SC / (WD_SC * ACT_SC);
#pragma unroll
        for (int ai = 0; ai < 2; ++ai)
#pragma unroll
            for (int m = 0; m < 4; ++m) { const int rl = ai * HALF + wr * 64 + m * 16 + fr;
                const bool ok = rl < u.nv; const unsigned ts = (unsigned)tab[T_ROWTAB / 4 + ui * 256 + (ok ? rl : 0)];
                u32x2 pk[2];
#pragma unroll
                for (int bj = 0; bj < 2; ++bj) { const f32x4 v0 = acc[ai][bj][m][0] * sc, v1 = acc[ai][bj][m][1] * sc;
                    const float f8[8] = {v0[0], v0[1], v0[2], v0[3], v1[0], v1[1], v1[2], v1[3]}; pk[bj] = pack8_fp8(f8); }
                u32x4 w; w.x = pk[0].x; w.y = pk[0].y; w.z = pk[1].x; w.w = pk[1].y;
                if (ok) *(u32x4*)(Y + (size_t)ts * DM + col0) = w; }
    }
};
}

#define XB_TMO      128
#define XB_XCNT(j)  (256  + 64 * (j))
#define XB_XSUB(j)  (1280 + 64 * (j))
#define XB_XGEN(j)  (2304 + 64 * (j))
#define XB_TOP      3328
#define XB_TOPGEN   3392
#define XCD_BAR_WORDS 3456
#define XB_SPIN_CAP (1u << 18)
__device__ __forceinline__ unsigned xb_ld(unsigned* p)              { return __hip_atomic_load(p, __ATOMIC_RELAXED, __HIP_MEMORY_SCOPE_AGENT); }
__device__ __forceinline__ unsigned xb_add(unsigned* p, unsigned v) { return __hip_atomic_fetch_add(p, v, __ATOMIC_RELAXED, __HIP_MEMORY_SCOPE_AGENT); }
__device__ __forceinline__ unsigned xb_xcc_id() { return (unsigned)__builtin_amdgcn_s_getreg((3 << 11) | 20) & 0xFu; }
#define XB_SPIN(cond, bar) do { unsigned _sp = 0; while (cond) { __builtin_amdgcn_s_sleep(1); \
    if ((++_sp & 255u) == 0u) { if (xb_ld(&(bar)[XB_TMO])) break; if (_sp > XB_SPIN_CAP) { atomicAdd(&(bar)[XB_TMO], 1u); break; } } } } while (0)
struct XcdBarrier { unsigned* bar; unsigned x; volatile LAS unsigned* st; };
__device__ __forceinline__ XcdBarrier xcd_barrier_post(unsigned* bar, volatile LAS unsigned* st) {
    XcdBarrier b; b.bar = bar; b.x = xb_xcc_id(); b.st = st;
    if (threadIdx.x == 0) (void)xb_add(&bar[XB_XCNT(b.x)], 1u);
    return b;
}
__device__ __forceinline__ void xcd_barrier_complete(unsigned* bar, unsigned x, unsigned& nloc, unsigned& nx) {
    const unsigned G = gridDim.x * gridDim.y * gridDim.z;
    unsigned sum, cnt, mine, sp = 0u;
    for (;;) {
        sum = 0u; cnt = 0u; mine = 0u;
#pragma unroll
        for (unsigned j = 0; j < 16; ++j) { const unsigned c = xb_ld(&bar[XB_XCNT(j)]); sum += c; cnt += (c > 0u) ? 1u : 0u; mine = (j == x) ? c : mine; }
        if (sum == G) break;
        __builtin_amdgcn_s_sleep(1);
        if ((++sp & 255u) == 0u) { if (xb_ld(&bar[XB_TMO])) break; if (sp > XB_SPIN_CAP) { atomicAdd(&bar[XB_TMO], 1u); break; } }
    }
    nloc = mine > 0u ? mine : 1u; nx = cnt > 0u ? cnt : 1u;
}
__device__ __forceinline__ void xcd_barrier(const XcdBarrier& b) {
    asm volatile("s_waitcnt vmcnt(0)" ::: "memory");
    __syncthreads();
    if (threadIdx.x == 0) {
        unsigned* bar = b.bar;
        __builtin_amdgcn_s_waitcnt(0);
        unsigned nloc = b.st[0], nx = b.st[1];
        if (nloc == 0u) { xcd_barrier_complete(bar, b.x, nloc, nx); b.st[0] = nloc; b.st[1] = nx; }
        const unsigned old = xb_add(&bar[XB_XSUB(b.x)], 1u);
        const unsigned gen = old / nloc;
        if (old + 1u == (gen + 1u) * nloc) {
            __builtin_amdgcn_fence(__ATOMIC_RELEASE, "agent");
            asm volatile("s_waitcnt vmcnt(0)" ::: "memory");
            const unsigned og = xb_add(&bar[XB_TOP], 1u);
            const unsigned tg = og / nx;
            if (og + 1u == (tg + 1u) * nx) xb_add(&bar[XB_TOPGEN], 1u);
            else XB_SPIN(xb_ld(&bar[XB_TOPGEN]) == tg, bar);
            __builtin_amdgcn_fence(__ATOMIC_ACQUIRE, "agent");
            xb_add(&bar[XB_XGEN(b.x)], 1u);
            asm volatile("s_waitcnt vmcnt(0)" ::: "memory");
        } else {
            XB_SPIN(xb_ld(&bar[XB_XGEN(b.x)]) == gen, bar);
            __builtin_amdgcn_fence(__ATOMIC_ACQUIRE, "agent");
            asm volatile("s_waitcnt vmcnt(0)" ::: "memory");
        }
    }
    __syncthreads();
}

__device__ __forceinline__ void xcd_barrier_arrive(const XcdBarrier& b, volatile LAS unsigned* sv) {
    asm volatile("s_waitcnt vmcnt(0)" ::: "memory");
    __syncthreads();
    if (threadIdx.x == 0) {
        unsigned* bar = b.bar;
        __builtin_amdgcn_s_waitcnt(0);
        unsigned nloc = b.st[0], nx = b.st[1];
        if (nloc == 0u) { xcd_barrier_complete(bar, b.x, nloc, nx); b.st[0] = nloc; b.st[1] = nx; }
        const unsigned old = xb_add(&bar[XB_XSUB(b.x)], 1u);
        const unsigned gen = old / nloc;
        unsigned role = 0u, tg = 0u;
        if (old + 1u == (gen + 1u) * nloc) {
            __builtin_amdgcn_fence(__ATOMIC_RELEASE, "agent");
            asm volatile("s_waitcnt vmcnt(0)" ::: "memory");
            const unsigned og = xb_add(&bar[XB_TOP], 1u);
            tg = og / nx;
            if (og + 1u == (tg + 1u) * nx) { xb_add(&bar[XB_TOPGEN], 1u); role = 2u; } else role = 1u;
        }
        sv[0] = role; sv[1] = gen; sv[2] = tg;
    }
}
__device__ __forceinline__ void xcd_barrier_wait(const XcdBarrier& b, volatile LAS unsigned* sv) {
    asm volatile("s_waitcnt vmcnt(0)" ::: "memory");
    __syncthreads();
    if (threadIdx.x == 0) {
        unsigned* bar = b.bar; const unsigned role = sv[0], gen = sv[1], tg = sv[2];
        if (role != 0u) {
            if (role == 1u) XB_SPIN(xb_ld(&bar[XB_TOPGEN]) == tg, bar);
            __builtin_amdgcn_fence(__ATOMIC_ACQUIRE, "agent");
            xb_add(&bar[XB_XGEN(b.x)], 1u);
            asm volatile("s_waitcnt vmcnt(0)" ::: "memory");
        } else {
            XB_SPIN(xb_ld(&bar[XB_XGEN(b.x)]) == gen, bar);
            __builtin_amdgcn_fence(__ATOMIC_ACQUIRE, "agent");
            asm volatile("s_waitcnt vmcnt(0)" ::: "memory");
        }
    }
    __syncthreads();
}

__device__ __forceinline__ float wave_sum(float v) {
#pragma unroll
    for (int o = 1; o < 64; o <<= 1) v += __shfl_xor(v, o);
    return v;
}
__device__ __forceinline__ void tr_item(const float* src, int srcN, int k0, int n0, bf16* dst, int drow0, int dK, const float* kscale, LAS float* scr, int lane) {
    f32x4 w[8];
    const int kq = lane >> 3, nq = lane & 7;
    const float* sp = src + (size_t)(k0 + kq) * srcN + n0 + 4 * nq;
#pragma unroll
    for (int i = 0; i < 8; ++i) w[i] = __builtin_nontemporal_load((const GAS f32x4*)(sp + (size_t)(8 * i) * srcN));
    float ksv = 1.f; if (kscale) ksv = kscale[k0 + lane];
#pragma unroll
    for (int i = 0; i < 8; ++i) { const float ks = __shfl(ksv, 8 * i + kq); LAS float* wp = scr + (8 * i + kq) * 33 + 4 * nq;
        wp[0] = w[i].x * ks; wp[1] = w[i].y * ks; wp[2] = w[i].z * ks; wp[3] = w[i].w * ks; }
    LDS_WAIT(); asm volatile("" ::: "memory");
    const int c = lane & 7;
#pragma unroll
    for (int j = 0; j < 4; ++j) { const int n = (lane >> 3) + 8 * j; const LAS float* s = scr + (8 * c) * 33 + n;
        u32x4 o; o.x = cvtpk(s[0 * 33], s[1 * 33]); o.y = cvtpk(s[2 * 33], s[3 * 33]); o.z = cvtpk(s[4 * 33], s[5 * 33]); o.w = cvtpk(s[6 * 33], s[7 * 33]);
        *(GAS u32x4*)(dst + (size_t)(drow0 + n) * dK + k0 + 8 * c) = o; }
    LDS_WAIT(); asm volatile("" ::: "memory");
}

template <bool PERM = false>
__device__ __forceinline__ void tr_item8(const float* src, int srcN, int k0, int n0, unsigned char* dst, int drow0, int dK, const float* kscale, float scale, LAS float* scr, int lane) {
    f32x4 w[8];
    const int kq = lane >> 3, nq = lane & 7;
    const float* sp = src + (size_t)(k0 + kq) * srcN + n0 + 4 * nq;
#pragma unroll
    for (int i = 0; i < 8; ++i) w[i] = __builtin_nontemporal_load((const GAS f32x4*)(sp + (size_t)(8 * i) * srcN));
    float ksv = scale; if (kscale) ksv *= kscale[k0 + lane];
#pragma unroll
    for (int i = 0; i < 8; ++i) { const float ks = __shfl(ksv, 8 * i + kq); LAS float* wp = scr + (8 * i + kq) * 33 + 4 * nq;
        wp[0] = w[i].x * ks; wp[1] = w[i].y * ks; wp[2] = w[i].z * ks; wp[3] = w[i].w * ks; }
    LDS_WAIT(); asm volatile("" ::: "memory");
#pragma unroll
    for (int j = 0; j < 2; ++j) { const int idx = lane + 64 * j, n = idx >> 2, c = idx & 3; const LAS float* sc_ = scr + (16 * c) * 33 + n;
        float f[16];
#pragma unroll
        for (int i = 0; i < 16; ++i) f[i] = sc_[i * 33];
        const u32x2 lo = pack8_fp8(f), hi = pack8_fp8(f + 8);
        u32x4 o; o.x = lo.x; o.y = lo.y; o.z = hi.x; o.w = hi.y;
        int drow = drow0 + n;
        if (PERM) { const int nl = drow & 255; drow = (drow & ~255) + 128 * ((nl >> 3) & 1) + 32 * (nl >> 6) + 8 * ((nl >> 4) & 3) + (nl & 7); }
        *(GAS u32x4*)(dst + (size_t)drow * dK + k0 + 16 * c) = o; }
    LDS_WAIT(); asm volatile("" ::: "memory");
}

struct Ptrs {
    const float *x, *attn_g, *w_in, *sbq_g, *sbk_g, *sbo_g, *w2, *gate_b, *glan_g, *w_out, *ffn_g, *rg_w, *rg_b, *re_w, *re_b, *wg, *wu, *wd;
    float* out; unsigned char* ws;
};

constexpr int SB_SPAN = 11, SB_VOFF = SB_SPAN * 4096, SB_XOFF = 2 * SB_VOFF;
constexpr float SB_RTOL = 0x1p-48f;
__device__ __forceinline__ int sb_keyK(int r) { return ((r >> 1) & 3) | (((r >> 4) & 1) << 2); }
__device__ __forceinline__ int sb_keyV(int r) { return ((r >> 2) & 1) | (((r >> 4) & 1) << 1); }
__device__ __forceinline__ void sb_round(LAS unsigned char* lds, const bf16* SQ, const bf16* SK, const bf16* TT, const float* gout, bf16* MIX, int b, int h, int qg, int tid, int wave, int lane) {
    const int il = lane & 31, hi = lane >> 5, pil = PI32(il);
    const int qt = 8 * qg + wave;
    const size_t row0 = (size_t)b * SEQ + (size_t)qt * 32;
    LAS unsigned char* xt = lds + SB_XOFF + wave * 4096;
    const int lr = lane >> 3, lc = lane & 7;
    bf16x8 qf[4];
    { u32x4 ql[4];
#pragma unroll
      for (int i = 0; i < 4; ++i) ql[i] = *(const u32x4*)(SQ + (row0 + lr + 8 * i) * 512 + h * 64 + 8 * lc);
#pragma unroll
      for (int i = 0; i < 4; ++i) { const int r = lr + 8 * i; *(LAS u32x4*)(xt + r * 128 + ((lc ^ sb_keyK(r)) << 4)) = ql[i]; }
      LDS_WAIT(); asm volatile("" ::: "memory");
#pragma unroll
      for (int s = 0; s < 4; ++s) qf[s] = *(const LAS bf16x8*)(xt + il * 128 + (((4 * hi + s) ^ sb_keyK(il)) << 4));
      LDS_WAIT(); asm volatile("" ::: "memory"); }
    const int lo = (8 * qg - (SB_SPAN - 8)) > 0 ? (8 * qg - (SB_SPAN - 8)) : 0, nblk = 8 * qg + 8 - lo;
    {
        u32x4 st[SB_SPAN];
        const bool isK = tid < 256; const int q = tid - 256;
        const bf16* src = isK ? SK + ((size_t)b * SEQ + (size_t)lo * 32 + (tid >> 3)) * 512 + h * 64 + 8 * (tid & 7)
                              : TT + ((size_t)(b * (SEQ / 32) + lo) * NB + h * 64 + (q >> 2)) * 32 + 8 * (q & 3);
        const size_t bstep = isK ? (size_t)32 * 512 : (size_t)NB * 32;
#pragma unroll
        for (int i = 0; i < SB_SPAN; ++i) if (i < nblk) st[i] = *(const u32x4*)(src + (size_t)i * bstep);
        const int r = isK ? (tid >> 3) : (q >> 2);
        const unsigned dst = isK ? (unsigned)(r * 128 + (((tid & 7) ^ sb_keyK(r)) << 4)) : (unsigned)(SB_VOFF + r * 64 + (((q & 3) ^ sb_keyV(r & 31)) << 4));
#pragma unroll
        for (int i = 0; i < SB_SPAN; ++i) if (i < nblk) *(LAS u32x4*)(lds + dst + i * 4096) = st[i];
    }
    __syncthreads();
    f32x16 o0, o1;
#pragma unroll
    for (int r = 0; r < 16; ++r) { o0[r] = 0.f; o1[r] = 0.f; }
    float R = 1.f;
#define SB_MATH(KC, VC, DIAG_) do { \
        f32x16 z; \
        _Pragma("unroll") for (int r = 0; r < 16; ++r) z[r] = 0.f; \
        _Pragma("unroll") for (int s = 0; s < 4; ++s) z = MFMA32(KC[s], qf[s], z); \
        float beta[16], omb[16]; \
        _Pragma("unroll") for (int r = 0; r < 16; ++r) { \
            const float u = __builtin_amdgcn_exp2f(-__builtin_amdgcn_fmed3f(z[r], -100.f, 3.0e38f)); float be = __builtin_amdgcn_rcpf(1.f + u); float om = u * be; \
            if (DIAG_) { const bool valid = (16 * hi + r) < il; be = valid ? be : 0.f; om = valid ? om : 1.f; } \
            beta[r] = be; omb[r] = om; } \
        float e[16]; e[15] = 1.f; \
        _Pragma("unroll") for (int r = 14; r >= 0; --r) e[r] = e[r + 1] * omb[r + 1]; \
        const float P16 = e[0] * omb[0]; \
        float Plo, Phi; swap32(P16, Plo, Phi); \
        const float base = R * (hi ? 1.f : Phi); \
        float a[16]; \
        _Pragma("unroll") for (int r = 0; r < 16; ++r) a[r] = beta[r] * e[r] * base; \
        R = R * (Plo * Phi); \
        const bf16x8 p0 = pack8(a), p1 = pack8(a + 8); \
        o0 = MFMA32(VC[0][0], p0, o0); o0 = MFMA32(VC[0][1], p1, o0); \
        o1 = MFMA32(VC[1][0], p0, o1); o1 = MFMA32(VC[1][1], p1, o1); } while (0)
    bool fin = false;
    {
        const unsigned kbase = (unsigned)(pil * 128), vbase = (unsigned)(SB_VOFF + pil * 64);
        unsigned kx[4], vx[2];
#pragma unroll
        for (int s = 0; s < 4; ++s) kx[s] = (unsigned)(((4 * hi + s) ^ sb_keyK(pil)) << 4);
#pragma unroll
        for (int s = 0; s < 2; ++s) vx[s] = (unsigned)(((2 * hi + s) ^ sb_keyV(pil)) << 4);
#define SB_LDSFRAG(kb_) const unsigned so = (unsigned)((kb_) - lo) * 4096u; bf16x8 kf[4], vf[2][2]; \
            _Pragma("unroll") for (int s = 0; s < 4; ++s) kf[s] = *(const LAS bf16x8*)(lds + so + kbase + kx[s]); \
            _Pragma("unroll") for (int dt = 0; dt < 2; ++dt) _Pragma("unroll") for (int s = 0; s < 2; ++s) vf[dt][s] = *(const LAS bf16x8*)(lds + so + vbase + dt * 2048 + vx[s]);
        bool more = false;
        { SB_LDSFRAG(qt); SB_MATH(kf, vf, true);
          if (qt == 0 || __all(R < SB_RTOL)) fin = true; else more = (qt != lo); }
        if (more) for (int kb = qt - 1; ; --kb) {
            SB_LDSFRAG(kb); SB_MATH(kf, vf, false);
            if (kb == 0 || __all(R < SB_RTOL)) { fin = true; break; }
            if (kb == lo) break;
        }
#undef SB_LDSFRAG
    }
    if (!fin) {
        for (int kb = lo - 1; ; --kb) {
            bf16x8 kf[4], vf[2][2];
            const bf16* kp = SK + ((size_t)b * SEQ + (size_t)kb * 32 + pil) * 512 + h * 64 + 32 * hi;
#pragma unroll
            for (int s = 0; s < 4; ++s) kf[s] = *(const bf16x8*)(kp + 8 * s);
            const bf16* vp = TT + ((size_t)(b * (SEQ / 32) + kb) * NB + h * 64 + pil) * 32 + 16 * hi;
#pragma unroll
            for (int dt = 0; dt < 2; ++dt)
#pragma unroll
                for (int s = 0; s < 2; ++s) vf[dt][s] = *(const bf16x8*)(vp + dt * 32 * 32 + 8 * s);
            SB_MATH(kf, vf, false);
            if (kb == 0 || __all(R < SB_RTOL)) break;
        }
    }
#undef SB_MATH
    float ss = 0.f;
#pragma unroll
    for (int r = 0; r < 16; ++r) ss += o0[r] * o0[r] + o1[r] * o1[r];
    float slo, shi; swap32(ss, slo, shi);
    const float rstd = __builtin_amdgcn_rsqf((slo + shi) * (1.f / 64.f) + EPS);
#pragma unroll
    for (int dt = 0; dt < 2; ++dt) {
        float v[16];
#pragma unroll
        for (int r4 = 0; r4 < 4; ++r4) { const f32x4 g = *(const f32x4*)(gout + 32 * dt + 16 * hi + 4 * r4);
#pragma unroll
            for (int e2 = 0; e2 < 4; ++e2) v[4 * r4 + e2] = (dt ? o1[4 * r4 + e2] : o0[4 * r4 + e2]) * rstd * g[e2]; }
        const int c0 = 4 * dt + 2 * hi;
        *(LAS bf16x8*)(xt + il * 128 + ((c0 ^ sb_keyK(il)) << 4)) = pack8(v); *(LAS bf16x8*)(xt + il * 128 + (((c0 + 1) ^ sb_keyK(il)) << 4)) = pack8(v + 8);
    }
    LDS_WAIT(); asm volatile("" ::: "memory");
    { u32x4 ol[4];
#pragma unroll
      for (int i = 0; i < 4; ++i) { const int r = lr + 8 * i; ol[i] = *(const LAS u32x4*)(xt + r * 128 + ((lc ^ sb_keyK(r)) << 4)); }
#pragma unroll
      for (int i = 0; i < 4; ++i) *(u32x4*)(MIX + (row0 + lr + 8 * i) * DM + h * 64 + 8 * lc) = ol[i]; }
    __syncthreads();
}

#define SB_ISSUE(nx_, b_, h_, qg_) do { const int lo_ = (8 * (qg_) - (SB_SPAN - 8)) > 0 ? (8 * (qg_) - (SB_SPAN - 8)) : 0, nb_ = 8 * (qg_) + 8 - lo_; const bool isK_ = tid < 256; const int q_ = tid - 256; \
        const bf16* p_ = isK_ ? SK + ((size_t)(b_) * SEQ + (size_t)lo_ * 32 + (tid >> 3)) * 512 + (h_) * 64 + 8 * (tid & 7) : TT + ((size_t)((b_) * (SEQ / 32) + lo_) * NB + (h_) * 64 + (q_ >> 2)) * 32 + 8 * (q_ & 3); \
        const size_t bs_ = isK_ ? (size_t)32 * 512 : (size_t)NB * 32; \
        _Pragma("unroll") for (int i = 0; i < SB_SPAN; ++i) { if (i < nb_) asm volatile("global_load_dwordx4 %0, %1, off" : "+v"((nx_)[i]), "+v"(p_) :: "memory"); p_ += bs_; } } while (0)
__device__ __forceinline__ void sb_round_pf(LAS unsigned char* lds, const bf16* SQ, const bf16* SK, const bf16* TT, const float* gout, bf16* MIX, int b, int h, int qg, int tid, int wave, int lane,
                                            u32x4 (&nx)[SB_SPAN], const bool pre, const bool has_next, const int nb, const int nh, const int nqg, unsigned* qctr, volatile LAS unsigned* qslot) {
    const int il = lane & 31, hi = lane >> 5, pil = PI32(il);
    const int qt = 8 * qg + wave;
    const size_t row0 = (size_t)b * SEQ + (size_t)qt * 32;
    LAS unsigned char* xt = lds + SB_XOFF + wave * 4096;
    const int lr = lane >> 3, lc = lane & 7;
    bf16x8 qf[4];
    { u32x4 ql[4];
#pragma unroll
      for (int i = 0; i < 4; ++i) ql[i] = *(const u32x4*)(SQ + (row0 + lr + 8 * i) * 512 + h * 64 + 8 * lc);
#pragma unroll
      for (int i = 0; i < 4; ++i) { const int r = lr + 8 * i; *(LAS u32x4*)(xt + r * 128 + ((lc ^ sb_keyK(r)) << 4)) = ql[i]; }
      LDS_WAIT(); asm volatile("" ::: "memory");
#pragma unroll
      for (int s = 0; s < 4; ++s) qf[s] = *(const LAS bf16x8*)(xt + il * 128 + (((4 * hi + s) ^ sb_keyK(il)) << 4));
      LDS_WAIT(); asm volatile("" ::: "memory"); }
    const int lo = (8 * qg - (SB_SPAN - 8)) > 0 ? (8 * qg - (SB_SPAN - 8)) : 0, nblk = 8 * qg + 8 - lo;
    {
        const bool isK = tid < 256; const int q = tid - 256;
        if (!pre) SB_ISSUE(nx, b, h, qg);
        static_assert(SB_SPAN == 11, "the wait below names the staging registers");
        asm volatile("s_waitcnt vmcnt(0)" : "+v"(nx[0]), "+v"(nx[1]), "+v"(nx[2]), "+v"(nx[3]), "+v"(nx[4]), "+v"(nx[5]), "+v"(nx[6]), "+v"(nx[7]), "+v"(nx[8]), "+v"(nx[9]), "+v"(nx[10]) :: "memory");
        const int r = isK ? (tid >> 3) : (q >> 2);
        const unsigned dst = isK ? (unsigned)(r * 128 + (((tid & 7) ^ sb_keyK(r)) << 4)) : (unsigned)(SB_VOFF + r * 64 + (((q & 3) ^ sb_keyV(r & 31)) << 4));
#pragma unroll
        for (int i = 0; i < SB_SPAN; ++i) if (i < nblk) *(LAS u32x4*)(lds + dst + i * 4096) = nx[i];
    }
    __syncthreads();
    if (has_next) SB_ISSUE(nx, nb, nh, nqg);
    f32x16 o0, o1;
#pragma unroll
    for (int r = 0; r < 16; ++r) { o0[r] = 0.f; o1[r] = 0.f; }
    float R = 1.f;
#define SB_MATH(KC, VC, DIAG_) do { \
        f32x16 z; \
        _Pragma("unroll") for (int r = 0; r < 16; ++r) z[r] = 0.f; \
        _Pragma("unroll") for (int s = 0; s < 4; ++s) z = MFMA32(KC[s], qf[s], z); \
        float beta[16], omb[16]; \
        _Pragma("unroll") for (int r = 0; r < 16; ++r) { \
            const float u = __builtin_amdgcn_exp2f(-__builtin_amdgcn_fmed3f(z[r], -100.f, 3.0e38f)); float be = __builtin_amdgcn_rcpf(1.f + u); float om = u * be; \
            if (DIAG_) { const bool valid = (16 * hi + r) < il; be = valid ? be : 0.f; om = valid ? om : 1.f; } \
            beta[r] = be; omb[r] = om; } \
        float e[16]; e[15] = 1.f; \
        _Pragma("unroll") for (int r = 14; r >= 0; --r) e[r] = e[r + 1] * omb[r + 1]; \
        const float P16 = e[0] * omb[0]; \
        float Plo, Phi; swap32(P16, Plo, Phi); \
        const float base = R * (hi ? 1.f : Phi); \
        float a[16]; \
        _Pragma("unroll") for (int r = 0; r < 16; ++r) a[r] = beta[r] * e[r] * base; \
        R = R * (Plo * Phi); \
        const bf16x8 p0 = pack8(a), p1 = pack8(a + 8); \
        o0 = MFMA32(VC[0][0], p0, o0); o0 = MFMA32(VC[0][1], p1, o0); \
        o1 = MFMA32(VC[1][0], p0, o1); o1 = MFMA32(VC[1][1], p1, o1); } while (0)
    bool fin = false;
    {
        const unsigned kbase = (unsigned)(pil * 128), vbase = (unsigned)(SB_VOFF + pil * 64);
        unsigned kx[4], vx[2];
#pragma unroll
        for (int s = 0; s < 4; ++s) kx[s] = (unsigned)(((4 * hi + s) ^ sb_keyK(pil)) << 4);
#pragma unroll
        for (int s = 0; s < 2; ++s) vx[s] = (unsigned)(((2 * hi + s) ^ sb_keyV(pil)) << 4);
#define SB_LDSFRAG(kb_) const unsigned so = (unsigned)((kb_) - lo) * 4096u; bf16x8 kf[4], vf[2][2]; \
            _Pragma("unroll") for (int s = 0; s < 4; ++s) kf[s] = *(const LAS bf16x8*)(lds + so + kbase + kx[s]); \
            _Pragma("unroll") for (int dt = 0; dt < 2; ++dt) _Pragma("unroll") for (int s = 0; s < 2; ++s) vf[dt][s] = *(const LAS bf16x8*)(lds + so + vbase + dt * 2048 + vx[s]);
        bool more = false;
        { SB_LDSFRAG(qt); SB_MATH(kf, vf, true);
          if (qt == 0 || __all(R < SB_RTOL)) fin = true; else more = (qt != lo); }
        if (more) for (int kb = qt - 1; ; --kb) {
            SB_LDSFRAG(kb); SB_MATH(kf, vf, false);
            if (kb == 0 || __all(R < SB_RTOL)) { fin = true; break; }
            if (kb == lo) break;
        }
#undef SB_LDSFRAG
    }
    if (!fin) {
        for (int kb = lo - 1; ; --kb) {
            bf16x8 kf[4], vf[2][2];
            const bf16* kp = SK + ((size_t)b * SEQ + (size_t)kb * 32 + pil) * 512 + h * 64 + 32 * hi;
#pragma unroll
            for (int s = 0; s < 4; ++s) kf[s] = *(const bf16x8*)(kp + 8 * s);
            const bf16* vp = TT + ((size_t)(b * (SEQ / 32) + kb) * NB + h * 64 + pil) * 32 + 16 * hi;
#pragma unroll
            for (int dt = 0; dt < 2; ++dt)
#pragma unroll
                for (int s = 0; s < 2; ++s) vf[dt][s] = *(const bf16x8*)(vp + dt * 32 * 32 + 8 * s);
            SB_MATH(kf, vf, false);
            if (kb == 0 || __all(R < SB_RTOL)) break;
        }
    }
#undef SB_MATH
    unsigned tkn_ = 0u;
    if (tid == 0) tkn_ = __hip_atomic_fetch_add(qctr, 1u, __ATOMIC_RELAXED, __HIP_MEMORY_SCOPE_AGENT);
    float ss = 0.f;
#pragma unroll
    for (int r = 0; r < 16; ++r) ss += o0[r] * o0[r] + o1[r] * o1[r];
    float slo, shi; swap32(ss, slo, shi);
    const float rstd = __builtin_amdgcn_rsqf((slo + shi) * (1.f / 64.f) + EPS);
#pragma unroll
    for (int dt = 0; dt < 2; ++dt) {
        float v[16];
#pragma unroll
        for (int r4 = 0; r4 < 4; ++r4) { const f32x4 g = *(const f32x4*)(gout + 32 * dt + 16 * hi + 4 * r4);
#pragma unroll
            for (int e2 = 0; e2 < 4; ++e2) v[4 * r4 + e2] = (dt ? o1[4 * r4 + e2] : o0[4 * r4 + e2]) * rstd * g[e2]; }
        const int c0 = 4 * dt + 2 * hi;
        *(LAS bf16x8*)(xt + il * 128 + ((c0 ^ sb_keyK(il)) << 4)) = pack8(v); *(LAS bf16x8*)(xt + il * 128 + (((c0 + 1) ^ sb_keyK(il)) << 4)) = pack8(v + 8);
    }
    LDS_WAIT(); asm volatile("" ::: "memory");
    { u32x4 ol[4];
#pragma unroll
      for (int i = 0; i < 4; ++i) { const int r = lr + 8 * i; ol[i] = *(const LAS u32x4*)(xt + r * 128 + ((lc ^ sb_keyK(r)) << 4)); }
#pragma unroll
      for (int i = 0; i < 4; ++i) *(u32x4*)(MIX + (row0 + lr + 8 * i) * DM + h * 64 + 8 * lc) = ol[i]; }
    if (tid == 0) *qslot = tkn_;
    __syncthreads();
}

#undef SB_ISSUE
__device__ __forceinline__ void gla_a(LAS unsigned char* wl, const bf16* GLR, const bf16* W2T, const float* gate_b, const bf16* TT, bf16* KV, float* DTOT, int bh, int j, int lane) {
    const int il = lane & 31, hi = lane >> 5, pil = PI32(il);
    const int b = bh >> 2, h = bh & 3;
    const size_t t0 = (size_t)b * SEQ + (size_t)j * 64;
    bf16x8 gf[2], wf[2], gkf[2][2][2], bvf[4][4]; float bias[2];
#pragma unroll
    for (int ch = 0; ch < 2; ++ch) gf[ch] = *(const bf16x8*)(GLR + (t0 + 32 * ch + pil) * 16 + 8 * hi);
#pragma unroll
    for (int kh = 0; kh < 2; ++kh) { const int kcol = 64 * h + 32 * kh + pil; wf[kh] = *(const bf16x8*)(W2T + kcol * 16 + 8 * hi); bias[kh] = gate_b[kcol];
        const bf16* gkp = TT + ((t0 >> 5) * NB + 512 + kcol) * 32 + 16 * hi;
#pragma unroll
        for (int ch = 0; ch < 2; ++ch) { gkf[kh][ch][0] = *(const bf16x8*)(gkp + ch * NB * 32); gkf[kh][ch][1] = *(const bf16x8*)(gkp + ch * NB * 32 + 8); } }
#pragma unroll
    for (int vq = 0; vq < 4; ++vq) { const bf16* vp = TT + ((t0 >> 5) * NB + 768 + 128 * h + 32 * vq + il) * 32 + 16 * hi;
#pragma unroll
        for (int s = 0; s < 4; ++s) bvf[vq][s] = *(const bf16x8*)(vp + (s >> 1) * NB * 32 + 8 * (s & 1)); }
    bf16x8 akf[2][4];
#pragma unroll
    for (int kh = 0; kh < 2; ++kh) {
        const int kcol = 64 * h + 32 * kh + pil;
        float cs[2][16];
#pragma unroll
        for (int ch = 0; ch < 2; ++ch) {
            f32x16 g;
#pragma unroll
            for (int r = 0; r < 16; ++r) g[r] = 0.f;
            g = MFMA32(gf[ch], wf[kh], g);
            if (kh == 0 && ch == 0) asm volatile("" : "+v"(g) :: "memory");
            float run = 0.f;
#pragma unroll
            for (int r = 0; r < 16; ++r) { const float x = g[r] + bias[kh];
                const float ls2 = __builtin_fminf(x, 0.f) * LOG2E - __builtin_amdgcn_logf(1.f + __builtin_amdgcn_exp2f(-__builtin_fabsf(x) * LOG2E));
                run += ls2 * (1.f / 16.f); cs[ch][r] = run; }
        }
        float t0lo, t0hi, t1lo, t1hi; swap32(cs[0][15], t0lo, t0hi); swap32(cs[1][15], t1lo, t1hi);
        const float off0 = hi ? t0lo : 0.f, off1 = (t0lo + t0hi) + (hi ? t1lo : 0.f), total = (t0lo + t0hi) + (t1lo + t1hi);
        if (hi == 0) DTOT[((size_t)bh * 32 + j) * 64 + 32 * kh + pil] = __builtin_amdgcn_exp2f(total);
#pragma unroll
        for (int ch = 0; ch < 2; ++ch) {
            const bf16x8 k0 = gkf[kh][ch][0], k1 = gkf[kh][ch][1];
            float kd[16]; const float off = ch ? off1 : off0;
#pragma unroll
            for (int r = 0; r < 16; ++r) { const float dec = __builtin_amdgcn_exp2f(total - (cs[ch][r] + off)); kd[r] = bf2f(r < 8 ? k0[r] : k1[r - 8]) * dec; }
            akf[kh][2 * ch] = pack8(kd); akf[kh][2 * ch + 1] = pack8(kd + 8);
        }
    }
#pragma unroll
    for (int vq = 0; vq < 4; ++vq) {
#pragma unroll
        for (int kh = 0; kh < 2; ++kh) {
            f32x16 kv;
#pragma unroll
            for (int r = 0; r < 16; ++r) kv[r] = 0.f;
#pragma unroll
            for (int s = 0; s < 4; ++s) kv = MFMA32(akf[kh][s], bvf[vq][s], kv);
            const int v = 32 * vq + il, c0 = 4 * kh + 2 * hi;
            float kvf[16];
#pragma unroll
            for (int r = 0; r < 16; ++r) kvf[r] = kv[r];
            *(LAS bf16x8*)(wl + v * 128 + ((c0 ^ (v & 7)) << 4)) = pack8(kvf); *(LAS bf16x8*)(wl + v * 128 + (((c0 + 1) ^ (v & 7)) << 4)) = pack8(kvf + 8);
        }
    }
    LDS_WAIT(); asm volatile("" ::: "memory");
    { unsigned char* dst = (unsigned char*)(KV + ((size_t)bh * 32 + j) * 8192) + lane * 16;
      u32x4 t[16];
#pragma unroll
      for (int i = 0; i < 16; ++i) { const int v = 8 * i + (lane >> 3), c = lane & 7; t[i] = *(const LAS u32x4*)(wl + v * 128 + ((c ^ (v & 7)) << 4)); }
#pragma unroll
      for (int i = 0; i < 16; ++i) *(u32x4*)(dst + i * 1024) = t[i]; }
    LDS_WAIT(); asm volatile("" ::: "memory");
}
__device__ __forceinline__ void gla_b(const bf16* KV, const float* DTOT, bf16* ST, int task, int lane) {
    const int bh = task >> 5, part = task & 31; const int e0 = part * 256 + lane * 4; const int k = e0 & 63;
    f32x4 S = (f32x4){0.f, 0.f, 0.f, 0.f};
#pragma unroll
    for (int half = 0; half < 2; ++half) {
        u32x2 kvp[16]; f32x4 d[16];
#pragma unroll
        for (int q = 0; q < 16; ++q) { const int j = 16 * half + q;
            kvp[q] = *(const u32x2*)(KV + ((size_t)bh * 32 + j) * 8192 + e0); d[q] = *(const f32x4*)(DTOT + ((size_t)bh * 32 + j) * 64 + k); }
#pragma unroll
        for (int q = 0; q < 16; ++q) { const int j = 16 * half + q;
            const f32x4 kv = (f32x4){__uint_as_float(kvp[q].x << 16), __uint_as_float(kvp[q].x & 0xffff0000u), __uint_as_float(kvp[q].y << 16), __uint_as_float(kvp[q].y & 0xffff0000u)};
            S = d[q] * S + kv;
            u32x2 w; w.x = cvtpk(S[0], S[1]); w.y = cvtpk(S[2], S[3]);
            *(u32x2*)(ST + ((size_t)bh * 32 + j) * 8192 + e0) = w; }
        asm volatile("" ::: "memory");
    }
}
__device__ __forceinline__ void gla_c(LAS unsigned char* wl, const bf16* ST, const bf16* GQ, const bf16* GRS, const float* gn, bf16* MIX, int bh, int j, int lane) {
    const int il = lane & 31, hi = lane >> 5, pil = PI32(il);
    const int b = bh >> 2, h = bh & 3;
    const size_t t0 = (size_t)b * SEQ + (size_t)j * 64;
    const bf16* sp = ST + ((size_t)bh * 32 + j) * 8192 + lane * 8;
    u32x4 st[16];
#pragma unroll
    for (int i = 0; i < 16; ++i) st[i] = *(const u32x4*)(sp + i * 512);
    bf16x8 bq[2][4], gr[2][4][2];
#pragma unroll
    for (int ch = 0; ch < 2; ++ch) { const size_t row = t0 + 32 * ch + il;
#pragma unroll
        for (int s = 0; s < 4; ++s) bq[ch][s] = *(const bf16x8*)(GQ + row * 256 + 64 * h + 16 * s + 8 * hi); }
    { const size_t row = t0 + il;
#pragma unroll
      for (int vt = 0; vt < 4; ++vt) { gr[0][vt][0] = *(const bf16x8*)(GRS + row * 512 + 128 * h + 32 * vt + 16 * hi); gr[0][vt][1] = *(const bf16x8*)(GRS + row * 512 + 128 * h + 32 * vt + 16 * hi + 8); } }
    { const int vr = lane >> 3, c = lane & 7;
#pragma unroll
      for (int i = 0; i < 16; ++i) { const int v = 8 * i + vr; *(LAS u32x4*)(wl + v * 128 + ((c ^ sb_keyK(v & 31)) << 4)) = st[i]; } }
    LDS_WAIT(); asm volatile("" ::: "memory");
    unsigned ax[4];
#pragma unroll
    for (int s = 0; s < 4; ++s) ax[s] = (unsigned)(pil * 128 + (((2 * s + hi) ^ sb_keyK(pil)) << 4));
#pragma unroll
    for (int ch = 0; ch < 2; ++ch) {
        const size_t row = t0 + 32 * ch + il;
        f32x16 O[4]; float ss = 0.f;
#pragma unroll
        for (int vt = 0; vt < 4; ++vt) {
#pragma unroll
            for (int r = 0; r < 16; ++r) O[vt][r] = 0.f;
#pragma unroll
            for (int s = 0; s < 4; ++s) { const bf16x8 af = *(const LAS bf16x8*)(wl + vt * 4096 + ax[s]); O[vt] = MFMA32(af, bq[ch][s], O[vt]); }
            if (ch == 0 && vt == 0) {
                const size_t row1 = t0 + 32 + il;
#pragma unroll
                for (int v2 = 0; v2 < 4; ++v2) { gr[1][v2][0] = *(const bf16x8*)(GRS + row1 * 512 + 128 * h + 32 * v2 + 16 * hi); gr[1][v2][1] = *(const bf16x8*)(GRS + row1 * 512 + 128 * h + 32 * v2 + 16 * hi + 8); }
                asm volatile("" : "+v"(O[0]) :: "memory"); }
#pragma unroll
            for (int r = 0; r < 16; ++r) ss += O[vt][r] * O[vt][r];
        }
        float slo, shi; swap32(ss, slo, shi);
        const float rstd = __builtin_amdgcn_rsqf((slo + shi) * (1.f / 128.f) + EPS);
#pragma unroll
        for (int vt = 0; vt < 4; ++vt) {
            const int vc0 = 32 * vt + 16 * hi;
            float v[16];
#pragma unroll
            for (int r4 = 0; r4 < 4; ++r4) { const f32x4 g = *(const f32x4*)(gn + vc0 + 4 * r4);
#pragma unroll
                for (int e2 = 0; e2 < 4; ++e2) { const int r = 4 * r4 + e2; v[r] = O[vt][r] * rstd * g[e2] * bf2f(r < 8 ? gr[ch][vt][0][r] : gr[ch][vt][1][r - 8]); } }
            bf16* op = MIX + row * DM + 512 + 128 * h + vc0;
            *(bf16x8*)(op) = pack8(v); *(bf16x8*)(op + 8) = pack8(v + 8);
        }
    }
    LDS_WAIT(); asm volatile("" ::: "memory");
}

#define GS_LD16(dst, ptr, off) asm volatile("global_load_dwordx4 %0, %1, off offset:%2" : "+v"(dst) : "v"(ptr), "n"(off) : "memory")
#define GS_LD8(dst, ptr, off)  asm volatile("global_load_dwordx2 %0, %1, off offset:%2" : "+v"(dst) : "v"(ptr), "n"(off) : "memory")
#define GS_BAR() do { asm volatile("s_waitcnt lgkmcnt(0)" ::: "memory"); __builtin_amdgcn_s_barrier(); asm volatile("" ::: "memory"); } while (0)
__device__ __forceinline__ void gla_seq(LAS unsigned char* lds, const bf16* KV, const float* DTOT, const bf16* GQ, const bf16* GRS, const float* gn, bf16* MIX, int bh, int tid, int wave, int lane, const int j0, const int nch, const bool warm) {
    const int b = bh >> 2, h = bh & 3; const int jend = j0 + nch;
    LAS float* sf = (LAS float*)(lds + 66560);
    if (warm) {
        LAS float* dl = (LAS float*)(lds + 99328);
        { const int idx = tid * 2; if (idx < j0 * 64) { const float2 dv = *(const float2*)(DTOT + (size_t)bh * 32 * 64 + idx); dl[idx] = dv.x; dl[idx + 1] = dv.y; } }
        u32x4 kw[16][2];
        const bf16* kp = KV + (size_t)bh * 32 * 8192 + tid * 16;
#pragma unroll
        for (int j = 0; j < 16; ++j) if (j < j0) { kw[j][0] = *(const u32x4*)(kp + (size_t)j * 8192); kw[j][1] = *(const u32x4*)(kp + (size_t)j * 8192 + 8); }
        __syncthreads();
        f32x4 Sw[4]; const int kb_ = (tid & 3) * 16;
#pragma unroll
        for (int q = 0; q < 4; ++q) Sw[q] = (f32x4){0.f, 0.f, 0.f, 0.f};
#pragma unroll
        for (int j = 0; j < 16; ++j) if (j < j0) {
#pragma unroll
            for (int q = 0; q < 4; ++q) { const f32x4 d = *(const LAS f32x4*)(dl + j * 64 + kb_ + 4 * q); const unsigned w0 = kw[j][q >> 1][2 * (q & 1)], w1 = kw[j][q >> 1][2 * (q & 1) + 1];
                Sw[q] = d * Sw[q] + (f32x4){__uint_as_float(w0 << 16), __uint_as_float(w0 & 0xffff0000u), __uint_as_float(w1 << 16), __uint_as_float(w1 & 0xffff0000u)}; } }
#pragma unroll
        for (int q = 0; q < 4; ++q) *(LAS f32x4*)(sf + tid * 16 + 4 * q) = Sw[q];
        __syncthreads();
    }
    if (wave >= 4) {
        const int pt = tid - 256, k = (pt & 15) * 4, vr = pt >> 4;
        const bf16* kvp = KV + (size_t)bh * 32 * 8192 + pt * 4; const float* dp = DTOT + (size_t)bh * 32 * 64 + k;
        const unsigned wo = (unsigned)(vr * 128 + (k & 4) * 2); const int ck = k >> 3, kf = (vr >> 1) & 3;
        f32x4 S[8]; u32x2 kvr[4][8]; f32x4 dr[4];
#pragma unroll
        for (int g = 0; g < 8; ++g) S[g] = warm ? *(const LAS f32x4*)(sf + (g * 256 + pt) * 4) : (f32x4){0.f, 0.f, 0.f, 0.f};
#define GS_PLOAD(sl_, j_) do { const int jj_ = (j_) < jend ? (j_) : jend - 1; const float* d_ = dp + jj_ * 64; const bf16* k_ = kvp + (size_t)jj_ * 8192; GS_LD16(dr[sl_], d_, 0); \
            _Pragma("unroll") for (int g = 0; g < 8; g += 2) { const bf16* kg_ = k_ + g * 1024; GS_LD8(kvr[sl_][g], kg_, 0); GS_LD8(kvr[sl_][g + 1], kg_, 2048); } } while (0)
#define GS_PWAIT(sl_, n_) asm volatile("s_waitcnt vmcnt(" #n_ ")" : "+v"(dr[sl_]), "+v"(kvr[sl_][0]), "+v"(kvr[sl_][1]), "+v"(kvr[sl_][2]), "+v"(kvr[sl_][3]), "+v"(kvr[sl_][4]), "+v"(kvr[sl_][5]), "+v"(kvr[sl_][6]), "+v"(kvr[sl_][7]) :: "memory")
#pragma unroll
        for (int q = 0; q < 4; ++q) { dr[q] = (f32x4){0.f, 0.f, 0.f, 0.f};
#pragma unroll
            for (int g = 0; g < 8; ++g) kvr[q][g] = (u32x2){0u, 0u}; }
        GS_PLOAD(0, j0); GS_PLOAD(1, j0 + 1); GS_PLOAD(2, j0 + 2); GS_PLOAD(3, j0 + 3);
        GS_PWAIT(0, 0); GS_PWAIT(1, 0); GS_PWAIT(2, 0); GS_PWAIT(3, 0);
        for (int p0 = 0; p0 < nch + 4; p0 += 4) {
#pragma unroll
            for (int u = 0; u < 4; ++u) { const int j = p0 + u;
                if (j > nch) break;
                if (j < nch) {
                    GS_PWAIT(u, 27);
                    LAS unsigned char* img = lds + (j & 1) * 16384;
#pragma unroll
                    for (int g = 0; g < 8; ++g) { const u32x2 kk = kvr[u][g];
                        const f32x4 kv = (f32x4){__uint_as_float(kk.x << 16), __uint_as_float(kk.x & 0xffff0000u), __uint_as_float(kk.y << 16), __uint_as_float(kk.y & 0xffff0000u)};
                        S[g] = dr[u] * S[g] + kv;
                        u32x2 w; w.x = cvtpk(S[g][0], S[g][1]); w.y = cvtpk(S[g][2], S[g][3]);
                        *(LAS u32x2*)(img + g * 2048 + wo + ((ck ^ (kf | ((g & 1) << 2))) << 4)) = w; }
                    GS_PLOAD(u, j0 + j + 4);
                }
                GS_BAR();
            }
        }
        asm volatile("s_waitcnt vmcnt(0)" ::: "memory");
#undef GS_PLOAD
#undef GS_PWAIT
    } else {
        const int fr = lane & 15, fq = lane >> 4, kf = (fr >> 1) & 3, lr = lane >> 4, lc = lane & 15;
        const size_t rowb = (size_t)b * SEQ + 16 * wave;
        const bf16* qp = GQ + (rowb + fr) * 256 + 64 * h + 8 * fq; const bf16* gp = GRS + (rowb + lr) * 512 + 128 * h + 8 * lc; bf16* op = MIX + (rowb + lr) * DM + 512 + 128 * h + 8 * lc;
        LAS float* ot = (LAS float*)(lds + 32768 + wave * 8448);
        f32x4 gnv[8]; u32x4 qr[4][2]; u32x4 gl[4][4];
#pragma unroll
        for (int vt = 0; vt < 8; ++vt) gnv[vt] = *(const f32x4*)(gn + 16 * vt + 4 * fq);
#define GS_CLOAD(sl_, c_) do { const int cc_ = (c_) < jend ? (c_) : jend - 1; const bf16* q_ = qp + (size_t)cc_ * 64 * 256; const bf16* g_ = gp + (size_t)cc_ * 64 * 512; \
            GS_LD16(qr[sl_][0], q_, 0); GS_LD16(qr[sl_][1], q_, 64); \
            _Pragma("unroll") for (int i = 0; i < 4; ++i) { const bf16* gi_ = g_ + i * 4 * 512; GS_LD16(gl[sl_][i], gi_, 0); } } while (0)
#define GS_CWAIT(sl_, n_) asm volatile("s_waitcnt vmcnt(" #n_ ")" : "+v"(qr[sl_][0]), "+v"(qr[sl_][1]), "+v"(gl[sl_][0]), "+v"(gl[sl_][1]), "+v"(gl[sl_][2]), "+v"(gl[sl_][3]) :: "memory")
#pragma unroll
        for (int q = 0; q < 4; ++q) { qr[q][0] = (u32x4){0u, 0u, 0u, 0u}; qr[q][1] = (u32x4){0u, 0u, 0u, 0u};
#pragma unroll
            for (int i = 0; i < 4; ++i) gl[q][i] = (u32x4){0u, 0u, 0u, 0u}; }
        asm volatile("s_waitcnt vmcnt(0)" ::: "memory");
        GS_CLOAD(0, j0); GS_CLOAD(1, j0 + 1); GS_CLOAD(2, j0 + 2); GS_CLOAD(3, j0 + 3);
        GS_CWAIT(0, 0); GS_CWAIT(1, 0); GS_CWAIT(2, 0); GS_CWAIT(3, 0);
        for (int p0 = 0; p0 < nch + 4; p0 += 4) {
#pragma unroll
            for (int u = 0; u < 4; ++u) { const int p = p0 + u;
                if (p > nch) break;
                if (p >= 1) { const int c = j0 + p - 1;
                    const int sl = (u + 3) & 3;
                    GS_CWAIT(sl, 30);
                    const LAS unsigned char* img = lds + (c & 1) * 16384;
                    const bf16x8 q0 = __builtin_bit_cast(bf16x8, qr[sl][0]), q1 = __builtin_bit_cast(bf16x8, qr[sl][1]);
                    f32x4 acc[8]; float ss = 0.f;
#pragma unroll
                    for (int vt = 0; vt < 8; ++vt) { const unsigned ro = (unsigned)((16 * vt + fr) * 128); const int key = kf | ((vt & 1) << 2);
                        const bf16x8 a0 = *(const LAS bf16x8*)(img + ro + ((fq ^ key) << 4)), a1 = *(const LAS bf16x8*)(img + ro + (((4 + fq) ^ key) << 4));
                        acc[vt] = (f32x4){0.f, 0.f, 0.f, 0.f};
                        acc[vt] = MFMA16(a0, q0, acc[vt]); acc[vt] = MFMA16(a1, q1, acc[vt]); }
#pragma unroll
                    for (int vt = 0; vt < 8; ++vt) ss += (acc[vt][0] * acc[vt][0] + acc[vt][1] * acc[vt][1]) + (acc[vt][2] * acc[vt][2] + acc[vt][3] * acc[vt][3]);
                    ss += __shfl_xor(ss, 16); ss += __shfl_xor(ss, 32);
                    const float rstd = __builtin_amdgcn_rsqf(ss * (1.f / 128.f) + EPS);
#pragma unroll
                    for (int vt = 0; vt < 8; ++vt) *(LAS f32x4*)(ot + fr * 132 + 16 * vt + 4 * fq) = acc[vt] * rstd * gnv[vt];
                    asm volatile("s_waitcnt lgkmcnt(0)" ::: "memory");
#pragma unroll
                    for (int i = 0; i < 4; ++i) { const LAS float* rp = ot + (lr + 4 * i) * 132 + 8 * lc; const f32x4 x0 = *(const LAS f32x4*)rp, x1 = *(const LAS f32x4*)(rp + 4); const u32x4 gg = gl[sl][i];
                        u32x4 w; w.x = cvtpk(x0[0] * __uint_as_float(gg.x << 16), x0[1] * __uint_as_float(gg.x & 0xffff0000u)); w.y = cvtpk(x0[2] * __uint_as_float(gg.y << 16), x0[3] * __uint_as_float(gg.y & 0xffff0000u));
                        w.z = cvtpk(x1[0] * __uint_as_float(gg.z << 16), x1[1] * __uint_as_float(gg.z & 0xffff0000u)); w.w = cvtpk(x1[2] * __uint_as_float(gg.w << 16), x1[3] * __uint_as_float(gg.w & 0xffff0000u));
                        *(u32x4*)(op + (size_t)c * 64 * DM + (size_t)i * 4 * DM) = w; }
                    asm volatile("s_waitcnt lgkmcnt(0)" ::: "memory");
                    GS_CLOAD(sl, c + 4);
                }
                GS_BAR();
            }
        }
        asm volatile("s_waitcnt vmcnt(0)" ::: "memory");
#undef GS_CLOAD
#undef GS_CWAIT
    }
}
#undef GS_BAR
#undef GS_LD16
#undef GS_LD8

constexpr int NWAVES = 8;
constexpr int N_PHASES = 10;
struct Args { Ptrs p; int ph_lo, ph_hi; };

__global__ void __launch_bounds__(NWAVES * 64, 2) fwd_kernel(Args args) {
    extern __shared__ __attribute__((aligned(16))) unsigned char lds_raw[];
    LAS unsigned char* lds = (LAS unsigned char*)lds_raw;
    const Ptrs& P = args.p;
    const int tid = threadIdx.x, lane = tid & 63, wave = __builtin_amdgcn_readfirstlane(tid >> 6);
    const int G = gridDim.x; const int bx = blockIdx.x; const int vcu = (G % 8 == 0) ? (bx % 8) * (G / 8) + bx / 8 : bx;
    const int gw = vcu * NWAVES + wave, NGW = G * NWAVES;
    unsigned char* ws = P.ws;
    gu32* ctl = (gu32*)(ws + WS_CTL);
    volatile LAS unsigned* MISC = (volatile LAS unsigned*)(lds + MISC_OFF);
    LAS int* tab = (LAS int*)(lds + TAB_OFF);
    for (int u = tid; u < (LDS_BYTES - LDSCTL_OFF) / 4; u += NWAVES * 64) ((LAS unsigned*)(lds + LDSCTL_OFF))[u] = 0u;
    __syncthreads();
    XcdBarrier bar; bar.bar = (unsigned*)(ctl + CW_BAR); bar.x = 0; bar.st = nullptr;
    if (MK_N_LAUNCHES == 1) bar = xcd_barrier_post((unsigned*)(ctl + CW_BAR), MISC + 8);
#define GRID_BAR() do { if (MK_N_LAUNCHES == 1) xcd_barrier(bar); } while (0)
#define BAR_ARRIVE() do { if (MK_N_LAUNCHES == 1) xcd_barrier_arrive(bar, MISC + 12); } while (0)
#define BAR_WAIT() do { if (MK_N_LAUNCHES == 1) xcd_barrier_wait(bar, MISC + 12); } while (0)
    const int lo = args.ph_lo, hi_ph = args.ph_hi;
#ifndef PHASE_MASK
#define PHASE_MASK 0x3ff
#endif
#define IN(k) (((PHASE_MASK >> (k)) & 1) && lo <= (k) && (k) < hi_ph)
#define BOTH(k) (IN(k) && IN((k) + 1))
#ifndef PROBE_TWICE
#define PROBE_TWICE -1
#endif
#define REP(k) for (int rep_ = 0; rep_ < ((PROBE_TWICE == (k)) ? 2 : 1); ++rep_)
#define REPBAR(k) do { if (PROBE_TWICE == (k) && rep_ == 0) GRID_BAR(); } while (0)

    bf16* WA = (bf16*)(ws + WS_WA); bf16* WB = (bf16*)(ws + WS_WB); bf16* WO = (bf16*)(ws + WS_WO);
    bf16* WRH = (bf16*)(ws + WS_WR); bf16* WRL = WRH + 48 * 1024; bf16* W2T = (bf16*)(ws + WS_W2T);
    bf16* WGU = (bf16*)(ws + WS_WGU); bf16* WD = (bf16*)(ws + WS_WD);
    bf16* H = (bf16*)(ws + WS_H); bf16* KV = (bf16*)(ws + WS_KV);
    bf16* XB = (bf16*)(ws + WS_XB); bf16* MIX = (bf16*)(ws + WS_MIX); float* RSTD1 = (float*)(ws + WS_RSTD1);
    bf16* SQ = (bf16*)(ws + WS_SQ); bf16* SK = (bf16*)(ws + WS_SK); bf16* GQ = (bf16*)(ws + WS_GQ); bf16* GRS = (bf16*)(ws + WS_GRS);
    bf16* TT = (bf16*)(ws + WS_TT); bf16* GLR = (bf16*)(ws + WS_GLR); bf16* ST = (bf16*)(ws + WS_ST); float* DTOT = (float*)(ws + WS_DTOT);
    unsigned char* ACT = ws + WS_ACT; unsigned char* Y = ws + WS_Y;
    unsigned char* WGU8 = ws + WS_WGU; unsigned char* WD8 = ws + WS_WD; unsigned char* H8 = ws + WS_H8;
    unsigned* LOCL = (unsigned*)(ws + WS_LOCL); unsigned* CNTS = (unsigned*)(ws + WS_CNTS); float* GATE = (float*)(ws + WS_GATE); float* RSTD = (float*)(ws + WS_RSTD);

#define WGU_PIECE(q_) do { LAS float* scr_ = (LAS float*)(lds + RING_OFF + wave * 16384); \
        for (int r = (q_) * 4096 + gw; r < ((q_) + 1) * 4096; r += NGW) { \
            const int e = r >> 9, q = r & 511, ib = 4 * (q >> 6) + (q & 3), kb = 2 * ((q >> 3) & 7) + ((q >> 2) & 1), P0 = 32 * ib; const int pn = P0 >> 8, bj = (P0 >> 7) & 1, r0 = P0 & 127; \
            const float* src = (bj ? P.wu : P.wg) + (size_t)e * DM * DEXP; \
            tr_item8(src, DEXP, 64 * kb, 128 * pn + r0, WGU8 + (size_t)e * DM * DM, P0, DM, P.ffn_g, WGU_SC, scr_, lane); } } while (0)
    const bool grpB = (vcu & 1) != 0;
    if (IN(0)) { REP(0) {
        LAS float* scr = (LAS float*)(lds + RING_OFF + wave * 16384);
        constexpr int I_A = (NA / 32) * 16, I_B = (NB / 32) * 16, I_O = 32 * 16, I_GU = 32 * 32 * 16, I_D = 32 * 32 * 8;
        constexpr int NITEMS = I_A + I_B + I_O;
        for (int it = gw; it < NITEMS; it += NGW) {
            int r = it;
            if (r < I_A) { const int ib = r >> 4, kb = r & 15, P0 = 32 * ib; const int pn = P0 >> 8, bj = (P0 >> 7) & 1, wcc = (P0 >> 5) & 3; const int LA = 256 * pn + 64 * wcc + 32 * bj;
                const int sc = LA < 1024 ? LA : (LA < 1280 ? 1536 + (LA - 1024) : 2560 + (LA - 1280));
                tr_item(P.w_in, IN_DIM, 64 * kb, sc, WA, P0, DM, P.attn_g, scr, lane); continue; } r -= I_A;
            if (r < I_B) { const int ib = r >> 4, kb = r & 15, P0 = 32 * ib; const int sc = P0 < 512 ? 1024 + P0 : (P0 < 768 ? 1792 + (P0 - 512) : 2048 + (P0 - 768));
                tr_item(P.w_in, IN_DIM, 64 * kb, sc, WB, P0, DM, P.attn_g, scr, lane); continue; } r -= I_B;
            if (r < I_O) { const int ib = r >> 4, kb = r & 15; tr_item(P.w_out, DM, 64 * kb, 32 * ib, WO, 32 * ib, DM, nullptr, scr, lane); continue; } r -= I_O;
        }
        (void)I_D; (void)I_GU;
        for (int idx = gw * 64 + lane; idx < 48 * 1024; idx += NGW * 64) {
            const int rho = idx >> 10, k = idx & 1023, m = rho >> 4, i = rho & 15;
            float v = (m < 2) ? P.re_w[k * 32 + 8 * (i >> 2) + 4 * m + (i & 3)] : P.rg_w[k * 4 + (i & 3)];
            v *= P.ffn_g[k];
            WRH[idx] = __builtin_bit_cast(unsigned short, (_Float16)v);
        }
        for (int idx = gw * 64 + lane; idx < 256 * 16; idx += NGW * 64) { const int kc = idx >> 4, r = idx & 15; W2T[idx] = (bf16)(cvtpk(P.w2[r * 256 + kc], 0.f) & 0xffffu); }
        __syncthreads();
        constexpr int WLP = 1032;
        LAS bf16* wl = (LAS bf16*)(lds + RING_OFF);
        for (int idx = tid; idx < 16 * 1024; idx += NWAVES * 64) { const int c = idx & 15, k = idx >> 4; wl[c * WLP + k] = (bf16)(cvtpk(P.attn_g[k] * P.w_in[(size_t)k * IN_DIM + 3072 + c], 0.f) & 0xffffu); }
        __syncthreads();
        {
            for (int task = gw; task < NTOK / 16; task += NGW) {
                const size_t row0 = (size_t)task * 16;
                f32x4 cur[2][4], nxt[2][4]; float rsv = 0.f;
#pragma unroll
                for (int t = 0; t < 2; ++t)
#pragma unroll
                    for (int j = 0; j < 4; ++j) { cur[t][j] = __builtin_nontemporal_load((const GAS f32x4*)(P.x + (row0 + t) * DM) + lane + 64 * j); nxt[t][j] = cur[t][j]; }
                const bool odd = (lane & 1) != 0;
#pragma unroll 2
                for (int r = 0; r < 16; r += 2) {
                    if (r < 14) {
#pragma unroll
                        for (int t = 0; t < 2; ++t)
#pragma unroll
                            for (int j = 0; j < 4; ++j) nxt[t][j] = __builtin_nontemporal_load((const GAS f32x4*)(P.x + (row0 + r + 2 + t) * DM) + lane + 64 * j); }
                    float s2[2] = {0.f, 0.f};
#pragma unroll
                    for (int t = 0; t < 2; ++t)
#pragma unroll
                        for (int j = 0; j < 4; ++j) s2[t] += (cur[t][j].x * cur[t][j].x + cur[t][j].y * cur[t][j].y) + (cur[t][j].z * cur[t][j].z + cur[t][j].w * cur[t][j].w);
                    const float rstd0 = __builtin_amdgcn_rsqf(wave_sum(s2[0]) * (1.f / DM) + EPS), rstd1 = __builtin_amdgcn_rsqf(wave_sum(s2[1]) * (1.f / DM) + EPS);
                    if ((lane & 15) == r) rsv = rstd0;
                    if ((lane & 15) == r + 1) rsv = rstd1;
                    bf16* orow = XB + (row0 + r + (odd ? 1 : 0)) * DM + 4 * (lane & ~1);
#pragma unroll
                    for (int j = 0; j < 4; ++j) { const f32x4 v0 = cur[0][j], v1 = cur[1][j];
                        const unsigned a0 = cvtpk(v0.x, v0.y), a1 = cvtpk(v0.z, v0.w), b0 = cvtpk(v1.x, v1.y), b1 = cvtpk(v1.z, v1.w);
                        const unsigned s0 = odd ? a0 : b0, s1 = odd ? a1 : b1;
                        const unsigned r0 = (unsigned)__builtin_amdgcn_mov_dpp((int)s0, 0xB1, 0xf, 0xf, false), r1 = (unsigned)__builtin_amdgcn_mov_dpp((int)s1, 0xB1, 0xf, 0xf, false);
                        u32x4 w; if (odd) { w.x = r0; w.y = r1; w.z = b0; w.w = b1; } else { w.x = a0; w.y = a1; w.z = r0; w.w = r1; }
                        *(u32x4*)(orow + 256 * j) = w; }
#pragma unroll
                    for (int t = 0; t < 2; ++t)
#pragma unroll
                        for (int j = 0; j < 4; ++j) cur[t][j] = nxt[t][j];
                }
                if (lane < 16) RSTD1[row0 + lane] = rsv;
            }
        }
        REPBAR(0); }
        if (BOTH(0)) BAR_ARRIVE();
        else { VM_WAIT(); __syncthreads(); }
        {
            constexpr int WLP = 1032; const LAS bf16* wl = (const LAS bf16*)(lds + RING_OFF);
            for (int task = gw; task < NTOK / 16; task += NGW) {
                const size_t row0 = (size_t)task * 16;
                const int fr = lane & 15, fq = lane >> 4;
                const float rsv = RSTD1[row0 + fr];
                f32x4 acc = (f32x4){0.f, 0.f, 0.f, 0.f};
                const bf16* up = XB + (row0 + fr) * DM + 8 * fq;
#pragma unroll 8
                for (int ks = 0; ks < 32; ++ks) { const bf16x8 ub = *(const bf16x8*)(up + 32 * ks); const bf16x8 wb = *(const LAS bf16x8*)(wl + fr * WLP + 32 * ks + 8 * fq); acc = MFMA16(wb, ub, acc); }
                u32x2 o; o.x = cvtpk(acc[0] * rsv, acc[1] * rsv); o.y = cvtpk(acc[2] * rsv, acc[3] * rsv);
                *(u32x2*)(GLR + (row0 + fr) * 16 + 4 * fq) = o;
            }
        }
        __syncthreads();
        WGU_PIECE(0);
        if (BOTH(0)) BAR_WAIT();
    }

#define PH1_BODY() do { \
        pg8::SchedP1 S; S.a.init(XB, WA, NTOK, NA, DM, G, 0); S.b.init(WB, XB, NB, NTOK, DM, G, 0); S.nA = S.a.nwg; S.G = G; S.c = bx; \
        pg8::EpiP1 E{pg8::EpiA{SQ, SK, GQ, GRS, P.sbq_g, P.sbk_g, RSTD1}, pg8::EpiTT{TT, RSTD1}}; \
        pg8::gemm_phase<pg8::EpiP1, pg8::SchedP1>(lds + RING_OFF, DM, S, E); } while (0)
    if (IN(1)) {
        if (PROBE_TWICE == 1) { PH1_BODY(); GRID_BAR(); }
        if (grpB) { WGU_PIECE(1); __syncthreads(); }
        PH1_BODY();
        if (BOTH(1)) BAR_ARRIVE();
        if (!grpB) WGU_PIECE(1);
        if (BOTH(1)) BAR_WAIT();
    }

#define SB_ROUND(rho_) do { for (int u__ = (rho_) * G + vcu; u__ < 1024; u__ += 4 * G) { const int bh_ = u__ & 127; \
        sb_round(lds + RING_OFF, SQ, SK, TT, P.sbo_g + (bh_ & 7) * 64, MIX, bh_ >> 3, bh_ & 7, u__ >> 7, tid, wave, lane); } } while (0)
#define REPX(code) for (int rx_ = 0; rx_ < ((PROBE_TWICE == (code)) ? 5 : 1); ++rx_)
    if (IN(2)) {
        const bool sbfirst = (vcu & 1) != 0;
        if (sbfirst && vcu < 1024) { const int bh_ = vcu & 127; sb_round(lds + RING_OFF, SQ, SK, TT, P.sbo_g + (bh_ & 7) * 64, MIX, bh_ >> 3, bh_ & 7, vcu >> 7, tid, wave, lane); }
        for (int t = gw; t < 2048; t += NGW) gla_a(lds + RING_OFF + wave * 16384, GLR, W2T, P.gate_b, TT, KV, DTOT, t >> 5, t & 31, lane);
        if (BOTH(2)) BAR_ARRIVE();
        if (!sbfirst && vcu < 1024) { const int bh_ = vcu & 127; sb_round(lds + RING_OFF, SQ, SK, TT, P.sbo_g + (bh_ & 7) * 64, MIX, bh_ >> 3, bh_ & 7, vcu >> 7, tid, wave, lane); }
        if (BOTH(2)) BAR_WAIT();
    }
    if (IN(3)) {
        if (G >= 256) { if ((vcu & 1) == 0 && (vcu >> 2) < 64) gla_seq(lds + RING_OFF, KV, DTOT, GQ, GRS, P.glan_g, MIX, vcu >> 2, tid, wave, lane, 8 * (vcu & 2), 16, (vcu & 2) != 0); }
        else for (int bh = vcu; bh < 64; bh += G) gla_seq(lds + RING_OFF, KV, DTOT, GQ, GRS, P.glan_g, MIX, bh, tid, wave, lane, 0, 32, false);
        __syncthreads();
        if (tid == 0) { MISC[20] = __hip_atomic_fetch_add((unsigned*)(ctl + CW_SBQ), 1u, __ATOMIC_RELAXED, __HIP_MEMORY_SCOPE_AGENT); MISC[21] = __hip_atomic_fetch_add((unsigned*)(ctl + CW_SBQ), 1u, __ATOMIC_RELAXED, __HIP_MEMORY_SCOPE_AGENT); }
        __syncthreads();
        { unsigned tc_ = MISC[20], tn_ = MISC[21]; bool pre_ = false;
          u32x4 nx[SB_SPAN];
#pragma unroll
          for (int i = 0; i < SB_SPAN; ++i) nx[i] = (u32x4){0u, 0u, 0u, 0u};
          for (;;) {
              const int uc_ = G + (int)tc_; if (uc_ >= 1024) break;
              const int un_ = G + (int)tn_; const bool hn_ = un_ < 1024;
              const int bh_ = uc_ & 127, bn_ = un_ & 127;
              sb_round_pf(lds + RING_OFF, SQ, SK, TT, P.sbo_g + (bh_ & 7) * 64, MIX, bh_ >> 3, bh_ & 7, uc_ >> 7, tid, wave, lane, nx, pre_, hn_, bn_ >> 3, bn_ & 7, un_ >> 7, (unsigned*)(ctl + CW_SBQ), MISC + 22);
              tc_ = tn_; tn_ = MISC[22]; pre_ = hn_;
          } }
    }
    if (IN(4)) {
        if (BOTH(4)) BAR_ARRIVE();
        WGU_PIECE(2);
        if (BOTH(4)) BAR_WAIT();
    }

#define PH5_BODY() do { \
        pg8::SchedDense S; S.init(MIX, WO, NTOK, DM, DM, G, bx); \
        pg8::EpiH E{XB, H, H8}; \
        pg8::gemm_phase<pg8::EpiH, pg8::SchedDense>(lds + RING_OFF, DM, S, E); } while (0)
    if (IN(5)) {
        if (PROBE_TWICE == 5) { PH5_BODY(); GRID_BAR(); }
        if (grpB) { WGU_PIECE(3); __syncthreads(); }
        PH5_BODY();
        if (BOTH(5)) BAR_ARRIVE();
        if (!grpB) WGU_PIECE(3);
        if (BOTH(5) && PROBE_TWICE != 6) {
            __syncthreads();
            LAS unsigned short* wl16 = (LAS unsigned short*)(lds + RING_OFF);
            for (int idx = tid; idx < 48 * 128; idx += NWAVES * 64) { const int row = idx >> 7, c = idx & 127; *(LAS u32x4*)(wl16 + row * 1032 + 8 * c) = *(const u32x4*)(WRH + row * 1024 + 8 * c); } }
        if (BOTH(5)) BAR_WAIT();
    }

    if (IN(6)) { REP(6) {
        constexpr int WP = 1032;
        LAS unsigned short* wl16 = (LAS unsigned short*)(lds + RING_OFF);
        LAS unsigned* lcount = (LAS unsigned*)(lds + RING_OFF + 48 * WP * 2);
        if (!(BOTH(5) && PROBE_TWICE != 6)) for (int idx = tid; idx < 48 * 128; idx += NWAVES * 64) { const int row = idx >> 7, c = idx & 127; *(LAS u32x4*)(wl16 + row * WP + 8 * c) = *(const u32x4*)(WRH + row * 1024 + 8 * c); }
        const int fr = lane & 15, fq = lane >> 4;
        for (int it = 0; it * G < NGRP; ++it) {
            const int grp = it * G + vcu;
            const int tile = grp * 8 + wave; const int ntile = NGRP * 8;
            if (tid < 32) lcount[tid] = 0u;
            __syncthreads();
            bool owner = false; int e1 = 0, e2 = 0; unsigned lr1 = 0, lr2 = 0; int tok = 0;
            if (tile < ntile) {
                tok = tile * 16 + fr;
                const bf16* hp = H + (size_t)tok * DM + 8 * fq;
                f32x4 acc[3]; acc[0] = acc[1] = acc[2] = (f32x4){0.f, 0.f, 0.f, 0.f};
                float ssq = 0.f;
#pragma unroll 1
                for (int half = 0; half < 2; ++half) {
                    bf16x8 hb[16];
#pragma unroll
                    for (int q = 0; q < 16; ++q) hb[q] = *(const bf16x8*)(hp + 32 * (16 * half + q));
#pragma unroll
                    for (int q = 0; q < 16; ++q) { const int ks = 16 * half + q;
                        float f[8];
#pragma unroll
                        for (int e = 0; e < 8; ++e) { f[e] = bf2f(hb[q][e]); ssq += f[e] * f[e]; }
                        f16x8 hh;
#pragma unroll
                        for (int e = 0; e < 8; ++e) hh[e] = (_Float16)f[e];
#pragma unroll
                        for (int m = 0; m < 3; ++m) { const f16x8 wv = *(const LAS f16x8*)(wl16 + (16 * m + fr) * WP + 32 * ks + 8 * fq);
                            acc[m] = __builtin_amdgcn_mfma_f32_16x16x32_f16(wv, hh, acc[m], 0, 0, 0); }
                    }
                }
                ssq += __shfl_xor(ssq, 16); ssq += __shfl_xor(ssq, 32);
                const float rstd = __builtin_amdgcn_rsqf(ssq * (1.f / DM) + EPS);
                float gl[4];
#pragma unroll
                for (int r = 0; r < 4; ++r) gl[r] = acc[2][r] * rstd + P.rg_b[r];
                int gsel = 0; float gmax = gl[0];
#pragma unroll
                for (int r = 1; r < 4; ++r) if (gl[r] > gmax) { gmax = gl[r]; gsel = r; }
                float gden = 0.f;
#pragma unroll
                for (int r = 0; r < 4; ++r) gden += __builtin_amdgcn_exp2f((gl[r] - gmax) * LOG2E);
                const float pgrp = 1.f / gden;
                float el[8];
#pragma unroll
                for (int r = 0; r < 4; ++r) { el[r] = acc[0][r] * rstd + P.re_b[8 * fq + r]; el[4 + r] = acc[1][r] * rstd + P.re_b[8 * fq + 4 + r]; }
                int i1 = 0; float l1 = el[0];
#pragma unroll
                for (int r = 1; r < 8; ++r) if (el[r] > l1) { l1 = el[r]; i1 = r; }
                int i2 = -1; float l2 = -3.0e38f;
#pragma unroll
                for (int r = 0; r < 8; ++r) if (r != i1 && el[r] > l2) { l2 = el[r]; i2 = r; }
                const float ex = __builtin_amdgcn_exp2f((l2 - l1) * LOG2E);
                const float p1 = 1.f / (1.f + ex), p2 = ex * p1;
                owner = (fq == gsel);
                if (owner) {
                    e1 = 8 * gsel + i1; e2 = 8 * gsel + i2;
                    lr1 = __hip_atomic_fetch_add(lcount + e1, 1u, __ATOMIC_RELAXED, __HIP_MEMORY_SCOPE_WORKGROUP);
                    lr2 = __hip_atomic_fetch_add(lcount + e2, 1u, __ATOMIC_RELAXED, __HIP_MEMORY_SCOPE_WORKGROUP);
                    RSTD[tok] = rstd; GATE[2 * tok] = pgrp * p1; GATE[2 * tok + 1] = pgrp * p2;
                }
            }
            __syncthreads();
            if (grp < NGRP) {
                if (tid < 32) CNTS[grp * 32 + tid] = lcount[tid];
                if (owner) { LOCL[((size_t)grp * 32 + e1) * 128 + lr1] = 2u * tok; LOCL[((size_t)grp * 32 + e2) * 128 + lr2] = 2u * tok + 1u; }
            }
            __syncthreads();
        }
        REPBAR(6); }
        if (BOTH(6)) GRID_BAR();
    }

    if (IN(7) || IN(8)) {
        LAS int* pre = (LAS int*)(lds + RING_OFF);
        LAS int* segsum = pre + NGRP * 32;
        for (int i = tid; i < NGRP * 32; i += NWAVES * 64) pre[i] = (int)CNTS[i];
        __syncthreads();
        { const int e = tid & 31, seg = tid >> 5; int run = 0;
          for (int g = seg * 16; g < seg * 16 + 16; ++g) { const int c = pre[g * 32 + e]; pre[g * 32 + e] = run; run += c; }
          segsum[seg * 32 + e] = run; }
        __syncthreads();
        { const int e = tid & 31, seg = tid >> 5; int off = 0, tot = 0;
          for (int q = 0; q < 16; ++q) { const int v = segsum[q * 32 + e]; if (q < seg) off += v; tot += v; }
          for (int g = seg * 16; g < seg * 16 + 16; ++g) pre[g * 32 + e] += off;
          if (seg == 0) tab[T_CNT / 4 + e] = tot; }
        __syncthreads();
        if (tid == 0) { int tb = 0; for (int e = 0; e < 32; ++e) { tab[T_TBASE / 4 + e] = tb; tb += (tab[T_CNT / 4 + e] + 255) >> 8; } tab[T_TBASE / 4 + 32] = tb; tab[T_NT / 4] = tb; }
        __syncthreads();
        { const int NT = tab[T_NT / 4];
          for (int t = tid; t < NT; t += NWAVES * 64) { int e = 0; for (int q = 0; q < 32; ++q) if (tab[T_TBASE / 4 + q] <= t && t < tab[T_TBASE / 4 + q + 1]) e = q; tab[T_TILE_E / 4 + t] = e; } }
        __syncthreads();
        { pg8::SchedMoE<false> S0; S0.A = nullptr; S0.Bt = nullptr; S0.K = 0; S0.bstride = 0; S0.G = G; S0.c = vcu; S0.tab = tab;
          const int half = tid >> 8, r = tid & 255; unsigned vals[NU_MAX / 2]; bool ok[NU_MAX / 2];
#pragma unroll
          for (int k = 0; k < NU_MAX / 2; ++k) { const int ui = 2 * k + half; pg8::Unit u; ok[k] = S0.next(ui, u); vals[k] = 0u;
              if (ok[k]) { const int cnt = tab[T_CNT / 4 + u.e], e = u.e; int p = u.rt * 256 + r; if (p > cnt - 1) p = cnt - 1;
                  int lo_ = 0, hi_ = NGRP - 1;
                  while (lo_ < hi_) { const int mid = (lo_ + hi_ + 1) >> 1; if (pre[mid * 32 + e] <= p) lo_ = mid; else hi_ = mid - 1; }
                  vals[k] = LOCL[((size_t)lo_ * 32 + e) * 128 + (p - pre[lo_ * 32 + e])]; } }
          float rsl[NU_MAX / 2];
#pragma unroll
          for (int k = 0; k < NU_MAX / 2; ++k) rsl[k] = ok[k] ? RSTD[vals[k] >> 1] : 0.f;
#pragma unroll
          for (int k = 0; k < NU_MAX / 2; ++k) if (ok[k]) { tab[T_ROWTAB / 4 + (2 * k + half) * 256 + r] = (int)vals[k]; ((LAS float*)tab)[T_RSTAB / 4 + (2 * k + half) * 256 + r] = rsl[k]; }
        }
        __syncthreads();
    }
#define PH7_BODY() do { \
        pg8::SchedMoE<true> S; S.A = (const char*)H8; S.Bt = (const char*)WGU8; S.K = DM / 2; S.bstride = (size_t)DM * DM; S.G = G; S.c = vcu; S.tab = tab; \
        pg8::EpiGU E{ACT, RSTD, tab}; \
        pg8::gemm_phase<pg8::EpiGU, pg8::SchedMoE<true>, false, true>(lds + RING_OFF, DM / 2, S, E); } while (0)
    if (IN(7)) {
        if (PROBE_TWICE == 7) { PH7_BODY(); GRID_BAR(); }
        PH7_BODY();
        {
            const int NT4 = tab[T_NT / 4] * 4, remu = NT4 % G;
            const bool early = (remu == 0) || (vcu >= remu); const int nE = (remu == 0) ? G : (G - remu), rank = (remu == 0) ? vcu : (vcu - remu);
            if (early) { LAS float* scr = (LAS float*)(lds + RING_OFF + wave * 16384);
                for (int r = rank * NWAVES + wave; r < 32 * 32 * 8; r += nE * NWAVES) {
                    const int e = r >> 8, q = r & 255, nb = 4 * (q >> 5) + (q & 3), kb = 2 * ((q >> 3) & 3) + ((q >> 2) & 1);
                    tr_item8<true>(P.wd + (size_t)e * DEXP * DM, DM, 64 * kb, 32 * nb, WD8 + (size_t)e * DM * DEXP, 32 * nb, DEXP, nullptr, WD_SC, scr, lane); } }
        }
        if (BOTH(7)) GRID_BAR();
    }
    if (IN(8)) { REP(8) {
        pg8::SchedMoE<false> S; S.A = (const char*)ACT; S.Bt = (const char*)WD8; S.K = DEXP / 2; S.bstride = (size_t)DM * DEXP; S.G = G; S.c = vcu; S.tab = tab;
        pg8::EpiDown E{Y, tab};
        pg8::gemm_phase<pg8::EpiDown, pg8::SchedMoE<false>, false, true>(lds + RING_OFF, DEXP / 2, S, E);
        REPBAR(8); }
        if (BOTH(8)) GRID_BAR();
    }
    if (IN(9)) { REP(9) {
        LAS unsigned char* cs = lds + RING_OFF + wave * 16384;
        for (int m0 = gw; m0 < NTOK; m0 += 2 * NGW) {
            u32x4 hl[2][2], yl[2][2]; float g0[2], g1[2];
#pragma unroll
            for (int t = 0; t < 2; ++t) { int m = m0 + t * NGW; if (m >= NTOK) m = m0;
                g0[t] = GATE[2 * m] * (1.f / Y_SC); g1[t] = GATE[2 * m + 1] * (1.f / Y_SC);
                const bf16* hp = H + (size_t)m * DM + 8 * lane; const unsigned char* y0 = Y + (size_t)(2 * m) * DM + 16 * lane;
                hl[t][0] = *(const u32x4*)(hp); hl[t][1] = *(const u32x4*)(hp + 512); yl[t][0] = *(const u32x4*)(y0); yl[t][1] = *(const u32x4*)(y0 + DM); }
#pragma unroll
            for (int t = 0; t < 2; ++t) { LAS unsigned char* cr = cs + t * 4096;
                *(LAS u32x4*)(cr + 16 * lane) = hl[t][0]; *(LAS u32x4*)(cr + 1024 + 16 * lane) = hl[t][1];
                *(LAS u32x4*)(cr + 2048 + 16 * lane) = yl[t][0]; *(LAS u32x4*)(cr + 3072 + 16 * lane) = yl[t][1]; }
            LDS_WAIT(); asm volatile("" ::: "memory");
#pragma unroll
            for (int t = 0; t < 2; ++t) { const int m = m0 + t * NGW; if (m < NTOK) {
                float* op = P.out + (size_t)m * DM + 4 * lane; const LAS unsigned char* cr = cs + t * 4096;
#pragma unroll
                for (int q = 0; q < 4; ++q) { const u32x2 hv = *(const LAS u32x2*)(cr + 512 * q + 8 * lane);
                    const unsigned wa = *(const LAS unsigned*)(cr + 2048 + 256 * q + 4 * lane), wb = *(const LAS unsigned*)(cr + 3072 + 256 * q + 4 * lane);
                    const f32x2_t a0 = __builtin_amdgcn_cvt_pk_f32_fp8((int)wa, false), a1 = __builtin_amdgcn_cvt_pk_f32_fp8((int)wa, true);
                    const f32x2_t b0 = __builtin_amdgcn_cvt_pk_f32_fp8((int)wb, false), b1 = __builtin_amdgcn_cvt_pk_f32_fp8((int)wb, true);
                    const unsigned h01 = hv.x, h23 = hv.y;
                    f32x4 o; o[0] = __uint_as_float(h01 << 16) + g0[t] * a0.x + g1[t] * b0.x; o[1] = __uint_as_float(h01 & 0xffff0000u) + g0[t] * a0.y + g1[t] * b0.y;
                    o[2] = __uint_as_float(h23 << 16) + g0[t] * a1.x + g1[t] * b1.x; o[3] = __uint_as_float(h23 & 0xffff0000u) + g0[t] * a1.y + g1[t] * b1.y;
                    *(f32x4*)(op + 256 * q) = o; } } }
            LDS_WAIT(); asm volatile("" ::: "memory");
        }
    REPBAR(9); } }
#undef IN
#undef BOTH
}

extern "C" void kernel_launch(void* const* d_in, const int* in_sizes, int n_in, void* d_out, int out_size, void* d_ws, size_t ws_size, hipStream_t stream) {
    static int grid = 0;
    if (grid == 0) {
        if (n_in != 18 || in_sizes[0] != NTOK * DM || out_size != NTOK * DM || ws_size < WS_END) { fprintf(stderr, "kernel_launch: unexpected shapes / workspace (n_in %d, in0 %d, out %d, ws %zu, need %zu)\n", n_in, n_in > 0 ? in_sizes[0] : -1, out_size, ws_size, (size_t)WS_END); grid = -1; return; }
        int dev = 0, cus = 0, per_cu = 0;
        if (hipGetDevice(&dev) != hipSuccess || hipDeviceGetAttribute(&cus, hipDeviceAttributeMultiprocessorCount, dev) != hipSuccess) { grid = -1; return; }
        if (hipFuncSetAttribute((const void*)fwd_kernel, hipFuncAttributeMaxDynamicSharedMemorySize, LDS_BYTES) != hipSuccess) { fprintf(stderr, "kernel_launch: hipFuncSetAttribute failed\n"); grid = -1; return; }
        if (hipOccupancyMaxActiveBlocksPerMultiprocessor(&per_cu, (const void*)fwd_kernel, NWAVES * 64, LDS_BYTES) != hipSuccess || per_cu < 1) fprintf(stderr, "kernel_launch: occupancy query reports %d\n", per_cu);
        (void)hipGetLastError();
        grid = cus;
    }
    if (grid < 0) return;
    if (hipMemsetAsync((char*)d_ws + WS_CTL, 0, CTL_ZERO_BYTES, stream) != hipSuccess) return;
    Args a{};
    const float** pp = (const float**)&a.p;
    for (int i = 0; i < 18; ++i) pp[i] = (const float*)d_in[i];
    a.p.out = (float*)d_out; a.p.ws = (unsigned char*)d_ws;
    if (MK_N_LAUNCHES == 1) { a.ph_lo = 0; a.ph_hi = N_PHASES; hipLaunchKernelGGL(fwd_kernel, dim3(grid), dim3(NWAVES * 64), LDS_BYTES, stream, a); }
    else for (int li = 0; li < N_PHASES; ++li) { a.ph_lo = li; a.ph_hi = li + 1; hipLaunchKernelGGL(fwd_kernel, dim3(grid), dim3(NWAVES * 64), LDS_BYTES, stream, a); }
}
```
